# Optimizing an MI355X kernel written in HIP

```python
import jax, jax.numpy as jnp
from jax import lax
import numpy as np

D_MODEL = 2048
BATCH = 4
SEQ = 8192
DEPTH = 4

N_BRANCH = 4
MIX_W = 512
S5_GROUP = 16
S5_GROUPS = MIX_W // S5_GROUP
S5_STATE = 64
LRU_HEADS = 8
LRU_HD = MIX_W // LRU_HEADS
LRU_CONV = 4
LRU_C = 8.0
M2_HEADDIM = 64
M2_HEADS = MIX_W // M2_HEADDIM
M2_GROUPS = 2
M2_STATE = 128
M2_CONV = 4
M2_CHUNK = 128
M2_CONV_DIM = MIX_W + 2 * M2_GROUPS * M2_STATE
RW_HD = 64
RW_HEADS = MIX_W // RW_HD
RW_DECAY_R = 32
RW_A_R = 32
RW_GATE_R = 96
RW_COLS = 3 * MIX_W + RW_DECAY_R + RW_A_R + RW_GATE_R
RW_LN_EPS = 64e-5
FFN_DIM = 3 * D_MODEL
FFN_CONV = 3
EPS = 1e-6
MIXER_SPLITS = (MIX_W, MIX_W, MIX_W, MIX_W, M2_CONV_DIM, M2_HEADS, RW_COLS)
MIXER_COLS = MIX_W * 4 + M2_CONV_DIM + M2_HEADS + RW_COLS
IN_COLS = MIXER_COLS + N_BRANCH * D_MODEL

kernel_name = "hybrid_gated_s5_rglru_ssd_rwkv7"


def split_cols(t, sizes):
    offs, s = [], 0
    for n in sizes[:-1]:
        s += n
        offs.append(s)
    return jnp.split(t, offs, axis=-1)


def rms_norm(x, g):
    x32 = x.astype(jnp.float32)
    y = x32 * lax.rsqrt(jnp.mean(x32 * x32, axis=-1, keepdims=True) + EPS)
    return (y * g.astype(jnp.float32)).astype(x.dtype)


def causal_dwconv(x, w, b):
    k_w, seq = w.shape[0], x.shape[1]
    xp = jnp.pad(x, ((0, 0), (k_w - 1, 0), (0, 0)))
    out = b + xp[:, k_w - 1:k_w - 1 + seq] * w[k_w - 1]
    for j in range(k_w - 1):
        out = out + xp[:, j:j + seq] * w[j]
    return out


def token_shift(x):
    return jnp.pad(x, ((0, 0), (1, 0), (0, 0)))[:, :-1]


def real_scan_op(e1, e2):
    a1, b1 = e1
    a2, b2 = e2
    return a2 * a1, a2 * b1 + b2


def complex_scan_op(e1, e2):
    ar1, ai1, br1, bi1 = e1
    ar2, ai2, br2, bi2 = e2
    return (ar2 * ar1 - ai2 * ai1, ar2 * ai1 + ai2 * ar1,
            ar2 * br1 - ai2 * bi1 + br2, ar2 * bi1 + ai2 * br1 + bi2)


def s5_mixer(u, lam_re, lam_im, b_re, b_im, c_re, c_im, d, log_dt, w_glu):
    bsz, seq, _ = u.shape
    f32 = jnp.float32
    u32 = u.astype(f32)
    ug = u32.reshape(bsz, seq, S5_GROUPS, S5_GROUP)
    lr, li = lam_re.astype(f32), lam_im.astype(f32)
    dt = jnp.exp(log_dt.astype(f32))[:, None]
    mag = jnp.exp(lr * dt)
    ab_re, ab_im = mag * jnp.cos(li * dt), mag * jnp.sin(li * dt)
    den = lr * lr + li * li
    nr, ni = ab_re - 1.0, ab_im
    f_re, f_im = (nr * lr + ni * li) / den, (ni * lr - nr * li) / den
    bu_re = jnp.einsum("blgc,gpc->blgp", ug, b_re.astype(f32))
    bu_im = jnp.einsum("blgc,gpc->blgp", ug, b_im.astype(f32))
    x_re = f_re * bu_re - f_im * bu_im
    x_im = f_re * bu_im + f_im * bu_re
    a_re = jnp.broadcast_to(ab_re, (1, seq) + ab_re.shape)
    a_im = jnp.broadcast_to(ab_im, (1, seq) + ab_im.shape)
    _, _, s_re, s_im = lax.associative_scan(complex_scan_op, (a_re, a_im, x_re, x_im), axis=1)
    y = (jnp.einsum("blgp,gcp->blgc", s_re, c_re.astype(f32))
         - jnp.einsum("blgp,gcp->blgc", s_im, c_im.astype(f32)))
    y = y.reshape(bsz, seq, MIX_W) + d.astype(f32) * u32
    y = jax.nn.gelu(y)
    y = y * jax.nn.sigmoid(y @ w_glu.astype(f32))
    return y.astype(u.dtype)


def rglru_mixer(xb, gate, conv_w, conv_b, w_a, b_a, w_x, b_x, lam):
    bsz, seq, _ = xb.shape
    f32 = jnp.float32
    x = causal_dwconv(xb, conv_w, conv_b)
    xh = x.reshape(bsz, seq, LRU_HEADS, LRU_HD)
    r = jax.nn.sigmoid(jnp.einsum("blhi,hij->blhj", xh, w_a).reshape(bsz, seq, MIX_W) + b_a)
    i = jax.nn.sigmoid(jnp.einsum("blhi,hij->blhj", xh, w_x).reshape(bsz, seq, MIX_W) + b_x)
    log_a = (-LRU_C * r.astype(f32)) * jax.nn.softplus(-lam.astype(f32))
    a = jnp.exp(log_a)
    mult = jnp.sqrt(-jnp.expm1(2.0 * log_a))
    bx = (x * i).astype(f32) * mult
    _, h = lax.associative_scan(real_scan_op, (a, bx), axis=1)
    return (h.astype(xb.dtype) * jax.nn.gelu(gate)).astype(xb.dtype)


def ssd_chunked(x, dt, a, b, c):
    bsz, seq, nh, hp = x.shape
    ng, ns = b.shape[2], b.shape[3]
    hg, q = nh // ng, M2_CHUNK
    nc = seq // q
    xd = (x * dt[..., None]).reshape(bsz, nc, q, ng, hg, hp)
    ad = (dt * a).reshape(bsz, nc, q, ng, hg).transpose(0, 3, 4, 1, 2)
    bq = b.reshape(bsz, nc, q, ng, ns)
    cq = c.reshape(bsz, nc, q, ng, ns)
    a_cs = jnp.cumsum(ad, axis=-1)
    causal = jnp.tril(jnp.ones((q, q), dtype=bool))
    seg = a_cs[..., :, None] - a_cs[..., None, :]
    decay_in = jnp.exp(jnp.where(causal, seg, -jnp.inf))
    cb = jnp.einsum("bcign,bcjgn->bgcij", cq, bq)
    y_diag = jnp.einsum("bgcij,bghcij,bcjghp->bcighp", cb, decay_in, xd)
    decay_st = jnp.exp(a_cs[..., -1:] - a_cs)
    states = jnp.einsum("bcjgn,bghcj,bcjghp->cbghpn", bq, decay_st, xd)
    chunk_decay = jnp.exp(a_cs[..., -1]).transpose(3, 0, 1, 2)

    def step(carry, inp):
        s_c, dec = inp
        return carry * dec[..., None, None] + s_c, carry

    _, s_in = lax.scan(step, jnp.zeros(states.shape[1:], states.dtype), (states, chunk_decay))
    y_off = jnp.einsum("bcign,cbghpn,bghci->bcighp", cq, s_in, jnp.exp(a_cs))
    return (y_diag + y_off).reshape(bsz, seq, nh, hp)


def mamba2_mixer(z, xbc, dt_raw, conv_w, conv_b, dt_bias, a_log, d, norm_g):
    bsz, seq, _ = z.shape
    f32 = jnp.float32
    xbc = jax.nn.silu(causal_dwconv(xbc, conv_w, conv_b)).astype(f32)
    xs, bs, cs = split_cols(xbc, (MIX_W, M2_GROUPS * M2_STATE, M2_GROUPS * M2_STATE))
    xs = xs.reshape(bsz, seq, M2_HEADS, M2_HEADDIM)
    bs = bs.reshape(bsz, seq, M2_GROUPS, M2_STATE)
    cs = cs.reshape(bsz, seq, M2_GROUPS, M2_STATE)
    dt = jax.nn.softplus(dt_raw.astype(f32) + dt_bias.astype(f32))
    a = -jnp.exp(a_log.astype(f32))
    y = ssd_chunked(xs, dt, a, bs, cs) + d.astype(f32)[:, None] * xs
    y = y.reshape(bsz, seq, MIX_W) * jax.nn.silu(z.astype(f32))
    return rms_norm(y, norm_g).astype(z.dtype)


def rwkv7_scan(r, w, k, v, a, b):
    tm = lambda t: jnp.moveaxis(t, 1, 0)

    def step(s, inp):
        rt, wt, kt, vt, at, bt = inp
        sa = jnp.einsum("bhvk,bhk->bhv", s, at)
        s = s * wt[:, :, None, :] + sa[..., None] * bt[:, :, None, :] + vt[..., None] * kt[:, :, None, :]
        return s, jnp.einsum("bhvk,bhk->bhv", s, rt)

    bsz = r.shape[0]
    s0 = jnp.zeros((bsz, RW_HEADS, RW_HD, RW_HD), jnp.float32)
    _, y = lax.scan(step, s0, (tm(r), tm(w), tm(k), tm(v), tm(a), tm(b)))
    return jnp.moveaxis(y, 0, 1)


def rwkv7_mixer(p, mu, w0, w2, a0, a2, g2, k_k, k_a, r_k, ln_g, ln_b):
    bsz, seq, _ = p.shape
    f32 = jnp.float32
    p = p + (token_shift(p) - p) * mu
    r, k, v, xw, xa, xg = split_cols(p, (MIX_W, MIX_W, MIX_W, RW_DECAY_R, RW_A_R, RW_GATE_R))
    w = -jax.nn.softplus(-(w0 + jnp.tanh(xw) @ w2).astype(f32)) - 0.5
    decay = jnp.exp(-jnp.exp(w))
    a = jax.nn.sigmoid((a0 + xa @ a2).astype(f32))
    g = jax.nn.sigmoid(xg) @ g2
    heads = lambda t: t.reshape(bsz, seq, RW_HEADS, RW_HD)
    kk = heads((k * k_k).astype(f32))
    kk = kk / jnp.maximum(jnp.sqrt(jnp.sum(kk * kk, axis=-1, keepdims=True)), 1e-12)
    k = k.astype(f32) * (1.0 + (a - 1.0) * k_a.astype(f32))
    rh, kh, vh, wh, ah = heads(r.astype(f32)), heads(k), heads(v.astype(f32)), heads(decay), heads(a)
    y = rwkv7_scan(rh, wh, kh, vh, -kk, kk * ah)
    mean = jnp.mean(y, axis=-1, keepdims=True)
    var = jnp.mean(jnp.square(y - mean), axis=-1, keepdims=True)
    y = ((y - mean) * lax.rsqrt(var + RW_LN_EPS)).reshape(bsz, seq, MIX_W)
    y = y * ln_g.astype(f32) + ln_b.astype(f32)
    bonus = jnp.sum(rh * kh * r_k.astype(f32), axis=-1, keepdims=True) * vh
    y = y + bonus.reshape(bsz, seq, MIX_W)
    return (y * g.astype(f32)).astype(p.dtype)


def setup_inputs(seed: int = 0) -> dict:
    key = jax.random.key(seed)
    ks = iter(jax.random.split(key, 64))
    f32 = jnp.float32
    nrm = lambda shape, scale: scale * jax.random.normal(next(ks), shape, f32)
    unif = lambda shape, lo, hi: jax.random.uniform(next(ks), shape, f32, lo, hi)
    L, D, W = DEPTH, D_MODEL, MIX_W
    x = nrm((BATCH, SEQ, D), 1.0)
    norm_mix_g = 1.0 + nrm((L, D), 0.01)
    w_in = nrm((L, D, IN_COLS), D ** -0.5)
    s5_lambda_re = -0.5 + nrm((L, S5_GROUPS, S5_STATE), 0.01)
    s5_lambda_im = jnp.pi * jnp.arange(S5_STATE, dtype=f32) + nrm((L, S5_GROUPS, S5_STATE), 0.01)
    s5_b_re = nrm((L, S5_GROUPS, S5_STATE, S5_GROUP), (2 * S5_GROUP) ** -0.5)
    s5_b_im = nrm((L, S5_GROUPS, S5_STATE, S5_GROUP), (2 * S5_GROUP) ** -0.5)
    s5_c_re = nrm((L, S5_GROUPS, S5_GROUP, S5_STATE), S5_STATE ** -0.5)
    s5_c_im = nrm((L, S5_GROUPS, S5_GROUP, S5_STATE), S5_STATE ** -0.5)
    s5_d = nrm((L, W), 1.0)
    s5_log_dt = unif((L, S5_GROUPS), float(np.log(1e-3)), float(np.log(1e-1)))
    s5_w_glu = nrm((L, W, W), W ** -0.5)
    lru_conv_w = nrm((L, LRU_CONV, W), LRU_CONV ** -0.5)
    lru_conv_b = nrm((L, W), 0.01)
    lru_w_a = nrm((L, LRU_HEADS, LRU_HD, LRU_HD), LRU_HD ** -0.5)
    lru_b_a = nrm((L, W), 0.01)
    lru_w_x = nrm((L, LRU_HEADS, LRU_HD, LRU_HD), LRU_HD ** -0.5)
    lru_b_x = nrm((L, W), 0.01)
    base = unif((L, W), 0.9, 0.999) ** (1.0 / LRU_C)
    lru_lambda = jnp.log(base) - jnp.log1p(-base)
    m2_conv_w = nrm((L, M2_CONV, M2_CONV_DIM), M2_CONV ** -0.5)
    m2_conv_b = nrm((L, M2_CONV_DIM), 0.01)
    dt0 = jnp.exp(unif((L, M2_HEADS), float(np.log(1e-3)), float(np.log(1e-1))))
    m2_dt_bias = dt0 + jnp.log(-jnp.expm1(-dt0))
    m2_a_log = jnp.log(unif((L, M2_HEADS), 1.0, 16.0))
    m2_d = 1.0 + nrm((L, M2_HEADS), 0.1)
    m2_norm_g = 1.0 + nrm((L, W), 0.01)
    rw_mu = unif((L, RW_COLS), 0.0, 1.0)
    rw_w0 = unif((L, W), -6.0, -1.0)
    rw_w2 = nrm((L, RW_DECAY_R, W), 0.1)
    rw_a0 = nrm((L, W), 0.1)
    rw_a2 = nrm((L, RW_A_R, W), RW_A_R ** -0.5)
    rw_g2 = nrm((L, RW_GATE_R, W), RW_GATE_R ** -0.5)
    rw_k_k = 0.85 + nrm((L, W), 0.05)
    rw_k_a = 1.0 + nrm((L, W), 0.05)
    rw_r_k = nrm((L, RW_HEADS, RW_HD), 0.1)
    rw_ln_g = 1.0 + nrm((L, W), 0.01)
    rw_ln_b = nrm((L, W), 0.01)
    w_branch = nrm((L, N_BRANCH, W, D), W ** -0.5)
    w_out = nrm((L, D, D), D ** -0.5)
    norm_ffn_g = 1.0 + nrm((L, D), 0.01)
    w_ffn_gate = nrm((L, D, FFN_DIM), D ** -0.5)
    w_ffn_up = nrm((L, D, FFN_DIM), D ** -0.5)
    ffn_conv_w = nrm((L, FFN_CONV, FFN_DIM), FFN_CONV ** -0.5)
    ffn_conv_b = nrm((L, FFN_DIM), 0.01)
    w_ffn_down = nrm((L, FFN_DIM, D), FFN_DIM ** -0.5)
    final_norm_g = 1.0 + nrm((D,), 0.01)
    return {
        "x": x, "norm_mix_g": norm_mix_g, "w_in": w_in,
        "s5_lambda_re": s5_lambda_re, "s5_lambda_im": s5_lambda_im,
        "s5_b_re": s5_b_re, "s5_b_im": s5_b_im, "s5_c_re": s5_c_re, "s5_c_im": s5_c_im,
        "s5_d": s5_d, "s5_log_dt": s5_log_dt, "s5_w_glu": s5_w_glu,
        "lru_conv_w": lru_conv_w, "lru_conv_b": lru_conv_b, "lru_w_a": lru_w_a, "lru_b_a": lru_b_a,
        "lru_w_x": lru_w_x, "lru_b_x": lru_b_x, "lru_lambda": lru_lambda,
        "m2_conv_w": m2_conv_w, "m2_conv_b": m2_conv_b, "m2_dt_bias": m2_dt_bias,
        "m2_a_log": m2_a_log, "m2_d": m2_d, "m2_norm_g": m2_norm_g,
        "rw_mu": rw_mu, "rw_w0": rw_w0, "rw_w2": rw_w2, "rw_a0": rw_a0, "rw_a2": rw_a2,
        "rw_g2": rw_g2, "rw_k_k": rw_k_k, "rw_k_a": rw_k_a, "rw_r_k": rw_r_k,
        "rw_ln_g": rw_ln_g, "rw_ln_b": rw_ln_b,
        "w_branch": w_branch, "w_out": w_out,
        "norm_ffn_g": norm_ffn_g, "w_ffn_gate": w_ffn_gate, "w_ffn_up": w_ffn_up,
        "ffn_conv_w": ffn_conv_w, "ffn_conv_b": ffn_conv_b, "w_ffn_down": w_ffn_down,
        "final_norm_g": final_norm_g,
    }


def reference(x, norm_mix_g, w_in,
              s5_lambda_re, s5_lambda_im, s5_b_re, s5_b_im, s5_c_re, s5_c_im,
              s5_d, s5_log_dt, s5_w_glu,
              lru_conv_w, lru_conv_b, lru_w_a, lru_b_a, lru_w_x, lru_b_x, lru_lambda,
              m2_conv_w, m2_conv_b, m2_dt_bias, m2_a_log, m2_d, m2_norm_g,
              rw_mu, rw_w0, rw_w2, rw_a0, rw_a2, rw_g2, rw_k_k, rw_k_a, rw_r_k,
              rw_ln_g, rw_ln_b,
              w_branch, w_out,
              norm_ffn_g, w_ffn_gate, w_ffn_up, ffn_conv_w, ffn_conv_b, w_ffn_down,
              final_norm_g):
    for l in range(DEPTH):
        h = rms_norm(x, norm_mix_g[l])
        proj = h @ w_in[l, :, :MIXER_COLS]
        s5_u, lru_x, lru_g, m2_z, m2_xbc, m2_dt, rw_p = split_cols(proj, MIXER_SPLITS)
        y_a = s5_mixer(s5_u, s5_lambda_re[l], s5_lambda_im[l], s5_b_re[l], s5_b_im[l],
                       s5_c_re[l], s5_c_im[l], s5_d[l], s5_log_dt[l], s5_w_glu[l])
        y_b = rglru_mixer(lru_x, lru_g, lru_conv_w[l], lru_conv_b[l], lru_w_a[l], lru_b_a[l],
                          lru_w_x[l], lru_b_x[l], lru_lambda[l])
        y_c = mamba2_mixer(m2_z, m2_xbc, m2_dt, m2_conv_w[l], m2_conv_b[l], m2_dt_bias[l],
                           m2_a_log[l], m2_d[l], m2_norm_g[l])
        y_d = rwkv7_mixer(rw_p, rw_mu[l], rw_w0[l], rw_w2[l], rw_a0[l], rw_a2[l], rw_g2[l],
                          rw_k_k[l], rw_k_a[l], rw_r_k[l], rw_ln_g[l], rw_ln_b[l])
        branches = (y_a, y_b, y_c, y_d)
        merged = jnp.zeros_like(x)
        for k in range(N_BRANCH):
            c0 = MIXER_COLS + k * D_MODEL
            gate = jax.nn.sigmoid(h @ w_in[l, :, c0:c0 + D_MODEL])
            merged = merged + gate * (branches[k] @ w_branch[l, k])
        x = x + merged @ w_out[l]
        h = rms_norm(x, norm_ffn_g[l])
        u = causal_dwconv(h @ w_ffn_gate[l], ffn_conv_w[l], ffn_conv_b[l])
        x = x + (jax.nn.gelu(u) * (h @ w_ffn_up[l])) @ w_ffn_down[l]
    return rms_norm(x, final_norm_g)
```

```cpp
#include <hip/hip_runtime.h>
#include <cstdio>
#include <cstdint>

#define LAS __attribute__((address_space(3)))
typedef unsigned short bf16;
typedef short bf16x8 __attribute__((ext_vector_type(8)));
typedef float f32x4 __attribute__((ext_vector_type(4)));
typedef float f32x2 __attribute__((ext_vector_type(2)));
typedef unsigned u32x4 __attribute__((ext_vector_type(4)));
typedef unsigned u32x2 __attribute__((ext_vector_type(2)));
typedef __bf16 bf16v2 __attribute__((ext_vector_type(2)));

constexpr int NB = 4, SEQ = 8192, DM = 2048, MTOK = NB * SEQ, DEPTH = 4;
constexpr int MIXC = 4776, MIXP = 4864, INC = 12968, FF = 6144, NGATE = 8192;
constexpr int RWC = 1696;
constexpr int PC_S5U = 0, PC_LRX = 512, PC_LRG = 1024, PC_M2Z = 1536, PC_XBC = 2048, PC_DT = 3072, PC_RW = 3080;

constexpr size_t MiB = 1u << 20;
constexpr size_t WS_CTL = 0, CTL_BYTES = 1 * MiB;
constexpr size_t WS_WIN = 1 * MiB, WS_WPK = 52 * MiB, WS_WOUT = 60 * MiB, WS_WFG = 68 * MiB, WS_WFU = 92 * MiB, WS_WFD = 116 * MiB, WS_WGLU = 140 * MiB;
constexpr size_t WS_H = 144 * MiB, WS_YK = 272 * MiB, WS_PROJ = 400 * MiB, WS_MERGED = 400 * MiB, WS_GATES = 704 * MiB;
constexpr size_t WS_RW_R = 1216 * MiB, WS_RW_K = 1248 * MiB, WS_RW_V = 1280 * MiB, WS_RW_A = 1312 * MiB, WS_RW_B = 1344 * MiB, WS_RW_G = 1376 * MiB,
                 WS_RW_DEC = 1408 * MiB, WS_RW_Y = 1472 * MiB, WS_RW_BON = 1536 * MiB, WS_END = 1538 * MiB;
constexpr size_t WS_S5Z = 704 * MiB, WS_S5E = 736 * MiB, WS_S5I = 740 * MiB, WS_LRE = 744 * MiB, WS_LRA = 745 * MiB, WS_LRI = 746 * MiB;
constexpr size_t WS_M2S = 752 * MiB, WS_M2D = 1008 * MiB, WS_M2Y = 1012 * MiB;
constexpr size_t WS_FG = 400 * MiB, WS_HID = 784 * MiB;
constexpr int CW_BAR = 4096;

__device__ __forceinline__ float bf2f(bf16 b) { return __uint_as_float(((unsigned)b) << 16); }
__device__ __forceinline__ unsigned f2bf(float f) { const __bf16 b = (__bf16)f; return (unsigned)__builtin_bit_cast(unsigned short, b); }
__device__ __forceinline__ unsigned pk2(float lo, float hi) { const f32x2 v = {lo, hi}; const bf16v2 b = __builtin_convertvector(v, bf16v2); return __builtin_bit_cast(unsigned, b); }
__device__ __forceinline__ float lo16(unsigned w) { return __uint_as_float(w << 16); }
__device__ __forceinline__ float hi16(unsigned w) { return __uint_as_float(w & 0xffff0000u); }
__device__ __forceinline__ float rcpf_(float x) { return __builtin_amdgcn_rcpf(x); }
__device__ __forceinline__ float sigmoidf_(float x) { return rcpf_(1.0f + __expf(-x)); }
__device__ __forceinline__ float siluf_(float x) { return x * rcpf_(1.0f + __expf(-x)); }
__device__ __forceinline__ float geluf_(float x) { const float u = 0.7978845608028654f * (x + 0.044715f * x * x * x); return x * rcpf_(1.0f + __expf(-2.0f * u)); }
__device__ __forceinline__ float softplusf_(float x) { return fmaxf(x, 0.f) + __logf(1.0f + __expf(-fabsf(x))); }
__device__ __forceinline__ float row16_sum(float v) {
    v += __int_as_float(__builtin_amdgcn_update_dpp(0, __float_as_int(v), 0x128, 0xf, 0xf, true));
    v += __int_as_float(__builtin_amdgcn_update_dpp(0, __float_as_int(v), 0x124, 0xf, 0xf, true));
    v += __int_as_float(__builtin_amdgcn_update_dpp(0, __float_as_int(v), 0x122, 0xf, 0xf, true));
    v += __int_as_float(__builtin_amdgcn_update_dpp(0, __float_as_int(v), 0x121, 0xf, 0xf, true));
    return v;
}
__device__ __forceinline__ float wave_sum(float v) {
    v = row16_sum(v);
    const float a = __int_as_float(__builtin_amdgcn_readlane(__float_as_int(v), 0)), b = __int_as_float(__builtin_amdgcn_readlane(__float_as_int(v), 16));
    const float c = __int_as_float(__builtin_amdgcn_readlane(__float_as_int(v), 32)), d = __int_as_float(__builtin_amdgcn_readlane(__float_as_int(v), 48));
    return (a + b) + (c + d);
}
__device__ __forceinline__ float rdlane(float v, int l) { return __int_as_float(__builtin_amdgcn_readlane(__float_as_int(v), l)); }

namespace pg8 {
constexpr int BM = 256, BK = 64, HALF = 128, HTB = HALF * BK * 2, STAGE_BYTES = 8 * HTB, NXCD = 8, WGM = 4;
__host__ __device__ __forceinline__ int lds_byte(int r, int c) { const int st = (r >> 4) * 2 + (c >> 5), rr = r & 15, cc = c & 31, ob = rr * 64 + cc * 2; return st * 1024 + (ob ^ (((ob >> 9) & 1) << 5)); }
__host__ __device__ __forceinline__ void stage_rc(int b, int& R, int& C) { const int st = b / 1024, sb = b % 1024, swz = sb ^ (((sb >> 9) & 1) << 5); R = (st >> 1) * 16 + swz / 64; C = (st & 1) * 32 + (swz % 64) / 2; }
__host__ __device__ __forceinline__ int perm32(int rho) { const int n = rho >> 4, i = rho & 15; return 8 * (i >> 2) + 4 * n + (i & 3); }
struct Unit { int pm, pn; };
struct Gemm { const bf16* A; const bf16* Bt; int M, N, K; };
struct StaticOrder {
    int nM, nN, nwg, G, c, wgm;
    __device__ void init(int M, int N, int G_, int c_, int wgm_ = WGM) { nM = M / BM; nN = N / BM; nwg = nM * nN; G = G_; c = c_; wgm = wgm_; }
    __device__ bool next(int i, Unit& u) const {
        const long L = (long)i * G + c; if (L >= nwg || c < 0) return false;
        int wgid = (int)L; { const int q = nwg / NXCD, r = nwg % NXCD, xcd = wgid % NXCD, off = wgid / NXCD; wgid = (xcd < r ? xcd * (q + 1) : r * (q + 1) + (xcd - r) * q) + off; }
        const int nig = wgm * nN, gid = wgid / nig, fm = gid * wgm, gsz = (nM - fm) < wgm ? (nM - fm) : wgm;
        u.pm = fm + ((wgid % nig) % gsz); u.pn = (wgid % nig) / gsz; return true;
    }
    __device__ __forceinline__ void a_ready(const Unit&) const {}
    __device__ __forceinline__ void done(const Unit&) const {}
};
struct SplitOrder {
    int nM, nN, nwg, G, c, base, n;
    __device__ void init(int M, int N, int G_, int c_, int base_, int n_) { nM = M / BM; nN = N / BM; nwg = nM * nN; G = G_; c = c_; base = base_; n = n_; }
    __device__ bool next(int i, Unit& u) const {
        if (i >= n) return false; const long L = (long)base + (long)i * G + c; if (L >= nwg) return false;
        int wgid = (int)L; { const int q = nwg / NXCD, r = nwg % NXCD, xcd = wgid % NXCD, off = wgid / NXCD; wgid = (xcd < r ? xcd * (q + 1) : r * (q + 1) + (xcd - r) * q) + off; }
        const int nig = WGM * nN, gid = wgid / nig, fm = gid * WGM, gsz = (nM - fm) < WGM ? (nM - fm) : WGM;
        u.pm = fm + ((wgid % nig) % gsz); u.pn = (wgid % nig) / gsz; return true;
    }
    __device__ __forceinline__ void a_ready(const Unit&) const {}
    __device__ __forceinline__ void done(const Unit&) const {}
};
struct OrderYK {
    int G, c;
    __device__ bool next(int i, Unit& u) const {
        const int k = i & 3; const long T = (long)(i >> 2) * G + c; if (T >= 1024) return false;
        int wgid = (int)T; { const int xcd = wgid % 8, off = wgid / 8; wgid = xcd * 128 + off; }
        const int gid = wgid / 32, fm = gid * 4; const int pm = fm + ((wgid % 32) % 4), pn = (wgid % 32) / 4;
        u.pm = k * 128 + pm; u.pn = k * 8 + pn; return true;
    }
    __device__ __forceinline__ void a_ready(const Unit&) const {}
    __device__ __forceinline__ void done(const Unit&) const {}
};
__device__ __forceinline__ unsigned cvt_pk_bf16(float lo, float hi) { return pk2(lo, hi); }

template <int ACT> struct EpiStore {
    static constexpr bool PERM = true;
    bf16* O; int ldc;
    __device__ __forceinline__ void operator()(const f32x4 (&acc)[2][2][4][2], const Unit& u, int wr, int wc, int fr, int fq) const {
        const int row0 = u.pm * BM + wr * 64 + fr, col0 = u.pn * BM + wc * 32 + 8 * fq;
#pragma unroll
        for (int ai = 0; ai < 2; ++ai)
#pragma unroll
            for (int m = 0; m < 4; ++m) { bf16* rowp = O + (size_t)(row0 + ai * HALF + m * 16) * ldc + col0;
#pragma unroll
                for (int bj = 0; bj < 2; ++bj) { f32x4 v0 = acc[ai][bj][m][0], v1 = acc[ai][bj][m][1];
                    if (ACT == 1) {
#pragma unroll
                        for (int j = 0; j < 4; ++j) { v0[j] = sigmoidf_(v0[j]); v1[j] = sigmoidf_(v1[j]); } }
                    u32x4 w; w.x = cvt_pk_bf16(v0[0], v0[1]); w.y = cvt_pk_bf16(v0[2], v0[3]); w.z = cvt_pk_bf16(v1[0], v1[1]); w.w = cvt_pk_bf16(v1[2], v1[3]);
                    *(u32x4*)(rowp + bj * HALF) = w; } }
    }
};
struct EpiAddF32 {
    static constexpr bool PERM = false;
    const float* base; float* out; int ldc;
    __device__ __forceinline__ void operator()(const f32x4 (&acc)[2][2][4][2], const Unit& u, int wr, int wc, int fr, int fq) const {
        const int row0 = u.pm * BM + wr * 64 + fr, col0 = u.pn * BM + wc * 32 + 4 * fq;
#pragma unroll
        for (int ai = 0; ai < 2; ++ai)
#pragma unroll
            for (int m = 0; m < 4; ++m) { const size_t off = (size_t)(row0 + ai * HALF + m * 16) * ldc + col0;
#pragma unroll
                for (int bj = 0; bj < 2; ++bj)
#pragma unroll
                    for (int n = 0; n < 2; ++n) { const size_t p = off + bj * HALF + n * 16; const f32x4 b = *(const f32x4*)(base + p); *(f32x4*)(out + p) = b + acc[ai][bj][m][n]; } }
    }
};
struct EpiGateAcc {
    static constexpr bool PERM = true;
    const bf16* gates; bf16* merged;
    __device__ __forceinline__ void operator()(const f32x4 (&acc)[2][2][4][2], const Unit& u, int wr, int wc, int fr, int fq) const {
        const int k = u.pn >> 3, pn = u.pn & 7, pm = u.pm & 127;
        const int row0 = pm * BM + wr * 64 + fr, col0 = pn * BM + wc * 32 + 8 * fq;
#pragma unroll
        for (int ai = 0; ai < 2; ++ai) {
            u32x4 g[4][2], pv[4][2];
#pragma unroll
            for (int m = 0; m < 4; ++m)
#pragma unroll
                for (int bj = 0; bj < 2; ++bj) { const size_t r = (size_t)(row0 + ai * HALF + m * 16); const int c = col0 + bj * HALF;
                    g[m][bj] = *(const u32x4*)(gates + r * NGATE + k * DM + c);
                    pv[m][bj] = (u32x4){0u, 0u, 0u, 0u}; if (k) pv[m][bj] = *(const u32x4*)(merged + r * DM + c); }
#pragma unroll
            for (int m = 0; m < 4; ++m)
#pragma unroll
                for (int bj = 0; bj < 2; ++bj) { const size_t r = (size_t)(row0 + ai * HALF + m * 16); const int c = col0 + bj * HALF;
                    const f32x4 v0 = acc[ai][bj][m][0], v1 = acc[ai][bj][m][1]; const u32x4 gg = g[m][bj], pp = pv[m][bj];
                    float o[8];
                    o[0] = lo16(pp.x) + lo16(gg.x) * v0[0]; o[1] = hi16(pp.x) + hi16(gg.x) * v0[1]; o[2] = lo16(pp.y) + lo16(gg.y) * v0[2]; o[3] = hi16(pp.y) + hi16(gg.y) * v0[3];
                    o[4] = lo16(pp.z) + lo16(gg.z) * v1[0]; o[5] = hi16(pp.z) + hi16(gg.z) * v1[1]; o[6] = lo16(pp.w) + lo16(gg.w) * v1[2]; o[7] = hi16(pp.w) + hi16(gg.w) * v1[3];
                    u32x4 w; w.x = cvt_pk_bf16(o[0], o[1]); w.y = cvt_pk_bf16(o[2], o[3]); w.z = cvt_pk_bf16(o[4], o[5]); w.w = cvt_pk_bf16(o[6], o[7]);
                    *(u32x4*)(merged + r * DM + c) = w; }
            asm volatile("" ::: "memory");
        }
    }
};
struct EpiGlu {
    static constexpr bool PERM = true;
    const bf16* Z; bf16* O;
    __device__ __forceinline__ void operator()(const f32x4 (&acc)[2][2][4][2], const Unit& u, int wr, int wc, int fr, int fq) const {
        const int row0 = u.pm * BM + wr * 64 + fr, col0 = u.pn * BM + wc * 32 + 8 * fq;
#pragma unroll
        for (int ai = 0; ai < 2; ++ai)
#pragma unroll
            for (int m = 0; m < 4; ++m) { const size_t r = (size_t)(row0 + ai * HALF + m * 16);
#pragma unroll
                for (int bj = 0; bj < 2; ++bj) { const int c = col0 + bj * HALF;
                    const u32x4 z = *(const u32x4*)(Z + r * 512 + c);
                    const f32x4 v0 = acc[ai][bj][m][0], v1 = acc[ai][bj][m][1];
                    float o[8];
                    o[0] = lo16(z.x) * sigmoidf_(v0[0]); o[1] = hi16(z.x) * sigmoidf_(v0[1]); o[2] = lo16(z.y) * sigmoidf_(v0[2]); o[3] = hi16(z.y) * sigmoidf_(v0[3]);
                    o[4] = lo16(z.z) * sigmoidf_(v1[0]); o[5] = hi16(z.z) * sigmoidf_(v1[1]); o[6] = lo16(z.w) * sigmoidf_(v1[2]); o[7] = hi16(z.w) * sigmoidf_(v1[3]);
                    u32x4 w; w.x = cvt_pk_bf16(o[0], o[1]); w.y = cvt_pk_bf16(o[2], o[3]); w.z = cvt_pk_bf16(o[4], o[5]); w.w = cvt_pk_bf16(o[6], o[7]);
                    *(u32x4*)(O + r * 512 + c) = w; }
                asm volatile("" ::: "memory"); }
    }
};
struct EpiFfnUp {
    static constexpr bool PERM = true;
    const bf16* G; bf16* O; const float* cw; const float* cb;
    __device__ __forceinline__ void operator()(const f32x4 (&acc)[2][2][4][2], const Unit& u, int wr, int wc, int fr, int fq) const {
        const int row0 = u.pm * BM + wr * 64 + fr, col0 = u.pn * BM + wc * 32 + 8 * fq;
#pragma unroll
        for (int bj = 0; bj < 2; ++bj) { const int c = col0 + bj * HALF;
            float w0[8], w1[8], w2[8], bb[8];
#pragma unroll
            for (int h = 0; h < 2; ++h) { const f32x4 a = *(const f32x4*)(cw + c + 4 * h), b = *(const f32x4*)(cw + FF + c + 4 * h), d = *(const f32x4*)(cw + 2 * FF + c + 4 * h), e = *(const f32x4*)(cb + c + 4 * h);
#pragma unroll
                for (int j = 0; j < 4; ++j) { w0[4 * h + j] = a[j]; w1[4 * h + j] = b[j]; w2[4 * h + j] = d[j]; bb[4 * h + j] = e[j]; } }
#pragma unroll
            for (int aim = 0; aim < 4; ++aim) { const int ai = aim >> 1, mb = (aim & 1) * 2;
                u32x4 g2[4], g1[4], g0[4];
#pragma unroll
                for (int m = mb; m < mb + 2; ++m) { const int ri = row0 + ai * HALF + m * 16; const size_t r = (size_t)ri; const int t = ri & (SEQ - 1);
                    g2[m] = *(const u32x4*)(G + r * FF + c); g1[m] = (u32x4){0u, 0u, 0u, 0u}; g0[m] = (u32x4){0u, 0u, 0u, 0u};
                    if (t >= 1) g1[m] = *(const u32x4*)(G + (r - 1) * FF + c);
                    if (t >= 2) g0[m] = *(const u32x4*)(G + (r - 2) * FF + c); }
#pragma unroll
                for (int m = mb; m < mb + 2; ++m) { const size_t r = (size_t)(row0 + ai * HALF + m * 16);
                    const f32x4 v0 = acc[ai][bj][m][0], v1 = acc[ai][bj][m][1];
                    const float x2[8] = {lo16(g2[m].x), hi16(g2[m].x), lo16(g2[m].y), hi16(g2[m].y), lo16(g2[m].z), hi16(g2[m].z), lo16(g2[m].w), hi16(g2[m].w)};
                    const float x1[8] = {lo16(g1[m].x), hi16(g1[m].x), lo16(g1[m].y), hi16(g1[m].y), lo16(g1[m].z), hi16(g1[m].z), lo16(g1[m].w), hi16(g1[m].w)};
                    const float x0[8] = {lo16(g0[m].x), hi16(g0[m].x), lo16(g0[m].y), hi16(g0[m].y), lo16(g0[m].z), hi16(g0[m].z), lo16(g0[m].w), hi16(g0[m].w)};
                    float o[8];
#pragma unroll
                    for (int j = 0; j < 8; ++j) { const float uu = bb[j] + w0[j] * x0[j] + w1[j] * x1[j] + w2[j] * x2[j]; o[j] = geluf_(uu) * (j < 4 ? v0[j & 3] : v1[j & 3]); }
                    u32x4 w; w.x = cvt_pk_bf16(o[0], o[1]); w.y = cvt_pk_bf16(o[2], o[3]); w.z = cvt_pk_bf16(o[4], o[5]); w.w = cvt_pk_bf16(o[6], o[7]);
                    *(u32x4*)(O + r * FF + c) = w; }
                asm volatile("" ::: "memory"); } }
    }
};

#ifndef PG8_SP2
#define PG8_SP2 true
#endif
#ifndef PG8_ALIGN
#define PG8_ALIGN true
#endif
template <class Epi, class Sched, bool ALIGN_EPI = PG8_ALIGN, bool SP2 = PG8_SP2>
__device__ __forceinline__ void gemm_phase(LAS unsigned char* lds, const Gemm g, const Sched& S, const Epi& E, int tid_) {
    const int tid = tid_, wid = __builtin_amdgcn_readfirstlane(tid >> 6), lane = tid & 63, wr = wid >> 2, wc = wid & 3, fr = lane & 15, fq = lane >> 4;
    const int K = g.K, nt = K / BK;
    unsigned voffA[2], voffB[2];
#pragma unroll
    for (int i = 0; i < 2; ++i) { int R, C; stage_rc(tid * 16 + i * 8192, R, C); const int Rb = Epi::PERM ? ((R & ~31) + perm32(R & 31)) : R;
        voffA[i] = (unsigned)(R * K + C) * 2u; voffB[i] = (unsigned)(Rb * K + C) * 2u; }
    const size_t kstep = (size_t)(BK * 2);
    const size_t hstep = (size_t)HALF * K * 2;
    const size_t tstep = 2 * hstep;
    const unsigned ldsw = (unsigned)wid * 1024u;
    const int aoff = lds_byte(wr * 64 + fr, fq * 8), boff = lds_byte(wc * 32 + fr, fq * 8);
#define PG8_SA(b, h) (((b) * 2 + (h)) * HTB)
#define PG8_SB(b, h) ((4 + (b) * 2 + (h)) * HTB)
#define PG8_STAGE(bufoff, gbase, voff) do { _Pragma("unroll") for (int _i = 0; _i < 2; ++_i) \
        __builtin_amdgcn_global_load_lds((const unsigned*)((const char*)(gbase) + (voff)[_i]), (LAS unsigned*)(lds + (bufoff) + ldsw + _i * 8192), 16, 0, 0); } while (0)
#define PG8_LDA(dst, b, h) do { _Pragma("unroll") for (int m = 0; m < 4; ++m) _Pragma("unroll") for (int k = 0; k < 2; ++k) dst[m][k] = *(const LAS bf16x8*)(lds + PG8_SA(b, h) + aoff + m * 2048 + k * 1024); } while (0)
#define PG8_LDB(dst, b, h) do { _Pragma("unroll") for (int n = 0; n < 2; ++n) _Pragma("unroll") for (int k = 0; k < 2; ++k) dst[n][k] = *(const LAS bf16x8*)(lds + PG8_SB(b, h) + boff + n * 2048 + k * 1024); } while (0)
#define PG8_MMA(ai, bj, At, Bt) do { __builtin_amdgcn_s_setprio(1); _Pragma("unroll") for (int m = 0; m < 4; ++m) _Pragma("unroll") for (int n = 0; n < 2; ++n) _Pragma("unroll") for (int k = 0; k < 2; ++k) \
        acc[ai][bj][m][n] = __builtin_amdgcn_mfma_f32_16x16x32_bf16(Bt[n][k], At[m][k], acc[ai][bj][m][n], 0, 0, 0); __builtin_amdgcn_s_setprio(0); } while (0)
#define PG8_WAIT_V(n) asm volatile("s_waitcnt vmcnt(" #n ")" ::: "memory")
#define PG8_WAIT_L(n) asm volatile("s_waitcnt lgkmcnt(" #n ")" ::: "memory")
#define PG8_BAR __builtin_amdgcn_s_barrier()
#define PG8_SCHED __builtin_amdgcn_sched_barrier(0)
    Unit cur, nxt; int ui = 0;
    if (!S.next(0, cur)) return;
    f32x4 acc[2][2][4][2];
#pragma unroll
    for (int a = 0; a < 2; ++a)
#pragma unroll
        for (int b = 0; b < 2; ++b)
#pragma unroll
            for (int m = 0; m < 4; ++m)
#pragma unroll
                for (int n = 0; n < 2; ++n) acc[a][b][m][n] = (f32x4){0.f, 0.f, 0.f, 0.f};
    bf16x8 At[4][2], B0[2][2], B1[2][2];
    const char* cA = (const char*)g.A + (size_t)cur.pm * tstep; const char* cB = (const char*)g.Bt + (size_t)cur.pn * tstep;
    S.a_ready(cur);
    if constexpr (SP2) {
        PG8_STAGE(PG8_SB(0, 0), cB, voffB); PG8_STAGE(PG8_SB(0, 1), cB + hstep, voffB); PG8_STAGE(PG8_SA(0, 0), cA, voffA); PG8_STAGE(PG8_SA(0, 1), cA + hstep, voffA);
        if (wr == 1) PG8_BAR;
        PG8_WAIT_V(2); PG8_BAR;
        PG8_STAGE(PG8_SB(1, 0), cB + kstep, voffB); PG8_STAGE(PG8_SA(1, 0), cA + kstep, voffA); PG8_STAGE(PG8_SB(1, 1), cB + hstep + kstep, voffB);
        PG8_WAIT_V(6); PG8_BAR;
    } else {
    PG8_STAGE(PG8_SB(0, 0), cB, voffB); PG8_STAGE(PG8_SA(0, 0), cA, voffA); PG8_STAGE(PG8_SB(0, 1), cB + hstep, voffB); PG8_STAGE(PG8_SA(0, 1), cA + hstep, voffA);
    if (wr == 1) PG8_BAR;
    PG8_WAIT_V(4); PG8_BAR;
    PG8_STAGE(PG8_SB(1, 0), cB + kstep, voffB); PG8_STAGE(PG8_SA(1, 0), cA + kstep, voffA); PG8_STAGE(PG8_SB(1, 1), cB + hstep + kstep, voffB);
    PG8_WAIT_V(6); PG8_BAR;
    }
    for (;;) {
        const bool has_next = S.next(ui + 1, nxt);
        const char* nA = has_next ? (const char*)g.A + (size_t)nxt.pm * tstep : cA; const char* nB = has_next ? (const char*)g.Bt + (size_t)nxt.pn * tstep : cB;
        for (int t = 0; t < nt; t += 2) {
            const bool last = (t == nt - 2);
            const char* a1 = cA + (size_t)(t + 1) * kstep;
            const char* a2 = last ? nA : cA + (size_t)(t + 2) * kstep; const char* b2 = last ? nB : cB + (size_t)(t + 2) * kstep;
            const char* a3 = a2 + kstep; const char* b3 = b2 + kstep;
            if (last && has_next) S.a_ready(nxt);
            if constexpr (SP2) {
            PG8_LDB(B0, 0, 0); PG8_LDB(B1, 0, 1); PG8_SCHED; PG8_LDA(At, 0, 0); PG8_STAGE(PG8_SA(1, 1), a1 + hstep, voffA);
            PG8_WAIT_V(8); PG8_WAIT_L(0); PG8_BAR; PG8_MMA(0, 0, At, B0); PG8_MMA(0, 1, At, B1); PG8_BAR; PG8_SCHED;
            PG8_LDA(At, 0, 1); PG8_STAGE(PG8_SB(0, 0), b2, voffB); PG8_STAGE(PG8_SB(0, 1), b2 + hstep, voffB); PG8_STAGE(PG8_SA(0, 0), a2, voffA);
            PG8_WAIT_V(8); PG8_WAIT_L(0); PG8_BAR; PG8_MMA(1, 0, At, B0); PG8_MMA(1, 1, At, B1); PG8_BAR; PG8_SCHED;
            PG8_LDB(B0, 1, 0); PG8_LDB(B1, 1, 1); PG8_SCHED; PG8_LDA(At, 1, 0); PG8_STAGE(PG8_SA(0, 1), a2 + hstep, voffA);
            PG8_WAIT_V(8); PG8_WAIT_L(0); PG8_BAR; PG8_MMA(0, 0, At, B0); PG8_MMA(0, 1, At, B1); PG8_BAR; PG8_SCHED;
            PG8_LDA(At, 1, 1); PG8_STAGE(PG8_SB(1, 0), b3, voffB); PG8_STAGE(PG8_SB(1, 1), b3 + hstep, voffB); PG8_STAGE(PG8_SA(1, 0), a3, voffA);
            PG8_WAIT_V(8); PG8_WAIT_L(0); PG8_BAR; PG8_MMA(1, 0, At, B0); PG8_MMA(1, 1, At, B1); PG8_BAR; PG8_SCHED;
            } else {
            PG8_LDB(B0, 0, 0); PG8_SCHED; PG8_LDA(At, 0, 0); PG8_STAGE(PG8_SA(1, 1), a1 + hstep, voffA);
            PG8_WAIT_L(8); PG8_BAR; PG8_WAIT_L(0); PG8_MMA(0, 0, At, B0); PG8_BAR; PG8_SCHED;
            PG8_LDB(B1, 0, 1); PG8_STAGE(PG8_SB(0, 0), b2, voffB);
            PG8_BAR; PG8_WAIT_L(0); PG8_MMA(0, 1, At, B1); PG8_BAR;
            PG8_LDA(At, 0, 1); PG8_STAGE(PG8_SA(0, 0), a2, voffA);
            PG8_BAR; PG8_WAIT_L(0); PG8_MMA(1, 0, At, B0); PG8_BAR; PG8_SCHED;
            PG8_STAGE(PG8_SB(0, 1), b2 + hstep, voffB);
            PG8_WAIT_V(6); PG8_BAR; PG8_MMA(1, 1, At, B1); PG8_BAR;
            PG8_LDB(B0, 1, 0); PG8_SCHED; PG8_LDA(At, 1, 0); PG8_STAGE(PG8_SA(0, 1), a2 + hstep, voffA);
            PG8_WAIT_L(8); PG8_BAR; PG8_WAIT_L(0); PG8_MMA(0, 0, At, B0); PG8_BAR; PG8_SCHED;
            PG8_LDB(B1, 1, 1); PG8_STAGE(PG8_SB(1, 0), b3, voffB);
            PG8_BAR; PG8_WAIT_L(0); PG8_MMA(0, 1, At, B1); PG8_BAR;
            PG8_LDA(At, 1, 1); PG8_STAGE(PG8_SA(1, 0), a3, voffA);
            PG8_BAR; PG8_WAIT_L(0); PG8_MMA(1, 0, At, B0); PG8_BAR; PG8_SCHED;
            PG8_STAGE(PG8_SB(1, 1), b3 + hstep, voffB);
            PG8_WAIT_V(6); PG8_BAR; PG8_MMA(1, 1, At, B1); PG8_BAR;
            }
        }
        if constexpr (ALIGN_EPI) { if (wr == 0) PG8_BAR; }
        E(acc, cur, wr, wc, fr, fq); S.done(cur);
        if (!has_next) break;
#pragma unroll
        for (int a = 0; a < 2; ++a)
#pragma unroll
            for (int b = 0; b < 2; ++b)
#pragma unroll
                for (int m = 0; m < 4; ++m)
#pragma unroll
                    for (int n = 0; n < 2; ++n) acc[a][b][m][n] = (f32x4){0.f, 0.f, 0.f, 0.f};
        cur = nxt; cA = nA; cB = nB; ++ui;
        if constexpr (ALIGN_EPI) { if (wr == 1) PG8_BAR; }
    }
    PG8_WAIT_V(0);
    if constexpr (!ALIGN_EPI) { if (wr == 0) PG8_BAR; }
    PG8_BAR;
#undef PG8_SA
#undef PG8_SB
#undef PG8_STAGE
#undef PG8_LDA
#undef PG8_LDB
#undef PG8_MMA
#undef PG8_WAIT_V
#undef PG8_WAIT_L
#undef PG8_BAR
#undef PG8_SCHED
}
}

#define XB_TMO      128
#define XB_XCNT(j)  (256  + 64 * (j))
#define XB_XSUB(j)  (1280 + 64 * (j))
#define XB_XGEN(j)  (2304 + 64 * (j))
#define XB_TOP      3328
#define XB_TOPGEN   3392
#define XCD_BAR_WORDS 3456
#define XB_SPIN_CAP (1u << 22)
__device__ __forceinline__ unsigned xb_ld(unsigned* p)              { return __hip_atomic_load(p, __ATOMIC_RELAXED, __HIP_MEMORY_SCOPE_AGENT); }
__device__ __forceinline__ unsigned xb_add(unsigned* p, unsigned v) { return __hip_atomic_fetch_add(p, v, __ATOMIC_RELAXED, __HIP_MEMORY_SCOPE_AGENT); }
__device__ __forceinline__ unsigned xb_xcc_id() { return (unsigned)__builtin_amdgcn_s_getreg((3 << 11) | 20) & 0xFu; }
#define XB_SPIN(cond, bar) do { unsigned _sp = 0; while (cond) { __builtin_amdgcn_s_sleep(1); \
    if ((++_sp & 255u) == 0u) { if (xb_ld(&(bar)[XB_TMO])) break; if (_sp > XB_SPIN_CAP) { atomicAdd(&(bar)[XB_TMO], 1u); break; } } } } while (0)
struct XcdBarrier { unsigned* bar; unsigned x; volatile LAS unsigned* st; };
__device__ __forceinline__ XcdBarrier xcd_barrier_post(unsigned* bar, volatile LAS unsigned* st) {
    XcdBarrier b; b.bar = bar; b.x = xb_xcc_id(); b.st = st;
    if (threadIdx.x == 0) (void)xb_add(&bar[XB_XCNT(b.x)], 1u);
    return b;
}
__device__ __forceinline__ void xcd_barrier_complete(unsigned* bar, unsigned x, unsigned& nloc, unsigned& nx) {
    const unsigned G = gridDim.x * gridDim.y * gridDim.z;
    unsigned sum, cnt, mine, sp = 0u;
    for (;;) {
        sum = 0u; cnt = 0u; mine = 0u;
#pragma unroll
        for (unsigned j = 0; j < 16; ++j) { const unsigned c = xb_ld(&bar[XB_XCNT(j)]); sum += c; cnt += (c > 0u) ? 1u : 0u; mine = (j == x) ? c : mine; }
        if (sum == G) break;
        __builtin_amdgcn_s_sleep(1);
        if ((++sp & 255u) == 0u) { if (xb_ld(&bar[XB_TMO])) break; if (sp > XB_SPIN_CAP) { atomicAdd(&bar[XB_TMO], 1u); break; } }
    }
    nloc = mine > 0u ? mine : 1u; nx = cnt > 0u ? cnt : 1u;
}
__device__ __forceinline__ void xcd_barrier(const XcdBarrier& b) {
    asm volatile("s_waitcnt vmcnt(0)" ::: "memory");
    __syncthreads();
    if (threadIdx.x == 0) {
        unsigned* bar = b.bar;
        __builtin_amdgcn_s_waitcnt(0);
        unsigned nloc = b.st[0], nx = b.st[1];
        if (nloc == 0u) { xcd_barrier_complete(bar, b.x, nloc, nx); b.st[0] = nloc; b.st[1] = nx; }
        const unsigned old = xb_add(&bar[XB_XSUB(b.x)], 1u);
        const unsigned gen = old / nloc;
        if (old + 1u == (gen + 1u) * nloc) {
            __builtin_amdgcn_fence(__ATOMIC_RELEASE, "agent");
            asm volatile("s_waitcnt vmcnt(0)" ::: "memory");
            const unsigned og = xb_add(&bar[XB_TOP], 1u);
            const unsigned tg = og / nx;
            if (og + 1u == (tg + 1u) * nx) xb_add(&bar[XB_TOPGEN], 1u);
            else XB_SPIN(xb_ld(&bar[XB_TOPGEN]) == tg, bar);
            __builtin_amdgcn_fence(__ATOMIC_ACQUIRE, "agent");
            xb_add(&bar[XB_XGEN(b.x)], 1u);
            asm volatile("s_waitcnt vmcnt(0)" ::: "memory");
        } else {
            XB_SPIN(xb_ld(&bar[XB_XGEN(b.x)]) == gen, bar);
            __builtin_amdgcn_fence(__ATOMIC_ACQUIRE, "agent");
            asm volatile("s_waitcnt vmcnt(0)" ::: "memory");
        }
    }
    __syncthreads();
}

constexpr int NWAVES = 8, NTHR = 512;
constexpr int LDS_MISC = 131072, LDS_BYTES = 131072 + 1024;
struct Args { const float* in[45]; float* out; unsigned char* ws; };
#define GAS __attribute__((address_space(1)))
struct Frame {
    LAS unsigned char* lds; float* out; unsigned char* ws;
    int tid, lane, wave, blk, G;
};
#define WSP(T, off) ((T*)(F.ws + (off)))
__device__ __forceinline__ const float* inp_(LAS unsigned char* lds, int k) {
    const LAS unsigned* t = (const LAS unsigned*)(lds + 131072 + 256) + 2 * k;
    const unsigned lo = __builtin_amdgcn_readfirstlane(t[0]), hi = __builtin_amdgcn_readfirstlane(t[1]);
    return (const float*)(const GAS float*)(((unsigned long long)hi << 32) | lo);
}
#define INP(k) inp_(F.lds, (k))

__device__ __forceinline__ void tr_item(const float* W, int ld, int col0, int ncv, bf16* WT, int K, int row_off, LAS float* scr, int kb, int nb, int lane) {
    const int k0 = 64 * kb, n0 = 32 * nb; const int nn = n0 + (lane & 31); const bool ok = nn < ncv;
#pragma unroll 8
    for (int i = 0; i < 32; ++i) { const int kk = 2 * i + (lane >> 5); scr[kk * 33 + (lane & 31)] = ok ? W[(size_t)(k0 + kk) * ld + col0 + nn] : 0.f; }
    asm volatile("s_waitcnt lgkmcnt(0)" ::: "memory");
    const int c = lane & 7;
#pragma unroll
    for (int j = 0; j < 4; ++j) { const int n = (lane >> 3) + 8 * j; const LAS float* s = scr + (8 * c) * 33 + n;
        u32x4 o; o.x = pk2(s[0 * 33], s[1 * 33]); o.y = pk2(s[2 * 33], s[3 * 33]); o.z = pk2(s[4 * 33], s[5 * 33]); o.w = pk2(s[6 * 33], s[7 * 33]);
        *(u32x4*)(WT + (size_t)(row_off + n0 + n) * K + k0 + 8 * c) = o; }
    asm volatile("s_waitcnt lgkmcnt(0)" ::: "memory");
}
__device__ __forceinline__ void convert_weights(Frame& F, int l) {
    LAS float* scr = (LAS float*)(F.lds + F.wave * 16384);
    const int gw = F.blk * NWAVES + F.wave, NGW = F.G * NWAVES;
    constexpr int I0 = 32 * 152, I1 = I0 + 32 * 256, I2 = I1 + 4 * 8 * 64, I3 = I2 + 32 * 64, I4 = I3 + 32 * 192, I5 = I4 + 32 * 192, I6 = I5 + 96 * 64, I7 = I6 + 8 * 16;
    const float* win = INP(2) + (size_t)l * DM * INC;
    for (int it = gw; it < I7; it += NGW) {
        if (it < I0) { const int r = it; tr_item(win, INC, 0, MIXC, WSP(bf16, WS_WIN), DM, 0, scr, r / 152, r % 152, F.lane); }
        else if (it < I1) { const int r = it - I0; tr_item(win, INC, MIXC, NGATE, WSP(bf16, WS_WIN), DM, MIXP, scr, r / 256, r % 256, F.lane); }
        else if (it < I2) { const int r = it - I1; const int k = r / 512, rr = r % 512; tr_item(INP(36) + ((size_t)l * 4 + k) * 512 * DM, DM, 0, DM, WSP(bf16, WS_WPK), 512, k * DM, scr, rr / 64, rr % 64, F.lane); }
        else if (it < I3) { const int r = it - I2; tr_item(INP(37) + (size_t)l * DM * DM, DM, 0, DM, WSP(bf16, WS_WOUT), DM, 0, scr, r / 64, r % 64, F.lane); }
        else if (it < I4) { const int r = it - I3; tr_item(INP(39) + (size_t)l * DM * FF, FF, 0, FF, WSP(bf16, WS_WFG), DM, 0, scr, r / 192, r % 192, F.lane); }
        else if (it < I5) { const int r = it - I4; tr_item(INP(40) + (size_t)l * DM * FF, FF, 0, FF, WSP(bf16, WS_WFU), DM, 0, scr, r / 192, r % 192, F.lane); }
        else if (it < I6) { const int r = it - I5; tr_item(INP(43) + (size_t)l * FF * DM, DM, 0, DM, WSP(bf16, WS_WFD), FF, 0, scr, r / 64, r % 64, F.lane); }
        else { const int r = it - I6; tr_item(INP(11) + (size_t)l * 512 * 512, 512, 0, 512, WSP(bf16, WS_WGLU), 512, 0, scr, r / 16, r % 16, F.lane); }
    }
}
__device__ __forceinline__ void rmsnorm_rows(Frame& F, const float* x, const float* g, bf16* obf, float* of32) {
    const int gw = F.blk * NWAVES + F.wave, NGW = F.G * NWAVES;
    f32x4 gv[8];
#pragma unroll
    for (int j = 0; j < 8; ++j) gv[j] = ((const f32x4*)g)[64 * j + F.lane];
    for (int m = gw; m < MTOK; m += NGW) {
        const f32x4* xr = (const f32x4*)(x + (size_t)m * DM) + F.lane;
        f32x4 v[8]; float s = 0.f;
#pragma unroll
        for (int j = 0; j < 8; ++j) { v[j] = xr[64 * j]; s += (v[j].x * v[j].x + v[j].y * v[j].y) + (v[j].z * v[j].z + v[j].w * v[j].w); }
        const float rs = 1.0f / sqrtf(wave_sum(s) * (1.f / DM) + 1e-6f);
        if (obf) { u32x2* o = (u32x2*)(obf + (size_t)m * DM) + F.lane;
#pragma unroll
            for (int j = 0; j < 8; ++j) { u32x2 w; w.x = pk2(v[j].x * rs * gv[j].x, v[j].y * rs * gv[j].y); w.y = pk2(v[j].z * rs * gv[j].z, v[j].w * rs * gv[j].w); o[64 * j] = w; } }
        else { f32x4* o = (f32x4*)(of32 + (size_t)m * DM) + F.lane;
#pragma unroll
            for (int j = 0; j < 8; ++j) o[64 * j] = v[j] * rs * gv[j]; }
    }
}

constexpr int WAVE_LDS = 16384;
constexpr int LR_XLD = 72, LR_FLD = 66, LR_ALD = 132;
constexpr int LR_XF = 16 * LR_XLD * 2, LR_AB = LR_XF + 16 * LR_FLD * 4;
template <bool FINAL> __device__ __forceinline__ void lru_task(Frame& F, int l, int task) {
    const int lane = F.lane, fr = lane & 15, fq = lane >> 4; const int b = task >> 9, h = (task >> 6) & 7, c = task & 63; const int ch = 64 * h + lane;
    LAS unsigned char* wl = F.lds + F.wave * WAVE_LDS;
    LAS bf16* XC = (LAS bf16*)wl; LAS float* XF = (LAS float*)(wl + LR_XF); LAS float* AB = (LAS float*)(wl + LR_AB);
    const float* WA = INP(14) + ((size_t)l * 8 + h) * 4096; const float* WX = INP(16) + ((size_t)l * 8 + h) * 4096;
    bf16x8 Wa[4][2], Wx[4][2];
#pragma unroll
    for (int nt = 0; nt < 4; ++nt)
#pragma unroll
        for (int kk = 0; kk < 2; ++kk) { const float* pa = WA + (size_t)(32 * kk + 8 * fq) * 64 + 16 * nt + fr; const float* px_ = WX + (size_t)(32 * kk + 8 * fq) * 64 + 16 * nt + fr;
            u32x4 wa_, wx_; wa_.x = pk2(pa[0], pa[64]); wa_.y = pk2(pa[128], pa[192]); wa_.z = pk2(pa[256], pa[320]); wa_.w = pk2(pa[384], pa[448]);
            wx_.x = pk2(px_[0], px_[64]); wx_.y = pk2(px_[128], px_[192]); wx_.z = pk2(px_[256], px_[320]); wx_.w = pk2(px_[384], px_[448]);
            Wa[nt][kk] = __builtin_bit_cast(bf16x8, wa_); Wx[nt][kk] = __builtin_bit_cast(bf16x8, wx_); }
    float ba4[4], bx4[4], sp4[4], slp[4];
#pragma unroll
    for (int nt = 0; nt < 4; ++nt) { const int jj = l * 512 + 64 * h + 16 * nt + fr; ba4[nt] = INP(15)[jj]; bx4[nt] = INP(17)[jj]; sp4[nt] = softplusf_(-INP(18)[jj]); slp[nt] = 0.f; }
    const float* cwp = INP(12) + (size_t)l * 4 * 512 + ch;
    const float cw0 = cwp[0], cw1 = cwp[512], cw2 = cwp[1024], cw3 = cwp[1536];
    const float cb = INP(13)[l * 512 + ch];
    const size_t row0 = (size_t)b * SEQ + (size_t)c * 128;
    const bf16* px = WSP(const bf16, WS_PROJ) + row0 * MIXP + PC_LRX + ch;
    const bf16* pg = WSP(const bf16, WS_PROJ) + row0 * MIXP + PC_LRG + ch;
    float xm3 = 0.f, xm2 = 0.f, xm1 = 0.f;
    if (c > 0) { xm3 = bf2f(*(px - 3 * (ptrdiff_t)MIXP)); xm2 = bf2f(*(px - 2 * (ptrdiff_t)MIXP)); xm1 = bf2f(*(px - (ptrdiff_t)MIXP)); }
    float hs = 0.f;
    const size_t cidx = ((size_t)b * 64 + c) * 512 + ch;
    if (FINAL) hs = WSP(const float, WS_LRI)[cidx];
    bf16* yo = WSP(bf16, WS_YK) + (size_t)1 * MTOK * 512 + row0 * 512 + ch;
    bf16 xs[16], gs[16];
#pragma unroll
    for (int j = 0; j < 16; ++j) { xs[j] = px[(size_t)j * MIXP]; if (FINAL) gs[j] = pg[(size_t)j * MIXP]; }
#pragma unroll 1
    for (int sb = 0; sb < 8; ++sb) {
#pragma unroll
        for (int t = 0; t < 16; ++t) { const float xv = bf2f(xs[t]); const float xc = cb + cw0 * xm3 + cw1 * xm2 + cw2 * xm1 + cw3 * xv; xm3 = xm2; xm2 = xm1; xm1 = xv;
            XC[t * LR_XLD + lane] = (bf16)f2bf(xc); XF[t * LR_FLD + lane] = xc; }
        float gl[16];
        if (FINAL) {
#pragma unroll
            for (int t = 0; t < 16; ++t) gl[t] = bf2f(gs[t]); }
        if (sb < 7) {
#pragma unroll
            for (int j = 0; j < 16; ++j) { xs[j] = px[(size_t)((sb + 1) * 16 + j) * MIXP]; if (FINAL) gs[j] = pg[(size_t)((sb + 1) * 16 + j) * MIXP]; } }
        const bf16x8 af0 = *(const LAS bf16x8*)(XC + fr * LR_XLD + 8 * fq), af1 = *(const LAS bf16x8*)(XC + fr * LR_XLD + 32 + 8 * fq);
#pragma unroll
        for (int nt = 0; nt < 4; ++nt) {
            f32x4 aa = (f32x4){0.f, 0.f, 0.f, 0.f}, ax = (f32x4){0.f, 0.f, 0.f, 0.f};
            aa = __builtin_amdgcn_mfma_f32_16x16x32_bf16(af0, Wa[nt][0], aa, 0, 0, 0); aa = __builtin_amdgcn_mfma_f32_16x16x32_bf16(af1, Wa[nt][1], aa, 0, 0, 0);
            ax = __builtin_amdgcn_mfma_f32_16x16x32_bf16(af0, Wx[nt][0], ax, 0, 0, 0); ax = __builtin_amdgcn_mfma_f32_16x16x32_bf16(af1, Wx[nt][1], ax, 0, 0, 0);
#pragma unroll
            for (int e = 0; e < 4; ++e) { const int t = 4 * fq + e, jj = 16 * nt + fr; const float xc = XF[t * LR_FLD + jj];
                const float r = sigmoidf_(aa[e] + ba4[nt]), ig = sigmoidf_(ax[e] + bx4[nt]); const float la = -8.0f * r * sp4[nt]; const float av = __expf(la);
                const float mult = __builtin_amdgcn_sqrtf(fmaxf(1.0f - av * av, 0.f));
                AB[t * LR_ALD + jj] = av; AB[t * LR_ALD + 64 + jj] = xc * ig * mult; if (!FINAL) slp[nt] += la; }
        }
#pragma unroll
        for (int t = 0; t < 16; ++t) { const float av = AB[t * LR_ALD + lane], bv = AB[t * LR_ALD + 64 + lane]; hs = av * hs + bv;
            if (FINAL) yo[(size_t)(sb * 16 + t) * 512] = (bf16)f2bf(hs * geluf_(gl[t])); }
    }
    if (!FINAL) { WSP(float, WS_LRE)[cidx] = hs;
#pragma unroll
        for (int nt = 0; nt < 4; ++nt) { float v = slp[nt]; v += __shfl_xor(v, 16); v += __shfl_xor(v, 32); if (fq == 0) WSP(float, WS_LRA)[((size_t)b * 64 + c) * 512 + 64 * h + 16 * nt + fr] = v; } }
}
__device__ __forceinline__ void lru_carry(Frame& F, int task) {
    const int b = task >> 3, ch = (task & 7) * 64 + F.lane; float run = 0.f;
#pragma unroll 1
    for (int c = 0; c < 64; ++c) { const size_t i = ((size_t)b * 64 + c) * 512 + ch; WSP(float, WS_LRI)[i] = run; run = __expf(WSP(const float, WS_LRA)[i]) * run + WSP(const float, WS_LRE)[i]; }
}

constexpr int S5_XLD = 132, S5_SLD = 136, S5_SB = 16 * S5_XLD * 4;
template <bool FINAL> __device__ __forceinline__ void s5_task(Frame& F, int l, int task) {
    const int lane = F.lane, fr = lane & 15, fq = lane >> 4; const int b = task >> 11, g = (task >> 6) & 31, c = task & 63; const int p = lane;
    LAS unsigned char* wl = F.lds + F.wave * WAVE_LDS;
    LAS float* X = (LAS float*)wl; LAS bf16* Sb = (LAS bf16*)(wl + S5_SB);
    const int lg = l * 32 + g;
    const float lr = INP(3)[lg * 64 + p], li = INP(4)[lg * 64 + p]; const float dt = expf(INP(10)[lg]);
    const float mag = expf(lr * dt); float sn, cs; sincosf(li * dt, &sn, &cs); const float abr = mag * cs, abi = mag * sn;
    const float den = lr * lr + li * li, nr = abr - 1.0f, ni = abi; const float fre = (nr * lr + ni * li) / den, fim = (ni * lr - nr * li) / den;
    bf16x8 Bf[8];
#pragma unroll
    for (int nq = 0; nq < 4; ++nq) { const int pp = 16 * nq + fr; const float fr_ = __shfl(fre, pp), fi_ = __shfl(fim, pp);
        u32x4 wr_ = (u32x4){0u, 0u, 0u, 0u}, wi_ = (u32x4){0u, 0u, 0u, 0u};
        if (fq < 2) { const f32x4* br = (const f32x4*)(INP(5) + ((size_t)lg * 64 + pp) * 16 + 8 * fq); const f32x4* bi = (const f32x4*)(INP(6) + ((size_t)lg * 64 + pp) * 16 + 8 * fq);
            const f32x4 r0 = br[0], r1 = br[1], i0 = bi[0], i1 = bi[1];
            wr_.x = pk2(fr_ * r0[0] - fi_ * i0[0], fr_ * r0[1] - fi_ * i0[1]); wr_.y = pk2(fr_ * r0[2] - fi_ * i0[2], fr_ * r0[3] - fi_ * i0[3]);
            wr_.z = pk2(fr_ * r1[0] - fi_ * i1[0], fr_ * r1[1] - fi_ * i1[1]); wr_.w = pk2(fr_ * r1[2] - fi_ * i1[2], fr_ * r1[3] - fi_ * i1[3]);
            wi_.x = pk2(fr_ * i0[0] + fi_ * r0[0], fr_ * i0[1] + fi_ * r0[1]); wi_.y = pk2(fr_ * i0[2] + fi_ * r0[2], fr_ * i0[3] + fi_ * r0[3]);
            wi_.z = pk2(fr_ * i1[0] + fi_ * r1[0], fr_ * i1[1] + fi_ * r1[1]); wi_.w = pk2(fr_ * i1[2] + fi_ * r1[2], fr_ * i1[3] + fi_ * r1[3]); }
        Bf[nq] = __builtin_bit_cast(bf16x8, wr_); Bf[nq + 4] = __builtin_bit_cast(bf16x8, wi_); }
    bf16x8 Cf[4], Df;
    if (FINAL) {
#pragma unroll
        for (int kk = 0; kk < 4; ++kk) { const float* src = (kk < 2 ? INP(7) : INP(8)) + ((size_t)lg * 16 + fr) * 64 + 32 * (kk & 1) + 8 * fq; const float sg = kk < 2 ? 1.0f : -1.0f;
            const f32x4 c0 = *(const f32x4*)src, c1 = *(const f32x4*)(src + 4);
            u32x4 w; w.x = pk2(sg * c0[0], sg * c0[1]); w.y = pk2(sg * c0[2], sg * c0[3]); w.z = pk2(sg * c1[0], sg * c1[1]); w.w = pk2(sg * c1[2], sg * c1[3]); Cf[kk] = __builtin_bit_cast(bf16x8, w); }
        const float dv = INP(9)[l * 512 + 16 * g + fr]; float dd[8];
#pragma unroll
        for (int j = 0; j < 8; ++j) dd[j] = (8 * fq + j == fr) ? dv : 0.f;
        u32x4 w; w.x = pk2(dd[0], dd[1]); w.y = pk2(dd[2], dd[3]); w.z = pk2(dd[4], dd[5]); w.w = pk2(dd[6], dd[7]); Df = __builtin_bit_cast(bf16x8, w);
    }
    float sre = 0.f, sim = 0.f;
    const size_t sidx = (((size_t)b * 32 + g) * 64 + c) * 128 + p;
    if (FINAL) { sre = WSP(const float, WS_S5I)[sidx]; sim = WSP(const float, WS_S5I)[sidx + 64]; }
    const size_t row0 = (size_t)b * SEQ + (size_t)c * 128;
    const bf16* up = WSP(const bf16, WS_PROJ) + (row0 + fr) * MIXP + PC_S5U + 16 * g + 8 * (fq & 1);
    u32x4 aun = *(const u32x4*)up;
#pragma unroll 1
    for (int sb = 0; sb < 8; ++sb) {
        u32x4 au_ = aun; if (fq >= 2) au_ = (u32x4){0u, 0u, 0u, 0u};
        const bf16x8 au = __builtin_bit_cast(bf16x8, au_);
        if (sb < 7) aun = *(const u32x4*)(up + (size_t)(sb + 1) * 16 * MIXP);
#pragma unroll
        for (int nt = 0; nt < 8; ++nt) { const f32x4 a = __builtin_amdgcn_mfma_f32_16x16x32_bf16(au, Bf[nt], (f32x4){0.f, 0.f, 0.f, 0.f}, 0, 0, 0);
#pragma unroll
            for (int e = 0; e < 4; ++e) X[(4 * fq + e) * S5_XLD + 16 * nt + fr] = a[e]; }
#pragma unroll
        for (int t = 0; t < 16; ++t) { const float xr = X[t * S5_XLD + p], xi = X[t * S5_XLD + 64 + p];
            const float nre = abr * sre - abi * sim + xr, nim = abr * sim + abi * sre + xi; sre = nre; sim = nim;
            if (FINAL) { Sb[t * S5_SLD + p] = (bf16)f2bf(sre); Sb[t * S5_SLD + 64 + p] = (bf16)f2bf(sim); } }
        if (FINAL) {
            f32x4 y = (f32x4){0.f, 0.f, 0.f, 0.f};
#pragma unroll
            for (int kk = 0; kk < 4; ++kk) y = __builtin_amdgcn_mfma_f32_16x16x32_bf16(*(const LAS bf16x8*)(Sb + fr * S5_SLD + 32 * kk + 8 * fq), Cf[kk], y, 0, 0, 0);
            y = __builtin_amdgcn_mfma_f32_16x16x32_bf16(au, Df, y, 0, 0, 0);
#pragma unroll
            for (int e = 0; e < 4; ++e) WSP(bf16, WS_S5Z)[(row0 + sb * 16 + 4 * fq + e) * 512 + 16 * g + fr] = (bf16)f2bf(geluf_(y[e]));
        }
    }
    if (!FINAL) { WSP(float, WS_S5E)[sidx] = sre; WSP(float, WS_S5E)[sidx + 64] = sim; }
}
__device__ __forceinline__ void s5_carry(Frame& F, int l, int task) {
    const int b = task >> 5, g = task & 31, p = F.lane;
    const float lr = INP(3)[(l * 32 + g) * 64 + p], li = INP(4)[(l * 32 + g) * 64 + p]; const float dt = expf(INP(10)[l * 32 + g]);
    const float mag = expf(lr * dt); float sn, cs; sincosf(li * dt, &sn, &cs); float ar = mag * cs, ai = mag * sn;
#pragma unroll
    for (int i = 0; i < 7; ++i) { const float nr = ar * ar - ai * ai, ni = 2.0f * ar * ai; ar = nr; ai = ni; }
    float rr = 0.f, ri = 0.f;
#pragma unroll 1
    for (int c = 0; c < 64; ++c) { const size_t i = (((size_t)b * 32 + g) * 64 + c) * 128 + p;
        WSP(float, WS_S5I)[i] = rr; WSP(float, WS_S5I)[i + 64] = ri;
        const float er = WSP(const float, WS_S5E)[i], ei = WSP(const float, WS_S5E)[i + 64];
        const float nr = ar * rr - ai * ri + er, ni = ar * ri + ai * rr + ei; rr = nr; ri = ni; }
}

constexpr int M2_CS = 0, M2_BS = 17408, M2_BST = 34816, M2_XT = 53248, M2_GS = 90112, M2_CUM = 107520, M2_DTV = 108544, M2_END = 109568;
constexpr int LDP = 136, LDT = 72, LDG = 68;
__device__ __forceinline__ void m2_stage(Frame& F, int l, int b, int c, int gr) {
    LAS bf16* Cs = (LAS bf16*)(F.lds + M2_CS); LAS bf16* Bs = (LAS bf16*)(F.lds + M2_BS); LAS bf16* BsT = (LAS bf16*)(F.lds + M2_BST); LAS bf16* XT = (LAS bf16*)(F.lds + M2_XT);
    LAS float* cum = (LAS float*)(F.lds + M2_CUM); LAS float* dtv = (LAS float*)(F.lds + M2_DTV);
    const int tid = F.tid; const size_t row0 = (size_t)b * SEQ + (size_t)c * 64;
    {
        const int kind = tid < 256 ? 0 : (tid < 384 ? 1 : 2); const int idx = kind == 0 ? tid : (kind == 1 ? tid - 256 : tid - 384);
        const int col = kind == 0 ? 256 * gr + idx : (kind == 1 ? 512 + 128 * gr + idx : 768 + 128 * gr + idx);
        const float* cwp = INP(19) + (size_t)l * 4 * 1024 + col; const float cw0 = cwp[0], cw1 = cwp[1024], cw2 = cwp[2048], cw3 = cwp[3072]; const float cb = INP(20)[l * 1024 + col];
        const bf16* px = WSP(const bf16, WS_PROJ) + row0 * MIXP + PC_XBC + col;
        float xm3 = 0.f, xm2 = 0.f, xm1 = 0.f;
        if (c > 0) { xm3 = bf2f(*(px - 3 * (ptrdiff_t)MIXP)); xm2 = bf2f(*(px - 2 * (ptrdiff_t)MIXP)); xm1 = bf2f(*(px - (ptrdiff_t)MIXP)); }
        bf16 xall[64];
#pragma unroll
        for (int j = 0; j < 64; ++j) xall[j] = px[(size_t)j * MIXP];
#pragma unroll
        for (int tb = 0; tb < 8; ++tb) {
            float vv[8];
#pragma unroll
            for (int j = 0; j < 8; ++j) { const float xv = bf2f(xall[tb * 8 + j]);
                vv[j] = siluf_(cb + cw0 * xm3 + cw1 * xm2 + cw2 * xm1 + cw3 * xv); xm3 = xm2; xm2 = xm1; xm1 = xv; }
            u32x4 w; w.x = pk2(vv[0], vv[1]); w.y = pk2(vv[2], vv[3]); w.z = pk2(vv[4], vv[5]); w.w = pk2(vv[6], vv[7]);
            if (kind == 0) *(LAS u32x4*)(XT + idx * LDT + tb * 8) = w;
            else if (kind == 1) { *(LAS u32x4*)(BsT + idx * LDT + tb * 8) = w;
#pragma unroll
                for (int j = 0; j < 8; ++j) Bs[(tb * 8 + j) * LDP + idx] = (bf16)f2bf(vv[j]); }
            else {
#pragma unroll
                for (int j = 0; j < 8; ++j) Cs[(tb * 8 + j) * LDP + idx] = (bf16)f2bf(vv[j]); }
        }
    }
    if (tid < 256) { const int hh = tid >> 6, t = tid & 63, h = 4 * gr + hh;
        const float dtr = bf2f(WSP(const bf16, WS_PROJ)[(row0 + t) * MIXP + PC_DT + h]);
        const float dt = softplusf_(dtr + INP(21)[l * 8 + h]); const float a = -expf(INP(22)[l * 8 + h]);
        float s = dt * a;
#pragma unroll
        for (int o = 1; o < 64; o <<= 1) { const float n = __shfl_up(s, o); if (t >= o) s += n; }
        dtv[hh * 64 + t] = dt; cum[hh * 64 + t] = s; }
    __syncthreads();
}
__device__ __forceinline__ bf16x8 ldfrag(const LAS bf16* p) { return *(const LAS bf16x8*)p; }
__device__ __forceinline__ void m2_pass1(Frame& F, int l, int task) {
    const int b = task >> 8, c = (task >> 1) & 127, gr = task & 1;
    m2_stage(F, l, b, c, gr);
    LAS bf16* BsT = (LAS bf16*)(F.lds + M2_BST); LAS bf16* XT = (LAS bf16*)(F.lds + M2_XT); LAS float* cum = (LAS float*)(F.lds + M2_CUM); LAS float* dtv = (LAS float*)(F.lds + M2_DTV);
    const int lane = F.lane, hh = F.wave >> 1, half = F.wave & 1, h = 4 * gr + hh; const int fr = lane & 15, fq = lane >> 4;
    const float clast = cum[hh * 64 + 63];
    f32x4 acc[2][8];
#pragma unroll
    for (int i = 0; i < 2; ++i)
#pragma unroll
        for (int j = 0; j < 8; ++j) acc[i][j] = (f32x4){0.f, 0.f, 0.f, 0.f};
#pragma unroll
    for (int kk = 0; kk < 2; ++kk) {
        float fj[8];
#pragma unroll
        for (int e = 0; e < 8; ++e) { const int j = 32 * kk + 8 * fq + e; fj[e] = dtv[hh * 64 + j] * __expf(clast - cum[hh * 64 + j]); }
        bf16x8 af[2];
#pragma unroll
        for (int pi = 0; pi < 2; ++pi) { const int p = 16 * (2 * half + pi) + fr; const u32x4 raw = *(const LAS u32x4*)(XT + (64 * hh + p) * LDT + 32 * kk + 8 * fq);
            u32x4 w; w.x = pk2(lo16(raw.x) * fj[0], hi16(raw.x) * fj[1]); w.y = pk2(lo16(raw.y) * fj[2], hi16(raw.y) * fj[3]); w.z = pk2(lo16(raw.z) * fj[4], hi16(raw.z) * fj[5]); w.w = pk2(lo16(raw.w) * fj[6], hi16(raw.w) * fj[7]);
            af[pi] = __builtin_bit_cast(bf16x8, w); }
#pragma unroll
        for (int nt = 0; nt < 8; ++nt) { const bf16x8 bfr = ldfrag(BsT + (16 * nt + fr) * LDT + 32 * kk + 8 * fq);
#pragma unroll
            for (int pi = 0; pi < 2; ++pi) acc[pi][nt] = __builtin_amdgcn_mfma_f32_16x16x32_bf16(af[pi], bfr, acc[pi][nt], 0, 0, 0); }
    }
    bf16* S = WSP(bf16, WS_M2S) + ((((size_t)b * 128 + c) * 8 + h) * 64) * 128;
#pragma unroll
    for (int pi = 0; pi < 2; ++pi)
#pragma unroll
        for (int nt = 0; nt < 8; ++nt)
#pragma unroll
            for (int e = 0; e < 4; ++e) S[(size_t)(16 * (2 * half + pi) + 4 * fq + e) * 128 + 16 * nt + fr] = (bf16)f2bf(acc[pi][nt][e]);
    if (half == 0 && lane == 0) WSP(float, WS_M2D)[((size_t)b * 128 + c) * 8 + h] = __expf(clast);
    __syncthreads();
}
__device__ __forceinline__ void m2_carry(Frame& F) {
    const int gt = F.blk * NTHR + F.tid;
    for (int e = gt; e < NB * 8 * 8192; e += F.G * NTHR) {
        const int b = e >> 16, h = (e >> 13) & 7, pn = e & 8191; float run = 0.f;
        bf16* S = WSP(bf16, WS_M2S) + (((size_t)b * 128) * 8 + h) * 8192 + pn; const float* D = WSP(const float, WS_M2D) + (size_t)b * 128 * 8 + h;
#pragma unroll 1
        for (int c8 = 0; c8 < 16; ++c8) {
            float tv[8], dv[8];
#pragma unroll
            for (int j = 0; j < 8; ++j) { tv[j] = bf2f(S[(size_t)(c8 * 8 + j) * 8 * 8192]); dv[j] = D[(c8 * 8 + j) * 8]; }
#pragma unroll
            for (int j = 0; j < 8; ++j) { S[(size_t)(c8 * 8 + j) * 8 * 8192] = (bf16)f2bf(run); run = dv[j] * run + tv[j]; }
        }
    }
}
__device__ __forceinline__ void m2_pass2(Frame& F, int l, int task) {
    const int b = task >> 8, c = (task >> 1) & 127, gr = task & 1;
    m2_stage(F, l, b, c, gr);
    LAS bf16* Cs = (LAS bf16*)(F.lds + M2_CS); LAS bf16* Bs = (LAS bf16*)(F.lds + M2_BS); LAS bf16* XT = (LAS bf16*)(F.lds + M2_XT);
    LAS float* Gs = (LAS float*)(F.lds + M2_GS); LAS float* cum = (LAS float*)(F.lds + M2_CUM); LAS float* dtv = (LAS float*)(F.lds + M2_DTV);
    const int lane = F.lane, w = F.wave, fr = lane & 15, fq = lane >> 4;
#pragma unroll
    for (int q = 0; q < 2; ++q) { const int tile = 2 * w + q, it = tile >> 2, jt = tile & 3; f32x4 a = (f32x4){0.f, 0.f, 0.f, 0.f};
#pragma unroll
        for (int kk = 0; kk < 4; ++kk) a = __builtin_amdgcn_mfma_f32_16x16x32_bf16(ldfrag(Cs + (16 * it + fr) * LDP + 32 * kk + 8 * fq), ldfrag(Bs + (16 * jt + fr) * LDP + 32 * kk + 8 * fq), a, 0, 0, 0);
#pragma unroll
        for (int e = 0; e < 4; ++e) Gs[(16 * it + 4 * fq + e) * LDG + 16 * jt + fr] = a[e]; }
    __syncthreads();
    const int hh = w >> 1, half = w & 1, h = 4 * gr + hh;
    f32x4 accd[2][4], acco[2][4];
#pragma unroll
    for (int i = 0; i < 2; ++i)
#pragma unroll
        for (int j = 0; j < 4; ++j) { accd[i][j] = (f32x4){0.f, 0.f, 0.f, 0.f}; acco[i][j] = (f32x4){0.f, 0.f, 0.f, 0.f}; }
#pragma unroll
    for (int ii = 0; ii < 2; ++ii) { const int it = 2 * half + ii; const int i = 16 * it + fr; const float ci = cum[hh * 64 + i];
#pragma unroll
        for (int kk = 0; kk < 2; ++kk) { if (32 * kk > 16 * it + 15) continue;
            float wv[8];
#pragma unroll
            for (int e = 0; e < 8; ++e) { const int j = 32 * kk + 8 * fq + e; const float gv = Gs[i * LDG + j]; wv[e] = (j <= i) ? gv * __expf(ci - cum[hh * 64 + j]) * dtv[hh * 64 + j] : 0.f; }
            u32x4 ww; ww.x = pk2(wv[0], wv[1]); ww.y = pk2(wv[2], wv[3]); ww.z = pk2(wv[4], wv[5]); ww.w = pk2(wv[6], wv[7]);
            const bf16x8 af = __builtin_bit_cast(bf16x8, ww);
#pragma unroll
            for (int pt = 0; pt < 4; ++pt) accd[ii][pt] = __builtin_amdgcn_mfma_f32_16x16x32_bf16(af, ldfrag(XT + (64 * hh + 16 * pt + fr) * LDT + 32 * kk + 8 * fq), accd[ii][pt], 0, 0, 0); } }
    const bf16* S = WSP(const bf16, WS_M2S) + ((((size_t)b * 128 + c) * 8 + h) * 64) * 128;
#pragma unroll
    for (int kk = 0; kk < 4; ++kk) {
        bf16x8 bfr[4];
#pragma unroll
        for (int pt = 0; pt < 4; ++pt) bfr[pt] = *(const bf16x8*)(S + (size_t)(16 * pt + fr) * 128 + 32 * kk + 8 * fq);
#pragma unroll
        for (int ii = 0; ii < 2; ++ii) { const bf16x8 af = ldfrag(Cs + (16 * (2 * half + ii) + fr) * LDP + 32 * kk + 8 * fq);
#pragma unroll
            for (int pt = 0; pt < 4; ++pt) acco[ii][pt] = __builtin_amdgcn_mfma_f32_16x16x32_bf16(af, bfr[pt], acco[ii][pt], 0, 0, 0); }
    }
    const float dpar = INP(23)[l * 8 + h]; const size_t row0 = (size_t)b * SEQ + (size_t)c * 64;
#pragma unroll
    for (int ii = 0; ii < 2; ++ii)
#pragma unroll
        for (int e = 0; e < 4; ++e) { const int i = 16 * (2 * half + ii) + 4 * fq + e; const float ec = __expf(cum[hh * 64 + i]);
#pragma unroll
            for (int pt = 0; pt < 4; ++pt) { const int p = 16 * pt + fr;
                float y = accd[ii][pt][e] + ec * acco[ii][pt][e] + dpar * bf2f(XT[(64 * hh + p) * LDT + i]);
                const float z = bf2f(WSP(const bf16, WS_PROJ)[(row0 + i) * MIXP + PC_M2Z + 64 * h + p]);
                WSP(float, WS_M2Y)[(row0 + i) * 512 + 64 * h + p] = y * siluf_(z); } }
    __syncthreads();
}
__device__ __forceinline__ void m2_norm(Frame& F, int l, int gw, int ngw) {
    f32x4 g0 = *(const f32x4*)(INP(24) + l * 512 + 8 * F.lane), g1 = *(const f32x4*)(INP(24) + l * 512 + 8 * F.lane + 4);
    for (int m = gw; m < MTOK; m += ngw) { const f32x4* yp = (const f32x4*)(WSP(const float, WS_M2Y) + (size_t)m * 512 + 8 * F.lane); const f32x4 a = yp[0], b = yp[1];
        const float ss = wave_sum((a.x * a.x + a.y * a.y) + (a.z * a.z + a.w * a.w) + (b.x * b.x + b.y * b.y) + (b.z * b.z + b.w * b.w));
        const float rs = 1.0f / sqrtf(ss * (1.f / 512.f) + 1e-6f);
        u32x4 w; w.x = pk2(a.x * rs * g0.x, a.y * rs * g0.y); w.y = pk2(a.z * rs * g0.z, a.w * rs * g0.w); w.z = pk2(b.x * rs * g1.x, b.y * rs * g1.y); w.w = pk2(b.z * rs * g1.z, b.w * rs * g1.w);
        *(u32x4*)(WSP(bf16, WS_YK) + (size_t)2 * MTOK * 512 + (size_t)m * 512 + 8 * F.lane) = w; }
}

constexpr int RP_LDA = 72, RP_LDB = 104;
#define RWP_WFRAG(dst, base, ldrow) do { const float* p_ = (base); u32x4 w_; w_.x = pk2(p_[0], p_[512]); w_.y = pk2(p_[1024], p_[1536]); w_.z = pk2(p_[2048], p_[2560]); w_.w = pk2(p_[3072], p_[3584]); dst = __builtin_bit_cast(bf16x8, w_); } while (0)
__device__ __forceinline__ void rw_pre(Frame& F, int l, int task) {
    LAS bf16* SM0 = (LAS bf16*)F.lds;
    const int tid = F.tid, lane = F.lane, hh = F.wave, fr = lane & 15, fq = lane >> 4;
    const float* mu = INP(25) + (size_t)l * RWC;
    const size_t rowb = (size_t)task * 128;
    const bf16* P = WSP(const bf16, WS_PROJ);
    const bool nofirst = (rowb & (SEQ - 1)) != 0;
    const int c4 = 64 * hh + 4 * fr;
    {
        bf16x8 Bw[4], Ba[4];
#pragma unroll
        for (int ct = 0; ct < 4; ++ct) { RWP_WFRAG(Bw[ct], INP(27) + ((size_t)l * 32 + 8 * fq) * 512 + c4 + ct, 512); RWP_WFRAG(Ba[ct], INP(29) + ((size_t)l * 32 + 8 * fq) * 512 + c4 + ct, 512); }
        const float* pw0 = INP(26) + l * 512 + c4; const float* pa0 = INP(28) + l * 512 + c4; const float* pkk = INP(31) + l * 512 + c4; const float* pka = INP(32) + l * 512 + c4; const float* prk = INP(33) + l * 512 + c4;
        const int sj = tid & 63, st0 = tid >> 6, st1 = 8 + (tid >> 6); const float smu = mu[1536 + sj];
        const bf16* sq = P + rowb * MIXP + PC_RW + 1536 + sj;
        bf16 sc0, sp0, sc1, sp1;
        u32x2 rkv[4][3], rkvp[3];
        const bf16* rq = P + (rowb + 4 * fq) * MIXP + PC_RW + c4;
#define RWP_STAGE_LOAD(sb) do { const size_t o_ = (size_t)((sb) * 16) * MIXP; sc0 = sq[o_ + (size_t)st0 * MIXP]; sc1 = sq[o_ + (size_t)st1 * MIXP]; sp1 = sq[o_ + (size_t)(st1 - 1) * MIXP]; \
            sp0 = (nofirst || (sb) > 0 || st0 > 0) ? sq[o_ + (size_t)st0 * MIXP - MIXP] : (bf16)0; } while (0)
#define RWP_STAGE_WRITE(buf) do { { const float pt_ = bf2f(sc0), pp_ = bf2f(sp0); const float pm_ = pt_ + (pp_ - pt_) * smu; SM0[(buf) * 1664 + st0 * RP_LDA + sj] = (bf16)f2bf(sj < 32 ? (1.0f - 2.0f * rcpf_(__expf(2.0f * pm_) + 1.0f)) : pm_); } \
            { const float pt_ = bf2f(sc1), pp_ = bf2f(sp1); const float pm_ = pt_ + (pp_ - pt_) * smu; SM0[(buf) * 1664 + st1 * RP_LDA + sj] = (bf16)f2bf(sj < 32 ? (1.0f - 2.0f * rcpf_(__expf(2.0f * pm_) + 1.0f)) : pm_); } } while (0)
#define RWP_RKV_LOAD(sb, cur, prev) do { const bf16* q_ = rq + (size_t)((sb) * 16) * MIXP; \
            _Pragma("unroll") for (int e_ = 0; e_ < 4; ++e_) _Pragma("unroll") for (int a_ = 0; a_ < 3; ++a_) cur[e_][a_] = *(const u32x2*)(q_ + (size_t)e_ * MIXP + 512 * a_); \
            const bool hp_ = nofirst || (sb) > 0 || fq > 0; \
            _Pragma("unroll") for (int a_ = 0; a_ < 3; ++a_) prev[a_] = hp_ ? *(const u32x2*)(q_ - (ptrdiff_t)MIXP + 512 * a_) : (u32x2){0u, 0u}; } while (0)
        RWP_STAGE_LOAD(0); RWP_RKV_LOAD(0, rkv, rkvp); RWP_STAGE_WRITE(0);
        __syncthreads();
#pragma unroll 1
        for (int sb = 0; sb < 8; ++sb) {
            if (sb < 7) { RWP_STAGE_LOAD(sb + 1); }
            const LAS bf16* SM = SM0 + (sb & 1) * 1664;
            const bf16x8 Aw = ldfrag(SM + fr * RP_LDA + 8 * fq), Aa = ldfrag(SM + fr * RP_LDA + 32 + 8 * fq);
            f32x4 aw[4], aa[4];
#pragma unroll
            for (int ct = 0; ct < 4; ++ct) { const f32x4 z = (f32x4){0.f, 0.f, 0.f, 0.f};
                aw[ct] = __builtin_amdgcn_mfma_f32_16x16x32_bf16(Aw, Bw[ct], z, 0, 0, 0); aa[ct] = __builtin_amdgcn_mfma_f32_16x16x32_bf16(Aa, Ba[ct], z, 0, 0, 0); }
            const size_t r0 = rowb + sb * 16 + 4 * fq;
            asm volatile("" ::: "memory");
            const f32x4 mu_r = *(const f32x4*)(mu + c4), mu_k = *(const f32x4*)(mu + 512 + c4), mu_v = *(const f32x4*)(mu + 1024 + c4);
            const f32x4 w0c = *(const f32x4*)pw0, a0c = *(const f32x4*)pa0, kkc = *(const f32x4*)pkk, kac = *(const f32x4*)pka, rkc = *(const f32x4*)prk;
#pragma unroll
            for (int e = 0; e < 4; ++e) { const size_t row = r0 + e; const size_t o = row * 512 + c4;
                const u32x2 pr_ = e == 0 ? rkvp[0] : rkv[e > 0 ? e - 1 : 0][0], pk_ = e == 0 ? rkvp[1] : rkv[e > 0 ? e - 1 : 0][1], pv_ = e == 0 ? rkvp[2] : rkv[e > 0 ? e - 1 : 0][2];
                const float rc[4] = {lo16(rkv[e][0].x), hi16(rkv[e][0].x), lo16(rkv[e][0].y), hi16(rkv[e][0].y)}, rp[4] = {lo16(pr_.x), hi16(pr_.x), lo16(pr_.y), hi16(pr_.y)};
                const float kc[4] = {lo16(rkv[e][1].x), hi16(rkv[e][1].x), lo16(rkv[e][1].y), hi16(rkv[e][1].y)}, kp[4] = {lo16(pk_.x), hi16(pk_.x), lo16(pk_.y), hi16(pk_.y)};
                const float vc[4] = {lo16(rkv[e][2].x), hi16(rkv[e][2].x), lo16(rkv[e][2].y), hi16(rkv[e][2].y)}, vp[4] = {lo16(pv_.x), hi16(pv_.x), lo16(pv_.y), hi16(pv_.y)};
                float rr[4], kpr[4], vv[4], kk[4], av[4], dec[4]; float ssp = 0.f, bonp = 0.f;
#pragma unroll
                for (int ct = 0; ct < 4; ++ct) {
                    rr[ct] = rc[ct] + (rp[ct] - rc[ct]) * mu_r[ct]; const float k = kc[ct] + (kp[ct] - kc[ct]) * mu_k[ct]; vv[ct] = vc[ct] + (vp[ct] - vc[ct]) * mu_v[ct];
                    const float wlog = -softplusf_(-(aw[ct][e] + w0c[ct])) - 0.5f; dec[ct] = __expf(-__expf(wlog)); av[ct] = sigmoidf_(aa[ct][e] + a0c[ct]);
                    kk[ct] = k * kkc[ct]; ssp += kk[ct] * kk[ct]; kpr[ct] = k * (1.0f + (av[ct] - 1.0f) * kac[ct]); bonp += rr[ct] * kpr[ct] * rkc[ct]; }
                const float ss = row16_sum(ssp), bon = row16_sum(bonp); const float rn = __builtin_amdgcn_rsqf(fmaxf(ss, 1e-24f));
                u32x2 w;
                w.x = pk2(rr[0], rr[1]); w.y = pk2(rr[2], rr[3]); *(u32x2*)(WSP(bf16, WS_RW_R) + o) = w;
                w.x = pk2(kpr[0], kpr[1]); w.y = pk2(kpr[2], kpr[3]); *(u32x2*)(WSP(bf16, WS_RW_K) + o) = w;
                w.x = pk2(vv[0], vv[1]); w.y = pk2(vv[2], vv[3]); *(u32x2*)(WSP(bf16, WS_RW_V) + o) = w;
                w.x = pk2(-kk[0] * rn, -kk[1] * rn); w.y = pk2(-kk[2] * rn, -kk[3] * rn); *(u32x2*)(WSP(bf16, WS_RW_A) + o) = w;
                w.x = pk2(kk[0] * rn * av[0], kk[1] * rn * av[1]); w.y = pk2(kk[2] * rn * av[2], kk[3] * rn * av[3]); *(u32x2*)(WSP(bf16, WS_RW_B) + o) = w;
                *(f32x4*)(WSP(float, WS_RW_DEC) + o) = (f32x4){dec[0], dec[1], dec[2], dec[3]};
                if (fr == 0) WSP(float, WS_RW_BON)[row * 8 + hh] = bon; }
            if (sb < 7) { RWP_RKV_LOAD(sb + 1, rkv, rkvp); RWP_STAGE_WRITE((sb + 1) & 1); }
            __syncthreads();
        }
#undef RWP_STAGE_LOAD
#undef RWP_STAGE_WRITE
#undef RWP_RKV_LOAD
    }
    {
        int tidb = F.tid; asm volatile("" : "+v"(tidb));
        const int tid = tidb, lane = tid & 63, fr = lane & 15, fq = lane >> 4; const int c4 = 64 * hh + 4 * fr;
        bf16x8 Bg[4][3];
#pragma unroll
        for (int ct = 0; ct < 4; ++ct)
#pragma unroll
            for (int kk = 0; kk < 3; ++kk) RWP_WFRAG(Bg[ct][kk], INP(30) + ((size_t)l * 96 + 32 * kk + 8 * fq) * 512 + c4 + ct, 512);
        int stk[3], sjj[3]; float smv[3]; bf16 sc[3], sp[3];
#pragma unroll
        for (int i = 0; i < 3; ++i) { const int idx = tid + 512 * i; stk[i] = idx / 96; sjj[i] = idx % 96; smv[i] = mu[1600 + sjj[i]]; }
        const bf16* sq = P + rowb * MIXP + PC_RW + 1600;
#define RWP_STAGE_LOAD(sb) do { _Pragma("unroll") for (int i_ = 0; i_ < 3; ++i_) { const bf16* q_ = sq + (size_t)((sb) * 16 + stk[i_]) * MIXP + sjj[i_]; sc[i_] = q_[0]; \
            sp[i_] = (nofirst || (sb) > 0 || stk[i_] > 0) ? *(q_ - (ptrdiff_t)MIXP) : (bf16)0; } } while (0)
#define RWP_STAGE_WRITE(buf) do { _Pragma("unroll") for (int i_ = 0; i_ < 3; ++i_) { const float pt_ = bf2f(sc[i_]), pp_ = bf2f(sp[i_]); \
            SM0[(buf) * 1664 + stk[i_] * RP_LDB + sjj[i_]] = (bf16)f2bf(sigmoidf_(pt_ + (pp_ - pt_) * smv[i_])); } } while (0)
        RWP_STAGE_LOAD(0); RWP_STAGE_WRITE(0);
        __syncthreads();
#pragma unroll 1
        for (int sb = 0; sb < 8; ++sb) {
            if (sb < 7) RWP_STAGE_LOAD(sb + 1);
            const LAS bf16* SM = SM0 + (sb & 1) * 1664;
            const bf16x8 Ag0 = ldfrag(SM + fr * RP_LDB + 8 * fq), Ag1 = ldfrag(SM + fr * RP_LDB + 32 + 8 * fq), Ag2 = ldfrag(SM + fr * RP_LDB + 64 + 8 * fq);
            f32x4 ag[4];
#pragma unroll
            for (int ct = 0; ct < 4; ++ct) { f32x4 g = __builtin_amdgcn_mfma_f32_16x16x32_bf16(Ag0, Bg[ct][0], (f32x4){0.f, 0.f, 0.f, 0.f}, 0, 0, 0);
                g = __builtin_amdgcn_mfma_f32_16x16x32_bf16(Ag1, Bg[ct][1], g, 0, 0, 0); ag[ct] = __builtin_amdgcn_mfma_f32_16x16x32_bf16(Ag2, Bg[ct][2], g, 0, 0, 0); }
            const size_t r0 = rowb + sb * 16 + 4 * fq;
#pragma unroll
            for (int e = 0; e < 4; ++e) { u32x2 w; w.x = pk2(ag[0][e], ag[1][e]); w.y = pk2(ag[2][e], ag[3][e]); *(u32x2*)(WSP(bf16, WS_RW_G) + (r0 + e) * 512 + c4) = w; }
            if (sb < 7) RWP_STAGE_WRITE((sb + 1) & 1);
            __syncthreads();
        }
#undef RWP_STAGE_LOAD
#undef RWP_STAGE_WRITE
    }
}
constexpr int RC_G1 = 0, RC_G2 = 8192, RC_Q1 = 10240, RC_Q2 = 12288, RC_GAM = 13312, RC_VT = 13568, RC_BYTES = 16384;
constexpr size_t WS_RWC = WS_PROJ;
constexpr int CP_IMG = 0, CP_MAT = 9216, CP_P2 = 13568, CP_Q2 = 14656;
constexpr int CP_P1I = 0, CP_BGI = 3072, CP_Q1I = 6144;
__device__ __forceinline__ void rw_chunk_prep(Frame& F, int task) {
    int lane = F.lane; asm volatile("" : "+v"(lane)); const int fr = lane & 15, fq = lane >> 4; const int b = task >> 12, h = (task >> 9) & 7, c = task & 511;
    LAS unsigned char* wl = F.lds + F.wave * WAVE_LDS;
    LAS bf16* IMG = (LAS bf16*)(wl + CP_IMG); LAS float* MAT = (LAS float*)(wl + CP_MAT); LAS float* P2m = (LAS float*)(wl + CP_P2); LAS float* Q2m = (LAS float*)(wl + CP_Q2);
    unsigned char* rec = F.ws + WS_RWC + (size_t)task * RC_BYTES;
    const size_t e0 = ((size_t)b * SEQ + (size_t)c * 16) * 512 + 64 * h + lane;
    float At[16], Bt[16], Kt[16], Rt[16]; float gT;
    { float wv[16]; bf16 av[16], bv[16], kv[16], rv[16];
#pragma unroll
      for (int t = 0; t < 16; ++t) { const size_t o = e0 + (size_t)t * 512; wv[t] = WSP(const float, WS_RW_DEC)[o]; av[t] = WSP(const bf16, WS_RW_A)[o]; bv[t] = WSP(const bf16, WS_RW_B)[o]; kv[t] = WSP(const bf16, WS_RW_K)[o]; rv[t] = WSP(const bf16, WS_RW_R)[o]; }
      float g = 1.0f;
#pragma unroll
      for (int t = 0; t < 16; ++t) { const float gp = g; g *= wv[t]; const float inv = rcpf_(g);
          At[t] = bf2f(av[t]) * gp; Bt[t] = bf2f(bv[t]) * inv; Kt[t] = bf2f(kv[t]) * inv; Rt[t] = bf2f(rv[t]) * g;
          IMG[0 * 1152 + t * 72 + lane] = (bf16)f2bf(At[t]); IMG[1 * 1152 + t * 72 + lane] = (bf16)f2bf(Bt[t]); IMG[2 * 1152 + t * 72 + lane] = (bf16)f2bf(Kt[t]); IMG[3 * 1152 + t * 72 + lane] = (bf16)f2bf(Rt[t]); }
      gT = g; }
    { unsigned vp[8];
#pragma unroll
      for (int t = 0; t < 16; t += 2) vp[t >> 1] = (unsigned)WSP(const bf16, WS_RW_V)[e0 + (size_t)t * 512] | ((unsigned)WSP(const bf16, WS_RW_V)[e0 + (size_t)(t + 1) * 512] << 16);
      u32x4* d = (u32x4*)(rec + RC_VT + lane * 32); d[0] = (u32x4){vp[0], vp[1], vp[2], vp[3]}; d[1] = (u32x4){vp[4], vp[5], vp[6], vp[7]};
      ((float*)(rec + RC_GAM))[lane] = gT; }
    { f32x4 nab = (f32x4){0.f, 0.f, 0.f, 0.f}, nak = nab, mbr = nab, mkr = nab;
#pragma unroll
      for (int kk = 0; kk < 2; ++kk) { const int o = fr * 72 + 32 * kk + 8 * fq;
          const bf16x8 fa = ldfrag(IMG + 0 * 1152 + o), fb = ldfrag(IMG + 1 * 1152 + o), fk = ldfrag(IMG + 2 * 1152 + o), frr = ldfrag(IMG + 3 * 1152 + o);
          nab = __builtin_amdgcn_mfma_f32_16x16x32_bf16(fb, fa, nab, 0, 0, 0); nak = __builtin_amdgcn_mfma_f32_16x16x32_bf16(fk, fa, nak, 0, 0, 0);
          mbr = __builtin_amdgcn_mfma_f32_16x16x32_bf16(fb, frr, mbr, 0, 0, 0); mkr = __builtin_amdgcn_mfma_f32_16x16x32_bf16(fk, frr, mkr, 0, 0, 0); }
#pragma unroll
      for (int e = 0; e < 4; ++e) { const int s_ = 4 * fq + e, t_ = fr; const int o = s_ * 17 + t_;
          MAT[0 * 272 + o] = s_ < t_ ? nab[e] : 0.f; MAT[1 * 272 + o] = s_ < t_ ? nak[e] : 0.f; MAT[2 * 272 + o] = s_ <= t_ ? mbr[e] : 0.f; MAT[3 * 272 + o] = s_ <= t_ ? mkr[e] : 0.f; } }
    float P1[16], P2[16];
#pragma unroll
    for (int t = 0; t < 16; ++t) { float p1 = At[t], p2 = MAT[1 * 272 + fr * 17 + t];
#pragma unroll
        for (int s_ = 0; s_ < t; ++s_) { const float n = MAT[0 * 272 + s_ * 17 + t]; p1 += P1[s_] * n; p2 += P2[s_] * n; }
        P1[t] = p1; P2[t] = p2; asm volatile("" ::: "memory"); }
    LAS bf16* Q1I = (LAS bf16*)(wl + CP_Q1I);
#pragma unroll
    for (int t = 0; t < 16; ++t) { float q1 = Rt[t], q2 = MAT[3 * 272 + fr * 17 + t];
#pragma unroll
        for (int s_ = 0; s_ <= t; ++s_) { const float m = MAT[2 * 272 + s_ * 17 + t]; q1 += P1[s_] * m; q2 += P2[s_] * m; }
        Q1I[t * 72 + lane] = (bf16)f2bf(q1); if (lane < 16) { Q2m[lane * 17 + t] = q2; P2m[lane * 17 + t] = P2[t]; }
        asm volatile("" ::: "memory"); }
    { LAS bf16* P1I = (LAS bf16*)(wl + CP_P1I); LAS bf16* BGI = (LAS bf16*)(wl + CP_BGI);
      u32x4 w0, w1;
      w0.x = pk2(P1[0], P1[1]); w0.y = pk2(P1[2], P1[3]); w0.z = pk2(P1[4], P1[5]); w0.w = pk2(P1[6], P1[7]); w1.x = pk2(P1[8], P1[9]); w1.y = pk2(P1[10], P1[11]); w1.z = pk2(P1[12], P1[13]); w1.w = pk2(P1[14], P1[15]);
      *(LAS u32x4*)(P1I + lane * 24) = w0; *(LAS u32x4*)(P1I + lane * 24 + 8) = w1;
      w0.x = pk2(Bt[0] * gT, Bt[1] * gT); w0.y = pk2(Bt[2] * gT, Bt[3] * gT); w0.z = pk2(Bt[4] * gT, Bt[5] * gT); w0.w = pk2(Bt[6] * gT, Bt[7] * gT);
      w1.x = pk2(Bt[8] * gT, Bt[9] * gT); w1.y = pk2(Bt[10] * gT, Bt[11] * gT); w1.z = pk2(Bt[12] * gT, Bt[13] * gT); w1.w = pk2(Bt[14] * gT, Bt[15] * gT);
      *(LAS u32x4*)(BGI + lane * 24) = w0; *(LAS u32x4*)(BGI + lane * 24 + 8) = w1;
      const u32x4 z4 = (u32x4){0u, 0u, 0u, 0u};
      bf16x8 Af[4], Bf[4];
#pragma unroll
      for (int i = 0; i < 4; ++i) { u32x4 ta = z4, tb = z4; if (fq < 2) { ta = *(const LAS u32x4*)(P1I + (16 * i + fr) * 24 + 8 * fq); tb = *(const LAS u32x4*)(BGI + (16 * i + fr) * 24 + 8 * fq); }
          Af[i] = __builtin_bit_cast(bf16x8, ta); Bf[i] = __builtin_bit_cast(bf16x8, tb); }
#pragma unroll
      for (int j = 0; j < 4; ++j)
#pragma unroll
          for (int s_ = 0; s_ < 2; ++s_) { const f32x4 lo = __builtin_amdgcn_mfma_f32_16x16x32_bf16(Af[2 * s_], Bf[j], (f32x4){0.f, 0.f, 0.f, 0.f}, 0, 0, 0);
              const f32x4 hi = __builtin_amdgcn_mfma_f32_16x16x32_bf16(Af[2 * s_ + 1], Bf[j], (f32x4){0.f, 0.f, 0.f, 0.f}, 0, 0, 0);
              u32x4 w; w.x = pk2(lo[0], lo[1]); w.y = pk2(lo[2], lo[3]); w.z = pk2(hi[0], hi[1]); w.w = pk2(hi[2], hi[3]);
              *(u32x4*)(rec + RC_G1 + ((j * 2 + s_) * 64 + lane) * 16) = w; } }
    { float g2v[16];
#pragma unroll
      for (int t = 0; t < 16; ++t) { float acc = Kt[t];
#pragma unroll
          for (int s_ = 0; s_ < 16; ++s_) acc += P2m[t * 17 + s_] * Bt[s_];
          g2v[t] = acc * gT; asm volatile("" ::: "memory"); }
      u32x4 w0, w1; w0.x = pk2(g2v[0], g2v[1]); w0.y = pk2(g2v[2], g2v[3]); w0.z = pk2(g2v[4], g2v[5]); w0.w = pk2(g2v[6], g2v[7]); w1.x = pk2(g2v[8], g2v[9]); w1.y = pk2(g2v[10], g2v[11]); w1.z = pk2(g2v[12], g2v[13]); w1.w = pk2(g2v[14], g2v[15]);
      u32x4* d = (u32x4*)(rec + RC_G2 + lane * 32); d[0] = w0; d[1] = w1; }
    {
#pragma unroll
      for (int s_ = 0; s_ < 2; ++s_) { const u32x2 lo = *(const LAS u32x2*)(Q1I + fr * 72 + 32 * s_ + 4 * fq), hi = *(const LAS u32x2*)(Q1I + fr * 72 + 32 * s_ + 16 + 4 * fq);
          *(u32x4*)(rec + RC_Q1 + (s_ * 64 + lane) * 16) = (u32x4){lo.x, lo.y, hi.x, hi.y}; } }
    { u32x4 w = (u32x4){0u, 0u, 0u, 0u};
      if (fq < 2) { float q[8];
#pragma unroll
          for (int j = 0; j < 8; ++j) q[j] = Q2m[(8 * fq + j) * 17 + fr];
          w.x = pk2(q[0], q[1]); w.y = pk2(q[2], q[3]); w.z = pk2(q[4], q[5]); w.w = pk2(q[6], q[7]); }
      *(u32x4*)(rec + RC_Q2 + lane * 16) = w; }
}
__device__ __forceinline__ void rw_chunk_step(const LAS unsigned char* rc, f32x4 (&X)[4], float* yo, int w, int lane, int fr, int fq) {
    const u32x4 z4 = (u32x4){0u, 0u, 0u, 0u};
    u32x4 b0, b1; b0.x = pk2(X[0][0], X[0][1]); b0.y = pk2(X[0][2], X[0][3]); b0.z = pk2(X[1][0], X[1][1]); b0.w = pk2(X[1][2], X[1][3]);
    b1.x = pk2(X[2][0], X[2][1]); b1.y = pk2(X[2][2], X[2][3]); b1.z = pk2(X[3][0], X[3][1]); b1.w = pk2(X[3][2], X[3][3]);
    const bf16x8 Bx0 = __builtin_bit_cast(bf16x8, b0), Bx1 = __builtin_bit_cast(bf16x8, b1);
    u32x4 vt = z4; if (fq < 2) vt = *(const LAS u32x4*)(rc + RC_VT + (16 * w + fr) * 32 + 16 * fq);
    const bf16x8 Vf = __builtin_bit_cast(bf16x8, vt);
    f32x4 Y = (f32x4){0.f, 0.f, 0.f, 0.f};
    Y = __builtin_amdgcn_mfma_f32_16x16x32_bf16(*(const LAS bf16x8*)(rc + RC_Q1 + (0 * 64 + lane) * 16), Bx0, Y, 0, 0, 0);
    Y = __builtin_amdgcn_mfma_f32_16x16x32_bf16(*(const LAS bf16x8*)(rc + RC_Q1 + (1 * 64 + lane) * 16), Bx1, Y, 0, 0, 0);
    Y = __builtin_amdgcn_mfma_f32_16x16x32_bf16(*(const LAS bf16x8*)(rc + RC_Q2 + lane * 16), Vf, Y, 0, 0, 0);
#pragma unroll
    for (int j = 0; j < 4; ++j) { const f32x4 gm = *(const LAS f32x4*)(rc + RC_GAM + (16 * j + 4 * fq) * 4);
        f32x4 C = X[j] * gm;
        C = __builtin_amdgcn_mfma_f32_16x16x32_bf16(*(const LAS bf16x8*)(rc + RC_G1 + ((j * 2 + 0) * 64 + lane) * 16), Bx0, C, 0, 0, 0);
        C = __builtin_amdgcn_mfma_f32_16x16x32_bf16(*(const LAS bf16x8*)(rc + RC_G1 + ((j * 2 + 1) * 64 + lane) * 16), Bx1, C, 0, 0, 0);
        u32x4 g2 = z4; if (fq < 2) g2 = *(const LAS u32x4*)(rc + RC_G2 + (16 * j + fr) * 32 + 16 * fq);
        C = __builtin_amdgcn_mfma_f32_16x16x32_bf16(__builtin_bit_cast(bf16x8, g2), Vf, C, 0, 0, 0);
        X[j] = C; }
#pragma unroll
    for (int e = 0; e < 4; ++e) yo[(size_t)(4 * fq + e) * 512] = Y[e];
}
__device__ __forceinline__ void rw_scan2(Frame& F, int task) {
    const int tid = F.tid, lane = F.lane, w = F.wave, fr = lane & 15, fq = lane >> 4;
    const unsigned char* recs = F.ws + WS_RWC + (size_t)task * 512 * RC_BYTES;
    constexpr int NP = SEQ / 32;
    if (w >= 4) {
        const int lt = tid - 256;
        const u32x4* src = (const u32x4*)recs + lt;
        u32x4 rg[4][8];
#pragma unroll
        for (int u = 0; u < 4; ++u)
#pragma unroll
            for (int i = 0; i < 8; ++i) rg[u][i] = src[(size_t)u * 2048 + i * 256];
#pragma unroll 1
        for (int g4 = 0; g4 < NP / 4; ++g4) {
#pragma unroll
            for (int u = 0; u < 4; ++u) { const int g = 4 * g4 + u;
                LAS u32x4* dst = (LAS u32x4*)(F.lds + ((2 * g) & 7) * RC_BYTES) + lt;
#pragma unroll
                for (int i = 0; i < 8; ++i) dst[i * 256] = rg[u][i];
                if (g + 4 < NP) {
#pragma unroll
                    for (int i = 0; i < 8; ++i) rg[u][i] = src[(size_t)(g + 4) * 2048 + i * 256]; }
                __syncthreads(); }
        }
        __syncthreads();
    } else {
        const int b = task >> 3, h = task & 7;
        f32x4 X[4];
#pragma unroll
        for (int j = 0; j < 4; ++j) X[j] = (f32x4){0.f, 0.f, 0.f, 0.f};
        float* yo = WSP(float, WS_RW_Y) + ((size_t)b * SEQ) * 512 + 64 * h + 16 * w + fr;
        __syncthreads();
#pragma unroll 1
        for (int g = 0; g < NP; ++g) {
            rw_chunk_step(F.lds + ((2 * g) & 7) * RC_BYTES, X, yo + (size_t)(2 * g) * 16 * 512, w, lane, fr, fq);
            rw_chunk_step(F.lds + ((2 * g + 1) & 7) * RC_BYTES, X, yo + (size_t)(2 * g + 1) * 16 * 512, w, lane, fr, fq);
            __syncthreads();
        }
    }
}
__device__ __forceinline__ void rw_post(Frame& F, int l, int gw, int ngw) {
    const int lane = F.lane;
    const f32x4 g0 = *(const f32x4*)(INP(34) + l * 512 + 8 * lane), g1 = *(const f32x4*)(INP(34) + l * 512 + 8 * lane + 4);
    const f32x4 b0 = *(const f32x4*)(INP(35) + l * 512 + 8 * lane), b1 = *(const f32x4*)(INP(35) + l * 512 + 8 * lane + 4);
    for (int m = gw; m < MTOK; m += ngw) { const size_t o = (size_t)m * 512 + 8 * lane;
        const f32x4 ya = *(const f32x4*)(WSP(const float, WS_RW_Y) + o), yb = *(const f32x4*)(WSP(const float, WS_RW_Y) + o + 4);
        float y[8] = {ya.x, ya.y, ya.z, ya.w, yb.x, yb.y, yb.z, yb.w};
        float s = 0.f;
#pragma unroll
        for (int j = 0; j < 8; ++j) s += y[j];
        s += __shfl_xor(s, 1); s += __shfl_xor(s, 2); s += __shfl_xor(s, 4); const float mean = s * (1.f / 64.f);
        float qv = 0.f;
#pragma unroll
        for (int j = 0; j < 8; ++j) { y[j] -= mean; qv += y[j] * y[j]; }
        qv += __shfl_xor(qv, 1); qv += __shfl_xor(qv, 2); qv += __shfl_xor(qv, 4); const float rs = 1.0f / sqrtf(qv * (1.f / 64.f) + 64e-5f);
        const u32x4 vr = *(const u32x4*)(WSP(const bf16, WS_RW_V) + o), gr_ = *(const u32x4*)(WSP(const bf16, WS_RW_G) + o);
        const float bon = WSP(const float, WS_RW_BON)[(size_t)m * 8 + (lane >> 3)];
        const float vv[8] = {lo16(vr.x), hi16(vr.x), lo16(vr.y), hi16(vr.y), lo16(vr.z), hi16(vr.z), lo16(vr.w), hi16(vr.w)};
        const float gg[8] = {lo16(gr_.x), hi16(gr_.x), lo16(gr_.y), hi16(gr_.y), lo16(gr_.z), hi16(gr_.z), lo16(gr_.w), hi16(gr_.w)};
        const float lg[8] = {g0.x, g0.y, g0.z, g0.w, g1.x, g1.y, g1.z, g1.w}, lb[8] = {b0.x, b0.y, b0.z, b0.w, b1.x, b1.y, b1.z, b1.w};
        float ov[8];
#pragma unroll
        for (int j = 0; j < 8; ++j) ov[j] = (y[j] * rs * lg[j] + lb[j] + bon * vv[j]) * gg[j];
        u32x4 w; w.x = pk2(ov[0], ov[1]); w.y = pk2(ov[2], ov[3]); w.z = pk2(ov[4], ov[5]); w.w = pk2(ov[6], ov[7]);
        *(u32x4*)(WSP(bf16, WS_YK) + (size_t)3 * MTOK * 512 + o) = w; }
}

#ifndef WGM_A
#define WGM_A 4
#endif
#ifndef WGM_F
#define WGM_F 4
#endif
#ifndef WGM_E
#define WGM_E 4
#endif
#ifndef GATE_NA
#define GATE_NA 17
#endif
#ifndef PHMASK
#define PHMASK 0xFFFFFFFFu
#endif
#define PH(n) (((PHMASK) >> (n)) & 1u)
#ifndef REPMASK
#define REPMASK 0u
#endif
#define NREP(n) ((((REPMASK) >> (n)) & 1u) ? 2 : 1)
template <class T> __device__ __forceinline__ T* launder_ptr(T* p) { const unsigned long long w = (unsigned long long)p; unsigned lo = __builtin_amdgcn_readfirstlane((unsigned)w), hi = __builtin_amdgcn_readfirstlane((unsigned)(w >> 32));
    asm volatile("" : "+s"(lo), "+s"(hi)); return (T*)(GAS T*)(((unsigned long long)hi << 32) | lo); }
#define PHASE_BEGIN() do { F.ws = launder_ptr(F.ws); F.out = launder_ptr(F.out); { unsigned la_ = __builtin_amdgcn_readfirstlane((unsigned)(size_t)F.lds); int bk_ = __builtin_amdgcn_readfirstlane(F.blk); asm volatile("" : "+s"(la_), "+s"(bk_)); F.lds = (LAS unsigned char*)(size_t)la_; F.blk = bk_; } asm volatile("" : "+v"(F.tid)); F.lane = F.tid & 63; F.wave = __builtin_amdgcn_readfirstlane(F.tid >> 6); } while (0)
__global__ void __launch_bounds__(NTHR, 2) hybrid_fwd(Args args) {
    extern __shared__ __attribute__((aligned(16))) unsigned char lds_raw[];
    Frame F;
    F.lds = (LAS unsigned char*)lds_raw; F.out = args.out; F.ws = args.ws;
    F.tid = threadIdx.x; F.lane = F.tid & 63; F.wave = __builtin_amdgcn_readfirstlane(F.tid >> 6); F.blk = blockIdx.x; F.G = gridDim.x;
    volatile LAS unsigned* MISC = (volatile LAS unsigned*)(F.lds + LDS_MISC);
    if (F.tid < 64) MISC[F.tid] = 0u;
    if (F.tid < 45) { const unsigned long long p = ((const __attribute__((address_space(4))) unsigned long long*)__builtin_amdgcn_kernarg_segment_ptr())[F.tid]; MISC[64 + 2 * F.tid] = (unsigned)p; MISC[64 + 2 * F.tid + 1] = (unsigned)(p >> 32); }
    __syncthreads();
    XcdBarrier bar = xcd_barrier_post((unsigned*)(F.ws + WS_CTL) + CW_BAR, MISC + 8);
#define gw (F.blk * NWAVES + F.wave)
#define NGW (F.G * NWAVES)
#define glds (F.lds)

#pragma unroll 1
    for (int l = 0; l < DEPTH; ++l) {
        const float* xin = (l == 0) ? INP(0) : F.out;
        PHASE_BEGIN();
        for (int rep_ = 0; rep_ < NREP(0); ++rep_) if (PH(0)) convert_weights(F, l);
        PHASE_BEGIN();
        for (int rep_ = 0; rep_ < NREP(1); ++rep_) if (PH(1)) rmsnorm_rows(F, xin, INP(1) + (size_t)l * DM, WSP(bf16, WS_H), nullptr);
        xcd_barrier(bar);
        PHASE_BEGIN();
        for (int rep_ = 0; rep_ < NREP(2); ++rep_) if (PH(2)) { pg8::Gemm g{WSP(const bf16, WS_H), WSP(const bf16, WS_WIN), MTOK, MIXP, DM}; pg8::StaticOrder S; S.init(MTOK, MIXP, F.G, F.blk, WGM_A);
          pg8::EpiStore<0> E{WSP(bf16, WS_PROJ), MIXP}; pg8::gemm_phase(glds, g, S, E, F.tid); }
        xcd_barrier(bar);
        PHASE_BEGIN();
        for (int rep_ = 0; rep_ < NREP(3); ++rep_) if (PH(3)) for (int t = F.blk; t < MTOK / 128; t += F.G) rw_pre(F, l, t);
        PHASE_BEGIN();
        for (int rep_ = 0; rep_ < NREP(4); ++rep_) if (PH(4)) for (int t = F.blk; t < 1024; t += F.G) m2_pass1(F, l, t);
        PHASE_BEGIN();
        for (int rep_ = 0; rep_ < NREP(5); ++rep_) if (PH(5)) for (int t = gw; t < 8192; t += NGW) s5_task<false>(F, l, t);
        PHASE_BEGIN();
        for (int rep_ = 0; rep_ < NREP(6); ++rep_) if (PH(6)) for (int t = gw; t < 2048; t += NGW) lru_task<false>(F, l, t);
        xcd_barrier(bar);
        PHASE_BEGIN();
        for (int rep_ = 0; rep_ < NREP(7); ++rep_) if (PH(7)) m2_carry(F);
        PHASE_BEGIN();
        for (int rep_ = 0; rep_ < NREP(8); ++rep_) if (PH(8)) for (int t = gw; t < 128; t += NGW) s5_carry(F, l, t);
        PHASE_BEGIN();
        for (int rep_ = 0; rep_ < NREP(9); ++rep_) if (PH(9)) for (int t = NGW - 1 - gw; t < 32; t += NGW) lru_carry(F, t);
        xcd_barrier(bar);
        PHASE_BEGIN();
        for (int rep_ = 0; rep_ < NREP(10); ++rep_) if (PH(10)) for (int t = F.blk; t < 1024; t += F.G) m2_pass2(F, l, t);
        PHASE_BEGIN();
        for (int rep_ = 0; rep_ < NREP(11); ++rep_) if (PH(11)) for (int t = gw; t < 8192; t += NGW) s5_task<true>(F, l, t);
        PHASE_BEGIN();
        for (int rep_ = 0; rep_ < NREP(12); ++rep_) if (PH(12)) for (int t = gw; t < 2048; t += NGW) lru_task<true>(F, l, t);
        xcd_barrier(bar);
        PHASE_BEGIN();
        for (int rep_ = 0; rep_ < NREP(14); ++rep_) if (PH(14)) {
            { pg8::Gemm g{WSP(const bf16, WS_S5Z), WSP(const bf16, WS_WGLU), MTOK, 512, 512}; pg8::StaticOrder S; S.init(MTOK, 512, F.G, F.blk);
              pg8::EpiGlu E{WSP(const bf16, WS_S5Z), WSP(bf16, WS_YK)}; pg8::gemm_phase(glds, g, S, E, F.tid); }
            m2_norm(F, l, gw, NGW);
        }
        PHASE_BEGIN();
        for (int rep_ = 0; rep_ < NREP(24); ++rep_) if (PH(24)) for (int t = gw; t < NB * 8 * 512; t += NGW) rw_chunk_prep(F, t);
        xcd_barrier(bar);
        PHASE_BEGIN();
        if (F.blk < 32) { if (PH(13)) rw_scan2(F, F.blk); }
        PHASE_BEGIN();
        if (PH(16)) { pg8::Gemm g{WSP(const bf16, WS_H), WSP(const bf16, WS_WIN) + (size_t)MIXP * DM, MTOK, NGATE, DM};
          pg8::SplitOrder S; if (F.blk >= 32) S.init(MTOK, NGATE, 224, F.blk - 32, 0, GATE_NA); else S.init(MTOK, NGATE, 32, F.blk, 224 * GATE_NA, (4096 - 224 * GATE_NA) / 32);
          pg8::EpiStore<1> E{WSP(bf16, WS_GATES), NGATE}; pg8::gemm_phase(glds, g, S, E, F.tid); }
        xcd_barrier(bar);
        PHASE_BEGIN();
        for (int rep_ = 0; rep_ < NREP(15); ++rep_) if (PH(15)) rw_post(F, l, gw, NGW);
        xcd_barrier(bar);
        PHASE_BEGIN();
        for (int rep_ = 0; rep_ < NREP(17); ++rep_) if (PH(17)) { pg8::Gemm g{WSP(const bf16, WS_YK), WSP(const bf16, WS_WPK), 4 * MTOK, 4 * DM, 512}; pg8::OrderYK S{F.G, F.blk};
          pg8::EpiGateAcc E{WSP(const bf16, WS_GATES), WSP(bf16, WS_MERGED)}; pg8::gemm_phase(glds, g, S, E, F.tid); }
        xcd_barrier(bar);
        PHASE_BEGIN();
        for (int rep_ = 0; rep_ < NREP(18); ++rep_) if (PH(18)) { pg8::Gemm g{WSP(const bf16, WS_MERGED), WSP(const bf16, WS_WOUT), MTOK, DM, DM}; pg8::StaticOrder S; S.init(MTOK, DM, F.G, F.blk, WGM_E);
          pg8::EpiAddF32 E{xin, F.out, DM}; pg8::gemm_phase(glds, g, S, E, F.tid); }
        xcd_barrier(bar);
        PHASE_BEGIN();
        for (int rep_ = 0; rep_ < NREP(19); ++rep_) if (PH(19)) rmsnorm_rows(F, F.out, INP(38) + (size_t)l * DM, WSP(bf16, WS_H), nullptr);
        xcd_barrier(bar);
        PHASE_BEGIN();
        for (int rep_ = 0; rep_ < NREP(20); ++rep_) if (PH(20)) { pg8::Gemm g{WSP(const bf16, WS_H), WSP(const bf16, WS_WFG), MTOK, FF, DM}; pg8::StaticOrder S; S.init(MTOK, FF, F.G, F.blk, WGM_F);
          pg8::EpiStore<0> E{WSP(bf16, WS_FG), FF}; pg8::gemm_phase(glds, g, S, E, F.tid); }
        xcd_barrier(bar);
        PHASE_BEGIN();
        for (int rep_ = 0; rep_ < NREP(21); ++rep_) if (PH(21)) { pg8::Gemm g{WSP(const bf16, WS_H), WSP(const bf16, WS_WFU), MTOK, FF, DM}; pg8::StaticOrder S; S.init(MTOK, FF, F.G, F.blk, WGM_F);
          pg8::EpiFfnUp E{WSP(const bf16, WS_FG), WSP(bf16, WS_HID), INP(41) + (size_t)l * 3 * FF, INP(42) + (size_t)l * FF}; pg8::gemm_phase(glds, g, S, E, F.tid); }
        xcd_barrier(bar);
        PHASE_BEGIN();
        for (int rep_ = 0; rep_ < NREP(22); ++rep_) if (PH(22)) { pg8::Gemm g{WSP(const bf16, WS_HID), WSP(const bf16, WS_WFD), MTOK, DM, FF}; pg8::StaticOrder S; S.init(MTOK, DM, F.G, F.blk, WGM_E);
          pg8::EpiAddF32 E{F.out, F.out, DM}; pg8::gemm_phase(glds, g, S, E, F.tid); }
        xcd_barrier(bar);
    }
    PHASE_BEGIN();
    for (int rep_ = 0; rep_ < NREP(23); ++rep_) if (PH(23)) rmsnorm_rows(F, F.out, INP(44), nullptr, F.out);
}

extern "C" void kernel_launch(void* const* d_in, const int* in_sizes, int n_in, void* d_out, int out_size, void* d_ws, size_t ws_size, hipStream_t stream) {
    static int grid = 0;
    if (grid == 0) {
        if (n_in != 45 || in_sizes[0] != MTOK * DM || out_size != MTOK * DM || ws_size < WS_END) {
            fprintf(stderr, "kernel_launch: unexpected shapes/workspace (n_in %d, in0 %d, out %d, ws %zu, need %zu); nothing launched\n", n_in, n_in > 0 ? in_sizes[0] : -1, out_size, ws_size, (size_t)WS_END); grid = -1; return; }
        int dev = 0, cus = 0, per_cu = 0;
        if (hipGetDevice(&dev) != hipSuccess || hipDeviceGetAttribute(&cus, hipDeviceAttributeMultiprocessorCount, dev) != hipSuccess) { grid = -1; return; }
        if (hipFuncSetAttribute((const void*)hybrid_fwd, hipFuncAttributeMaxDynamicSharedMemorySize, LDS_BYTES) != hipSuccess) { fprintf(stderr, "kernel_launch: hipFuncSetAttribute failed\n"); grid = -1; return; }
        if (hipOccupancyMaxActiveBlocksPerMultiprocessor(&per_cu, (const void*)hybrid_fwd, NTHR, LDS_BYTES) != hipSuccess || per_cu < 1) { fprintf(stderr, "kernel_launch: occupancy query says %d\n", per_cu); }
        (void)hipGetLastError();
        grid = cus;
        if (grid != 256) fprintf(stderr, "kernel_launch: note: %d CUs\n", grid);
    }
    if (grid < 0) return;
    if (hipMemsetAsync((char*)d_ws + WS_CTL, 0, CTL_BYTES, stream) != hipSuccess) return;
    Args a{};
    for (int i = 0; i < 45; ++i) a.in[i] = (const float*)d_in[i];
    a.out = (float*)d_out; a.ws = (unsigned char*)d_ws;
    hipLaunchKernelGGL(hybrid_fwd, dim3(grid), dim3(NTHR), LDS_BYTES, stream, a);
}
```

```cpp
#include <hip/hip_runtime.h>
#include <cstdio>
#include <cstdint>

#define LAS __attribute__((address_space(3)))
typedef unsigned short bf16;
typedef short bf16x8 __attribute__((ext_vector_type(8)));
typedef float f32x4 __attribute__((ext_vector_type(4)));
typedef float f32x2 __attribute__((ext_vector_type(2)));
typedef unsigned u32x4 __attribute__((ext_vector_type(4)));
typedef unsigned u32x2 __attribute__((ext_vector_type(2)));
typedef __bf16 bf16v2 __attribute__((ext_vector_type(2)));
typedef int i32x4 __attribute__((ext_vector_type(4)));

constexpr int NB = 4, SEQ = 8192, DM = 2048, MTOK = NB * SEQ, DEPTH = 4;
constexpr int MIXC = 4776, MIXP = 4864, INC = 12968, FF = 6144, NGATE = 8192;
constexpr int RWC = 1696;
constexpr int PC_S5U = 0, PC_LRX = 512, PC_LRG = 1024, PC_M2Z = 1536, PC_XBC = 2048, PC_DT = 3072, PC_RW = 3080;

constexpr size_t MiB = 1u << 20;
constexpr size_t WS_CTL = 0, CTL_BYTES = 1 * MiB;
constexpr size_t WS_WIN = 1 * MiB, WS_WPK = 52 * MiB, WS_WOUT = 60 * MiB, WS_WFG = 68 * MiB, WS_WFU = 92 * MiB, WS_WFD = 116 * MiB, WS_WGLU = 140 * MiB;
constexpr size_t WS_SA = 141 * MiB, WS_SB = 142 * MiB;
constexpr size_t WS_A8 = 1538 * MiB;
constexpr size_t WS_H = 144 * MiB, WS_YK = 272 * MiB, WS_PROJ = 400 * MiB, WS_MERGED = 400 * MiB, WS_GATES = 704 * MiB;
constexpr size_t WS_RW_R = 1216 * MiB, WS_RW_K = 1248 * MiB, WS_RW_V = 1280 * MiB, WS_RW_A = 1312 * MiB, WS_RW_B = 1344 * MiB, WS_RW_G = 1376 * MiB,
                 WS_RW_DEC = 1408 * MiB, WS_RW_Y = 1472 * MiB, WS_RW_BON = 1536 * MiB, WS_END = 1602 * MiB;
constexpr size_t WS_S5Z = 704 * MiB, WS_S5E = 736 * MiB, WS_S5I = 740 * MiB, WS_LRE = 744 * MiB, WS_LRA = 745 * MiB, WS_LRI = 746 * MiB;
constexpr size_t WS_M2S = 752 * MiB, WS_M2D = 1008 * MiB, WS_M2Y = 1012 * MiB;
constexpr size_t WS_FG = 400 * MiB, WS_HID = 784 * MiB;
constexpr int CW_BAR = 4096;

__device__ __forceinline__ float bf2f(bf16 b) { return __uint_as_float(((unsigned)b) << 16); }
__device__ __forceinline__ unsigned f2bf(float f) { const __bf16 b = (__bf16)f; return (unsigned)__builtin_bit_cast(unsigned short, b); }
__device__ __forceinline__ unsigned pk2(float lo, float hi) { const f32x2 v = {lo, hi}; const bf16v2 b = __builtin_convertvector(v, bf16v2); return __builtin_bit_cast(unsigned, b); }
__device__ __forceinline__ float lo16(unsigned w) { return __uint_as_float(w << 16); }
__device__ __forceinline__ float hi16(unsigned w) { return __uint_as_float(w & 0xffff0000u); }
__device__ __forceinline__ float rcpf_(float x) { return __builtin_amdgcn_rcpf(x); }
__device__ __forceinline__ float sigmoidf_(float x) { return rcpf_(1.0f + __expf(-x)); }
__device__ __forceinline__ float siluf_(float x) { return x * rcpf_(1.0f + __expf(-x)); }
__device__ __forceinline__ float geluf_(float x) { const float u = 0.7978845608028654f * (x + 0.044715f * x * x * x); return x * rcpf_(1.0f + __expf(-2.0f * u)); }
__device__ __forceinline__ float softplusf_(float x) { return fmaxf(x, 0.f) + __logf(1.0f + __expf(-fabsf(x))); }
__device__ __forceinline__ float row16_sum(float v) {
    v += __int_as_float(__builtin_amdgcn_update_dpp(0, __float_as_int(v), 0x128, 0xf, 0xf, true));
    v += __int_as_float(__builtin_amdgcn_update_dpp(0, __float_as_int(v), 0x124, 0xf, 0xf, true));
    v += __int_as_float(__builtin_amdgcn_update_dpp(0, __float_as_int(v), 0x122, 0xf, 0xf, true));
    v += __int_as_float(__builtin_amdgcn_update_dpp(0, __float_as_int(v), 0x121, 0xf, 0xf, true));
    return v;
}
__device__ __forceinline__ float wave_sum(float v) {
    v = row16_sum(v);
    const float a = __int_as_float(__builtin_amdgcn_readlane(__float_as_int(v), 0)), b = __int_as_float(__builtin_amdgcn_readlane(__float_as_int(v), 16));
    const float c = __int_as_float(__builtin_amdgcn_readlane(__float_as_int(v), 32)), d = __int_as_float(__builtin_amdgcn_readlane(__float_as_int(v), 48));
    return (a + b) + (c + d);
}
__device__ __forceinline__ float wave_max(float v) {
    v = fmaxf(v, __int_as_float(__builtin_amdgcn_update_dpp(0, __float_as_int(v), 0x128, 0xf, 0xf, true)));
    v = fmaxf(v, __int_as_float(__builtin_amdgcn_update_dpp(0, __float_as_int(v), 0x124, 0xf, 0xf, true)));
    v = fmaxf(v, __int_as_float(__builtin_amdgcn_update_dpp(0, __float_as_int(v), 0x122, 0xf, 0xf, true)));
    v = fmaxf(v, __int_as_float(__builtin_amdgcn_update_dpp(0, __float_as_int(v), 0x121, 0xf, 0xf, true)));
    const float a = __int_as_float(__builtin_amdgcn_readlane(__float_as_int(v), 0)), b = __int_as_float(__builtin_amdgcn_readlane(__float_as_int(v), 16));
    const float c = __int_as_float(__builtin_amdgcn_readlane(__float_as_int(v), 32)), d = __int_as_float(__builtin_amdgcn_readlane(__float_as_int(v), 48));
    return fmaxf(fmaxf(a, b), fmaxf(c, d));
}
__device__ __forceinline__ unsigned q8x4(float a, float b, float c, float d, float inv) {
    const int q0 = (int)rintf(a * inv), q1 = (int)rintf(b * inv), q2 = (int)rintf(c * inv), q3 = (int)rintf(d * inv);
    return (unsigned)(q0 & 0xff) | ((unsigned)(q1 & 0xff) << 8) | ((unsigned)(q2 & 0xff) << 16) | ((unsigned)q3 << 24);
}
__device__ __forceinline__ float rdlane(float v, int l) { return __int_as_float(__builtin_amdgcn_readlane(__float_as_int(v), l)); }

namespace pg8 {
constexpr int BM = 256, BK = 64, HALF = 128, HTB = HALF * BK * 2, STAGE_BYTES = 8 * HTB, NXCD = 8, WGM = 4;
__host__ __device__ __forceinline__ int lds_byte(int r, int c) { const int st = (r >> 4) * 2 + (c >> 5), rr = r & 15, cc = c & 31, ob = rr * 64 + cc * 2; return st * 1024 + (ob ^ (((ob >> 9) & 1) << 5)); }
__host__ __device__ __forceinline__ void stage_rc(int b, int& R, int& C) { const int st = b / 1024, sb = b % 1024, swz = sb ^ (((sb >> 9) & 1) << 5); R = (st >> 1) * 16 + swz / 64; C = (st & 1) * 32 + (swz % 64) / 2; }
__host__ __device__ __forceinline__ int perm32(int rho) { const int n = rho >> 4, i = rho & 15; return 8 * (i >> 2) + 4 * n + (i & 3); }
struct Unit { int pm, pn; };
struct Gemm { const bf16* A; const bf16* Bt; int M, N, K; };
struct StaticOrder {
    int nM, nN, nwg, G, c;
    __device__ void init(int M, int N, int G_, int c_) { nM = M / BM; nN = N / BM; nwg = nM * nN; G = G_; c = c_; }
    __device__ bool next(int i, Unit& u) const {
        const long L = (long)i * G + c; if (L >= nwg || c < 0) return false;
        int wgid = (int)L; { const int q = nwg / NXCD, r = nwg % NXCD, xcd = wgid % NXCD, off = wgid / NXCD; wgid = (xcd < r ? xcd * (q + 1) : r * (q + 1) + (xcd - r) * q) + off; }
        const int nig = WGM * nN, gid = wgid / nig, fm = gid * WGM, gsz = (nM - fm) < WGM ? (nM - fm) : WGM;
        u.pm = fm + ((wgid % nig) % gsz); u.pn = (wgid % nig) / gsz; return true;
    }
    __device__ __forceinline__ void a_ready(const Unit&) const {}
    __device__ __forceinline__ void done(const Unit&) const {}
};
struct SplitOrder {
    int nM, nN, nwg, G, c, base, n;
    __device__ void init(int M, int N, int G_, int c_, int base_, int n_) { nM = M / BM; nN = N / BM; nwg = nM * nN; G = G_; c = c_; base = base_; n = n_; }
    __device__ bool next(int i, Unit& u) const {
        if (i >= n) return false; const long L = (long)base + (long)i * G + c; if (L >= nwg) return false;
        int wgid = (int)L; { const int q = nwg / NXCD, r = nwg % NXCD, xcd = wgid % NXCD, off = wgid / NXCD; wgid = (xcd < r ? xcd * (q + 1) : r * (q + 1) + (xcd - r) * q) + off; }
        const int nig = WGM * nN, gid = wgid / nig, fm = gid * WGM, gsz = (nM - fm) < WGM ? (nM - fm) : WGM;
        u.pm = fm + ((wgid % nig) % gsz); u.pn = (wgid % nig) / gsz; return true;
    }
    __device__ __forceinline__ void a_ready(const Unit&) const {}
    __device__ __forceinline__ void done(const Unit&) const {}
};
struct OrderYK {
    int G, c;
    __device__ bool next(int i, Unit& u) const {
        const int k = i & 3; const long T = (long)(i >> 2) * G + c; if (T >= 1024) return false;
        int wgid = (int)T; { const int xcd = wgid % 8, off = wgid / 8; wgid = xcd * 128 + off; }
        const int gid = wgid / 32, fm = gid * 4; const int pm = fm + ((wgid % 32) % 4), pn = (wgid % 32) / 4;
        u.pm = k * 128 + pm; u.pn = k * 8 + pn; return true;
    }
    __device__ __forceinline__ void a_ready(const Unit&) const {}
    __device__ __forceinline__ void done(const Unit&) const {}
};
__device__ __forceinline__ unsigned cvt_pk_bf16(float lo, float hi) { return pk2(lo, hi); }

template <bool I8> struct AccOf { typedef f32x4 T; }; template <> struct AccOf<true> { typedef i32x4 T; };
template <int ACT> struct EpiStore {
    static constexpr bool I8 = false; static constexpr bool PERM = true;
    bf16* O; int ldc;
    __device__ __forceinline__ void operator()(const f32x4 (&acc)[2][2][4][2], const Unit& u, int wr, int wc, int fr, int fq) const {
        const int row0 = u.pm * BM + wr * 64 + fr, col0 = u.pn * BM + wc * 32 + 8 * fq;
#pragma unroll
        for (int ai = 0; ai < 2; ++ai)
#pragma unroll
            for (int m = 0; m < 4; ++m) { bf16* rowp = O + (size_t)(row0 + ai * HALF + m * 16) * ldc + col0;
#pragma unroll
                for (int bj = 0; bj < 2; ++bj) { f32x4 v0 = acc[ai][bj][m][0], v1 = acc[ai][bj][m][1];
                    if (ACT == 1) {
#pragma unroll
                        for (int j = 0; j < 4; ++j) { v0[j] = sigmoidf_(v0[j]); v1[j] = sigmoidf_(v1[j]); } }
                    u32x4 w; w.x = cvt_pk_bf16(v0[0], v0[1]); w.y = cvt_pk_bf16(v0[2], v0[3]); w.z = cvt_pk_bf16(v1[0], v1[1]); w.w = cvt_pk_bf16(v1[2], v1[3]);
                    *(u32x4*)(rowp + bj * HALF) = w; } }
    }
};
template <int ACT> struct EpiStoreI8 {
    static constexpr bool I8 = true; static constexpr bool PERM = true;
    bf16* O; int ldc; const float* sa; const float* sb;
    __device__ __forceinline__ void operator()(const i32x4 (&acc)[2][2][4][2], const Unit& u, int wr, int wc, int fr, int fq) const {
        const int row0 = u.pm * BM + wr * 64 + fr, col0 = u.pn * BM + wc * 32 + 8 * fq;
        float sav[8];
#pragma unroll
        for (int i = 0; i < 8; ++i) sav[i] = sa[row0 + (i >> 2) * HALF + (i & 3) * 16];
#pragma unroll
        for (int bj = 0; bj < 2; ++bj) { const f32x4 s0 = *(const f32x4*)(sb + col0 + bj * HALF), s1 = *(const f32x4*)(sb + col0 + bj * HALF + 4);
#pragma unroll
            for (int ai = 0; ai < 2; ++ai)
#pragma unroll
                for (int m = 0; m < 4; ++m) { const float ra = sav[ai * 4 + m]; const i32x4 a0 = acc[ai][bj][m][0], a1 = acc[ai][bj][m][1];
                    float v[8] = {(float)a0[0] * (ra * s0[0]), (float)a0[1] * (ra * s0[1]), (float)a0[2] * (ra * s0[2]), (float)a0[3] * (ra * s0[3]),
                                  (float)a1[0] * (ra * s1[0]), (float)a1[1] * (ra * s1[1]), (float)a1[2] * (ra * s1[2]), (float)a1[3] * (ra * s1[3])};
                    if (ACT == 1) {
#pragma unroll
                        for (int j = 0; j < 8; ++j) v[j] = sigmoidf_(v[j]); }
                    u32x4 w; w.x = cvt_pk_bf16(v[0], v[1]); w.y = cvt_pk_bf16(v[2], v[3]); w.z = cvt_pk_bf16(v[4], v[5]); w.w = cvt_pk_bf16(v[6], v[7]);
                    *(u32x4*)(O + (size_t)(row0 + ai * HALF + m * 16) * ldc + col0 + bj * HALF) = w; } }
    }
};
struct EpiAddF32 {
    static constexpr bool I8 = false; static constexpr bool PERM = false;
    const float* base; float* out; int ldc;
    __device__ __forceinline__ void operator()(const f32x4 (&acc)[2][2][4][2], const Unit& u, int wr, int wc, int fr, int fq) const {
        const int row0 = u.pm * BM + wr * 64 + fr, col0 = u.pn * BM + wc * 32 + 4 * fq;
#pragma unroll
        for (int ai = 0; ai < 2; ++ai)
#pragma unroll
            for (int m = 0; m < 4; ++m) { const size_t off = (size_t)(row0 + ai * HALF + m * 16) * ldc + col0;
#pragma unroll
                for (int bj = 0; bj < 2; ++bj)
#pragma unroll
                    for (int n = 0; n < 2; ++n) { const size_t p = off + bj * HALF + n * 16; const f32x4 b = *(const f32x4*)(base + p); *(f32x4*)(out + p) = b + acc[ai][bj][m][n]; } }
    }
};
struct EpiGateAcc {
    static constexpr bool I8 = false; static constexpr bool PERM = true;
    const bf16* gates; bf16* merged;
    __device__ __forceinline__ void operator()(const f32x4 (&acc)[2][2][4][2], const Unit& u, int wr, int wc, int fr, int fq) const {
        const int k = u.pn >> 3, pn = u.pn & 7, pm = u.pm & 127;
        const int row0 = pm * BM + wr * 64 + fr, col0 = pn * BM + wc * 32 + 8 * fq;
#pragma unroll
        for (int ai = 0; ai < 2; ++ai) {
            u32x4 g[4][2], pv[4][2];
#pragma unroll
            for (int m = 0; m < 4; ++m)
#pragma unroll
                for (int bj = 0; bj < 2; ++bj) { const size_t r = (size_t)(row0 + ai * HALF + m * 16); const int c = col0 + bj * HALF;
                    g[m][bj] = *(const u32x4*)(gates + r * NGATE + k * DM + c);
                    pv[m][bj] = (u32x4){0u, 0u, 0u, 0u}; if (k) pv[m][bj] = *(const u32x4*)(merged + r * DM + c); }
#pragma unroll
            for (int m = 0; m < 4; ++m)
#pragma unroll
                for (int bj = 0; bj < 2; ++bj) { const size_t r = (size_t)(row0 + ai * HALF + m * 16); const int c = col0 + bj * HALF;
                    const f32x4 v0 = acc[ai][bj][m][0], v1 = acc[ai][bj][m][1]; const u32x4 gg = g[m][bj], pp = pv[m][bj];
                    float o[8];
                    o[0] = lo16(pp.x) + lo16(gg.x) * v0[0]; o[1] = hi16(pp.x) + hi16(gg.x) * v0[1]; o[2] = lo16(pp.y) + lo16(gg.y) * v0[2]; o[3] = hi16(pp.y) + hi16(gg.y) * v0[3];
                    o[4] = lo16(pp.z) + lo16(gg.z) * v1[0]; o[5] = hi16(pp.z) + hi16(gg.z) * v1[1]; o[6] = lo16(pp.w) + lo16(gg.w) * v1[2]; o[7] = hi16(pp.w) + hi16(gg.w) * v1[3];
                    u32x4 w; w.x = cvt_pk_bf16(o[0], o[1]); w.y = cvt_pk_bf16(o[2], o[3]); w.z = cvt_pk_bf16(o[4], o[5]); w.w = cvt_pk_bf16(o[6], o[7]);
                    *(u32x4*)(merged + r * DM + c) = w; }
            asm volatile("" ::: "memory");
        }
    }
};
struct EpiGlu {
    static constexpr bool I8 = false; static constexpr bool PERM = true;
    const bf16* Z; bf16* O;
    __device__ __forceinline__ void operator()(const f32x4 (&acc)[2][2][4][2], const Unit& u, int wr, int wc, int fr, int fq) const {
        const int row0 = u.pm * BM + wr * 64 + fr, col0 = u.pn * BM + wc * 32 + 8 * fq;
#pragma unroll
        for (int ai = 0; ai < 2; ++ai)
#pragma unroll
            for (int m = 0; m < 4; ++m) { const size_t r = (size_t)(row0 + ai * HALF + m * 16);
#pragma unroll
                for (int bj = 0; bj < 2; ++bj) { const int c = col0 + bj * HALF;
                    const u32x4 z = *(const u32x4*)(Z + r * 512 + c);
                    const f32x4 v0 = acc[ai][bj][m][0], v1 = acc[ai][bj][m][1];
                    float o[8];
                    o[0] = lo16(z.x) * sigmoidf_(v0[0]); o[1] = hi16(z.x) * sigmoidf_(v0[1]); o[2] = lo16(z.y) * sigmoidf_(v0[2]); o[3] = hi16(z.y) * sigmoidf_(v0[3]);
                    o[4] = lo16(z.z) * sigmoidf_(v1[0]); o[5] = hi16(z.z) * sigmoidf_(v1[1]); o[6] = lo16(z.w) * sigmoidf_(v1[2]); o[7] = hi16(z.w) * sigmoidf_(v1[3]);
                    u32x4 w; w.x = cvt_pk_bf16(o[0], o[1]); w.y = cvt_pk_bf16(o[2], o[3]); w.z = cvt_pk_bf16(o[4], o[5]); w.w = cvt_pk_bf16(o[6], o[7]);
                    *(u32x4*)(O + r * 512 + c) = w; }
                asm volatile("" ::: "memory"); }
    }
};
template <bool I8_> struct EpiFfnUp {
    static constexpr bool I8 = I8_; static constexpr bool PERM = true;
    const bf16* G; bf16* O; const float* cw; const float* cb; const float* sa; const float* sb;
    __device__ __forceinline__ void operator()(const typename AccOf<I8_>::T (&acc)[2][2][4][2], const Unit& u, int wr, int wc, int fr, int fq) const {
        const int row0 = u.pm * BM + wr * 64 + fr, col0 = u.pn * BM + wc * 32 + 8 * fq;
#pragma unroll
        for (int bj = 0; bj < 2; ++bj) { const int c = col0 + bj * HALF;
            unsigned bbp[4], w0p[4], w1p[4], w2p[4];
#pragma unroll
            for (int h = 0; h < 2; ++h) { const f32x4 a = *(const f32x4*)(cw + c + 4 * h), b = *(const f32x4*)(cw + FF + c + 4 * h), d = *(const f32x4*)(cw + 2 * FF + c + 4 * h), e = *(const f32x4*)(cb + c + 4 * h);
                w0p[2 * h] = pk2(a[0], a[1]); w0p[2 * h + 1] = pk2(a[2], a[3]); w1p[2 * h] = pk2(b[0], b[1]); w1p[2 * h + 1] = pk2(b[2], b[3]); w2p[2 * h] = pk2(d[0], d[1]); w2p[2 * h + 1] = pk2(d[2], d[3]);
                bbp[2 * h] = pk2(e[0], e[1]); bbp[2 * h + 1] = pk2(e[2], e[3]); }
#pragma unroll
            for (int aim = 0; aim < 4; ++aim) { const int ai = aim >> 1, mb = (aim & 1) * 2;
                u32x4 g2[4], g1[4], g0[4];
#pragma unroll
                for (int m = mb; m < mb + 2; ++m) { const int ri = row0 + ai * HALF + m * 16; const size_t r = (size_t)ri; const int t = ri & (SEQ - 1);
                    g2[m] = *(const u32x4*)(G + r * FF + c); g1[m] = (u32x4){0u, 0u, 0u, 0u}; g0[m] = (u32x4){0u, 0u, 0u, 0u};
                    if (t >= 1) g1[m] = *(const u32x4*)(G + (r - 1) * FF + c);
                    if (t >= 2) g0[m] = *(const u32x4*)(G + (r - 2) * FF + c); }
#pragma unroll
                for (int m = mb; m < mb + 2; ++m) { const size_t r = (size_t)(row0 + ai * HALF + m * 16);
                    f32x4 v0, v1;
                    if constexpr (I8_) { const float ra = sa[row0 + ai * HALF + m * 16]; const f32x4 s0 = *(const f32x4*)(sb + c) * ra, s1 = *(const f32x4*)(sb + c + 4) * ra;
#pragma unroll
                        for (int j = 0; j < 4; ++j) { v0[j] = (float)acc[ai][bj][m][0][j] * s0[j]; v1[j] = (float)acc[ai][bj][m][1][j] * s1[j]; } }
                    else {
#pragma unroll
                        for (int j = 0; j < 4; ++j) { v0[j] = (float)acc[ai][bj][m][0][j]; v1[j] = (float)acc[ai][bj][m][1][j]; } }
                    const float x2[8] = {lo16(g2[m].x), hi16(g2[m].x), lo16(g2[m].y), hi16(g2[m].y), lo16(g2[m].z), hi16(g2[m].z), lo16(g2[m].w), hi16(g2[m].w)};
                    const float x1[8] = {lo16(g1[m].x), hi16(g1[m].x), lo16(g1[m].y), hi16(g1[m].y), lo16(g1[m].z), hi16(g1[m].z), lo16(g1[m].w), hi16(g1[m].w)};
                    const float x0[8] = {lo16(g0[m].x), hi16(g0[m].x), lo16(g0[m].y), hi16(g0[m].y), lo16(g0[m].z), hi16(g0[m].z), lo16(g0[m].w), hi16(g0[m].w)};
                    float o[8];
#pragma unroll
                    for (int j = 0; j < 8; ++j) { const float t0 = (j & 1) ? hi16(w0p[j >> 1]) : lo16(w0p[j >> 1]), t1 = (j & 1) ? hi16(w1p[j >> 1]) : lo16(w1p[j >> 1]), t2 = (j & 1) ? hi16(w2p[j >> 1]) : lo16(w2p[j >> 1]);
                        const float uu = ((j & 1) ? hi16(bbp[j >> 1]) : lo16(bbp[j >> 1])) + t0 * x0[j] + t1 * x1[j] + t2 * x2[j]; o[j] = geluf_(uu) * (j < 4 ? v0[j & 3] : v1[j & 3]); }
                    u32x4 w; w.x = cvt_pk_bf16(o[0], o[1]); w.y = cvt_pk_bf16(o[2], o[3]); w.z = cvt_pk_bf16(o[4], o[5]); w.w = cvt_pk_bf16(o[6], o[7]);
                    *(u32x4*)(O + r * FF + c) = w; }
                asm volatile("" ::: "memory"); } }
    }
};

__device__ __forceinline__ f32x4 mma16(bf16x8 b, bf16x8 a, f32x4 c) { return __builtin_amdgcn_mfma_f32_16x16x32_bf16(b, a, c, 0, 0, 0); }
__device__ __forceinline__ i32x4 mma16(bf16x8 b, bf16x8 a, i32x4 c) { return __builtin_amdgcn_mfma_i32_16x16x64_i8(__builtin_bit_cast(i32x4, b), __builtin_bit_cast(i32x4, a), c, 0, 0, 0); }
#ifndef PG8_SP2
#define PG8_SP2 true
#endif
#ifndef PG8_ALIGN
#define PG8_ALIGN true
#endif
template <class Epi, class Sched, bool ALIGN_EPI = PG8_ALIGN, bool SP2 = PG8_SP2>
__device__ __forceinline__ void gemm_phase(LAS unsigned char* lds, const Gemm g, const Sched& S, const Epi& E, int tid_) {
    const int tid = tid_, wid = __builtin_amdgcn_readfirstlane(tid >> 6), lane = tid & 63, wr = wid >> 2, wc = wid & 3, fr = lane & 15, fq = lane >> 4;
    const int K = g.K, nt = K / BK;
    unsigned voffA[2], voffB[2];
#pragma unroll
    for (int i = 0; i < 2; ++i) { int R, C; stage_rc(tid * 16 + i * 8192, R, C); const int Rb = Epi::PERM ? ((R & ~31) + perm32(R & 31)) : R;
        voffA[i] = (unsigned)(R * K + C) * 2u; voffB[i] = (unsigned)(Rb * K + C) * 2u; }
    const size_t kstep = (size_t)(BK * 2);
    const size_t hstep = (size_t)HALF * K * 2;
    const size_t tstep = 2 * hstep;
    const unsigned ldsw = (unsigned)wid * 1024u;
    const int aoff = lds_byte(wr * 64 + fr, fq * 8), boff = lds_byte(wc * 32 + fr, fq * 8);
#define PG8_SA(b, h) (((b) * 2 + (h)) * HTB)
#define PG8_SB(b, h) ((4 + (b) * 2 + (h)) * HTB)
#define PG8_STAGE(bufoff, gbase, voff) do { _Pragma("unroll") for (int _i = 0; _i < 2; ++_i) \
        __builtin_amdgcn_global_load_lds((const unsigned*)((const char*)(gbase) + (voff)[_i]), (LAS unsigned*)(lds + (bufoff) + ldsw + _i * 8192), 16, 0, 0); } while (0)
#define PG8_LDA(dst, b, h) do { _Pragma("unroll") for (int m = 0; m < 4; ++m) _Pragma("unroll") for (int k = 0; k < 2; ++k) dst[m][k] = *(const LAS bf16x8*)(lds + PG8_SA(b, h) + aoff + m * 2048 + k * 1024); } while (0)
#define PG8_LDB(dst, b, h) do { _Pragma("unroll") for (int n = 0; n < 2; ++n) _Pragma("unroll") for (int k = 0; k < 2; ++k) dst[n][k] = *(const LAS bf16x8*)(lds + PG8_SB(b, h) + boff + n * 2048 + k * 1024); } while (0)
#define PG8_MMA(ai, bj, At, Bt) do { __builtin_amdgcn_s_setprio(1); _Pragma("unroll") for (int m = 0; m < 4; ++m) _Pragma("unroll") for (int n = 0; n < 2; ++n) _Pragma("unroll") for (int k = 0; k < 2; ++k) \
        acc[ai][bj][m][n] = mma16(Bt[n][k], At[m][k], acc[ai][bj][m][n]); __builtin_amdgcn_s_setprio(0); } while (0)
#define PG8_WAIT_V(n) asm volatile("s_waitcnt vmcnt(" #n ")" ::: "memory")
#define PG8_WAIT_L(n) asm volatile("s_waitcnt lgkmcnt(" #n ")" ::: "memory")
#define PG8_BAR __builtin_amdgcn_s_barrier()
#define PG8_SCHED __builtin_amdgcn_sched_barrier(0)
    Unit cur, nxt; int ui = 0;
    if (!S.next(0, cur)) return;
    typedef typename AccOf<Epi::I8>::T acc_t;
    acc_t acc[2][2][4][2];
#pragma unroll
    for (int a = 0; a < 2; ++a)
#pragma unroll
        for (int b = 0; b < 2; ++b)
#pragma unroll
            for (int m = 0; m < 4; ++m)
#pragma unroll
                for (int n = 0; n < 2; ++n) acc[a][b][m][n] = (acc_t){0, 0, 0, 0};
    bf16x8 At[4][2], B0[2][2], B1[2][2];
    const char* cA = (const char*)g.A + (size_t)cur.pm * tstep; const char* cB = (const char*)g.Bt + (size_t)cur.pn * tstep;
    S.a_ready(cur);
    if constexpr (SP2) {
        PG8_STAGE(PG8_SB(0, 0), cB, voffB); PG8_STAGE(PG8_SB(0, 1), cB + hstep, voffB); PG8_STAGE(PG8_SA(0, 0), cA, voffA); PG8_STAGE(PG8_SA(0, 1), cA + hstep, voffA);
        if (wr == 1) PG8_BAR;
        PG8_WAIT_V(2); PG8_BAR;
        PG8_STAGE(PG8_SB(1, 0), cB + kstep, voffB); PG8_STAGE(PG8_SA(1, 0), cA + kstep, voffA); PG8_STAGE(PG8_SB(1, 1), cB + hstep + kstep, voffB);
        PG8_WAIT_V(6); PG8_BAR;
    } else {
    PG8_STAGE(PG8_SB(0, 0), cB, voffB); PG8_STAGE(PG8_SA(0, 0), cA, voffA); PG8_STAGE(PG8_SB(0, 1), cB + hstep, voffB); PG8_STAGE(PG8_SA(0, 1), cA + hstep, voffA);
    if (wr == 1) PG8_BAR;
    PG8_WAIT_V(4); PG8_BAR;
    PG8_STAGE(PG8_SB(1, 0), cB + kstep, voffB); PG8_STAGE(PG8_SA(1, 0), cA + kstep, voffA); PG8_STAGE(PG8_SB(1, 1), cB + hstep + kstep, voffB);
    PG8_WAIT_V(6); PG8_BAR;
    }
    for (;;) {
        const bool has_next = S.next(ui + 1, nxt);
        const char* nA = has_next ? (const char*)g.A + (size_t)nxt.pm * tstep : cA; const char* nB = has_next ? (const char*)g.Bt + (size_t)nxt.pn * tstep : cB;
        for (int t = 0; t < nt; t += 2) {
            const bool last = (t == nt - 2);
            const char* a1 = cA + (size_t)(t + 1) * kstep;
            const char* a2 = last ? nA : cA + (size_t)(t + 2) * kstep; const char* b2 = last ? nB : cB + (size_t)(t + 2) * kstep;
            const char* a3 = a2 + kstep; const char* b3 = b2 + kstep;
            if (last && has_next) S.a_ready(nxt);
            if constexpr (SP2) {
            PG8_LDB(B0, 0, 0); PG8_LDB(B1, 0, 1); PG8_SCHED; PG8_LDA(At, 0, 0); PG8_STAGE(PG8_SA(1, 1), a1 + hstep, voffA);
            PG8_WAIT_V(8); PG8_WAIT_L(0); PG8_BAR; PG8_MMA(0, 0, At, B0); PG8_MMA(0, 1, At, B1); PG8_BAR; PG8_SCHED;
            PG8_LDA(At, 0, 1); PG8_STAGE(PG8_SB(0, 0), b2, voffB); PG8_STAGE(PG8_SB(0, 1), b2 + hstep, voffB); PG8_STAGE(PG8_SA(0, 0), a2, voffA);
            PG8_WAIT_V(8); PG8_WAIT_L(0); PG8_BAR; PG8_MMA(1, 0, At, B0); PG8_MMA(1, 1, At, B1); PG8_BAR; PG8_SCHED;
            PG8_LDB(B0, 1, 0); PG8_LDB(B1, 1, 1); PG8_SCHED; PG8_LDA(At, 1, 0); PG8_STAGE(PG8_SA(0, 1), a2 + hstep, voffA);
            PG8_WAIT_V(8); PG8_WAIT_L(0); PG8_BAR; PG8_MMA(0, 0, At, B0); PG8_MMA(0, 1, At, B1); PG8_BAR; PG8_SCHED;
            PG8_LDA(At, 1, 1); PG8_STAGE(PG8_SB(1, 0), b3, voffB); PG8_STAGE(PG8_SB(1, 1), b3 + hstep, voffB); PG8_STAGE(PG8_SA(1, 0), a3, voffA);
            PG8_WAIT_V(8); PG8_WAIT_L(0); PG8_BAR; PG8_MMA(1, 0, At, B0); PG8_MMA(1, 1, At, B1); PG8_BAR; PG8_SCHED;
            } else {
            PG8_LDB(B0, 0, 0); PG8_SCHED; PG8_LDA(At, 0, 0); PG8_STAGE(PG8_SA(1, 1), a1 + hstep, voffA);
            PG8_WAIT_L(8); PG8_BAR; PG8_WAIT_L(0); PG8_MMA(0, 0, At, B0); PG8_BAR; PG8_SCHED;
            PG8_LDB(B1, 0, 1); PG8_STAGE(PG8_SB(0, 0), b2, voffB);
            PG8_BAR; PG8_WAIT_L(0); PG8_MMA(0, 1, At, B1); PG8_BAR;
            PG8_LDA(At, 0, 1); PG8_STAGE(PG8_SA(0, 0), a2, voffA);
            PG8_BAR; PG8_WAIT_L(0); PG8_MMA(1, 0, At, B0); PG8_BAR; PG8_SCHED;
            PG8_STAGE(PG8_SB(0, 1), b2 + hstep, voffB);
            PG8_WAIT_V(6); PG8_BAR; PG8_MMA(1, 1, At, B1); PG8_BAR;
            PG8_LDB(B0, 1, 0); PG8_SCHED; PG8_LDA(At, 1, 0); PG8_STAGE(PG8_SA(0, 1), a2 + hstep, voffA);
            PG8_WAIT_L(8); PG8_BAR; PG8_WAIT_L(0); PG8_MMA(0, 0, At, B0); PG8_BAR; PG8_SCHED;
            PG8_LDB(B1, 1, 1); PG8_STAGE(PG8_SB(1, 0), b3, voffB);
            PG8_BAR; PG8_WAIT_L(0); PG8_MMA(0, 1, At, B1); PG8_BAR;
            PG8_LDA(At, 1, 1); PG8_STAGE(PG8_SA(1, 0), a3, voffA);
            PG8_BAR; PG8_WAIT_L(0); PG8_MMA(1, 0, At, B0); PG8_BAR; PG8_SCHED;
            PG8_STAGE(PG8_SB(1, 1), b3 + hstep, voffB);
            PG8_WAIT_V(6); PG8_BAR; PG8_MMA(1, 1, At, B1); PG8_BAR;
            }
        }
        if constexpr (ALIGN_EPI) { if (wr == 0) PG8_BAR; }
        E(acc, cur, wr, wc, fr, fq); S.done(cur);
        if (!has_next) break;
#pragma unroll
        for (int a = 0; a < 2; ++a)
#pragma unroll
            for (int b = 0; b < 2; ++b)
#pragma unroll
                for (int m = 0; m < 4; ++m)
#pragma unroll
                    for (int n = 0; n < 2; ++n) acc[a][b][m][n] = (acc_t){0, 0, 0, 0};
        cur = nxt; cA = nA; cB = nB; ++ui;
        if constexpr (ALIGN_EPI) { if (wr == 1) PG8_BAR; }
    }
    PG8_WAIT_V(0);
    if constexpr (!ALIGN_EPI) { if (wr == 0) PG8_BAR; }
    PG8_BAR;
#undef PG8_SA
#undef PG8_SB
#undef PG8_STAGE
#undef PG8_LDA
#undef PG8_LDB
#undef PG8_MMA
#undef PG8_WAIT_V
#undef PG8_WAIT_L
#undef PG8_BAR
#undef PG8_SCHED
}
}

#define XB_TMO      128
#define XB_XCNT(j)  (256  + 64 * (j))
#define XB_XSUB(j)  (1280 + 64 * (j))
#define XB_XGEN(j)  (2304 + 64 * (j))
#define XB_TOP      3328
#define XB_TOPGEN   3392
#define XCD_BAR_WORDS 3456
#define XB_SPIN_CAP (1u << 22)
__device__ __forceinline__ unsigned xb_ld(unsigned* p)              { return __hip_atomic_load(p, __ATOMIC_RELAXED, __HIP_MEMORY_SCOPE_AGENT); }
__device__ __forceinline__ unsigned xb_add(unsigned* p, unsigned v) { return __hip_atomic_fetch_add(p, v, __ATOMIC_RELAXED, __HIP_MEMORY_SCOPE_AGENT); }
__device__ __forceinline__ unsigned xb_xcc_id() { return (unsigned)__builtin_amdgcn_s_getreg((3 << 11) | 20) & 0xFu; }
#define XB_SPIN(cond, bar) do { unsigned _sp = 0; while (cond) { __builtin_amdgcn_s_sleep(1); \
    if ((++_sp & 255u) == 0u) { if (xb_ld(&(bar)[XB_TMO])) break; if (_sp > XB_SPIN_CAP) { atomicAdd(&(bar)[XB_TMO], 1u); break; } } } } while (0)
struct XcdBarrier { unsigned* bar; unsigned x; volatile LAS unsigned* st; };
__device__ __forceinline__ XcdBarrier xcd_barrier_post(unsigned* bar, volatile LAS unsigned* st) {
    XcdBarrier b; b.bar = bar; b.x = xb_xcc_id(); b.st = st;
    if (threadIdx.x == 0) (void)xb_add(&bar[XB_XCNT(b.x)], 1u);
    return b;
}
__device__ __forceinline__ void xcd_barrier_complete(unsigned* bar, unsigned x, unsigned& nloc, unsigned& nx) {
    const unsigned G = gridDim.x * gridDim.y * gridDim.z;
    unsigned sum, cnt, mine, sp = 0u;
    for (;;) {
        sum = 0u; cnt = 0u; mine = 0u;
#pragma unroll
        for (unsigned j = 0; j < 16; ++j) { const unsigned c = xb_ld(&bar[XB_XCNT(j)]); sum += c; cnt += (c > 0u) ? 1u : 0u; mine = (j == x) ? c : mine; }
        if (sum == G) break;
        __builtin_amdgcn_s_sleep(1);
        if ((++sp & 255u) == 0u) { if (xb_ld(&bar[XB_TMO])) break; if (sp > XB_SPIN_CAP) { atomicAdd(&bar[XB_TMO], 1u); break; } }
    }
    nloc = mine > 0u ? mine : 1u; nx = cnt > 0u ? cnt : 1u;
}
__device__ __forceinline__ void xcd_barrier(const XcdBarrier& b) {
    asm volatile("s_waitcnt vmcnt(0)" ::: "memory");
    __syncthreads();
    if (threadIdx.x == 0) {
        unsigned* bar = b.bar;
        __builtin_amdgcn_s_waitcnt(0);
        unsigned nloc = b.st[0], nx = b.st[1];
        if (nloc == 0u) { xcd_barrier_complete(bar, b.x, nloc, nx); b.st[0] = nloc; b.st[1] = nx; }
        const unsigned old = xb_add(&bar[XB_XSUB(b.x)], 1u);
        const unsigned gen = old / nloc;
        if (old + 1u == (gen + 1u) * nloc) {
            __builtin_amdgcn_fence(__ATOMIC_RELEASE, "agent");
            asm volatile("s_waitcnt vmcnt(0)" ::: "memory");
            const unsigned og = xb_add(&bar[XB_TOP], 1u);
            const unsigned tg = og / nx;
            if (og + 1u == (tg + 1u) * nx) xb_add(&bar[XB_TOPGEN], 1u);
            else XB_SPIN(xb_ld(&bar[XB_TOPGEN]) == tg, bar);
            __builtin_amdgcn_fence(__ATOMIC_ACQUIRE, "agent");
            xb_add(&bar[XB_XGEN(b.x)], 1u);
            asm volatile("s_waitcnt vmcnt(0)" ::: "memory");
        } else {
            XB_SPIN(xb_ld(&bar[XB_XGEN(b.x)]) == gen, bar);
            __builtin_amdgcn_fence(__ATOMIC_ACQUIRE, "agent");
            asm volatile("s_waitcnt vmcnt(0)" ::: "memory");
        }
    }
    __syncthreads();
}

constexpr int NWAVES = 8, NTHR = 512;
constexpr int LDS_MISC = 131072, LDS_BYTES = 131072 + 1024;
struct Args { const float* in[45]; float* out; unsigned char* ws; };
#define GAS __attribute__((address_space(1)))
struct Frame {
    LAS unsigned char* lds; float* out; unsigned char* ws;
    int tid, lane, wave, blk, G;
};
#define WSP(T, off) ((T*)(F.ws + (off)))
__device__ __forceinline__ const float* inp_(LAS unsigned char* lds, int k) {
    const LAS unsigned* t = (const LAS unsigned*)(lds + 131072 + 256) + 2 * k;
    const unsigned lo = __builtin_amdgcn_readfirstlane(t[0]), hi = __builtin_amdgcn_readfirstlane(t[1]);
    return (const float*)(const GAS float*)(((unsigned long long)hi << 32) | lo);
}
#define INP(k) inp_(F.lds, (k))

__device__ __forceinline__ void tr_item(const float* W, int ld, int col0, int ncv, bf16* WT, int K, int row_off, LAS float* scr, int kb, int nb, int lane) {
    const int k0 = 64 * kb, n0 = 32 * nb; const int nn = n0 + (lane & 31); const bool ok = nn < ncv;
#pragma unroll 8
    for (int i = 0; i < 32; ++i) { const int kk = 2 * i + (lane >> 5); scr[kk * 33 + (lane & 31)] = ok ? W[(size_t)(k0 + kk) * ld + col0 + nn] : 0.f; }
    asm volatile("s_waitcnt lgkmcnt(0)" ::: "memory");
    const int c = lane & 7;
#pragma unroll
    for (int j = 0; j < 4; ++j) { const int n = (lane >> 3) + 8 * j; const LAS float* s = scr + (8 * c) * 33 + n;
        u32x4 o; o.x = pk2(s[0 * 33], s[1 * 33]); o.y = pk2(s[2 * 33], s[3 * 33]); o.z = pk2(s[4 * 33], s[5 * 33]); o.w = pk2(s[6 * 33], s[7 * 33]);
        *(u32x4*)(WT + (size_t)(row_off + n0 + n) * K + k0 + 8 * c) = o; }
    asm volatile("s_waitcnt lgkmcnt(0)" ::: "memory");
}
__device__ __forceinline__ void convert_weights(Frame& F, int l) {
    LAS float* scr = (LAS float*)(F.lds + F.wave * 16384);
    const int gw = F.blk * NWAVES + F.wave, NGW = F.G * NWAVES;
    constexpr int I0 = 32 * 152, I1 = I0, I2 = I1 + 4 * 8 * 64, I3 = I2 + 32 * 64, I4 = I3, I5 = I4, I6 = I5 + 96 * 64, I7 = I6 + 8 * 16;
    const float* win = INP(2) + (size_t)l * DM * INC;
    for (int it = gw; it < I7; it += NGW) {
        if (it < I0) { const int r = it; tr_item(win, INC, 0, MIXC, WSP(bf16, WS_WIN), DM, 0, scr, r / 152, r % 152, F.lane); }
        else if (it < I1) { }
        else if (it < I2) { const int r = it - I1; const int k = r / 512, rr = r % 512; tr_item(INP(36) + ((size_t)l * 4 + k) * 512 * DM, DM, 0, DM, WSP(bf16, WS_WPK), 512, k * DM, scr, rr / 64, rr % 64, F.lane); }
        else if (it < I3) { const int r = it - I2; tr_item(INP(37) + (size_t)l * DM * DM, DM, 0, DM, WSP(bf16, WS_WOUT), DM, 0, scr, r / 64, r % 64, F.lane); }
        else if (it < I4) { const int r = it - I3; tr_item(INP(39) + (size_t)l * DM * FF, FF, 0, FF, WSP(bf16, WS_WFG), DM, 0, scr, r / 192, r % 192, F.lane); }
        else if (it < I5) { const int r = it - I4; tr_item(INP(40) + (size_t)l * DM * FF, FF, 0, FF, WSP(bf16, WS_WFU), DM, 0, scr, r / 192, r % 192, F.lane); }
        else if (it < I6) { const int r = it - I5; tr_item(INP(43) + (size_t)l * FF * DM, DM, 0, DM, WSP(bf16, WS_WFD), FF, 0, scr, r / 64, r % 64, F.lane); }
        else { const int r = it - I6; tr_item(INP(11) + (size_t)l * 512 * 512, 512, 0, 512, WSP(bf16, WS_WGLU), 512, 0, scr, r / 16, r % 16, F.lane); }
    }
}
__device__ __forceinline__ void rmsnorm_rows(Frame& F, const float* x, const float* g, bf16* obf, float* of32, unsigned* a8 = nullptr, float* sa = nullptr) {
    const int gw = F.blk * NWAVES + F.wave, NGW = F.G * NWAVES;
    f32x4 gv[8];
#pragma unroll
    for (int j = 0; j < 8; ++j) gv[j] = ((const f32x4*)g)[64 * j + F.lane];
    for (int m = gw; m < MTOK; m += NGW) {
        const f32x4* xr = (const f32x4*)(x + (size_t)m * DM) + F.lane;
        f32x4 v[8]; float s = 0.f;
#pragma unroll
        for (int j = 0; j < 8; ++j) { v[j] = xr[64 * j]; s += (v[j].x * v[j].x + v[j].y * v[j].y) + (v[j].z * v[j].z + v[j].w * v[j].w); }
        const float rs = 1.0f / sqrtf(wave_sum(s) * (1.f / DM) + 1e-6f);
#pragma unroll
        for (int j = 0; j < 8; ++j) v[j] = v[j] * rs * gv[j];
        if (obf) { u32x2* o = (u32x2*)(obf + (size_t)m * DM) + F.lane;
#pragma unroll
            for (int j = 0; j < 8; ++j) { u32x2 w; w.x = pk2(v[j].x, v[j].y); w.y = pk2(v[j].z, v[j].w); o[64 * j] = w; } }
        if (of32) { f32x4* o = (f32x4*)(of32 + (size_t)m * DM) + F.lane;
#pragma unroll
            for (int j = 0; j < 8; ++j) o[64 * j] = v[j]; }
        if (a8) {
            float am = 0.f;
#pragma unroll
            for (int j = 0; j < 8; ++j) am = fmaxf(fmaxf(am, fmaxf(fabsf(v[j].x), fabsf(v[j].y))), fmaxf(fabsf(v[j].z), fabsf(v[j].w)));
            am = fmaxf(wave_max(am), 1e-20f); const float inv = 127.0f / am;
            unsigned* o = a8 + (size_t)m * (DM / 4) + F.lane;
#pragma unroll
            for (int j = 0; j < 8; ++j) o[64 * j] = q8x4(v[j].x, v[j].y, v[j].z, v[j].w, inv);
            if (F.lane == 0) sa[m] = am * (1.0f / 127.0f); }
    }
}
__device__ __forceinline__ void convert_cols_i8(Frame& F, const float* W, int ld, int col0, int nb, signed char* W8, float* sb, int row_off) {
    LAS float* red = (LAS float*)(F.lds + 8 * 16384 - 4096);
    LAS float* scl = red + 512;
    const int tid = F.tid, n = tid & 31, kg = tid >> 5; const float* wp = W + col0 + 32 * nb + n;
    float am = 0.f;
#pragma unroll 8
    for (int i = 0; i < 128; ++i) am = fmaxf(am, fabsf(wp[(size_t)(kg + 16 * i) * ld]));
    red[kg * 32 + n] = am;
    __syncthreads();
    if (tid < 32) { float a = 0.f;
#pragma unroll
        for (int q = 0; q < 16; ++q) a = fmaxf(a, red[q * 32 + tid]);
        a = fmaxf(a, 1e-30f); scl[tid] = 127.0f / a; sb[row_off + 32 * nb + tid] = a * (1.0f / 127.0f); }
    __syncthreads();
    LAS float* scr = (LAS float*)(F.lds + F.wave * 16384);
    const int lane = F.lane, rn = lane >> 1, half = lane & 1; const float inv = scl[rn];
#pragma unroll 1
    for (int kb = F.wave; kb < 32; kb += NWAVES) {
#pragma unroll 8
        for (int i = 0; i < 32; ++i) { const int kk = 2 * i + (lane >> 5); scr[kk * 33 + (lane & 31)] = W[(size_t)(64 * kb + kk) * ld + col0 + 32 * nb + (lane & 31)]; }
        asm volatile("s_waitcnt lgkmcnt(0)" ::: "memory");
        const LAS float* sp = scr + (32 * half) * 33 + rn;
        u32x4 w0, w1;
        w0.x = q8x4(sp[0 * 33], sp[1 * 33], sp[2 * 33], sp[3 * 33], inv); w0.y = q8x4(sp[4 * 33], sp[5 * 33], sp[6 * 33], sp[7 * 33], inv);
        w0.z = q8x4(sp[8 * 33], sp[9 * 33], sp[10 * 33], sp[11 * 33], inv); w0.w = q8x4(sp[12 * 33], sp[13 * 33], sp[14 * 33], sp[15 * 33], inv);
        w1.x = q8x4(sp[16 * 33], sp[17 * 33], sp[18 * 33], sp[19 * 33], inv); w1.y = q8x4(sp[20 * 33], sp[21 * 33], sp[22 * 33], sp[23 * 33], inv);
        w1.z = q8x4(sp[24 * 33], sp[25 * 33], sp[26 * 33], sp[27 * 33], inv); w1.w = q8x4(sp[28 * 33], sp[29 * 33], sp[30 * 33], sp[31 * 33], inv);
        u32x4* d = (u32x4*)(W8 + (size_t)(row_off + 32 * nb + rn) * DM + 64 * kb + 32 * half); d[0] = w0; d[1] = w1;
        asm volatile("s_waitcnt lgkmcnt(0)" ::: "memory");
    }
    __syncthreads();
}

constexpr int WAVE_LDS = 16384;
constexpr int LR_XLD = 72, LR_FLD = 66, LR_ALD = 132;
constexpr int LR_XF = 16 * LR_XLD * 2, LR_AB = LR_XF + 16 * LR_FLD * 4;
template <bool FINAL> __device__ __forceinline__ void lru_task(Frame& F, int l, int task) {
    const int lane = F.lane, fr = lane & 15, fq = lane >> 4; const int b = task >> 9, h = (task >> 6) & 7, c = task & 63; const int ch = 64 * h + lane;
    LAS unsigned char* wl = F.lds + F.wave * WAVE_LDS;
    LAS bf16* XC = (LAS bf16*)wl; LAS float* XF = (LAS float*)(wl + LR_XF); LAS float* AB = (LAS float*)(wl + LR_AB);
    const float* WA = INP(14) + ((size_t)l * 8 + h) * 4096; const float* WX = INP(16) + ((size_t)l * 8 + h) * 4096;
    bf16x8 Wa[4][2], Wx[4][2];
#pragma unroll
    for (int nt = 0; nt < 4; ++nt)
#pragma unroll
        for (int kk = 0; kk < 2; ++kk) { const float* pa = WA + (size_t)(32 * kk + 8 * fq) * 64 + 16 * nt + fr; const float* px_ = WX + (size_t)(32 * kk + 8 * fq) * 64 + 16 * nt + fr;
            u32x4 wa_, wx_; wa_.x = pk2(pa[0], pa[64]); wa_.y = pk2(pa[128], pa[192]); wa_.z = pk2(pa[256], pa[320]); wa_.w = pk2(pa[384], pa[448]);
            wx_.x = pk2(px_[0], px_[64]); wx_.y = pk2(px_[128], px_[192]); wx_.z = pk2(px_[256], px_[320]); wx_.w = pk2(px_[384], px_[448]);
            Wa[nt][kk] = __builtin_bit_cast(bf16x8, wa_); Wx[nt][kk] = __builtin_bit_cast(bf16x8, wx_); }
    float ba4[4], bx4[4], sp4[4], slp[4];
#pragma unroll
    for (int nt = 0; nt < 4; ++nt) { const int jj = l * 512 + 64 * h + 16 * nt + fr; ba4[nt] = INP(15)[jj]; bx4[nt] = INP(17)[jj]; sp4[nt] = softplusf_(-INP(18)[jj]); slp[nt] = 0.f; }
    const float* cwp = INP(12) + (size_t)l * 4 * 512 + ch;
    const float cw0 = cwp[0], cw1 = cwp[512], cw2 = cwp[1024], cw3 = cwp[1536];
    const float cb = INP(13)[l * 512 + ch];
    const size_t row0 = (size_t)b * SEQ + (size_t)c * 128;
    const bf16* px = WSP(const bf16, WS_PROJ) + row0 * MIXP + PC_LRX + ch;
    const bf16* pg = WSP(const bf16, WS_PROJ) + row0 * MIXP + PC_LRG + ch;
    float xm3 = 0.f, xm2 = 0.f, xm1 = 0.f;
    if (c > 0) { xm3 = bf2f(*(px - 3 * (ptrdiff_t)MIXP)); xm2 = bf2f(*(px - 2 * (ptrdiff_t)MIXP)); xm1 = bf2f(*(px - (ptrdiff_t)MIXP)); }
    float hs = 0.f;
    const size_t cidx = ((size_t)b * 64 + c) * 512 + ch;
    if (FINAL) hs = WSP(const float, WS_LRI)[cidx];
    bf16* yo = WSP(bf16, WS_YK) + (size_t)1 * MTOK * 512 + row0 * 512 + ch;
    bf16 xs[16], gs[16];
#pragma unroll
    for (int j = 0; j < 16; ++j) { xs[j] = px[(size_t)j * MIXP]; if (FINAL) gs[j] = pg[(size_t)j * MIXP]; }
#pragma unroll 1
    for (int sb = 0; sb < 8; ++sb) {
#pragma unroll
        for (int t = 0; t < 16; ++t) { const float xv = bf2f(xs[t]); const float xc = cb + cw0 * xm3 + cw1 * xm2 + cw2 * xm1 + cw3 * xv; xm3 = xm2; xm2 = xm1; xm1 = xv;
            XC[t * LR_XLD + lane] = (bf16)f2bf(xc); XF[t * LR_FLD + lane] = xc; }
        float gl[16];
        if (FINAL) {
#pragma unroll
            for (int t = 0; t < 16; ++t) gl[t] = bf2f(gs[t]); }
        if (sb < 7) {
#pragma unroll
            for (int j = 0; j < 16; ++j) { xs[j] = px[(size_t)((sb + 1) * 16 + j) * MIXP]; if (FINAL) gs[j] = pg[(size_t)((sb + 1) * 16 + j) * MIXP]; } }
        const bf16x8 af0 = *(const LAS bf16x8*)(XC + fr * LR_XLD + 8 * fq), af1 = *(const LAS bf16x8*)(XC + fr * LR_XLD + 32 + 8 * fq);
#pragma unroll
        for (int nt = 0; nt < 4; ++nt) {
            f32x4 aa = (f32x4){0.f, 0.f, 0.f, 0.f}, ax = (f32x4){0.f, 0.f, 0.f, 0.f};
            aa = __builtin_amdgcn_mfma_f32_16x16x32_bf16(af0, Wa[nt][0], aa, 0, 0, 0); aa = __builtin_amdgcn_mfma_f32_16x16x32_bf16(af1, Wa[nt][1], aa, 0, 0, 0);
            ax = __builtin_amdgcn_mfma_f32_16x16x32_bf16(af0, Wx[nt][0], ax, 0, 0, 0); ax = __builtin_amdgcn_mfma_f32_16x16x32_bf16(af1, Wx[nt][1], ax, 0, 0, 0);
#pragma unroll
            for (int e = 0; e < 4; ++e) { const int t = 4 * fq + e, jj = 16 * nt + fr; const float xc = XF[t * LR_FLD + jj];
                const float r = sigmoidf_(aa[e] + ba4[nt]), ig = sigmoidf_(ax[e] + bx4[nt]); const float la = -8.0f * r * sp4[nt]; const float av = __expf(la);
                const float mult = __builtin_amdgcn_sqrtf(fmaxf(1.0f - av * av, 0.f));
                AB[t * LR_ALD + jj] = av; AB[t * LR_ALD + 64 + jj] = xc * ig * mult; if (!FINAL) slp[nt] += la; }
        }
#pragma unroll
        for (int t = 0; t < 16; ++t) { const float av = AB[t * LR_ALD + lane], bv = AB[t * LR_ALD + 64 + lane]; hs = av * hs + bv;
            if (FINAL) yo[(size_t)(sb * 16 + t) * 512] = (bf16)f2bf(hs * geluf_(gl[t])); }
    }
    if (!FINAL) { WSP(float, WS_LRE)[cidx] = hs;
#pragma unroll
        for (int nt = 0; nt < 4; ++nt) { float v = slp[nt]; v += __shfl_xor(v, 16); v += __shfl_xor(v, 32); if (fq == 0) WSP(float, WS_LRA)[((size_t)b * 64 + c) * 512 + 64 * h + 16 * nt + fr] = v; } }
}
__device__ __forceinline__ void lru_carry(Frame& F, int task) {
    const int b = task >> 3, ch = (task & 7) * 64 + F.lane; float run = 0.f;
#pragma unroll 1
    for (int c = 0; c < 64; ++c) { const size_t i = ((size_t)b * 64 + c) * 512 + ch; WSP(float, WS_LRI)[i] = run; run = __expf(WSP(const float, WS_LRA)[i]) * run + WSP(const float, WS_LRE)[i]; }
}

constexpr int S5_XLD = 132, S5_SLD = 136, S5_SB = 16 * S5_XLD * 4;
template <bool FINAL> __device__ __forceinline__ void s5_task(Frame& F, int l, int task) {
    const int lane = F.lane, fr = lane & 15, fq = lane >> 4; const int b = task >> 11, g = (task >> 6) & 31, c = task & 63; const int p = lane;
    LAS unsigned char* wl = F.lds + F.wave * WAVE_LDS;
    LAS float* X = (LAS float*)wl; LAS bf16* Sb = (LAS bf16*)(wl + S5_SB);
    const int lg = l * 32 + g;
    const float lr = INP(3)[lg * 64 + p], li = INP(4)[lg * 64 + p]; const float dt = expf(INP(10)[lg]);
    const float mag = expf(lr * dt); float sn, cs; sincosf(li * dt, &sn, &cs); const float abr = mag * cs, abi = mag * sn;
    const float den = lr * lr + li * li, nr = abr - 1.0f, ni = abi; const float fre = (nr * lr + ni * li) / den, fim = (ni * lr - nr * li) / den;
    bf16x8 Bf[8];
#pragma unroll
    for (int nq = 0; nq < 4; ++nq) { const int pp = 16 * nq + fr; const float fr_ = __shfl(fre, pp), fi_ = __shfl(fim, pp);
        u32x4 wr_ = (u32x4){0u, 0u, 0u, 0u}, wi_ = (u32x4){0u, 0u, 0u, 0u};
        if (fq < 2) { const f32x4* br = (const f32x4*)(INP(5) + ((size_t)lg * 64 + pp) * 16 + 8 * fq); const f32x4* bi = (const f32x4*)(INP(6) + ((size_t)lg * 64 + pp) * 16 + 8 * fq);
            const f32x4 r0 = br[0], r1 = br[1], i0 = bi[0], i1 = bi[1];
            wr_.x = pk2(fr_ * r0[0] - fi_ * i0[0], fr_ * r0[1] - fi_ * i0[1]); wr_.y = pk2(fr_ * r0[2] - fi_ * i0[2], fr_ * r0[3] - fi_ * i0[3]);
            wr_.z = pk2(fr_ * r1[0] - fi_ * i1[0], fr_ * r1[1] - fi_ * i1[1]); wr_.w = pk2(fr_ * r1[2] - fi_ * i1[2], fr_ * r1[3] - fi_ * i1[3]);
            wi_.x = pk2(fr_ * i0[0] + fi_ * r0[0], fr_ * i0[1] + fi_ * r0[1]); wi_.y = pk2(fr_ * i0[2] + fi_ * r0[2], fr_ * i0[3] + fi_ * r0[3]);
            wi_.z = pk2(fr_ * i1[0] + fi_ * r1[0], fr_ * i1[1] + fi_ * r1[1]); wi_.w = pk2(fr_ * i1[2] + fi_ * r1[2], fr_ * i1[3] + fi_ * r1[3]); }
        Bf[nq] = __builtin_bit_cast(bf16x8, wr_); Bf[nq + 4] = __builtin_bit_cast(bf16x8, wi_); }
    bf16x8 Cf[4], Df;
    if (FINAL) {
#pragma unroll
        for (int kk = 0; kk < 4; ++kk) { const float* src = (kk < 2 ? INP(7) : INP(8)) + ((size_t)lg * 16 + fr) * 64 + 32 * (kk & 1) + 8 * fq; const float sg = kk < 2 ? 1.0f : -1.0f;
            const f32x4 c0 = *(const f32x4*)src, c1 = *(const f32x4*)(src + 4);
            u32x4 w; w.x = pk2(sg * c0[0], sg * c0[1]); w.y = pk2(sg * c0[2], sg * c0[3]); w.z = pk2(sg * c1[0], sg * c1[1]); w.w = pk2(sg * c1[2], sg * c1[3]); Cf[kk] = __builtin_bit_cast(bf16x8, w); }
        const float dv = INP(9)[l * 512 + 16 * g + fr]; float dd[8];
#pragma unroll
        for (int j = 0; j < 8; ++j) dd[j] = (8 * fq + j == fr) ? dv : 0.f;
        u32x4 w; w.x = pk2(dd[0], dd[1]); w.y = pk2(dd[2], dd[3]); w.z = pk2(dd[4], dd[5]); w.w = pk2(dd[6], dd[7]); Df = __builtin_bit_cast(bf16x8, w);
    }
    float sre = 0.f, sim = 0.f;
    const size_t sidx = (((size_t)b * 32 + g) * 64 + c) * 128 + p;
    if (FINAL) { sre = WSP(const float, WS_S5I)[sidx]; sim = WSP(const float, WS_S5I)[sidx + 64]; }
    const size_t row0 = (size_t)b * SEQ + (size_t)c * 128;
    const bf16* up = WSP(const bf16, WS_PROJ) + (row0 + fr) * MIXP + PC_S5U + 16 * g + 8 * (fq & 1);
    u32x4 aun = *(const u32x4*)up;
#pragma unroll 1
    for (int sb = 0; sb < 8; ++sb) {
        u32x4 au_ = aun; if (fq >= 2) au_ = (u32x4){0u, 0u, 0u, 0u};
        const bf16x8 au = __builtin_bit_cast(bf16x8, au_);
        if (sb < 7) aun = *(const u32x4*)(up + (size_t)(sb + 1) * 16 * MIXP);
#pragma unroll
        for (int nt = 0; nt < 8; ++nt) { const f32x4 a = __builtin_amdgcn_mfma_f32_16x16x32_bf16(au, Bf[nt], (f32x4){0.f, 0.f, 0.f, 0.f}, 0, 0, 0);
#pragma unroll
            for (int e = 0; e < 4; ++e) X[(4 * fq + e) * S5_XLD + 16 * nt + fr] = a[e]; }
#pragma unroll
        for (int t = 0; t < 16; ++t) { const float xr = X[t * S5_XLD + p], xi = X[t * S5_XLD + 64 + p];
            const float nre = abr * sre - abi * sim + xr, nim = abr * sim + abi * sre + xi; sre = nre; sim = nim;
            if (FINAL) { Sb[t * S5_SLD + p] = (bf16)f2bf(sre); Sb[t * S5_SLD + 64 + p] = (bf16)f2bf(sim); } }
        if (FINAL) {
            f32x4 y = (f32x4){0.f, 0.f, 0.f, 0.f};
#pragma unroll
            for (int kk = 0; kk < 4; ++kk) y = __builtin_amdgcn_mfma_f32_16x16x32_bf16(*(const LAS bf16x8*)(Sb + fr * S5_SLD + 32 * kk + 8 * fq), Cf[kk], y, 0, 0, 0);
            y = __builtin_amdgcn_mfma_f32_16x16x32_bf16(au, Df, y, 0, 0, 0);
#pragma unroll
            for (int e = 0; e < 4; ++e) WSP(bf16, WS_S5Z)[(row0 + sb * 16 + 4 * fq + e) * 512 + 16 * g + fr] = (bf16)f2bf(geluf_(y[e]));
        }
    }
    if (!FINAL) { WSP(float, WS_S5E)[sidx] = sre; WSP(float, WS_S5E)[sidx + 64] = sim; }
}
__device__ __forceinline__ void s5_carry(Frame& F, int l, int task) {
    const int b = task >> 5, g = task & 31, p = F.lane;
    const float lr = INP(3)[(l * 32 + g) * 64 + p], li = INP(4)[(l * 32 + g) * 64 + p]; const float dt = expf(INP(10)[l * 32 + g]);
    const float mag = expf(lr * dt); float sn, cs; sincosf(li * dt, &sn, &cs); float ar = mag * cs, ai = mag * sn;
#pragma unroll
    for (int i = 0; i < 7; ++i) { const float nr = ar * ar - ai * ai, ni = 2.0f * ar * ai; ar = nr; ai = ni; }
    float rr = 0.f, ri = 0.f;
#pragma unroll 1
    for (int c = 0; c < 64; ++c) { const size_t i = (((size_t)b * 32 + g) * 64 + c) * 128 + p;
        WSP(float, WS_S5I)[i] = rr; WSP(float, WS_S5I)[i + 64] = ri;
        const float er = WSP(const float, WS_S5E)[i], ei = WSP(const float, WS_S5E)[i + 64];
        const float nr = ar * rr - ai * ri + er, ni = ar * ri + ai * rr + ei; rr = nr; ri = ni; }
}

constexpr int M2_CS = 0, M2_BS = 17408, M2_BST = 34816, M2_XT = 53248, M2_GS = 90112, M2_CUM = 107520, M2_DTV = 108544, M2_END = 109568;
constexpr int LDP = 136, LDT = 72, LDG = 68;
__device__ __forceinline__ void m2_stage(Frame& F, int l, int b, int c, int gr) {
    LAS bf16* Cs = (LAS bf16*)(F.lds + M2_CS); LAS bf16* Bs = (LAS bf16*)(F.lds + M2_BS); LAS bf16* BsT = (LAS bf16*)(F.lds + M2_BST); LAS bf16* XT = (LAS bf16*)(F.lds + M2_XT);
    LAS float* cum = (LAS float*)(F.lds + M2_CUM); LAS float* dtv = (LAS float*)(F.lds + M2_DTV);
    const int tid = F.tid; const size_t row0 = (size_t)b * SEQ + (size_t)c * 64;
    {
        const int kind = tid < 256 ? 0 : (tid < 384 ? 1 : 2); const int idx = kind == 0 ? tid : (kind == 1 ? tid - 256 : tid - 384);
        const int col = kind == 0 ? 256 * gr + idx : (kind == 1 ? 512 + 128 * gr + idx : 768 + 128 * gr + idx);
        const float* cwp = INP(19) + (size_t)l * 4 * 1024 + col; const float cw0 = cwp[0], cw1 = cwp[1024], cw2 = cwp[2048], cw3 = cwp[3072]; const float cb = INP(20)[l * 1024 + col];
        const bf16* px = WSP(const bf16, WS_PROJ) + row0 * MIXP + PC_XBC + col;
        float xm3 = 0.f, xm2 = 0.f, xm1 = 0.f;
        if (c > 0) { xm3 = bf2f(*(px - 3 * (ptrdiff_t)MIXP)); xm2 = bf2f(*(px - 2 * (ptrdiff_t)MIXP)); xm1 = bf2f(*(px - (ptrdiff_t)MIXP)); }
        bf16 xall[64];
#pragma unroll
        for (int j = 0; j < 64; ++j) xall[j] = px[(size_t)j * MIXP];
#pragma unroll
        for (int tb = 0; tb < 8; ++tb) {
            float vv[8];
#pragma unroll
            for (int j = 0; j < 8; ++j) { const float xv = bf2f(xall[tb * 8 + j]);
                vv[j] = siluf_(cb + cw0 * xm3 + cw1 * xm2 + cw2 * xm1 + cw3 * xv); xm3 = xm2; xm2 = xm1; xm1 = xv; }
            u32x4 w; w.x = pk2(vv[0], vv[1]); w.y = pk2(vv[2], vv[3]); w.z = pk2(vv[4], vv[5]); w.w = pk2(vv[6], vv[7]);
            if (kind == 0) *(LAS u32x4*)(XT + idx * LDT + tb * 8) = w;
            else if (kind == 1) { *(LAS u32x4*)(BsT + idx * LDT + tb * 8) = w;
#pragma unroll
                for (int j = 0; j < 8; ++j) Bs[(tb * 8 + j) * LDP + idx] = (bf16)f2bf(vv[j]); }
            else {
#pragma unroll
                for (int j = 0; j < 8; ++j) Cs[(tb * 8 + j) * LDP + idx] = (bf16)f2bf(vv[j]); }
        }
    }
    if (tid < 256) { const int hh = tid >> 6, t = tid & 63, h = 4 * gr + hh;
        const float dtr = bf2f(WSP(const bf16, WS_PROJ)[(row0 + t) * MIXP + PC_DT + h]);
        const float dt = softplusf_(dtr + INP(21)[l * 8 + h]); const float a = -expf(INP(22)[l * 8 + h]);
        float s = dt * a;
#pragma unroll
        for (int o = 1; o < 64; o <<= 1) { const float n = __shfl_up(s, o); if (t >= o) s += n; }
        dtv[hh * 64 + t] = dt; cum[hh * 64 + t] = s; }
    __syncthreads();
}
__device__ __forceinline__ bf16x8 ldfrag(const LAS bf16* p) { return *(const LAS bf16x8*)p; }
__device__ __forceinline__ void m2_pass1(Frame& F, int l, int task) {
    const int b = task >> 8, c = (task >> 1) & 127, gr = task & 1;
    m2_stage(F, l, b, c, gr);
    LAS bf16* BsT = (LAS bf16*)(F.lds + M2_BST); LAS bf16* XT = (LAS bf16*)(F.lds + M2_XT); LAS float* cum = (LAS float*)(F.lds + M2_CUM); LAS float* dtv = (LAS float*)(F.lds + M2_DTV);
    const int lane = F.lane, hh = F.wave >> 1, half = F.wave & 1, h = 4 * gr + hh; const int fr = lane & 15, fq = lane >> 4;
    const float clast = cum[hh * 64 + 63];
    f32x4 acc[2][8];
#pragma unroll
    for (int i = 0; i < 2; ++i)
#pragma unroll
        for (int j = 0; j < 8; ++j) acc[i][j] = (f32x4){0.f, 0.f, 0.f, 0.f};
#pragma unroll
    for (int kk = 0; kk < 2; ++kk) {
        float fj[8];
#pragma unroll
        for (int e = 0; e < 8; ++e) { const int j = 32 * kk + 8 * fq + e; fj[e] = dtv[hh * 64 + j] * __expf(clast - cum[hh * 64 + j]); }
        bf16x8 af[2];
#pragma unroll
        for (int pi = 0; pi < 2; ++pi) { const int p = 16 * (2 * half + pi) + fr; const u32x4 raw = *(const LAS u32x4*)(XT + (64 * hh + p) * LDT + 32 * kk + 8 * fq);
            u32x4 w; w.x = pk2(lo16(raw.x) * fj[0], hi16(raw.x) * fj[1]); w.y = pk2(lo16(raw.y) * fj[2], hi16(raw.y) * fj[3]); w.z = pk2(lo16(raw.z) * fj[4], hi16(raw.z) * fj[5]); w.w = pk2(lo16(raw.w) * fj[6], hi16(raw.w) * fj[7]);
            af[pi] = __builtin_bit_cast(bf16x8, w); }
#pragma unroll
        for (int nt = 0; nt < 8; ++nt) { const bf16x8 bfr = ldfrag(BsT + (16 * nt + fr) * LDT + 32 * kk + 8 * fq);
#pragma unroll
            for (int pi = 0; pi < 2; ++pi) acc[pi][nt] = __builtin_amdgcn_mfma_f32_16x16x32_bf16(af[pi], bfr, acc[pi][nt], 0, 0, 0); }
    }
    bf16* S = WSP(bf16, WS_M2S) + ((((size_t)b * 128 + c) * 8 + h) * 64) * 128;
#pragma unroll
    for (int pi = 0; pi < 2; ++pi)
#pragma unroll
        for (int nt = 0; nt < 8; ++nt)
#pragma unroll
            for (int e = 0; e < 4; ++e) S[(size_t)(16 * (2 * half + pi) + 4 * fq + e) * 128 + 16 * nt + fr] = (bf16)f2bf(acc[pi][nt][e]);
    if (half == 0 && lane == 0) WSP(float, WS_M2D)[((size_t)b * 128 + c) * 8 + h] = __expf(clast);
    __syncthreads();
}
__device__ __forceinline__ void m2_carry(Frame& F) {
    const int gt = F.blk * NTHR + F.tid;
    for (int e = gt; e < NB * 8 * 8192; e += F.G * NTHR) {
        const int b = e >> 16, h = (e >> 13) & 7, pn = e & 8191; float run = 0.f;
        bf16* S = WSP(bf16, WS_M2S) + (((size_t)b * 128) * 8 + h) * 8192 + pn; const float* D = WSP(const float, WS_M2D) + (size_t)b * 128 * 8 + h;
#pragma unroll 1
        for (int c8 = 0; c8 < 16; ++c8) {
            float tv[8], dv[8];
#pragma unroll
            for (int j = 0; j < 8; ++j) { tv[j] = bf2f(S[(size_t)(c8 * 8 + j) * 8 * 8192]); dv[j] = D[(c8 * 8 + j) * 8]; }
#pragma unroll
            for (int j = 0; j < 8; ++j) { S[(size_t)(c8 * 8 + j) * 8 * 8192] = (bf16)f2bf(run); run = dv[j] * run + tv[j]; }
        }
    }
}
__device__ __forceinline__ void m2_pass2(Frame& F, int l, int task) {
    const int b = task >> 8, c = (task >> 1) & 127, gr = task & 1;
    m2_stage(F, l, b, c, gr);
    LAS bf16* Cs = (LAS bf16*)(F.lds + M2_CS); LAS bf16* Bs = (LAS bf16*)(F.lds + M2_BS); LAS bf16* XT = (LAS bf16*)(F.lds + M2_XT);
    LAS float* Gs = (LAS float*)(F.lds + M2_GS); LAS float* cum = (LAS float*)(F.lds + M2_CUM); LAS float* dtv = (LAS float*)(F.lds + M2_DTV);
    const int lane = F.lane, w = F.wave, fr = lane & 15, fq = lane >> 4;
#pragma unroll
    for (int q = 0; q < 2; ++q) { const int tile = 2 * w + q, it = tile >> 2, jt = tile & 3; f32x4 a = (f32x4){0.f, 0.f, 0.f, 0.f};
#pragma unroll
        for (int kk = 0; kk < 4; ++kk) a = __builtin_amdgcn_mfma_f32_16x16x32_bf16(ldfrag(Cs + (16 * it + fr) * LDP + 32 * kk + 8 * fq), ldfrag(Bs + (16 * jt + fr) * LDP + 32 * kk + 8 * fq), a, 0, 0, 0);
#pragma unroll
        for (int e = 0; e < 4; ++e) Gs[(16 * it + 4 * fq + e) * LDG + 16 * jt + fr] = a[e]; }
    __syncthreads();
    const int hh = w >> 1, half = w & 1, h = 4 * gr + hh;
    f32x4 accd[2][4], acco[2][4];
#pragma unroll
    for (int i = 0; i < 2; ++i)
#pragma unroll
        for (int j = 0; j < 4; ++j) { accd[i][j] = (f32x4){0.f, 0.f, 0.f, 0.f}; acco[i][j] = (f32x4){0.f, 0.f, 0.f, 0.f}; }
#pragma unroll
    for (int ii = 0; ii < 2; ++ii) { const int it = 2 * half + ii; const int i = 16 * it + fr; const float ci = cum[hh * 64 + i];
#pragma unroll
        for (int kk = 0; kk < 2; ++kk) { if (32 * kk > 16 * it + 15) continue;
            float wv[8];
#pragma unroll
            for (int e = 0; e < 8; ++e) { const int j = 32 * kk + 8 * fq + e; const float gv = Gs[i * LDG + j]; wv[e] = (j <= i) ? gv * __expf(ci - cum[hh * 64 + j]) * dtv[hh * 64 + j] : 0.f; }
            u32x4 ww; ww.x = pk2(wv[0], wv[1]); ww.y = pk2(wv[2], wv[3]); ww.z = pk2(wv[4], wv[5]); ww.w = pk2(wv[6], wv[7]);
            const bf16x8 af = __builtin_bit_cast(bf16x8, ww);
#pragma unroll
            for (int pt = 0; pt < 4; ++pt) accd[ii][pt] = __builtin_amdgcn_mfma_f32_16x16x32_bf16(af, ldfrag(XT + (64 * hh + 16 * pt + fr) * LDT + 32 * kk + 8 * fq), accd[ii][pt], 0, 0, 0); } }
    const bf16* S = WSP(const bf16, WS_M2S) + ((((size_t)b * 128 + c) * 8 + h) * 64) * 128;
#pragma unroll
    for (int kk = 0; kk < 4; ++kk) {
        bf16x8 bfr[4];
#pragma unroll
        for (int pt = 0; pt < 4; ++pt) bfr[pt] = *(const bf16x8*)(S + (size_t)(16 * pt + fr) * 128 + 32 * kk + 8 * fq);
#pragma unroll
        for (int ii = 0; ii < 2; ++ii) { const bf16x8 af = ldfrag(Cs + (16 * (2 * half + ii) + fr) * LDP + 32 * kk + 8 * fq);
#pragma unroll
            for (int pt = 0; pt < 4; ++pt) acco[ii][pt] = __builtin_amdgcn_mfma_f32_16x16x32_bf16(af, bfr[pt], acco[ii][pt], 0, 0, 0); }
    }
    const float dpar = INP(23)[l * 8 + h]; const size_t row0 = (size_t)b * SEQ + (size_t)c * 64;
#pragma unroll
    for (int ii = 0; ii < 2; ++ii)
#pragma unroll
        for (int e = 0; e < 4; ++e) { const int i = 16 * (2 * half + ii) + 4 * fq + e; const float ec = __expf(cum[hh * 64 + i]);
#pragma unroll
            for (int pt = 0; pt < 4; ++pt) { const int p = 16 * pt + fr;
                float y = accd[ii][pt][e] + ec * acco[ii][pt][e] + dpar * bf2f(XT[(64 * hh + p) * LDT + i]);
                const float z = bf2f(WSP(const bf16, WS_PROJ)[(row0 + i) * MIXP + PC_M2Z + 64 * h + p]);
                WSP(float, WS_M2Y)[(row0 + i) * 512 + 64 * h + p] = y * siluf_(z); } }
    __syncthreads();
}
__device__ __forceinline__ void m2_norm(Frame& F, int l, int gw, int ngw) {
    f32x4 g0 = *(const f32x4*)(INP(24) + l * 512 + 8 * F.lane), g1 = *(const f32x4*)(INP(24) + l * 512 + 8 * F.lane + 4);
    for (int m = gw; m < MTOK; m += ngw) { const f32x4* yp = (const f32x4*)(WSP(const float, WS_M2Y) + (size_t)m * 512 + 8 * F.lane); const f32x4 a = yp[0], b = yp[1];
        const float ss = wave_sum((a.x * a.x + a.y * a.y) + (a.z * a.z + a.w * a.w) + (b.x * b.x + b.y * b.y) + (b.z * b.z + b.w * b.w));
        const float rs = 1.0f / sqrtf(ss * (1.f / 512.f) + 1e-6f);
        u32x4 w; w.x = pk2(a.x * rs * g0.x, a.y * rs * g0.y); w.y = pk2(a.z * rs * g0.z, a.w * rs * g0.w); w.z = pk2(b.x * rs * g1.x, b.y * rs * g1.y); w.w = pk2(b.z * rs * g1.z, b.w * rs * g1.w);
        *(u32x4*)(WSP(bf16, WS_YK) + (size_t)2 * MTOK * 512 + (size_t)m * 512 + 8 * F.lane) = w; }
}

constexpr int RP_LDA = 72, RP_LDB = 104;
#define RWP_WFRAG(dst, base, ldrow) do { const float* p_ = (base); u32x4 w_; w_.x = pk2(p_[0], p_[512]); w_.y = pk2(p_[1024], p_[1536]); w_.z = pk2(p_[2048], p_[2560]); w_.w = pk2(p_[3072], p_[3584]); dst = __builtin_bit_cast(bf16x8, w_); } while (0)
__device__ __forceinline__ void rw_pre(Frame& F, int l, int task) {
    LAS bf16* SM0 = (LAS bf16*)F.lds;
    const int tid = F.tid, lane = F.lane, hh = F.wave, fr = lane & 15, fq = lane >> 4;
    const float* mu = INP(25) + (size_t)l * RWC;
    const size_t rowb = (size_t)task * 128;
    const bf16* P = WSP(const bf16, WS_PROJ);
    const bool nofirst = (rowb & (SEQ - 1)) != 0;
    const int c4 = 64 * hh + 4 * fr;
    {
        bf16x8 Bw[4], Ba[4];
#pragma unroll
        for (int ct = 0; ct < 4; ++ct) { RWP_WFRAG(Bw[ct], INP(27) + ((size_t)l * 32 + 8 * fq) * 512 + c4 + ct, 512); RWP_WFRAG(Ba[ct], INP(29) + ((size_t)l * 32 + 8 * fq) * 512 + c4 + ct, 512); }
        const float* pw0 = INP(26) + l * 512 + c4; const float* pa0 = INP(28) + l * 512 + c4; const float* pkk = INP(31) + l * 512 + c4; const float* pka = INP(32) + l * 512 + c4; const float* prk = INP(33) + l * 512 + c4;
        const int sj = tid & 63, st0 = tid >> 6, st1 = 8 + (tid >> 6); const float smu = mu[1536 + sj];
        const bf16* sq = P + rowb * MIXP + PC_RW + 1536 + sj;
        bf16 sc0, sp0, sc1, sp1;
        u32x2 rkv[4][3], rkvp[3];
        const bf16* rq = P + (rowb + 4 * fq) * MIXP + PC_RW + c4;
#define RWP_STAGE_LOAD(sb) do { const size_t o_ = (size_t)((sb) * 16) * MIXP; sc0 = sq[o_ + (size_t)st0 * MIXP]; sc1 = sq[o_ + (size_t)st1 * MIXP]; sp1 = sq[o_ + (size_t)(st1 - 1) * MIXP]; \
            sp0 = (nofirst || (sb) > 0 || st0 > 0) ? sq[o_ + (size_t)st0 * MIXP - MIXP] : (bf16)0; } while (0)
#define RWP_STAGE_WRITE(buf) do { { const float pt_ = bf2f(sc0), pp_ = bf2f(sp0); const float pm_ = pt_ + (pp_ - pt_) * smu; SM0[(buf) * 1664 + st0 * RP_LDA + sj] = (bf16)f2bf(sj < 32 ? (1.0f - 2.0f * rcpf_(__expf(2.0f * pm_) + 1.0f)) : pm_); } \
            { const float pt_ = bf2f(sc1), pp_ = bf2f(sp1); const float pm_ = pt_ + (pp_ - pt_) * smu; SM0[(buf) * 1664 + st1 * RP_LDA + sj] = (bf16)f2bf(sj < 32 ? (1.0f - 2.0f * rcpf_(__expf(2.0f * pm_) + 1.0f)) : pm_); } } while (0)
#define RWP_RKV_LOAD(sb, cur, prev) do { const bf16* q_ = rq + (size_t)((sb) * 16) * MIXP; \
            _Pragma("unroll") for (int e_ = 0; e_ < 4; ++e_) _Pragma("unroll") for (int a_ = 0; a_ < 3; ++a_) cur[e_][a_] = *(const u32x2*)(q_ + (size_t)e_ * MIXP + 512 * a_); \
            const bool hp_ = nofirst || (sb) > 0 || fq > 0; \
            _Pragma("unroll") for (int a_ = 0; a_ < 3; ++a_) prev[a_] = hp_ ? *(const u32x2*)(q_ - (ptrdiff_t)MIXP + 512 * a_) : (u32x2){0u, 0u}; } while (0)
        RWP_STAGE_LOAD(0); RWP_RKV_LOAD(0, rkv, rkvp); RWP_STAGE_WRITE(0);
        __syncthreads();
#pragma unroll 1
        for (int sb = 0; sb < 8; ++sb) {
            if (sb < 7) { RWP_STAGE_LOAD(sb + 1); }
            const LAS bf16* SM = SM0 + (sb & 1) * 1664;
            const bf16x8 Aw = ldfrag(SM + fr * RP_LDA + 8 * fq), Aa = ldfrag(SM + fr * RP_LDA + 32 + 8 * fq);
            f32x4 aw[4], aa[4];
#pragma unroll
            for (int ct = 0; ct < 4; ++ct) { const f32x4 z = (f32x4){0.f, 0.f, 0.f, 0.f};
                aw[ct] = __builtin_amdgcn_mfma_f32_16x16x32_bf16(Aw, Bw[ct], z, 0, 0, 0); aa[ct] = __builtin_amdgcn_mfma_f32_16x16x32_bf16(Aa, Ba[ct], z, 0, 0, 0); }
            const size_t r0 = rowb + sb * 16 + 4 * fq;
            asm volatile("" ::: "memory");
            const f32x4 mu_r = *(const f32x4*)(mu + c4), mu_k = *(const f32x4*)(mu + 512 + c4), mu_v = *(const f32x4*)(mu + 1024 + c4);
            const f32x4 w0c = *(const f32x4*)pw0, a0c = *(const f32x4*)pa0, kkc = *(const f32x4*)pkk, kac = *(const f32x4*)pka, rkc = *(const f32x4*)prk;
#pragma unroll
            for (int e = 0; e < 4; ++e) { const size_t row = r0 + e; const size_t o = row * 512 + c4;
                const u32x2 pr_ = e == 0 ? rkvp[0] : rkv[e > 0 ? e - 1 : 0][0], pk_ = e == 0 ? rkvp[1] : rkv[e > 0 ? e - 1 : 0][1], pv_ = e == 0 ? rkvp[2] : rkv[e > 0 ? e - 1 : 0][2];
                const float rc[4] = {lo16(rkv[e][0].x), hi16(rkv[e][0].x), lo16(rkv[e][0].y), hi16(rkv[e][0].y)}, rp[4] = {lo16(pr_.x), hi16(pr_.x), lo16(pr_.y), hi16(pr_.y)};
                const float kc[4] = {lo16(rkv[e][1].x), hi16(rkv[e][1].x), lo16(rkv[e][1].y), hi16(rkv[e][1].y)}, kp[4] = {lo16(pk_.x), hi16(pk_.x), lo16(pk_.y), hi16(pk_.y)};
                const float vc[4] = {lo16(rkv[e][2].x), hi16(rkv[e][2].x), lo16(rkv[e][2].y), hi16(rkv[e][2].y)}, vp[4] = {lo16(pv_.x), hi16(pv_.x), lo16(pv_.y), hi16(pv_.y)};
                float rr[4], kpr[4], vv[4], kk[4], av[4], dec[4]; float ssp = 0.f, bonp = 0.f;
#pragma unroll
                for (int ct = 0; ct < 4; ++ct) {
                    rr[ct] = rc[ct] + (rp[ct] - rc[ct]) * mu_r[ct]; const float k = kc[ct] + (kp[ct] - kc[ct]) * mu_k[ct]; vv[ct] = vc[ct] + (vp[ct] - vc[ct]) * mu_v[ct];
                    const float wlog = -softplusf_(-(aw[ct][e] + w0c[ct])) - 0.5f; dec[ct] = __expf(-__expf(wlog)); av[ct] = sigmoidf_(aa[ct][e] + a0c[ct]);
                    kk[ct] = k * kkc[ct]; ssp += kk[ct] * kk[ct]; kpr[ct] = k * (1.0f + (av[ct] - 1.0f) * kac[ct]); bonp += rr[ct] * kpr[ct] * rkc[ct]; }
                const float ss = row16_sum(ssp), bon = row16_sum(bonp); const float rn = __builtin_amdgcn_rsqf(fmaxf(ss, 1e-24f));
                u32x2 w;
                w.x = pk2(rr[0], rr[1]); w.y = pk2(rr[2], rr[3]); *(u32x2*)(WSP(bf16, WS_RW_R) + o) = w;
                w.x = pk2(kpr[0], kpr[1]); w.y = pk2(kpr[2], kpr[3]); *(u32x2*)(WSP(bf16, WS_RW_K) + o) = w;
                w.x = pk2(vv[0], vv[1]); w.y = pk2(vv[2], vv[3]); *(u32x2*)(WSP(bf16, WS_RW_V) + o) = w;
                w.x = pk2(-kk[0] * rn, -kk[1] * rn); w.y = pk2(-kk[2] * rn, -kk[3] * rn); *(u32x2*)(WSP(bf16, WS_RW_A) + o) = w;
                w.x = pk2(kk[0] * rn * av[0], kk[1] * rn * av[1]); w.y = pk2(kk[2] * rn * av[2], kk[3] * rn * av[3]); *(u32x2*)(WSP(bf16, WS_RW_B) + o) = w;
                *(f32x4*)(WSP(float, WS_RW_DEC) + o) = (f32x4){dec[0], dec[1], dec[2], dec[3]};
                if (fr == 0) WSP(float, WS_RW_BON)[row * 8 + hh] = bon; }
            if (sb < 7) { RWP_RKV_LOAD(sb + 1, rkv, rkvp); RWP_STAGE_WRITE((sb + 1) & 1); }
            __syncthreads();
        }
#undef RWP_STAGE_LOAD
#undef RWP_STAGE_WRITE
#undef RWP_RKV_LOAD
    }
    {
        int tidb = F.tid; asm volatile("" : "+v"(tidb));
        const int tid = tidb, lane = tid & 63, fr = lane & 15, fq = lane >> 4; const int c4 = 64 * hh + 4 * fr;
        bf16x8 Bg[4][3];
#pragma unroll
        for (int ct = 0; ct < 4; ++ct)
#pragma unroll
            for (int kk = 0; kk < 3; ++kk) RWP_WFRAG(Bg[ct][kk], INP(30) + ((size_t)l * 96 + 32 * kk + 8 * fq) * 512 + c4 + ct, 512);
        int stk[3], sjj[3]; float smv[3]; bf16 sc[3], sp[3];
#pragma unroll
        for (int i = 0; i < 3; ++i) { const int idx = tid + 512 * i; stk[i] = idx / 96; sjj[i] = idx % 96; smv[i] = mu[1600 + sjj[i]]; }
        const bf16* sq = P + rowb * MIXP + PC_RW + 1600;
#define RWP_STAGE_LOAD(sb) do { _Pragma("unroll") for (int i_ = 0; i_ < 3; ++i_) { const bf16* q_ = sq + (size_t)((sb) * 16 + stk[i_]) * MIXP + sjj[i_]; sc[i_] = q_[0]; \
            sp[i_] = (nofirst || (sb) > 0 || stk[i_] > 0) ? *(q_ - (ptrdiff_t)MIXP) : (bf16)0; } } while (0)
#define RWP_STAGE_WRITE(buf) do { _Pragma("unroll") for (int i_ = 0; i_ < 3; ++i_) { const float pt_ = bf2f(sc[i_]), pp_ = bf2f(sp[i_]); \
            SM0[(buf) * 1664 + stk[i_] * RP_LDB + sjj[i_]] = (bf16)f2bf(sigmoidf_(pt_ + (pp_ - pt_) * smv[i_])); } } while (0)
        RWP_STAGE_LOAD(0); RWP_STAGE_WRITE(0);
        __syncthreads();
#pragma unroll 1
        for (int sb = 0; sb < 8; ++sb) {
            if (sb < 7) RWP_STAGE_LOAD(sb + 1);
            const LAS bf16* SM = SM0 + (sb & 1) * 1664;
            const bf16x8 Ag0 = ldfrag(SM + fr * RP_LDB + 8 * fq), Ag1 = ldfrag(SM + fr * RP_LDB + 32 + 8 * fq), Ag2 = ldfrag(SM + fr * RP_LDB + 64 + 8 * fq);
            f32x4 ag[4];
#pragma unroll
            for (int ct = 0; ct < 4; ++ct) { f32x4 g = __builtin_amdgcn_mfma_f32_16x16x32_bf16(Ag0, Bg[ct][0], (f32x4){0.f, 0.f, 0.f, 0.f}, 0, 0, 0);
                g = __builtin_amdgcn_mfma_f32_16x16x32_bf16(Ag1, Bg[ct][1], g, 0, 0, 0); ag[ct] = __builtin_amdgcn_mfma_f32_16x16x32_bf16(Ag2, Bg[ct][2], g, 0, 0, 0); }
            const size_t r0 = rowb + sb * 16 + 4 * fq;
#pragma unroll
            for (int e = 0; e < 4; ++e) { u32x2 w; w.x = pk2(ag[0][e], ag[1][e]); w.y = pk2(ag[2][e], ag[3][e]); *(u32x2*)(WSP(bf16, WS_RW_G) + (r0 + e) * 512 + c4) = w; }
            if (sb < 7) RWP_STAGE_WRITE((sb + 1) & 1);
            __syncthreads();
        }
#undef RWP_STAGE_LOAD
#undef RWP_STAGE_WRITE
    }
}
constexpr int RC_G1 = 0, RC_G2 = 8192, RC_Q1 = 10240, RC_Q2 = 12288, RC_GAM = 13312, RC_VT = 13568, RC_BYTES = 16384;
constexpr size_t WS_RWC = WS_PROJ;
constexpr int CP_IMG = 0, CP_MAT = 9216, CP_P2 = 13568, CP_Q2 = 14656;
constexpr int CP_P1I = 0, CP_BGI = 3072, CP_Q1I = 6144;
__device__ __forceinline__ void rw_chunk_prep(Frame& F, int task) {
    int lane = F.lane; asm volatile("" : "+v"(lane)); const int fr = lane & 15, fq = lane >> 4; const int b = task >> 12, h = (task >> 9) & 7, c = task & 511;
    LAS unsigned char* wl = F.lds + F.wave * WAVE_LDS;
    LAS bf16* IMG = (LAS bf16*)(wl + CP_IMG); LAS float* MAT = (LAS float*)(wl + CP_MAT); LAS float* P2m = (LAS float*)(wl + CP_P2); LAS float* Q2m = (LAS float*)(wl + CP_Q2);
    unsigned char* rec = F.ws + WS_RWC + (size_t)task * RC_BYTES;
    const size_t e0 = ((size_t)b * SEQ + (size_t)c * 16) * 512 + 64 * h + lane;
    float At[16], Bt[16], Kt[16], Rt[16]; float gT;
    { float wv[16]; bf16 av[16], bv[16], kv[16], rv[16];
#pragma unroll
      for (int t = 0; t < 16; ++t) { const size_t o = e0 + (size_t)t * 512; wv[t] = WSP(const float, WS_RW_DEC)[o]; av[t] = WSP(const bf16, WS_RW_A)[o]; bv[t] = WSP(const bf16, WS_RW_B)[o]; kv[t] = WSP(const bf16, WS_RW_K)[o]; rv[t] = WSP(const bf16, WS_RW_R)[o]; }
      float g = 1.0f;
#pragma unroll
      for (int t = 0; t < 16; ++t) { const float gp = g; g *= wv[t]; const float inv = rcpf_(g);
          At[t] = bf2f(av[t]) * gp; Bt[t] = bf2f(bv[t]) * inv; Kt[t] = bf2f(kv[t]) * inv; Rt[t] = bf2f(rv[t]) * g;
          IMG[0 * 1152 + t * 72 + lane] = (bf16)f2bf(At[t]); IMG[1 * 1152 + t * 72 + lane] = (bf16)f2bf(Bt[t]); IMG[2 * 1152 + t * 72 + lane] = (bf16)f2bf(Kt[t]); IMG[3 * 1152 + t * 72 + lane] = (bf16)f2bf(Rt[t]); }
      gT = g; }
    { unsigned vp[8];
#pragma unroll
      for (int t = 0; t < 16; t += 2) vp[t >> 1] = (unsigned)WSP(const bf16, WS_RW_V)[e0 + (size_t)t * 512] | ((unsigned)WSP(const bf16, WS_RW_V)[e0 + (size_t)(t + 1) * 512] << 16);
      u32x4* d = (u32x4*)(rec + RC_VT + lane * 32); d[0] = (u32x4){vp[0], vp[1], vp[2], vp[3]}; d[1] = (u32x4){vp[4], vp[5], vp[6], vp[7]};
      ((float*)(rec + RC_GAM))[lane] = gT; }
    { f32x4 nab = (f32x4){0.f, 0.f, 0.f, 0.f}, nak = nab, mbr = nab, mkr = nab;
#pragma unroll
      for (int kk = 0; kk < 2; ++kk) { const int o = fr * 72 + 32 * kk + 8 * fq;
          const bf16x8 fa = ldfrag(IMG + 0 * 1152 + o), fb = ldfrag(IMG + 1 * 1152 + o), fk = ldfrag(IMG + 2 * 1152 + o), frr = ldfrag(IMG + 3 * 1152 + o);
          nab = __builtin_amdgcn_mfma_f32_16x16x32_bf16(fb, fa, nab, 0, 0, 0); nak = __builtin_amdgcn_mfma_f32_16x16x32_bf16(fk, fa, nak, 0, 0, 0);
          mbr = __builtin_amdgcn_mfma_f32_16x16x32_bf16(fb, frr, mbr, 0, 0, 0); mkr = __builtin_amdgcn_mfma_f32_16x16x32_bf16(fk, frr, mkr, 0, 0, 0); }
#pragma unroll
      for (int e = 0; e < 4; ++e) { const int s_ = 4 * fq + e, t_ = fr; const int o = s_ * 17 + t_;
          MAT[0 * 272 + o] = s_ < t_ ? nab[e] : 0.f; MAT[1 * 272 + o] = s_ < t_ ? nak[e] : 0.f; MAT[2 * 272 + o] = s_ <= t_ ? mbr[e] : 0.f; MAT[3 * 272 + o] = s_ <= t_ ? mkr[e] : 0.f; } }
    float P1[16], P2[16];
#pragma unroll
    for (int t = 0; t < 16; ++t) { float p1 = At[t], p2 = MAT[1 * 272 + fr * 17 + t];
#pragma unroll
        for (int s_ = 0; s_ < t; ++s_) { const float n = MAT[0 * 272 + s_ * 17 + t]; p1 += P1[s_] * n; p2 += P2[s_] * n; }
        P1[t] = p1; P2[t] = p2; asm volatile("" ::: "memory"); }
    LAS bf16* Q1I = (LAS bf16*)(wl + CP_Q1I);
#pragma unroll
    for (int t = 0; t < 16; ++t) { float q1 = Rt[t], q2 = MAT[3 * 272 + fr * 17 + t];
#pragma unroll
        for (int s_ = 0; s_ <= t; ++s_) { const float m = MAT[2 * 272 + s_ * 17 + t]; q1 += P1[s_] * m; q2 += P2[s_] * m; }
        Q1I[t * 72 + lane] = (bf16)f2bf(q1); if (lane < 16) { Q2m[lane * 17 + t] = q2; P2m[lane * 17 + t] = P2[t]; }
        asm volatile("" ::: "memory"); }
    { LAS bf16* P1I = (LAS bf16*)(wl + CP_P1I); LAS bf16* BGI = (LAS bf16*)(wl + CP_BGI);
      u32x4 w0, w1;
      w0.x = pk2(P1[0], P1[1]); w0.y = pk2(P1[2], P1[3]); w0.z = pk2(P1[4], P1[5]); w0.w = pk2(P1[6], P1[7]); w1.x = pk2(P1[8], P1[9]); w1.y = pk2(P1[10], P1[11]); w1.z = pk2(P1[12], P1[13]); w1.w = pk2(P1[14], P1[15]);
      *(LAS u32x4*)(P1I + lane * 24) = w0; *(LAS u32x4*)(P1I + lane * 24 + 8) = w1;
      w0.x = pk2(Bt[0] * gT, Bt[1] * gT); w0.y = pk2(Bt[2] * gT, Bt[3] * gT); w0.z = pk2(Bt[4] * gT, Bt[5] * gT); w0.w = pk2(Bt[6] * gT, Bt[7] * gT);
      w1.x = pk2(Bt[8] * gT, Bt[9] * gT); w1.y = pk2(Bt[10] * gT, Bt[11] * gT); w1.z = pk2(Bt[12] * gT, Bt[13] * gT); w1.w = pk2(Bt[14] * gT, Bt[15] * gT);
      *(LAS u32x4*)(BGI + lane * 24) = w0; *(LAS u32x4*)(BGI + lane * 24 + 8) = w1;
      const u32x4 z4 = (u32x4){0u, 0u, 0u, 0u};
      bf16x8 Af[4], Bf[4];
#pragma unroll
      for (int i = 0; i < 4; ++i) { u32x4 ta = z4, tb = z4; if (fq < 2) { ta = *(const LAS u32x4*)(P1I + (16 * i + fr) * 24 + 8 * fq); tb = *(const LAS u32x4*)(BGI + (16 * i + fr) * 24 + 8 * fq); }
          Af[i] = __builtin_bit_cast(bf16x8, ta); Bf[i] = __builtin_bit_cast(bf16x8, tb); }
#pragma unroll
      for (int j = 0; j < 4; ++j)
#pragma unroll
          for (int s_ = 0; s_ < 2; ++s_) { const f32x4 lo = __builtin_amdgcn_mfma_f32_16x16x32_bf16(Af[2 * s_], Bf[j], (f32x4){0.f, 0.f, 0.f, 0.f}, 0, 0, 0);
              const f32x4 hi = __builtin_amdgcn_mfma_f32_16x16x32_bf16(Af[2 * s_ + 1], Bf[j], (f32x4){0.f, 0.f, 0.f, 0.f}, 0, 0, 0);
              u32x4 w; w.x = pk2(lo[0], lo[1]); w.y = pk2(lo[2], lo[3]); w.z = pk2(hi[0], hi[1]); w.w = pk2(hi[2], hi[3]);
              *(u32x4*)(rec + RC_G1 + ((j * 2 + s_) * 64 + lane) * 16) = w; } }
    { float g2v[16];
#pragma unroll
      for (int t = 0; t < 16; ++t) { float acc = Kt[t];
#pragma unroll
          for (int s_ = 0; s_ < 16; ++s_) acc += P2m[t * 17 + s_] * Bt[s_];
          g2v[t] = acc * gT; asm volatile("" ::: "memory"); }
      u32x4 w0, w1; w0.x = pk2(g2v[0], g2v[1]); w0.y = pk2(g2v[2], g2v[3]); w0.z = pk2(g2v[4], g2v[5]); w0.w = pk2(g2v[6], g2v[7]); w1.x = pk2(g2v[8], g2v[9]); w1.y = pk2(g2v[10], g2v[11]); w1.z = pk2(g2v[12], g2v[13]); w1.w = pk2(g2v[14], g2v[15]);
      u32x4* d = (u32x4*)(rec + RC_G2 + lane * 32); d[0] = w0; d[1] = w1; }
    {
#pragma unroll
      for (int s_ = 0; s_ < 2; ++s_) { const u32x2 lo = *(const LAS u32x2*)(Q1I + fr * 72 + 32 * s_ + 4 * fq), hi = *(const LAS u32x2*)(Q1I + fr * 72 + 32 * s_ + 16 + 4 * fq);
          *(u32x4*)(rec + RC_Q1 + (s_ * 64 + lane) * 16) = (u32x4){lo.x, lo.y, hi.x, hi.y}; } }
    { u32x4 w = (u32x4){0u, 0u, 0u, 0u};
      if (fq < 2) { float q[8];
#pragma unroll
          for (int j = 0; j < 8; ++j) q[j] = Q2m[(8 * fq + j) * 17 + fr];
          w.x = pk2(q[0], q[1]); w.y = pk2(q[2], q[3]); w.z = pk2(q[4], q[5]); w.w = pk2(q[6], q[7]); }
      *(u32x4*)(rec + RC_Q2 + lane * 16) = w; }
}
__device__ __forceinline__ void rw_chunk_step(const LAS unsigned char* rc, f32x4 (&X)[4], float* yo, int w, int lane, int fr, int fq) {
    const u32x4 z4 = (u32x4){0u, 0u, 0u, 0u};
    u32x4 b0, b1; b0.x = pk2(X[0][0], X[0][1]); b0.y = pk2(X[0][2], X[0][3]); b0.z = pk2(X[1][0], X[1][1]); b0.w = pk2(X[1][2], X[1][3]);
    b1.x = pk2(X[2][0], X[2][1]); b1.y = pk2(X[2][2], X[2][3]); b1.z = pk2(X[3][0], X[3][1]); b1.w = pk2(X[3][2], X[3][3]);
    const bf16x8 Bx0 = __builtin_bit_cast(bf16x8, b0), Bx1 = __builtin_bit_cast(bf16x8, b1);
    u32x4 vt = z4; if (fq < 2) vt = *(const LAS u32x4*)(rc + RC_VT + (16 * w + fr) * 32 + 16 * fq);
    const bf16x8 Vf = __builtin_bit_cast(bf16x8, vt);
    f32x4 Y = (f32x4){0.f, 0.f, 0.f, 0.f};
    Y = __builtin_amdgcn_mfma_f32_16x16x32_bf16(*(const LAS bf16x8*)(rc + RC_Q1 + (0 * 64 + lane) * 16), Bx0, Y, 0, 0, 0);
    Y = __builtin_amdgcn_mfma_f32_16x16x32_bf16(*(const LAS bf16x8*)(rc + RC_Q1 + (1 * 64 + lane) * 16), Bx1, Y, 0, 0, 0);
    Y = __builtin_amdgcn_mfma_f32_16x16x32_bf16(*(const LAS bf16x8*)(rc + RC_Q2 + lane * 16), Vf, Y, 0, 0, 0);
#pragma unroll
    for (int j = 0; j < 4; ++j) { const f32x4 gm = *(const LAS f32x4*)(rc + RC_GAM + (16 * j + 4 * fq) * 4);
        f32x4 C = X[j] * gm;
        C = __builtin_amdgcn_mfma_f32_16x16x32_bf16(*(const LAS bf16x8*)(rc + RC_G1 + ((j * 2 + 0) * 64 + lane) * 16), Bx0, C, 0, 0, 0);
        C = __builtin_amdgcn_mfma_f32_16x16x32_bf16(*(const LAS bf16x8*)(rc + RC_G1 + ((j * 2 + 1) * 64 + lane) * 16), Bx1, C, 0, 0, 0);
        u32x4 g2 = z4; if (fq < 2) g2 = *(const LAS u32x4*)(rc + RC_G2 + (16 * j + fr) * 32 + 16 * fq);
        C = __builtin_amdgcn_mfma_f32_16x16x32_bf16(__builtin_bit_cast(bf16x8, g2), Vf, C, 0, 0, 0);
        X[j] = C; }
#pragma unroll
    for (int e = 0; e < 4; ++e) yo[(size_t)(4 * fq + e) * 512] = Y[e];
}
__device__ __forceinline__ void rw_scan2(Frame& F, int task) {
    const int tid = F.tid, lane = F.lane, w = F.wave, fr = lane & 15, fq = lane >> 4;
    const unsigned char* recs = F.ws + WS_RWC + (size_t)task * 512 * RC_BYTES;
    constexpr int NP = SEQ / 32;
    if (w >= 4) {
        const int lt = tid - 256;
        const u32x4* src = (const u32x4*)recs + lt;
        u32x4 rg[4][8];
#pragma unroll
        for (int u = 0; u < 4; ++u)
#pragma unroll
            for (int i = 0; i < 8; ++i) rg[u][i] = src[(size_t)u * 2048 + i * 256];
#pragma unroll 1
        for (int g4 = 0; g4 < NP / 4; ++g4) {
#pragma unroll
            for (int u = 0; u < 4; ++u) { const int g = 4 * g4 + u;
                LAS u32x4* dst = (LAS u32x4*)(F.lds + ((2 * g) & 7) * RC_BYTES) + lt;
#pragma unroll
                for (int i = 0; i < 8; ++i) dst[i * 256] = rg[u][i];
                if (g + 4 < NP) {
#pragma unroll
                    for (int i = 0; i < 8; ++i) rg[u][i] = src[(size_t)(g + 4) * 2048 + i * 256]; }
                __syncthreads(); }
        }
        __syncthreads();
    } else {
        const int b = task >> 3, h = task & 7;
        f32x4 X[4];
#pragma unroll
        for (int j = 0; j < 4; ++j) X[j] = (f32x4){0.f, 0.f, 0.f, 0.f};
        float* yo = WSP(float, WS_RW_Y) + ((size_t)b * SEQ) * 512 + 64 * h + 16 * w + fr;
        __syncthreads();
#pragma unroll 1
        for (int g = 0; g < NP; ++g) {
            rw_chunk_step(F.lds + ((2 * g) & 7) * RC_BYTES, X, yo + (size_t)(2 * g) * 16 * 512, w, lane, fr, fq);
            rw_chunk_step(F.lds + ((2 * g + 1) & 7) * RC_BYTES, X, yo + (size_t)(2 * g + 1) * 16 * 512, w, lane, fr, fq);
            __syncthreads();
        }
    }
}
__device__ __forceinline__ void rw_post(Frame& F, int l, int gw, int ngw) {
    const int lane = F.lane;
    const f32x4 g0 = *(const f32x4*)(INP(34) + l * 512 + 8 * lane), g1 = *(const f32x4*)(INP(34) + l * 512 + 8 * lane + 4);
    const f32x4 b0 = *(const f32x4*)(INP(35) + l * 512 + 8 * lane), b1 = *(const f32x4*)(INP(35) + l * 512 + 8 * lane + 4);
    for (int m = gw; m < MTOK; m += ngw) { const size_t o = (size_t)m * 512 + 8 * lane;
        const f32x4 ya = *(const f32x4*)(WSP(const float, WS_RW_Y) + o), yb = *(const f32x4*)(WSP(const float, WS_RW_Y) + o + 4);
        float y[8] = {ya.x, ya.y, ya.z, ya.w, yb.x, yb.y, yb.z, yb.w};
        float s = 0.f;
#pragma unroll
        for (int j = 0; j < 8; ++j) s += y[j];
        s += __shfl_xor(s, 1); s += __shfl_xor(s, 2); s += __shfl_xor(s, 4); const float mean = s * (1.f / 64.f);
        float qv = 0.f;
#pragma unroll
        for (int j = 0; j < 8; ++j) { y[j] -= mean; qv += y[j] * y[j]; }
        qv += __shfl_xor(qv, 1); qv += __shfl_xor(qv, 2); qv += __shfl_xor(qv, 4); const float rs = 1.0f / sqrtf(qv * (1.f / 64.f) + 64e-5f);
        const u32x4 vr = *(const u32x4*)(WSP(const bf16, WS_RW_V) + o), gr_ = *(const u32x4*)(WSP(const bf16, WS_RW_G) + o);
        const float bon = WSP(const float, WS_RW_BON)[(size_t)m * 8 + (lane >> 3)];
        const float vv[8] = {lo16(vr.x), hi16(vr.x), lo16(vr.y), hi16(vr.y), lo16(vr.z), hi16(vr.z), lo16(vr.w), hi16(vr.w)};
        const float gg[8] = {lo16(gr_.x), hi16(gr_.x), lo16(gr_.y), hi16(gr_.y), lo16(gr_.z), hi16(gr_.z), lo16(gr_.w), hi16(gr_.w)};
        const float lg[8] = {g0.x, g0.y, g0.z, g0.w, g1.x, g1.y, g1.z, g1.w}, lb[8] = {b0.x, b0.y, b0.z, b0.w, b1.x, b1.y, b1.z, b1.w};
        float ov[8];
#pragma unroll
        for (int j = 0; j < 8; ++j) ov[j] = (y[j] * rs * lg[j] + lb[j] + bon * vv[j]) * gg[j];
        u32x4 w; w.x = pk2(ov[0], ov[1]); w.y = pk2(ov[2], ov[3]); w.z = pk2(ov[4], ov[5]); w.w = pk2(ov[6], ov[7]);
        *(u32x4*)(WSP(bf16, WS_YK) + (size_t)3 * MTOK * 512 + o) = w; }
}

#ifndef GATE_NA
#define GATE_NA 18
#endif
#ifndef PHMASK
#define PHMASK 0xFFFFFFFFu
#endif
#define PH(n) (((PHMASK) >> (n)) & 1u)
#ifndef REPMASK
#define REPMASK 0u
#endif
#define NREP(n) ((((REPMASK) >> (n)) & 1u) ? 2 : 1)
template <class T> __device__ __forceinline__ T* launder_ptr(T* p) { const unsigned long long w = (unsigned long long)p; unsigned lo = __builtin_amdgcn_readfirstlane((unsigned)w), hi = __builtin_amdgcn_readfirstlane((unsigned)(w >> 32));
    asm volatile("" : "+s"(lo), "+s"(hi)); return (T*)(GAS T*)(((unsigned long long)hi << 32) | lo); }
#define PHASE_BEGIN() do { F.ws = launder_ptr(F.ws); F.out = launder_ptr(F.out); { unsigned la_ = __builtin_amdgcn_readfirstlane((unsigned)(size_t)F.lds); int bk_ = __builtin_amdgcn_readfirstlane(F.blk); asm volatile("" : "+s"(la_), "+s"(bk_)); F.lds = (LAS unsigned char*)(size_t)la_; F.blk = bk_; } asm volatile("" : "+v"(F.tid)); F.lane = F.tid & 63; F.wave = __builtin_amdgcn_readfirstlane(F.tid >> 6); } while (0)
__global__ void __launch_bounds__(NTHR, 2) hybrid_fwd(Args args) {
    extern __shared__ __attribute__((aligned(16))) unsigned char lds_raw[];
    Frame F;
    F.lds = (LAS unsigned char*)lds_raw; F.out = args.out; F.ws = args.ws;
    F.tid = threadIdx.x; F.lane = F.tid & 63; F.wave = __builtin_amdgcn_readfirstlane(F.tid >> 6); F.blk = blockIdx.x; F.G = gridDim.x;
    volatile LAS unsigned* MISC = (volatile LAS unsigned*)(F.lds + LDS_MISC);
    if (F.tid < 64) MISC[F.tid] = 0u;
    if (F.tid < 45) { const unsigned long long p = ((const __attribute__((address_space(4))) unsigned long long*)__builtin_amdgcn_kernarg_segment_ptr())[F.tid]; MISC[64 + 2 * F.tid] = (unsigned)p; MISC[64 + 2 * F.tid + 1] = (unsigned)(p >> 32); }
    __syncthreads();
    XcdBarrier bar = xcd_barrier_post((unsigned*)(F.ws + WS_CTL) + CW_BAR, MISC + 8);
#define gw (F.blk * NWAVES + F.wave)
#define NGW (F.G * NWAVES)
#define glds (F.lds)

#pragma unroll 1
    for (int l = 0; l < DEPTH; ++l) {
        const float* xin = (l == 0) ? INP(0) : F.out;
        PHASE_BEGIN();
        for (int rep_ = 0; rep_ < NREP(0); ++rep_) if (PH(0)) { convert_weights(F, l);
            for (int nb = F.blk; nb < NGATE / 32 + 2 * (FF / 32); nb += F.G) {
                const int seg = nb < NGATE / 32 ? 0 : (nb < NGATE / 32 + FF / 32 ? 1 : 2);
                const float* Wp = seg == 0 ? INP(2) + (size_t)l * DM * INC : (seg == 1 ? INP(39) : INP(40)) + (size_t)l * DM * FF;
                signed char* W8p = seg == 0 ? WSP(signed char, WS_WIN) + (size_t)MIXP * DM * 2 : (seg == 1 ? WSP(signed char, WS_WFG) : WSP(signed char, WS_WFU));
                convert_cols_i8(F, Wp, seg == 0 ? INC : FF, seg == 0 ? MIXC : 0, nb - (seg == 0 ? 0 : (seg == 1 ? NGATE / 32 : NGATE / 32 + FF / 32)), W8p, WSP(float, WS_SB) + 16384 * seg, 0); } }
        PHASE_BEGIN();
        for (int rep_ = 0; rep_ < NREP(1); ++rep_) if (PH(1)) rmsnorm_rows(F, xin, INP(1) + (size_t)l * DM, WSP(bf16, WS_H), nullptr, WSP(unsigned, WS_A8), WSP(float, WS_SA));
        xcd_barrier(bar);
        PHASE_BEGIN();
        for (int rep_ = 0; rep_ < NREP(2); ++rep_) if (PH(2)) { pg8::Gemm g{WSP(const bf16, WS_H), WSP(const bf16, WS_WIN), MTOK, MIXP, DM}; pg8::StaticOrder S; S.init(MTOK, MIXP, F.G, F.blk);
          pg8::EpiStore<0> E{WSP(bf16, WS_PROJ), MIXP}; pg8::gemm_phase(glds, g, S, E, F.tid); }
        xcd_barrier(bar);
        PHASE_BEGIN();
        for (int rep_ = 0; rep_ < NREP(3); ++rep_) if (PH(3)) for (int t = F.blk; t < MTOK / 128; t += F.G) rw_pre(F, l, t);
        PHASE_BEGIN();
        for (int rep_ = 0; rep_ < NREP(4); ++rep_) if (PH(4)) for (int t = F.blk; t < 1024; t += F.G) m2_pass1(F, l, t);
        PHASE_BEGIN();
        for (int rep_ = 0; rep_ < NREP(5); ++rep_) if (PH(5)) for (int t = gw; t < 8192; t += NGW) s5_task<false>(F, l, t);
        PHASE_BEGIN();
        for (int rep_ = 0; rep_ < NREP(6); ++rep_) if (PH(6)) for (int t = gw; t < 2048; t += NGW) lru_task<false>(F, l, t);
        xcd_barrier(bar);
        PHASE_BEGIN();
        for (int rep_ = 0; rep_ < NREP(7); ++rep_) if (PH(7)) m2_carry(F);
        PHASE_BEGIN();
        for (int rep_ = 0; rep_ < NREP(8); ++rep_) if (PH(8)) for (int t = gw; t < 128; t += NGW) s5_carry(F, l, t);
        PHASE_BEGIN();
        for (int rep_ = 0; rep_ < NREP(9); ++rep_) if (PH(9)) for (int t = NGW - 1 - gw; t < 32; t += NGW) lru_carry(F, t);
        xcd_barrier(bar);
        PHASE_BEGIN();
        for (int rep_ = 0; rep_ < NREP(10); ++rep_) if (PH(10)) for (int t = F.blk; t < 1024; t += F.G) m2_pass2(F, l, t);
        PHASE_BEGIN();
        for (int rep_ = 0; rep_ < NREP(11); ++rep_) if (PH(11)) for (int t = gw; t < 8192; t += NGW) s5_task<true>(F, l, t);
        PHASE_BEGIN();
        for (int rep_ = 0; rep_ < NREP(12); ++rep_) if (PH(12)) for (int t = gw; t < 2048; t += NGW) lru_task<true>(F, l, t);
        xcd_barrier(bar);
        PHASE_BEGIN();
        for (int rep_ = 0; rep_ < NREP(14); ++rep_) if (PH(14)) {
            { pg8::Gemm g{WSP(const bf16, WS_S5Z), WSP(const bf16, WS_WGLU), MTOK, 512, 512}; pg8::StaticOrder S; S.init(MTOK, 512, F.G, F.blk);
              pg8::EpiGlu E{WSP(const bf16, WS_S5Z), WSP(bf16, WS_YK)}; pg8::gemm_phase(glds, g, S, E, F.tid); }
            m2_norm(F, l, gw, NGW);
        }
        PHASE_BEGIN();
        for (int rep_ = 0; rep_ < NREP(24); ++rep_) if (PH(24)) for (int t = gw; t < NB * 8 * 512; t += NGW) rw_chunk_prep(F, t);
        xcd_barrier(bar);
        PHASE_BEGIN();
        if (F.blk < 32) { if (PH(13)) rw_scan2(F, F.blk); }
        PHASE_BEGIN();
        if (PH(16)) { pg8::Gemm g{WSP(const bf16, WS_A8), (const bf16*)(WSP(const signed char, WS_WIN) + (size_t)MIXP * DM * 2), MTOK, NGATE, DM / 2};
          pg8::SplitOrder S; if (F.blk >= 32) S.init(MTOK, NGATE, 224, F.blk - 32, 0, GATE_NA); else S.init(MTOK, NGATE, 32, F.blk, 224 * GATE_NA, (4096 - 224 * GATE_NA) / 32);
          pg8::EpiStoreI8<1> E{WSP(bf16, WS_GATES), NGATE, WSP(const float, WS_SA), WSP(const float, WS_SB)}; pg8::gemm_phase(glds, g, S, E, F.tid); }
        xcd_barrier(bar);
        PHASE_BEGIN();
        for (int rep_ = 0; rep_ < NREP(15); ++rep_) if (PH(15)) rw_post(F, l, gw, NGW);
        xcd_barrier(bar);
        PHASE_BEGIN();
        for (int rep_ = 0; rep_ < NREP(17); ++rep_) if (PH(17)) { pg8::Gemm g{WSP(const bf16, WS_YK), WSP(const bf16, WS_WPK), 4 * MTOK, 4 * DM, 512}; pg8::OrderYK S{F.G, F.blk};
          pg8::EpiGateAcc E{WSP(const bf16, WS_GATES), WSP(bf16, WS_MERGED)}; pg8::gemm_phase(glds, g, S, E, F.tid); }
        xcd_barrier(bar);
        PHASE_BEGIN();
        for (int rep_ = 0; rep_ < NREP(18); ++rep_) if (PH(18)) { pg8::Gemm g{WSP(const bf16, WS_MERGED), WSP(const bf16, WS_WOUT), MTOK, DM, DM}; pg8::StaticOrder S; S.init(MTOK, DM, F.G, F.blk);
          pg8::EpiAddF32 E{xin, F.out, DM}; pg8::gemm_phase(glds, g, S, E, F.tid); }
        xcd_barrier(bar);
        PHASE_BEGIN();
        for (int rep_ = 0; rep_ < NREP(19); ++rep_) if (PH(19)) rmsnorm_rows(F, F.out, INP(38) + (size_t)l * DM, nullptr, nullptr, WSP(unsigned, WS_A8), WSP(float, WS_SA));
        xcd_barrier(bar);
        PHASE_BEGIN();
        for (int rep_ = 0; rep_ < NREP(20); ++rep_) if (PH(20)) { pg8::Gemm g{WSP(const bf16, WS_A8), WSP(const bf16, WS_WFG), MTOK, FF, DM / 2}; pg8::StaticOrder S; S.init(MTOK, FF, F.G, F.blk);
          pg8::EpiStoreI8<0> E{WSP(bf16, WS_FG), FF, WSP(const float, WS_SA), WSP(const float, WS_SB) + 16384}; pg8::gemm_phase(glds, g, S, E, F.tid); }
        xcd_barrier(bar);
        PHASE_BEGIN();
        for (int rep_ = 0; rep_ < NREP(21); ++rep_) if (PH(21)) { pg8::Gemm g{WSP(const bf16, WS_A8), WSP(const bf16, WS_WFU), MTOK, FF, DM / 2}; pg8::StaticOrder S; S.init(MTOK, FF, F.G, F.blk);
          pg8::EpiFfnUp<true> E{WSP(const bf16, WS_FG), WSP(bf16, WS_HID), INP(41) + (size_t)l * 3 * FF, INP(42) + (size_t)l * FF, WSP(const float, WS_SA), WSP(const float, WS_SB) + 32768}; pg8::gemm_phase(glds, g, S, E, F.tid); }
        xcd_barrier(bar);
        PHASE_BEGIN();
        for (int rep_ = 0; rep_ < NREP(22); ++rep_) if (PH(22)) { pg8::Gemm g{WSP(const bf16, WS_HID), WSP(const bf16, WS_WFD), MTOK, DM, FF}; pg8::StaticOrder S; S.init(MTOK, DM, F.G, F.blk);
          pg8::EpiAddF32 E{F.out, F.out, DM}; pg8::gemm_phase(glds, g, S, E, F.tid); }
        xcd_barrier(bar);
    }
    PHASE_BEGIN();
    for (int rep_ = 0; rep_ < NREP(23); ++rep_) if (PH(23)) rmsnorm_rows(F, F.out, INP(44), nullptr, F.out);
}

extern "C" void kernel_launch(void* const* d_in, const int* in_sizes, int n_in, void* d_out, int out_size, void* d_ws, size_t ws_size, hipStream_t stream) {
    static int grid = 0;
    if (grid == 0) {
        if (n_in != 45 || in_sizes[0] != MTOK * DM || out_size != MTOK * DM || ws_size < WS_END) {
            fprintf(stderr, "kernel_launch: unexpected shapes/workspace (n_in %d, in0 %d, out %d, ws %zu, need %zu); nothing launched\n", n_in, n_in > 0 ? in_sizes[0] : -1, out_size, ws_size, (size_t)WS_END); grid = -1; return; }
        int dev = 0, cus = 0, per_cu = 0;
        if (hipGetDevice(&dev) != hipSuccess || hipDeviceGetAttribute(&cus, hipDeviceAttributeMultiprocessorCount, dev) != hipSuccess) { grid = -1; return; }
        if (hipFuncSetAttribute((const void*)hybrid_fwd, hipFuncAttributeMaxDynamicSharedMemorySize, LDS_BYTES) != hipSuccess) { fprintf(stderr, "kernel_launch: hipFuncSetAttribute failed\n"); grid = -1; return; }
        if (hipOccupancyMaxActiveBlocksPerMultiprocessor(&per_cu, (const void*)hybrid_fwd, NTHR, LDS_BYTES) != hipSuccess || per_cu < 1) { fprintf(stderr, "kernel_launch: occupancy query says %d\n", per_cu); }
        (void)hipGetLastError();
        grid = cus;
        if (grid != 256) fprintf(stderr, "kernel_launch: note: %d CUs\n", grid);
    }
    if (grid < 0) return;
    if (hipMemsetAsync((char*)d_ws + WS_CTL, 0, CTL_BYTES, stream) != hipSuccess) return;
    Args a{};
    for (int i = 0; i < 45; ++i) a.in[i] = (const float*)d_in[i];
    a.out = (float*)d_out; a.ws = (unsigned char*)d_ws;
    hipLaunchKernelGGL(hybrid_fwd, dim3(grid), dim3(NTHR), LDS_BYTES, stream, a);
}
```

```cpp
#include <hip/hip_runtime.h>
#include <cstdio>
#include <cstdint>

#define LAS __attribute__((address_space(3)))
typedef unsigned short bf16;
typedef short bf16x8 __attribute__((ext_vector_type(8)));
typedef float f32x4 __attribute__((ext_vector_type(4)));
typedef float f32x2 __attribute__((ext_vector_type(2)));
typedef unsigned u32x4 __attribute__((ext_vector_type(4)));
typedef unsigned u32x2 __attribute__((ext_vector_type(2)));
typedef __bf16 bf16v2 __attribute__((ext_vector_type(2)));
typedef int i32x4 __attribute__((ext_vector_type(4)));

constexpr int NB = 4, SEQ = 8192, DM = 2048, MTOK = NB * SEQ, DEPTH = 4;
constexpr int MIXC = 4776, MIXP = 4864, INC = 12968, FF = 6144, NGATE = 8192;
constexpr int RWC = 1696;
constexpr int PC_S5U = 0, PC_LRX = 512, PC_LRG = 1024, PC_M2Z = 1536, PC_XBC = 2048, PC_DT = 3072, PC_RW = 3080;

constexpr size_t MiB = 1u << 20;
constexpr size_t WS_CTL = 0, CTL_BYTES = 1 * MiB;
constexpr size_t WS_WIN = 1 * MiB, WS_WPK = 52 * MiB, WS_WOUT = 60 * MiB, WS_WFG = 68 * MiB, WS_WFU = 92 * MiB, WS_WFD = 116 * MiB, WS_WGLU = 140 * MiB;
constexpr size_t WS_SA = 141 * MiB, WS_SB = 142 * MiB;
constexpr size_t WS_A8 = 1538 * MiB;
constexpr size_t WS_H = 144 * MiB, WS_YK = 272 * MiB, WS_PROJ = 400 * MiB, WS_MERGED = 400 * MiB, WS_GATES = 704 * MiB;
constexpr size_t WS_RW_R = 1216 * MiB, WS_RW_K = 1248 * MiB, WS_RW_V = 1280 * MiB, WS_RW_A = 1312 * MiB, WS_RW_B = 1344 * MiB, WS_RW_G = 1376 * MiB,
                 WS_RW_DEC = 1408 * MiB, WS_RW_Y = 1472 * MiB, WS_RW_BON = 1536 * MiB, WS_END = 1602 * MiB;
constexpr size_t WS_S5Z = 704 * MiB, WS_S5E = 736 * MiB, WS_S5I = 740 * MiB, WS_LRE = 744 * MiB, WS_LRA = 745 * MiB, WS_LRI = 746 * MiB;
constexpr size_t WS_M2S = 752 * MiB, WS_M2D = 1008 * MiB, WS_M2Y = 1012 * MiB;
constexpr size_t WS_FG = 400 * MiB, WS_HID = 784 * MiB;
constexpr int CW_BAR = 4096;

__device__ __forceinline__ float bf2f(bf16 b) { return __uint_as_float(((unsigned)b) << 16); }
__device__ __forceinline__ unsigned f2bf(float f) { const __bf16 b = (__bf16)f; return (unsigned)__builtin_bit_cast(unsigned short, b); }
__device__ __forceinline__ unsigned pk2(float lo, float hi) { const f32x2 v = {lo, hi}; const bf16v2 b = __builtin_convertvector(v, bf16v2); return __builtin_bit_cast(unsigned, b); }
__device__ __forceinline__ float lo16(unsigned w) { return __uint_as_float(w << 16); }
__device__ __forceinline__ float hi16(unsigned w) { return __uint_as_float(w & 0xffff0000u); }
__device__ __forceinline__ float rcpf_(float x) { return __builtin_amdgcn_rcpf(x); }
__device__ __forceinline__ float sigmoidf_(float x) { return rcpf_(1.0f + __expf(-x)); }
__device__ __forceinline__ float siluf_(float x) { return x * rcpf_(1.0f + __expf(-x)); }
__device__ __forceinline__ float geluf_(float x) { const float u = 0.7978845608028654f * (x + 0.044715f * x * x * x); return x * rcpf_(1.0f + __expf(-2.0f * u)); }
__device__ __forceinline__ float softplusf_(float x) { return fmaxf(x, 0.f) + __logf(1.0f + __expf(-fabsf(x))); }
__device__ __forceinline__ float row16_sum(float v) {
    v += __int_as_float(__builtin_amdgcn_update_dpp(0, __float_as_int(v), 0x128, 0xf, 0xf, true));
    v += __int_as_float(__builtin_amdgcn_update_dpp(0, __float_as_int(v), 0x124, 0xf, 0xf, true));
    v += __int_as_float(__builtin_amdgcn_update_dpp(0, __float_as_int(v), 0x122, 0xf, 0xf, true));
    v += __int_as_float(__builtin_amdgcn_update_dpp(0, __float_as_int(v), 0x121, 0xf, 0xf, true));
    return v;
}
__device__ __forceinline__ float wave_sum(float v) {
    v = row16_sum(v);
    const float a = __int_as_float(__builtin_amdgcn_readlane(__float_as_int(v), 0)), b = __int_as_float(__builtin_amdgcn_readlane(__float_as_int(v), 16));
    const float c = __int_as_float(__builtin_amdgcn_readlane(__float_as_int(v), 32)), d = __int_as_float(__builtin_amdgcn_readlane(__float_as_int(v), 48));
    return (a + b) + (c + d);
}
__device__ __forceinline__ float wave_max(float v) {
    v = fmaxf(v, __int_as_float(__builtin_amdgcn_update_dpp(0, __float_as_int(v), 0x128, 0xf, 0xf, true)));
    v = fmaxf(v, __int_as_float(__builtin_amdgcn_update_dpp(0, __float_as_int(v), 0x124, 0xf, 0xf, true)));
    v = fmaxf(v, __int_as_float(__builtin_amdgcn_update_dpp(0, __float_as_int(v), 0x122, 0xf, 0xf, true)));
    v = fmaxf(v, __int_as_float(__builtin_amdgcn_update_dpp(0, __float_as_int(v), 0x121, 0xf, 0xf, true)));
    const float a = __int_as_float(__builtin_amdgcn_readlane(__float_as_int(v), 0)), b = __int_as_float(__builtin_amdgcn_readlane(__float_as_int(v), 16));
    const float c = __int_as_float(__builtin_amdgcn_readlane(__float_as_int(v), 32)), d = __int_as_float(__builtin_amdgcn_readlane(__float_as_int(v), 48));
    return fmaxf(fmaxf(a, b), fmaxf(c, d));
}
__device__ __forceinline__ unsigned q8x4(float a, float b, float c, float d, float inv) {
    const int q0 = (int)rintf(a * inv), q1 = (int)rintf(b * inv), q2 = (int)rintf(c * inv), q3 = (int)rintf(d * inv);
    return (unsigned)(q0 & 0xff) | ((unsigned)(q1 & 0xff) << 8) | ((unsigned)(q2 & 0xff) << 16) | ((unsigned)q3 << 24);
}
__device__ __forceinline__ float rdlane(float v, int l) { return __int_as_float(__builtin_amdgcn_readlane(__float_as_int(v), l)); }

namespace pg8 {
constexpr int BM = 256, BK = 64, HALF = 128, HTB = HALF * BK * 2, STAGE_BYTES = 8 * HTB, NXCD = 8, WGM = 4;
__host__ __device__ __forceinline__ int lds_byte(int r, int c) { const int st = (r >> 4) * 2 + (c >> 5), rr = r & 15, cc = c & 31, ob = rr * 64 + cc * 2; return st * 1024 + (ob ^ (((ob >> 9) & 1) << 5)); }
__host__ __device__ __forceinline__ void stage_rc(int b, int& R, int& C) { const int st = b / 1024, sb = b % 1024, swz = sb ^ (((sb >> 9) & 1) << 5); R = (st >> 1) * 16 + swz / 64; C = (st & 1) * 32 + (swz % 64) / 2; }
__host__ __device__ __forceinline__ int perm32(int rho) { const int n = rho >> 4, i = rho & 15; return 8 * (i >> 2) + 4 * n + (i & 3); }
struct Unit { int pm, pn; };
struct Gemm { const bf16* A; const bf16* Bt; int M, N, K; };
struct StaticOrder {
    int nM, nN, nwg, G, c;
    __device__ void init(int M, int N, int G_, int c_) { nM = M / BM; nN = N / BM; nwg = nM * nN; G = G_; c = c_; }
    __device__ bool next(int i, Unit& u) const {
        const long L = (long)i * G + c; if (L >= nwg || c < 0) return false;
        int wgid = (int)L; { const int q = nwg / NXCD, r = nwg % NXCD, xcd = wgid % NXCD, off = wgid / NXCD; wgid = (xcd < r ? xcd * (q + 1) : r * (q + 1) + (xcd - r) * q) + off; }
        const int nig = WGM * nN, gid = wgid / nig, fm = gid * WGM, gsz = (nM - fm) < WGM ? (nM - fm) : WGM;
        u.pm = fm + ((wgid % nig) % gsz); u.pn = (wgid % nig) / gsz; return true;
    }
    __device__ __forceinline__ void a_ready(const Unit&) const {}
    __device__ __forceinline__ void done(const Unit&) const {}
};
struct SplitOrder {
    int nM, nN, nwg, G, c, base, n;
    __device__ void init(int M, int N, int G_, int c_, int base_, int n_) { nM = M / BM; nN = N / BM; nwg = nM * nN; G = G_; c = c_; base = base_; n = n_; }
    __device__ bool next(int i, Unit& u) const {
        if (i >= n) return false; const long L = (long)base + (long)i * G + c; if (L >= nwg) return false;
        int wgid = (int)L; { const int q = nwg / NXCD, r = nwg % NXCD, xcd = wgid % NXCD, off = wgid / NXCD; wgid = (xcd < r ? xcd * (q + 1) : r * (q + 1) + (xcd - r) * q) + off; }
        const int nig = WGM * nN, gid = wgid / nig, fm = gid * WGM, gsz = (nM - fm) < WGM ? (nM - fm) : WGM;
        u.pm = fm + ((wgid % nig) % gsz); u.pn = (wgid % nig) / gsz; return true;
    }
    __device__ __forceinline__ void a_ready(const Unit&) const {}
    __device__ __forceinline__ void done(const Unit&) const {}
};
struct OrderYK {
    int G, c;
    __device__ bool next(int i, Unit& u) const {
        const int k = i & 3; const long T = (long)(i >> 2) * G + c; if (T >= 1024) return false;
        int wgid = (int)T; { const int xcd = wgid % 8, off = wgid / 8; wgid = xcd * 128 + off; }
        const int gid = wgid / 32, fm = gid * 4; const int pm = fm + ((wgid % 32) % 4), pn = (wgid % 32) / 4;
        u.pm = k * 128 + pm; u.pn = k * 8 + pn; return true;
    }
    __device__ __forceinline__ void a_ready(const Unit&) const {}
    __device__ __forceinline__ void done(const Unit&) const {}
};
__device__ __forceinline__ unsigned cvt_pk_bf16(float lo, float hi) { return pk2(lo, hi); }

template <bool I8> struct AccOf { typedef f32x4 T; }; template <> struct AccOf<true> { typedef i32x4 T; };
template <int ACT> struct EpiStore {
    static constexpr bool I8 = false; static constexpr bool PERM = true;
    bf16* O; int ldc;
    __device__ __forceinline__ void operator()(const f32x4 (&acc)[2][2][4][2], const Unit& u, int wr, int wc, int fr, int fq) const {
        const int row0 = u.pm * BM + wr * 64 + fr, col0 = u.pn * BM + wc * 32 + 8 * fq;
#pragma unroll
        for (int ai = 0; ai < 2; ++ai)
#pragma unroll
            for (int m = 0; m < 4; ++m) { bf16* rowp = O + (size_t)(row0 + ai * HALF + m * 16) * ldc + col0;
#pragma unroll
                for (int bj = 0; bj < 2; ++bj) { f32x4 v0 = acc[ai][bj][m][0], v1 = acc[ai][bj][m][1];
                    if (ACT == 1) {
#pragma unroll
                        for (int j = 0; j < 4; ++j) { v0[j] = sigmoidf_(v0[j]); v1[j] = sigmoidf_(v1[j]); } }
                    u32x4 w; w.x = cvt_pk_bf16(v0[0], v0[1]); w.y = cvt_pk_bf16(v0[2], v0[3]); w.z = cvt_pk_bf16(v1[0], v1[1]); w.w = cvt_pk_bf16(v1[2], v1[3]);
                    *(u32x4*)(rowp + bj * HALF) = w; } }
    }
};
template <int ACT> struct EpiStoreI8 {
    static constexpr bool I8 = true; static constexpr bool PERM = true;
    bf16* O; int ldc; const float* sa; const float* sb;
    __device__ __forceinline__ void operator()(const i32x4 (&acc)[2][2][4][2], const Unit& u, int wr, int wc, int fr, int fq) const {
        const int row0 = u.pm * BM + wr * 64 + fr, col0 = u.pn * BM + wc * 32 + 8 * fq;
        float sav[8];
#pragma unroll
        for (int i = 0; i < 8; ++i) sav[i] = sa[row0 + (i >> 2) * HALF + (i & 3) * 16];
#pragma unroll
        for (int bj = 0; bj < 2; ++bj) { const f32x4 s0 = *(const f32x4*)(sb + col0 + bj * HALF), s1 = *(const f32x4*)(sb + col0 + bj * HALF + 4);
#pragma unroll
            for (int ai = 0; ai < 2; ++ai)
#pragma unroll
                for (int m = 0; m < 4; ++m) { const float ra = sav[ai * 4 + m]; const i32x4 a0 = acc[ai][bj][m][0], a1 = acc[ai][bj][m][1];
                    float v[8] = {(float)a0[0] * (ra * s0[0]), (float)a0[1] * (ra * s0[1]), (float)a0[2] * (ra * s0[2]), (float)a0[3] * (ra * s0[3]),
                                  (float)a1[0] * (ra * s1[0]), (float)a1[1] * (ra * s1[1]), (float)a1[2] * (ra * s1[2]), (float)a1[3] * (ra * s1[3])};
                    if (ACT == 1) {
#pragma unroll
                        for (int j = 0; j < 8; ++j) v[j] = sigmoidf_(v[j]); }
                    u32x4 w; w.x = cvt_pk_bf16(v[0], v[1]); w.y = cvt_pk_bf16(v[2], v[3]); w.z = cvt_pk_bf16(v[4], v[5]); w.w = cvt_pk_bf16(v[6], v[7]);
                    *(u32x4*)(O + (size_t)(row0 + ai * HALF + m * 16) * ldc + col0 + bj * HALF) = w; } }
    }
};
struct EpiAddF32 {
    static constexpr bool I8 = false; static constexpr bool PERM = false;
    const float* base; float* out; int ldc;
    __device__ __forceinline__ void operator()(const f32x4 (&acc)[2][2][4][2], const Unit& u, int wr, int wc, int fr, int fq) const {
        const int row0 = u.pm * BM + wr * 64 + fr, col0 = u.pn * BM + wc * 32 + 4 * fq;
#pragma unroll
        for (int ai = 0; ai < 2; ++ai)
#pragma unroll
            for (int m = 0; m < 4; ++m) { const size_t off = (size_t)(row0 + ai * HALF + m * 16) * ldc + col0;
#pragma unroll
                for (int bj = 0; bj < 2; ++bj)
#pragma unroll
                    for (int n = 0; n < 2; ++n) { const size_t p = off + bj * HALF + n * 16; const f32x4 b = *(const f32x4*)(base + p); *(f32x4*)(out + p) = b + acc[ai][bj][m][n]; } }
    }
};
struct EpiGateAcc {
    static constexpr bool I8 = false; static constexpr bool PERM = true;
    const bf16* gates; bf16* merged;
    __device__ __forceinline__ void operator()(const f32x4 (&acc)[2][2][4][2], const Unit& u, int wr, int wc, int fr, int fq) const {
        const int k = u.pn >> 3, pn = u.pn & 7, pm = u.pm & 127;
        const int row0 = pm * BM + wr * 64 + fr, col0 = pn * BM + wc * 32 + 8 * fq;
#pragma unroll
        for (int ai = 0; ai < 2; ++ai) {
            u32x4 g[4][2], pv[4][2];
#pragma unroll
            for (int m = 0; m < 4; ++m)
#pragma unroll
                for (int bj = 0; bj < 2; ++bj) { const size_t r = (size_t)(row0 + ai * HALF + m * 16); const int c = col0 + bj * HALF;
                    g[m][bj] = *(const u32x4*)(gates + r * NGATE + k * DM + c);
                    pv[m][bj] = (u32x4){0u, 0u, 0u, 0u}; if (k) pv[m][bj] = *(const u32x4*)(merged + r * DM + c); }
#pragma unroll
            for (int m = 0; m < 4; ++m)
#pragma unroll
                for (int bj = 0; bj < 2; ++bj) { const size_t r = (size_t)(row0 + ai * HALF + m * 16); const int c = col0 + bj * HALF;
                    const f32x4 v0 = acc[ai][bj][m][0], v1 = acc[ai][bj][m][1]; const u32x4 gg = g[m][bj], pp = pv[m][bj];
                    float o[8];
                    o[0] = lo16(pp.x) + lo16(gg.x) * v0[0]; o[1] = hi16(pp.x) + hi16(gg.x) * v0[1]; o[2] = lo16(pp.y) + lo16(gg.y) * v0[2]; o[3] = hi16(pp.y) + hi16(gg.y) * v0[3];
                    o[4] = lo16(pp.z) + lo16(gg.z) * v1[0]; o[5] = hi16(pp.z) + hi16(gg.z) * v1[1]; o[6] = lo16(pp.w) + lo16(gg.w) * v1[2]; o[7] = hi16(pp.w) + hi16(gg.w) * v1[3];
                    u32x4 w; w.x = cvt_pk_bf16(o[0], o[1]); w.y = cvt_pk_bf16(o[2], o[3]); w.z = cvt_pk_bf16(o[4], o[5]); w.w = cvt_pk_bf16(o[6], o[7]);
                    *(u32x4*)(merged + r * DM + c) = w; }
            asm volatile("" ::: "memory");
        }
    }
};
struct EpiGlu {
    static constexpr bool I8 = false; static constexpr bool PERM = true;
    const bf16* Z; bf16* O;
    __device__ __forceinline__ void operator()(const f32x4 (&acc)[2][2][4][2], const Unit& u, int wr, int wc, int fr, int fq) const {
        const int row0 = u.pm * BM + wr * 64 + fr, col0 = u.pn * BM + wc * 32 + 8 * fq;
#pragma unroll
        for (int ai = 0; ai < 2; ++ai)
#pragma unroll
            for (int m = 0; m < 4; ++m) { const size_t r = (size_t)(row0 + ai * HALF + m * 16);
#pragma unroll
                for (int bj = 0; bj < 2; ++bj) { const int c = col0 + bj * HALF;
                    const u32x4 z = *(const u32x4*)(Z + r * 512 + c);
                    const f32x4 v0 = acc[ai][bj][m][0], v1 = acc[ai][bj][m][1];
                    float o[8];
                    o[0] = lo16(z.x) * sigmoidf_(v0[0]); o[1] = hi16(z.x) * sigmoidf_(v0[1]); o[2] = lo16(z.y) * sigmoidf_(v0[2]); o[3] = hi16(z.y) * sigmoidf_(v0[3]);
                    o[4] = lo16(z.z) * sigmoidf_(v1[0]); o[5] = hi16(z.z) * sigmoidf_(v1[1]); o[6] = lo16(z.w) * sigmoidf_(v1[2]); o[7] = hi16(z.w) * sigmoidf_(v1[3]);
                    u32x4 w; w.x = cvt_pk_bf16(o[0], o[1]); w.y = cvt_pk_bf16(o[2], o[3]); w.z = cvt_pk_bf16(o[4], o[5]); w.w = cvt_pk_bf16(o[6], o[7]);
                    *(u32x4*)(O + r * 512 + c) = w; }
                asm volatile("" ::: "memory"); }
    }
};
template <bool I8_> struct EpiFfnUp {
    static constexpr bool I8 = I8_; static constexpr bool PERM = true;
    const bf16* G; bf16* O; const float* cw; const float* cb; const float* sa; const float* sb;
    __device__ __forceinline__ void operator()(const typename AccOf<I8_>::T (&acc)[2][2][4][2], const Unit& u, int wr, int wc, int fr, int fq) const {
        const int row0 = u.pm * BM + wr * 64 + fr, col0 = u.pn * BM + wc * 32 + 8 * fq;
#pragma unroll
        for (int bj = 0; bj < 2; ++bj) { const int c = col0 + bj * HALF;
            unsigned bbp[4], w0p[4], w1p[4], w2p[4];
#pragma unroll
            for (int h = 0; h < 2; ++h) { const f32x4 a = *(const f32x4*)(cw + c + 4 * h), b = *(const f32x4*)(cw + FF + c + 4 * h), d = *(const f32x4*)(cw + 2 * FF + c + 4 * h), e = *(const f32x4*)(cb + c + 4 * h);
                w0p[2 * h] = pk2(a[0], a[1]); w0p[2 * h + 1] = pk2(a[2], a[3]); w1p[2 * h] = pk2(b[0], b[1]); w1p[2 * h + 1] = pk2(b[2], b[3]); w2p[2 * h] = pk2(d[0], d[1]); w2p[2 * h + 1] = pk2(d[2], d[3]);
                bbp[2 * h] = pk2(e[0], e[1]); bbp[2 * h + 1] = pk2(e[2], e[3]); }
#pragma unroll
            for (int aim = 0; aim < 4; ++aim) { const int ai = aim >> 1, mb = (aim & 1) * 2;
                u32x4 g2[4], g1[4], g0[4];
#pragma unroll
                for (int m = mb; m < mb + 2; ++m) { const int ri = row0 + ai * HALF + m * 16; const size_t r = (size_t)ri; const int t = ri & (SEQ - 1);
                    g2[m] = *(const u32x4*)(G + r * FF + c); g1[m] = (u32x4){0u, 0u, 0u, 0u}; g0[m] = (u32x4){0u, 0u, 0u, 0u};
                    if (t >= 1) g1[m] = *(const u32x4*)(G + (r - 1) * FF + c);
                    if (t >= 2) g0[m] = *(const u32x4*)(G + (r - 2) * FF + c); }
#pragma unroll
                for (int m = mb; m < mb + 2; ++m) { const size_t r = (size_t)(row0 + ai * HALF + m * 16);
                    f32x4 v0, v1;
                    if constexpr (I8_) { const float ra = sa[row0 + ai * HALF + m * 16]; const f32x4 s0 = *(const f32x4*)(sb + c) * ra, s1 = *(const f32x4*)(sb + c + 4) * ra;
#pragma unroll
                        for (int j = 0; j < 4; ++j) { v0[j] = (float)acc[ai][bj][m][0][j] * s0[j]; v1[j] = (float)acc[ai][bj][m][1][j] * s1[j]; } }
                    else {
#pragma unroll
                        for (int j = 0; j < 4; ++j) { v0[j] = (float)acc[ai][bj][m][0][j]; v1[j] = (float)acc[ai][bj][m][1][j]; } }
                    const float x2[8] = {lo16(g2[m].x), hi16(g2[m].x), lo16(g2[m].y), hi16(g2[m].y), lo16(g2[m].z), hi16(g2[m].z), lo16(g2[m].w), hi16(g2[m].w)};
                    const float x1[8] = {lo16(g1[m].x), hi16(g1[m].x), lo16(g1[m].y), hi16(g1[m].y), lo16(g1[m].z), hi16(g1[m].z), lo16(g1[m].w), hi16(g1[m].w)};
                    const float x0[8] = {lo16(g0[m].x), hi16(g0[m].x), lo16(g0[m].y), hi16(g0[m].y), lo16(g0[m].z), hi16(g0[m].z), lo16(g0[m].w), hi16(g0[m].w)};
                    float o[8];
#pragma unroll
                    for (int j = 0; j < 8; ++j) { const float t0 = (j & 1) ? hi16(w0p[j >> 1]) : lo16(w0p[j >> 1]), t1 = (j & 1) ? hi16(w1p[j >> 1]) : lo16(w1p[j >> 1]), t2 = (j & 1) ? hi16(w2p[j >> 1]) : lo16(w2p[j >> 1]);
                        const float uu = ((j & 1) ? hi16(bbp[j >> 1]) : lo16(bbp[j >> 1])) + t0 * x0[j] + t1 * x1[j] + t2 * x2[j]; o[j] = geluf_(uu) * (j < 4 ? v0[j & 3] : v1[j & 3]); }
                    u32x4 w; w.x = cvt_pk_bf16(o[0], o[1]); w.y = cvt_pk_bf16(o[2], o[3]); w.z = cvt_pk_bf16(o[4], o[5]); w.w = cvt_pk_bf16(o[6], o[7]);
                    *(u32x4*)(O + r * FF + c) = w; }
                asm volatile("" ::: "memory"); } }
    }
};

__device__ __forceinline__ f32x4 mma16(bf16x8 b, bf16x8 a, f32x4 c) { return __builtin_amdgcn_mfma_f32_16x16x32_bf16(b, a, c, 0, 0, 0); }
__device__ __forceinline__ i32x4 mma16(bf16x8 b, bf16x8 a, i32x4 c) { return __builtin_amdgcn_mfma_i32_16x16x64_i8(__builtin_bit_cast(i32x4, b), __builtin_bit_cast(i32x4, a), c, 0, 0, 0); }
#ifndef PG8_SP2
#define PG8_SP2 true
#endif
#ifndef PG8_ALIGN
#define PG8_ALIGN true
#endif
template <class Epi, class Sched, bool ALIGN_EPI = PG8_ALIGN, bool SP2 = PG8_SP2>
__device__ __forceinline__ void gemm_phase(LAS unsigned char* lds, const Gemm g, const Sched& S, const Epi& E, int tid_) {
    const int tid = tid_, wid = __builtin_amdgcn_readfirstlane(tid >> 6), lane = tid & 63, wr = wid >> 2, wc = wid & 3, fr = lane & 15, fq = lane >> 4;
    const int K = g.K, nt = K / BK;
    unsigned voffA[2], voffB[2];
#pragma unroll
    for (int i = 0; i < 2; ++i) { int R, C; stage_rc(tid * 16 + i * 8192, R, C); const int Rb = Epi::PERM ? ((R & ~31) + perm32(R & 31)) : R;
        voffA[i] = (unsigned)(R * K + C) * 2u; voffB[i] = (unsigned)(Rb * K + C) * 2u; }
    const size_t kstep = (size_t)(BK * 2);
    const size_t hstep = (size_t)HALF * K * 2;
    const size_t tstep = 2 * hstep;
    const unsigned ldsw = (unsigned)wid * 1024u;
    const int aoff = lds_byte(wr * 64 + fr, fq * 8), boff = lds_byte(wc * 32 + fr, fq * 8);
#define PG8_SA(b, h) (((b) * 2 + (h)) * HTB)
#define PG8_SB(b, h) ((4 + (b) * 2 + (h)) * HTB)
#define PG8_STAGE(bufoff, gbase, voff) do { _Pragma("unroll") for (int _i = 0; _i < 2; ++_i) \
        __builtin_amdgcn_global_load_lds((const unsigned*)((const char*)(gbase) + (voff)[_i]), (LAS unsigned*)(lds + (bufoff) + ldsw + _i * 8192), 16, 0, 0); } while (0)
#define PG8_LDA(dst, b, h) do { _Pragma("unroll") for (int m = 0; m < 4; ++m) _Pragma("unroll") for (int k = 0; k < 2; ++k) dst[m][k] = *(const LAS bf16x8*)(lds + PG8_SA(b, h) + aoff + m * 2048 + k * 1024); } while (0)
#define PG8_LDB(dst, b, h) do { _Pragma("unroll") for (int n = 0; n < 2; ++n) _Pragma("unroll") for (int k = 0; k < 2; ++k) dst[n][k] = *(const LAS bf16x8*)(lds + PG8_SB(b, h) + boff + n * 2048 + k * 1024); } while (0)
#define PG8_MMA(ai, bj, At, Bt) do { __builtin_amdgcn_s_setprio(1); _Pragma("unroll") for (int m = 0; m < 4; ++m) _Pragma("unroll") for (int n = 0; n < 2; ++n) _Pragma("unroll") for (int k = 0; k < 2; ++k) \
        acc[ai][bj][m][n] = mma16(Bt[n][k], At[m][k], acc[ai][bj][m][n]); __builtin_amdgcn_s_setprio(0); } while (0)
#define PG8_WAIT_V(n) asm volatile("s_waitcnt vmcnt(" #n ")" ::: "memory")
#define PG8_WAIT_L(n) asm volatile("s_waitcnt lgkmcnt(" #n ")" ::: "memory")
#define PG8_BAR __builtin_amdgcn_s_barrier()
#define PG8_SCHED __builtin_amdgcn_sched_barrier(0)
    Unit cur, nxt; int ui = 0;
    if (!S.next(0, cur)) return;
    typedef typename AccOf<Epi::I8>::T acc_t;
    acc_t acc[2][2][4][2];
#pragma unroll
    for (int a = 0; a < 2; ++a)
#pragma unroll
        for (int b = 0; b < 2; ++b)
#pragma unroll
            for (int m = 0; m < 4; ++m)
#pragma unroll
                for (int n = 0; n < 2; ++n) acc[a][b][m][n] = (acc_t){0, 0, 0, 0};
    bf16x8 At[4][2], B0[2][2], B1[2][2];
    const char* cA = (const char*)g.A + (size_t)cur.pm * tstep; const char* cB = (const char*)g.Bt + (size_t)cur.pn * tstep;
    S.a_ready(cur);
    if constexpr (SP2) {
        PG8_STAGE(PG8_SB(0, 0), cB, voffB); PG8_STAGE(PG8_SB(0, 1), cB + hstep, voffB); PG8_STAGE(PG8_SA(0, 0), cA, voffA); PG8_STAGE(PG8_SA(0, 1), cA + hstep, voffA);
        if (wr == 1) PG8_BAR;
        PG8_WAIT_V(2); PG8_BAR;
        PG8_STAGE(PG8_SB(1, 0), cB + kstep, voffB); PG8_STAGE(PG8_SA(1, 0), cA + kstep, voffA); PG8_STAGE(PG8_SB(1, 1), cB + hstep + kstep, voffB);
        PG8_WAIT_V(6); PG8_BAR;
    } else {
    PG8_STAGE(PG8_SB(0, 0), cB, voffB); PG8_STAGE(PG8_SA(0, 0), cA, voffA); PG8_STAGE(PG8_SB(0, 1), cB + hstep, voffB); PG8_STAGE(PG8_SA(0, 1), cA + hstep, voffA);
    if (wr == 1) PG8_BAR;
    PG8_WAIT_V(4); PG8_BAR;
    PG8_STAGE(PG8_SB(1, 0), cB + kstep, voffB); PG8_STAGE(PG8_SA(1, 0), cA + kstep, voffA); PG8_STAGE(PG8_SB(1, 1), cB + hstep + kstep, voffB);
    PG8_WAIT_V(6); PG8_BAR;
    }
    for (;;) {
        const bool has_next = S.next(ui + 1, nxt);
        const char* nA = has_next ? (const char*)g.A + (size_t)nxt.pm * tstep : cA; const char* nB = has_next ? (const char*)g.Bt + (size_t)nxt.pn * tstep : cB;
        for (int t = 0; t < nt; t += 2) {
            const bool last = (t == nt - 2);
            const char* a1 = cA + (size_t)(t + 1) * kstep;
            const char* a2 = last ? nA : cA + (size_t)(t + 2) * kstep; const char* b2 = last ? nB : cB + (size_t)(t + 2) * kstep;
            const char* a3 = a2 + kstep; const char* b3 = b2 + kstep;
            if (last && has_next) S.a_ready(nxt);
            if constexpr (SP2) {
            PG8_LDB(B0, 0, 0); PG8_LDB(B1, 0, 1); PG8_SCHED; PG8_LDA(At, 0, 0); PG8_STAGE(PG8_SA(1, 1), a1 + hstep, voffA);
            PG8_WAIT_V(8); PG8_WAIT_L(0); PG8_BAR; PG8_MMA(0, 0, At, B0); PG8_MMA(0, 1, At, B1); PG8_BAR; PG8_SCHED;
            PG8_LDA(At, 0, 1); PG8_STAGE(PG8_SB(0, 0), b2, voffB); PG8_STAGE(PG8_SB(0, 1), b2 + hstep, voffB); PG8_STAGE(PG8_SA(0, 0), a2, voffA);
            PG8_WAIT_V(8); PG8_WAIT_L(0); PG8_BAR; PG8_MMA(1, 0, At, B0); PG8_MMA(1, 1, At, B1); PG8_BAR; PG8_SCHED;
            PG8_LDB(B0, 1, 0); PG8_LDB(B1, 1, 1); PG8_SCHED; PG8_LDA(At, 1, 0); PG8_STAGE(PG8_SA(0, 1), a2 + hstep, voffA);
            PG8_WAIT_V(8); PG8_WAIT_L(0); PG8_BAR; PG8_MMA(0, 0, At, B0); PG8_MMA(0, 1, At, B1); PG8_BAR; PG8_SCHED;
            PG8_LDA(At, 1, 1); PG8_STAGE(PG8_SB(1, 0), b3, voffB); PG8_STAGE(PG8_SB(1, 1), b3 + hstep, voffB); PG8_STAGE(PG8_SA(1, 0), a3, voffA);
            PG8_WAIT_V(8); PG8_WAIT_L(0); PG8_BAR; PG8_MMA(1, 0, At, B0); PG8_MMA(1, 1, At, B1); PG8_BAR; PG8_SCHED;
            } else {
            PG8_LDB(B0, 0, 0); PG8_SCHED; PG8_LDA(At, 0, 0); PG8_STAGE(PG8_SA(1, 1), a1 + hstep, voffA);
            PG8_WAIT_L(8); PG8_BAR; PG8_WAIT_L(0); PG8_MMA(0, 0, At, B0); PG8_BAR; PG8_SCHED;
            PG8_LDB(B1, 0, 1); PG8_STAGE(PG8_SB(0, 0), b2, voffB);
            PG8_BAR; PG8_WAIT_L(0); PG8_MMA(0, 1, At, B1); PG8_BAR;
            PG8_LDA(At, 0, 1); PG8_STAGE(PG8_SA(0, 0), a2, voffA);
            PG8_BAR; PG8_WAIT_L(0); PG8_MMA(1, 0, At, B0); PG8_BAR; PG8_SCHED;
            PG8_STAGE(PG8_SB(0, 1), b2 + hstep, voffB);
            PG8_WAIT_V(6); PG8_BAR; PG8_MMA(1, 1, At, B1); PG8_BAR;
            PG8_LDB(B0, 1, 0); PG8_SCHED; PG8_LDA(At, 1, 0); PG8_STAGE(PG8_SA(0, 1), a2 + hstep, voffA);
            PG8_WAIT_L(8); PG8_BAR; PG8_WAIT_L(0); PG8_MMA(0, 0, At, B0); PG8_BAR; PG8_SCHED;
            PG8_LDB(B1, 1, 1); PG8_STAGE(PG8_SB(1, 0), b3, voffB);
            PG8_BAR; PG8_WAIT_L(0); PG8_MMA(0, 1, At, B1); PG8_BAR;
            PG8_LDA(At, 1, 1); PG8_STAGE(PG8_SA(1, 0), a3, voffA);
            PG8_BAR; PG8_WAIT_L(0); PG8_MMA(1, 0, At, B0); PG8_BAR; PG8_SCHED;
            PG8_STAGE(PG8_SB(1, 1), b3 + hstep, voffB);
            PG8_WAIT_V(6); PG8_BAR; PG8_MMA(1, 1, At, B1); PG8_BAR;
            }
        }
        if constexpr (ALIGN_EPI) { if (wr == 0) PG8_BAR; }
        E(acc, cur, wr, wc, fr, fq); S.done(cur);
        if (!has_next) break;
#pragma unroll
        for (int a = 0; a < 2; ++a)
#pragma unroll
            for (int b = 0; b < 2; ++b)
#pragma unroll
                for (int m = 0; m < 4; ++m)
#pragma unroll
                    for (int n = 0; n < 2; ++n) acc[a][b][m][n] = (acc_t){0, 0, 0, 0};
        cur = nxt; cA = nA; cB = nB; ++ui;
        if constexpr (ALIGN_EPI) { if (wr == 1) PG8_BAR; }
    }
    PG8_WAIT_V(0);
    if constexpr (!ALIGN_EPI) { if (wr == 0) PG8_BAR; }
    PG8_BAR;
#undef PG8_SA
#undef PG8_SB
#undef PG8_STAGE
#undef PG8_LDA
#undef PG8_LDB
#undef PG8_MMA
#undef PG8_WAIT_V
#undef PG8_WAIT_L
#undef PG8_BAR
#undef PG8_SCHED
}
}

#define XB_TMO      128
#define XB_XCNT(j)  (256  + 64 * (j))
#define XB_XSUB(j)  (1280 + 64 * (j))
#define XB_XGEN(j)  (2304 + 64 * (j))
#define XB_TOP      3328
#define XB_TOPGEN   3392
#define XCD_BAR_WORDS 3456
#define XB_SPIN_CAP (1u << 22)
__device__ __forceinline__ unsigned xb_ld(unsigned* p)              { return __hip_atomic_load(p, __ATOMIC_RELAXED, __HIP_MEMORY_SCOPE_AGENT); }
__device__ __forceinline__ unsigned xb_add(unsigned* p, unsigned v) { return __hip_atomic_fetch_add(p, v, __ATOMIC_RELAXED, __HIP_MEMORY_SCOPE_AGENT); }
__device__ __forceinline__ unsigned xb_xcc_id() { return (unsigned)__builtin_amdgcn_s_getreg((3 << 11) | 20) & 0xFu; }
#define XB_SPIN(cond, bar) do { unsigned _sp = 0; while (cond) { __builtin_amdgcn_s_sleep(1); \
    if ((++_sp & 255u) == 0u) { if (xb_ld(&(bar)[XB_TMO])) break; if (_sp > XB_SPIN_CAP) { atomicAdd(&(bar)[XB_TMO], 1u); break; } } } } while (0)
struct XcdBarrier { unsigned* bar; unsigned x; volatile LAS unsigned* st; };
__device__ __forceinline__ XcdBarrier xcd_barrier_post(unsigned* bar, volatile LAS unsigned* st) {
    XcdBarrier b; b.bar = bar; b.x = xb_xcc_id(); b.st = st;
    if (threadIdx.x == 0) (void)xb_add(&bar[XB_XCNT(b.x)], 1u);
    return b;
}
__device__ __forceinline__ void xcd_barrier_complete(unsigned* bar, unsigned x, unsigned& nloc, unsigned& nx) {
    const unsigned G = gridDim.x * gridDim.y * gridDim.z;
    unsigned sum, cnt, mine, sp = 0u;
    for (;;) {
        sum = 0u; cnt = 0u; mine = 0u;
#pragma unroll
        for (unsigned j = 0; j < 16; ++j) { const unsigned c = xb_ld(&bar[XB_XCNT(j)]); sum += c; cnt += (c > 0u) ? 1u : 0u; mine = (j == x) ? c : mine; }
        if (sum == G) break;
        __builtin_amdgcn_s_sleep(1);
        if ((++sp & 255u) == 0u) { if (xb_ld(&bar[XB_TMO])) break; if (sp > XB_SPIN_CAP) { atomicAdd(&bar[XB_TMO], 1u); break; } }
    }
    nloc = mine > 0u ? mine : 1u; nx = cnt > 0u ? cnt : 1u;
}
__device__ __forceinline__ void xcd_barrier(const XcdBarrier& b) {
    asm volatile("s_waitcnt vmcnt(0)" ::: "memory");
    __syncthreads();
    if (threadIdx.x == 0) {
        unsigned* bar = b.bar;
        __builtin_amdgcn_s_waitcnt(0);
        unsigned nloc = b.st[0], nx = b.st[1];
        if (nloc == 0u) { xcd_barrier_complete(bar, b.x, nloc, nx); b.st[0] = nloc; b.st[1] = nx; }
        const unsigned old = xb_add(&bar[XB_XSUB(b.x)], 1u);
        const unsigned gen = old / nloc;
        if (old + 1u == (gen + 1u) * nloc) {
            __builtin_amdgcn_fence(__ATOMIC_RELEASE, "agent");
            asm volatile("s_waitcnt vmcnt(0)" ::: "memory");
            const unsigned og = xb_add(&bar[XB_TOP], 1u);
            const unsigned tg = og / nx;
            if (og + 1u == (tg + 1u) * nx) xb_add(&bar[XB_TOPGEN], 1u);
            else XB_SPIN(xb_ld(&bar[XB_TOPGEN]) == tg, bar);
            __builtin_amdgcn_fence(__ATOMIC_ACQUIRE, "agent");
            xb_add(&bar[XB_XGEN(b.x)], 1u);
            asm volatile("s_waitcnt vmcnt(0)" ::: "memory");
        } else {
            XB_SPIN(xb_ld(&bar[XB_XGEN(b.x)]) == gen, bar);
            __builtin_amdgcn_fence(__ATOMIC_ACQUIRE, "agent");
            asm volatile("s_waitcnt vmcnt(0)" ::: "memory");
        }
    }
    __syncthreads();
}

constexpr int NWAVES = 8, NTHR = 512;
constexpr int LDS_MISC = 131072, LDS_BYTES = 131072 + 1024;
struct Args { const float* in[45]; float* out; unsigned char* ws; };
#define GAS __attribute__((address_space(1)))
struct Frame {
    LAS unsigned char* lds; float* out; unsigned char* ws;
    int tid, lane, wave, blk, G;
};
#define WSP(T, off) ((T*)(F.ws + (off)))
__device__ __forceinline__ const float* inp_(LAS unsigned char* lds, int k) {
    const LAS unsigned* t = (const LAS unsigned*)(lds + 131072 + 256) + 2 * k;
    const unsigned lo = __builtin_amdgcn_readfirstlane(t[0]), hi = __builtin_amdgcn_readfirstlane(t[1]);
    return (const float*)(const GAS float*)(((unsigned long long)hi << 32) | lo);
}
#define INP(k) inp_(F.lds, (k))

__device__ __forceinline__ void tr_item(const float* W, int ld, int col0, int ncv, bf16* WT, int K, int row_off, LAS float* scr, int kb, int nb, int lane) {
    const int k0 = 64 * kb, n0 = 32 * nb; const int nn = n0 + (lane & 31); const bool ok = nn < ncv;
    { float t[32]; const float* wp = W + (size_t)(k0 + (lane >> 5)) * ld + col0 + (ok ? nn : 0);
#pragma unroll
      for (int i = 0; i < 32; ++i) t[i] = wp[(size_t)(2 * i) * ld];
#pragma unroll
      for (int i = 0; i < 32; ++i) scr[(2 * i + (lane >> 5)) * 33 + (lane & 31)] = ok ? t[i] : 0.f; }
    asm volatile("s_waitcnt lgkmcnt(0)" ::: "memory");
    const int c = lane & 7;
#pragma unroll
    for (int j = 0; j < 4; ++j) { const int n = (lane >> 3) + 8 * j; const LAS float* s = scr + (8 * c) * 33 + n;
        u32x4 o; o.x = pk2(s[0 * 33], s[1 * 33]); o.y = pk2(s[2 * 33], s[3 * 33]); o.z = pk2(s[4 * 33], s[5 * 33]); o.w = pk2(s[6 * 33], s[7 * 33]);
        *(u32x4*)(WT + (size_t)(row_off + n0 + n) * K + k0 + 8 * c) = o; }
    asm volatile("s_waitcnt lgkmcnt(0)" ::: "memory");
}
__device__ __forceinline__ void convert_weights(Frame& F, int l) {
    LAS float* scr = (LAS float*)(F.lds + F.wave * 16384);
    const int gw = F.blk * NWAVES + F.wave, NGW = F.G * NWAVES;
    constexpr int I0 = 32 * 152, I1 = I0, I2 = I1 + 4 * 8 * 64, I3 = I2 + 32 * 64, I4 = I3, I5 = I4, I6 = I5 + 96 * 64, I7 = I6 + 8 * 16;
    const float* win = INP(2) + (size_t)l * DM * INC;
    for (int it = gw; it < I7; it += NGW) {
        if (it < I0) { const int r = it; tr_item(win, INC, 0, MIXC, WSP(bf16, WS_WIN), DM, 0, scr, r / 152, r % 152, F.lane); }
        else if (it < I1) { }
        else if (it < I2) { const int r = it - I1; const int k = r / 512, rr = r % 512; tr_item(INP(36) + ((size_t)l * 4 + k) * 512 * DM, DM, 0, DM, WSP(bf16, WS_WPK), 512, k * DM, scr, rr / 64, rr % 64, F.lane); }
        else if (it < I3) { const int r = it - I2; tr_item(INP(37) + (size_t)l * DM * DM, DM, 0, DM, WSP(bf16, WS_WOUT), DM, 0, scr, r / 64, r % 64, F.lane); }
        else if (it < I4) { const int r = it - I3; tr_item(INP(39) + (size_t)l * DM * FF, FF, 0, FF, WSP(bf16, WS_WFG), DM, 0, scr, r / 192, r % 192, F.lane); }
        else if (it < I5) { const int r = it - I4; tr_item(INP(40) + (size_t)l * DM * FF, FF, 0, FF, WSP(bf16, WS_WFU), DM, 0, scr, r / 192, r % 192, F.lane); }
        else if (it < I6) { const int r = it - I5; tr_item(INP(43) + (size_t)l * FF * DM, DM, 0, DM, WSP(bf16, WS_WFD), FF, 0, scr, r / 64, r % 64, F.lane); }
        else { const int r = it - I6; tr_item(INP(11) + (size_t)l * 512 * 512, 512, 0, 512, WSP(bf16, WS_WGLU), 512, 0, scr, r / 16, r % 16, F.lane); }
    }
}
__device__ __forceinline__ void rmsnorm_rows(Frame& F, const float* x, const float* g, bf16* obf, float* of32, unsigned* a8 = nullptr, float* sa = nullptr) {
    const int gw = F.blk * NWAVES + F.wave, NGW = F.G * NWAVES;
    f32x4 gv[8];
#pragma unroll
    for (int j = 0; j < 8; ++j) gv[j] = ((const f32x4*)g)[64 * j + F.lane];
    for (int m = gw; m < MTOK; m += NGW) {
        const f32x4* xr = (const f32x4*)(x + (size_t)m * DM) + F.lane;
        f32x4 v[8]; float s = 0.f;
#pragma unroll
        for (int j = 0; j < 8; ++j) { v[j] = xr[64 * j]; s += (v[j].x * v[j].x + v[j].y * v[j].y) + (v[j].z * v[j].z + v[j].w * v[j].w); }
        const float rs = 1.0f / sqrtf(wave_sum(s) * (1.f / DM) + 1e-6f);
#pragma unroll
        for (int j = 0; j < 8; ++j) v[j] = v[j] * rs * gv[j];
        if (obf) { u32x2* o = (u32x2*)(obf + (size_t)m * DM) + F.lane;
#pragma unroll
            for (int j = 0; j < 8; ++j) { u32x2 w; w.x = pk2(v[j].x, v[j].y); w.y = pk2(v[j].z, v[j].w); o[64 * j] = w; } }
        if (of32) { f32x4* o = (f32x4*)(of32 + (size_t)m * DM) + F.lane;
#pragma unroll
            for (int j = 0; j < 8; ++j) o[64 * j] = v[j]; }
        if (a8) {
            float am = 0.f;
#pragma unroll
            for (int j = 0; j < 8; ++j) am = fmaxf(fmaxf(am, fmaxf(fabsf(v[j].x), fabsf(v[j].y))), fmaxf(fabsf(v[j].z), fabsf(v[j].w)));
            am = fmaxf(wave_max(am), 1e-20f); const float inv = 127.0f / am;
            unsigned* o = a8 + (size_t)m * (DM / 4) + F.lane;
#pragma unroll
            for (int j = 0; j < 8; ++j) o[64 * j] = q8x4(v[j].x, v[j].y, v[j].z, v[j].w, inv);
            if (F.lane == 0) sa[m] = am * (1.0f / 127.0f); }
    }
}
__device__ __forceinline__ void convert_cols_i8(Frame& F, const float* W, int ld, int col0, int nb, signed char* W8, float* sb, int row_off) {
    LAS float* red = (LAS float*)(F.lds + 8 * 16384 - 4096);
    LAS float* scl = red + 512;
    const int tid = F.tid, n = tid & 31, kg = tid >> 5; const float* wp = W + col0 + 32 * nb + n;
    float am = 0.f;
#pragma unroll 1
    for (int i0 = 0; i0 < 128; i0 += 32) { float t[32];
#pragma unroll
        for (int i = 0; i < 32; ++i) t[i] = wp[(size_t)(kg + 16 * (i0 + i)) * ld];
#pragma unroll
        for (int i = 0; i < 32; ++i) am = fmaxf(am, fabsf(t[i])); }
    red[kg * 32 + n] = am;
    __syncthreads();
    if (tid < 32) { float a = 0.f;
#pragma unroll
        for (int q = 0; q < 16; ++q) a = fmaxf(a, red[q * 32 + tid]);
        a = fmaxf(a, 1e-30f); scl[tid] = 127.0f / a; sb[row_off + 32 * nb + tid] = a * (1.0f / 127.0f); }
    __syncthreads();
    LAS float* scr = (LAS float*)(F.lds + F.wave * 16384);
    const int lane = F.lane, rn = lane >> 1, half = lane & 1; const float inv = scl[rn];
#pragma unroll 1
    for (int kb = F.wave; kb < 32; kb += NWAVES) {
        { float t[32];
#pragma unroll
          for (int i = 0; i < 32; ++i) t[i] = W[(size_t)(64 * kb + 2 * i + (lane >> 5)) * ld + col0 + 32 * nb + (lane & 31)];
#pragma unroll
          for (int i = 0; i < 32; ++i) scr[(2 * i + (lane >> 5)) * 33 + (lane & 31)] = t[i]; }
        asm volatile("s_waitcnt lgkmcnt(0)" ::: "memory");
        const LAS float* sp = scr + (32 * half) * 33 + rn;
        u32x4 w0, w1;
        w0.x = q8x4(sp[0 * 33], sp[1 * 33], sp[2 * 33], sp[3 * 33], inv); w0.y = q8x4(sp[4 * 33], sp[5 * 33], sp[6 * 33], sp[7 * 33], inv);
        w0.z = q8x4(sp[8 * 33], sp[9 * 33], sp[10 * 33], sp[11 * 33], inv); w0.w = q8x4(sp[12 * 33], sp[13 * 33], sp[14 * 33], sp[15 * 33], inv);
        w1.x = q8x4(sp[16 * 33], sp[17 * 33], sp[18 * 33], sp[19 * 33], inv); w1.y = q8x4(sp[20 * 33], sp[21 * 33], sp[22 * 33], sp[23 * 33], inv);
        w1.z = q8x4(sp[24 * 33], sp[25 * 33], sp[26 * 33], sp[27 * 33], inv); w1.w = q8x4(sp[28 * 33], sp[29 * 33], sp[30 * 33], sp[31 * 33], inv);
        u32x4* d = (u32x4*)(W8 + (size_t)(row_off + 32 * nb + rn) * DM + 64 * kb + 32 * half); d[0] = w0; d[1] = w1;
        asm volatile("s_waitcnt lgkmcnt(0)" ::: "memory");
    }
    __syncthreads();
}

constexpr int WAVE_LDS = 16384;
constexpr int LR_XLD = 72, LR_FLD = 66, LR_ALD = 132;
constexpr int LR_XF = 16 * LR_XLD * 2, LR_AB = LR_XF + 16 * LR_FLD * 4;
template <bool FINAL> __device__ __forceinline__ void lru_task(Frame& F, int l, int task) {
    const int lane = F.lane, fr = lane & 15, fq = lane >> 4; const int b = task >> 9, h = (task >> 6) & 7, c = task & 63; const int ch = 64 * h + lane;
    LAS unsigned char* wl = F.lds + F.wave * WAVE_LDS;
    LAS bf16* XC = (LAS bf16*)wl; LAS float* XF = (LAS float*)(wl + LR_XF); LAS float* AB = (LAS float*)(wl + LR_AB);
    const float* WA = INP(14) + ((size_t)l * 8 + h) * 4096; const float* WX = INP(16) + ((size_t)l * 8 + h) * 4096;
    bf16x8 Wa[4][2], Wx[4][2];
#pragma unroll
    for (int nt = 0; nt < 4; ++nt)
#pragma unroll
        for (int kk = 0; kk < 2; ++kk) { const float* pa = WA + (size_t)(32 * kk + 8 * fq) * 64 + 16 * nt + fr; const float* px_ = WX + (size_t)(32 * kk + 8 * fq) * 64 + 16 * nt + fr;
            u32x4 wa_, wx_; wa_.x = pk2(pa[0], pa[64]); wa_.y = pk2(pa[128], pa[192]); wa_.z = pk2(pa[256], pa[320]); wa_.w = pk2(pa[384], pa[448]);
            wx_.x = pk2(px_[0], px_[64]); wx_.y = pk2(px_[128], px_[192]); wx_.z = pk2(px_[256], px_[320]); wx_.w = pk2(px_[384], px_[448]);
            Wa[nt][kk] = __builtin_bit_cast(bf16x8, wa_); Wx[nt][kk] = __builtin_bit_cast(bf16x8, wx_); }
    float ba4[4], bx4[4], sp4[4], slp[4];
#pragma unroll
    for (int nt = 0; nt < 4; ++nt) { const int jj = l * 512 + 64 * h + 16 * nt + fr; ba4[nt] = INP(15)[jj]; bx4[nt] = INP(17)[jj]; sp4[nt] = softplusf_(-INP(18)[jj]); slp[nt] = 0.f; }
    const float* cwp = INP(12) + (size_t)l * 4 * 512 + ch;
    const float cw0 = cwp[0], cw1 = cwp[512], cw2 = cwp[1024], cw3 = cwp[1536];
    const float cb = INP(13)[l * 512 + ch];
    const size_t row0 = (size_t)b * SEQ + (size_t)c * 128;
    const bf16* px = WSP(const bf16, WS_PROJ) + row0 * MIXP + PC_LRX + ch;
    const bf16* pg = WSP(const bf16, WS_PROJ) + row0 * MIXP + PC_LRG + ch;
    float xm3 = 0.f, xm2 = 0.f, xm1 = 0.f;
    if (c > 0) { xm3 = bf2f(*(px - 3 * (ptrdiff_t)MIXP)); xm2 = bf2f(*(px - 2 * (ptrdiff_t)MIXP)); xm1 = bf2f(*(px - (ptrdiff_t)MIXP)); }
    float hs = 0.f;
    const size_t cidx = ((size_t)b * 64 + c) * 512 + ch;
    if (FINAL) hs = WSP(const float, WS_LRI)[cidx];
    bf16* yo = WSP(bf16, WS_YK) + (size_t)1 * MTOK * 512 + row0 * 512 + ch;
    bf16 xs[16], gs[16];
#pragma unroll
    for (int j = 0; j < 16; ++j) { xs[j] = px[(size_t)j * MIXP]; if (FINAL) gs[j] = pg[(size_t)j * MIXP]; }
#pragma unroll 1
    for (int sb = 0; sb < 8; ++sb) {
#pragma unroll
        for (int t = 0; t < 16; ++t) { const float xv = bf2f(xs[t]); const float xc = cb + cw0 * xm3 + cw1 * xm2 + cw2 * xm1 + cw3 * xv; xm3 = xm2; xm2 = xm1; xm1 = xv;
            XC[t * LR_XLD + lane] = (bf16)f2bf(xc); XF[t * LR_FLD + lane] = xc; }
        float gl[16];
        if (FINAL) {
#pragma unroll
            for (int t = 0; t < 16; ++t) gl[t] = bf2f(gs[t]); }
        if (sb < 7) {
#pragma unroll
            for (int j = 0; j < 16; ++j) { xs[j] = px[(size_t)((sb + 1) * 16 + j) * MIXP]; if (FINAL) gs[j] = pg[(size_t)((sb + 1) * 16 + j) * MIXP]; } }
        const bf16x8 af0 = *(const LAS bf16x8*)(XC + fr * LR_XLD + 8 * fq), af1 = *(const LAS bf16x8*)(XC + fr * LR_XLD + 32 + 8 * fq);
#pragma unroll
        for (int nt = 0; nt < 4; ++nt) {
            f32x4 aa = (f32x4){0.f, 0.f, 0.f, 0.f}, ax = (f32x4){0.f, 0.f, 0.f, 0.f};
            aa = __builtin_amdgcn_mfma_f32_16x16x32_bf16(af0, Wa[nt][0], aa, 0, 0, 0); aa = __builtin_amdgcn_mfma_f32_16x16x32_bf16(af1, Wa[nt][1], aa, 0, 0, 0);
            ax = __builtin_amdgcn_mfma_f32_16x16x32_bf16(af0, Wx[nt][0], ax, 0, 0, 0); ax = __builtin_amdgcn_mfma_f32_16x16x32_bf16(af1, Wx[nt][1], ax, 0, 0, 0);
#pragma unroll
            for (int e = 0; e < 4; ++e) { const int t = 4 * fq + e, jj = 16 * nt + fr; const float xc = XF[t * LR_FLD + jj];
                const float r = sigmoidf_(aa[e] + ba4[nt]), ig = sigmoidf_(ax[e] + bx4[nt]); const float la = -8.0f * r * sp4[nt]; const float av = __expf(la);
                const float mult = __builtin_amdgcn_sqrtf(fmaxf(1.0f - av * av, 0.f));
                AB[t * LR_ALD + jj] = av; AB[t * LR_ALD + 64 + jj] = xc * ig * mult; if (!FINAL) slp[nt] += la; }
        }
#pragma unroll
        for (int t = 0; t < 16; ++t) { const float av = AB[t * LR_ALD + lane], bv = AB[t * LR_ALD + 64 + lane]; hs = av * hs + bv;
            if (FINAL) yo[(size_t)(sb * 16 + t) * 512] = (bf16)f2bf(hs * geluf_(gl[t])); }
    }
    if (!FINAL) { WSP(float, WS_LRE)[cidx] = hs;
#pragma unroll
        for (int nt = 0; nt < 4; ++nt) { float v = slp[nt]; v += __shfl_xor(v, 16); v += __shfl_xor(v, 32); if (fq == 0) WSP(float, WS_LRA)[((size_t)b * 64 + c) * 512 + 64 * h + 16 * nt + fr] = v; } }
}
__device__ __forceinline__ void lru_carry(Frame& F, int task) {
    const int b = task >> 3, ch = (task & 7) * 64 + F.lane; float run = 0.f;
#pragma unroll 1
    for (int c = 0; c < 64; ++c) { const size_t i = ((size_t)b * 64 + c) * 512 + ch; WSP(float, WS_LRI)[i] = run; run = __expf(WSP(const float, WS_LRA)[i]) * run + WSP(const float, WS_LRE)[i]; }
}

constexpr int S5_XLD = 132, S5_SLD = 136, S5_SB = 16 * S5_XLD * 4;
template <bool FINAL> __device__ __forceinline__ void s5_task(Frame& F, int l, int task) {
    const int lane = F.lane, fr = lane & 15, fq = lane >> 4; const int b = task >> 11, g = (task >> 6) & 31, c = task & 63; const int p = lane;
    LAS unsigned char* wl = F.lds + F.wave * WAVE_LDS;
    LAS float* X = (LAS float*)wl; LAS bf16* Sb = (LAS bf16*)(wl + S5_SB);
    const int lg = l * 32 + g;
    const float lr = INP(3)[lg * 64 + p], li = INP(4)[lg * 64 + p]; const float dt = expf(INP(10)[lg]);
    const float mag = expf(lr * dt); float sn, cs; sincosf(li * dt, &sn, &cs); const float abr = mag * cs, abi = mag * sn;
    const float den = lr * lr + li * li, nr = abr - 1.0f, ni = abi; const float fre = (nr * lr + ni * li) / den, fim = (ni * lr - nr * li) / den;
    bf16x8 Bf[8];
#pragma unroll
    for (int nq = 0; nq < 4; ++nq) { const int pp = 16 * nq + fr; const float fr_ = __shfl(fre, pp), fi_ = __shfl(fim, pp);
        u32x4 wr_ = (u32x4){0u, 0u, 0u, 0u}, wi_ = (u32x4){0u, 0u, 0u, 0u};
        if (fq < 2) { const f32x4* br = (const f32x4*)(INP(5) + ((size_t)lg * 64 + pp) * 16 + 8 * fq); const f32x4* bi = (const f32x4*)(INP(6) + ((size_t)lg * 64 + pp) * 16 + 8 * fq);
            const f32x4 r0 = br[0], r1 = br[1], i0 = bi[0], i1 = bi[1];
            wr_.x = pk2(fr_ * r0[0] - fi_ * i0[0], fr_ * r0[1] - fi_ * i0[1]); wr_.y = pk2(fr_ * r0[2] - fi_ * i0[2], fr_ * r0[3] - fi_ * i0[3]);
            wr_.z = pk2(fr_ * r1[0] - fi_ * i1[0], fr_ * r1[1] - fi_ * i1[1]); wr_.w = pk2(fr_ * r1[2] - fi_ * i1[2], fr_ * r1[3] - fi_ * i1[3]);
            wi_.x = pk2(fr_ * i0[0] + fi_ * r0[0], fr_ * i0[1] + fi_ * r0[1]); wi_.y = pk2(fr_ * i0[2] + fi_ * r0[2], fr_ * i0[3] + fi_ * r0[3]);
            wi_.z = pk2(fr_ * i1[0] + fi_ * r1[0], fr_ * i1[1] + fi_ * r1[1]); wi_.w = pk2(fr_ * i1[2] + fi_ * r1[2], fr_ * i1[3] + fi_ * r1[3]); }
        Bf[nq] = __builtin_bit_cast(bf16x8, wr_); Bf[nq + 4] = __builtin_bit_cast(bf16x8, wi_); }
    bf16x8 Cf[4], Df;
    if (FINAL) {
#pragma unroll
        for (int kk = 0; kk < 4; ++kk) { const float* src = (kk < 2 ? INP(7) : INP(8)) + ((size_t)lg * 16 + fr) * 64 + 32 * (kk & 1) + 8 * fq; const float sg = kk < 2 ? 1.0f : -1.0f;
            const f32x4 c0 = *(const f32x4*)src, c1 = *(const f32x4*)(src + 4);
            u32x4 w; w.x = pk2(sg * c0[0], sg * c0[1]); w.y = pk2(sg * c0[2], sg * c0[3]); w.z = pk2(sg * c1[0], sg * c1[1]); w.w = pk2(sg * c1[2], sg * c1[3]); Cf[kk] = __builtin_bit_cast(bf16x8, w); }
        const float dv = INP(9)[l * 512 + 16 * g + fr]; float dd[8];
#pragma unroll
        for (int j = 0; j < 8; ++j) dd[j] = (8 * fq + j == fr) ? dv : 0.f;
        u32x4 w; w.x = pk2(dd[0], dd[1]); w.y = pk2(dd[2], dd[3]); w.z = pk2(dd[4], dd[5]); w.w = pk2(dd[6], dd[7]); Df = __builtin_bit_cast(bf16x8, w);
    }
    float sre = 0.f, sim = 0.f;
    const size_t sidx = (((size_t)b * 32 + g) * 64 + c) * 128 + p;
    if (FINAL) { sre = WSP(const float, WS_S5I)[sidx]; sim = WSP(const float, WS_S5I)[sidx + 64]; }
    const size_t row0 = (size_t)b * SEQ + (size_t)c * 128;
    const bf16* up = WSP(const bf16, WS_PROJ) + (row0 + fr) * MIXP + PC_S5U + 16 * g + 8 * (fq & 1);
    u32x4 aun = *(const u32x4*)up;
#pragma unroll 1
    for (int sb = 0; sb < 8; ++sb) {
        u32x4 au_ = aun; if (fq >= 2) au_ = (u32x4){0u, 0u, 0u, 0u};
        const bf16x8 au = __builtin_bit_cast(bf16x8, au_);
        if (sb < 7) aun = *(const u32x4*)(up + (size_t)(sb + 1) * 16 * MIXP);
#pragma unroll
        for (int nt = 0; nt < 8; ++nt) { const f32x4 a = __builtin_amdgcn_mfma_f32_16x16x32_bf16(au, Bf[nt], (f32x4){0.f, 0.f, 0.f, 0.f}, 0, 0, 0);
#pragma unroll
            for (int e = 0; e < 4; ++e) X[(4 * fq + e) * S5_XLD + 16 * nt + fr] = a[e]; }
#pragma unroll
        for (int t = 0; t < 16; ++t) { const float xr = X[t * S5_XLD + p], xi = X[t * S5_XLD + 64 + p];
            const float nre = abr * sre - abi * sim + xr, nim = abr * sim + abi * sre + xi; sre = nre; sim = nim;
            if (FINAL) { Sb[t * S5_SLD + p] = (bf16)f2bf(sre); Sb[t * S5_SLD + 64 + p] = (bf16)f2bf(sim); } }
        if (FINAL) {
            f32x4 y = (f32x4){0.f, 0.f, 0.f, 0.f};
#pragma unroll
            for (int kk = 0; kk < 4; ++kk) y = __builtin_amdgcn_mfma_f32_16x16x32_bf16(*(const LAS bf16x8*)(Sb + fr * S5_SLD + 32 * kk + 8 * fq), Cf[kk], y, 0, 0, 0);
            y = __builtin_amdgcn_mfma_f32_16x16x32_bf16(au, Df, y, 0, 0, 0);
#pragma unroll
            for (int e = 0; e < 4; ++e) WSP(bf16, WS_S5Z)[(row0 + sb * 16 + 4 * fq + e) * 512 + 16 * g + fr] = (bf16)f2bf(geluf_(y[e]));
        }
    }
    if (!FINAL) { WSP(float, WS_S5E)[sidx] = sre; WSP(float, WS_S5E)[sidx + 64] = sim; }
}
__device__ __forceinline__ void s5_carry(Frame& F, int l, int task) {
    const int b = task >> 5, g = task & 31, p = F.lane;
    const float lr = INP(3)[(l * 32 + g) * 64 + p], li = INP(4)[(l * 32 + g) * 64 + p]; const float dt = expf(INP(10)[l * 32 + g]);
    const float mag = expf(lr * dt); float sn, cs; sincosf(li * dt, &sn, &cs); float ar = mag * cs, ai = mag * sn;
#pragma unroll
    for (int i = 0; i < 7; ++i) { const float nr = ar * ar - ai * ai, ni = 2.0f * ar * ai; ar = nr; ai = ni; }
    float rr = 0.f, ri = 0.f;
#pragma unroll 1
    for (int c = 0; c < 64; ++c) { const size_t i = (((size_t)b * 32 + g) * 64 + c) * 128 + p;
        WSP(float, WS_S5I)[i] = rr; WSP(float, WS_S5I)[i + 64] = ri;
        const float er = WSP(const float, WS_S5E)[i], ei = WSP(const float, WS_S5E)[i + 64];
        const float nr = ar * rr - ai * ri + er, ni = ar * ri + ai * rr + ei; rr = nr; ri = ni; }
}

constexpr int M2_CS = 0, M2_BS = 17408, M2_BST = 34816, M2_XT = 53248, M2_GS = 90112, M2_CUM = 107520, M2_DTV = 108544, M2_END = 109568;
constexpr int LDP = 136, LDT = 72, LDG = 68;
__device__ __forceinline__ void m2_stage(Frame& F, int l, int b, int c, int gr) {
    LAS bf16* Cs = (LAS bf16*)(F.lds + M2_CS); LAS bf16* Bs = (LAS bf16*)(F.lds + M2_BS); LAS bf16* BsT = (LAS bf16*)(F.lds + M2_BST); LAS bf16* XT = (LAS bf16*)(F.lds + M2_XT);
    LAS float* cum = (LAS float*)(F.lds + M2_CUM); LAS float* dtv = (LAS float*)(F.lds + M2_DTV);
    const int tid = F.tid; const size_t row0 = (size_t)b * SEQ + (size_t)c * 64;
    {
        const int kind = tid < 256 ? 0 : (tid < 384 ? 1 : 2); const int idx = kind == 0 ? tid : (kind == 1 ? tid - 256 : tid - 384);
        const int col = kind == 0 ? 256 * gr + idx : (kind == 1 ? 512 + 128 * gr + idx : 768 + 128 * gr + idx);
        const float* cwp = INP(19) + (size_t)l * 4 * 1024 + col; const float cw0 = cwp[0], cw1 = cwp[1024], cw2 = cwp[2048], cw3 = cwp[3072]; const float cb = INP(20)[l * 1024 + col];
        const bf16* px = WSP(const bf16, WS_PROJ) + row0 * MIXP + PC_XBC + col;
        float xm3 = 0.f, xm2 = 0.f, xm1 = 0.f;
        if (c > 0) { xm3 = bf2f(*(px - 3 * (ptrdiff_t)MIXP)); xm2 = bf2f(*(px - 2 * (ptrdiff_t)MIXP)); xm1 = bf2f(*(px - (ptrdiff_t)MIXP)); }
        bf16 xall[64];
#pragma unroll
        for (int j = 0; j < 64; ++j) xall[j] = px[(size_t)j * MIXP];
#pragma unroll
        for (int tb = 0; tb < 8; ++tb) {
            float vv[8];
#pragma unroll
            for (int j = 0; j < 8; ++j) { const float xv = bf2f(xall[tb * 8 + j]);
                vv[j] = siluf_(cb + cw0 * xm3 + cw1 * xm2 + cw2 * xm1 + cw3 * xv); xm3 = xm2; xm2 = xm1; xm1 = xv; }
            u32x4 w; w.x = pk2(vv[0], vv[1]); w.y = pk2(vv[2], vv[3]); w.z = pk2(vv[4], vv[5]); w.w = pk2(vv[6], vv[7]);
            if (kind == 0) *(LAS u32x4*)(XT + idx * LDT + tb * 8) = w;
            else if (kind == 1) { *(LAS u32x4*)(BsT + idx * LDT + tb * 8) = w;
#pragma unroll
                for (int j = 0; j < 8; ++j) Bs[(tb * 8 + j) * LDP + idx] = (bf16)f2bf(vv[j]); }
            else {
#pragma unroll
                for (int j = 0; j < 8; ++j) Cs[(tb * 8 + j) * LDP + idx] = (bf16)f2bf(vv[j]); }
        }
    }
    if (tid < 256) { const int hh = tid >> 6, t = tid & 63, h = 4 * gr + hh;
        const float dtr = bf2f(WSP(const bf16, WS_PROJ)[(row0 + t) * MIXP + PC_DT + h]);
        const float dt = softplusf_(dtr + INP(21)[l * 8 + h]); const float a = -expf(INP(22)[l * 8 + h]);
        float s = dt * a;
#pragma unroll
        for (int o = 1; o < 64; o <<= 1) { const float n = __shfl_up(s, o); if (t >= o) s += n; }
        dtv[hh * 64 + t] = dt; cum[hh * 64 + t] = s; }
    __syncthreads();
}
__device__ __forceinline__ bf16x8 ldfrag(const LAS bf16* p) { return *(const LAS bf16x8*)p; }
__device__ __forceinline__ void m2_pass1(Frame& F, int l, int task) {
    const int b = task >> 8, c = (task >> 1) & 127, gr = task & 1;
    m2_stage(F, l, b, c, gr);
    LAS bf16* BsT = (LAS bf16*)(F.lds + M2_BST); LAS bf16* XT = (LAS bf16*)(F.lds + M2_XT); LAS float* cum = (LAS float*)(F.lds + M2_CUM); LAS float* dtv = (LAS float*)(F.lds + M2_DTV);
    const int lane = F.lane, hh = F.wave >> 1, half = F.wave & 1, h = 4 * gr + hh; const int fr = lane & 15, fq = lane >> 4;
    const float clast = cum[hh * 64 + 63];
    f32x4 acc[2][8];
#pragma unroll
    for (int i = 0; i < 2; ++i)
#pragma unroll
        for (int j = 0; j < 8; ++j) acc[i][j] = (f32x4){0.f, 0.f, 0.f, 0.f};
#pragma unroll
    for (int kk = 0; kk < 2; ++kk) {
        float fj[8];
#pragma unroll
        for (int e = 0; e < 8; ++e) { const int j = 32 * kk + 8 * fq + e; fj[e] = dtv[hh * 64 + j] * __expf(clast - cum[hh * 64 + j]); }
        bf16x8 af[2];
#pragma unroll
        for (int pi = 0; pi < 2; ++pi) { const int p = 16 * (2 * half + pi) + fr; const u32x4 raw = *(const LAS u32x4*)(XT + (64 * hh + p) * LDT + 32 * kk + 8 * fq);
            u32x4 w; w.x = pk2(lo16(raw.x) * fj[0], hi16(raw.x) * fj[1]); w.y = pk2(lo16(raw.y) * fj[2], hi16(raw.y) * fj[3]); w.z = pk2(lo16(raw.z) * fj[4], hi16(raw.z) * fj[5]); w.w = pk2(lo16(raw.w) * fj[6], hi16(raw.w) * fj[7]);
            af[pi] = __builtin_bit_cast(bf16x8, w); }
#pragma unroll
        for (int nt = 0; nt < 8; ++nt) { const bf16x8 bfr = ldfrag(BsT + (16 * nt + fr) * LDT + 32 * kk + 8 * fq);
#pragma unroll
            for (int pi = 0; pi < 2; ++pi) acc[pi][nt] = __builtin_amdgcn_mfma_f32_16x16x32_bf16(af[pi], bfr, acc[pi][nt], 0, 0, 0); }
    }
    bf16* S = WSP(bf16, WS_M2S) + ((((size_t)b * 128 + c) * 8 + h) * 64) * 128;
#pragma unroll
    for (int pi = 0; pi < 2; ++pi)
#pragma unroll
        for (int nt = 0; nt < 8; ++nt)
#pragma unroll
            for (int e = 0; e < 4; ++e) S[(size_t)(16 * (2 * half + pi) + 4 * fq + e) * 128 + 16 * nt + fr] = (bf16)f2bf(acc[pi][nt][e]);
    if (half == 0 && lane == 0) WSP(float, WS_M2D)[((size_t)b * 128 + c) * 8 + h] = __expf(clast);
    __syncthreads();
}
__device__ __forceinline__ void m2_carry(Frame& F) {
    const int gt = F.blk * NTHR + F.tid;
    for (int e = gt; e < NB * 8 * 8192; e += F.G * NTHR) {
        const int b = e >> 16, h = (e >> 13) & 7, pn = e & 8191; float run = 0.f;
        bf16* S = WSP(bf16, WS_M2S) + (((size_t)b * 128) * 8 + h) * 8192 + pn; const float* D = WSP(const float, WS_M2D) + (size_t)b * 128 * 8 + h;
#pragma unroll 1
        for (int c8 = 0; c8 < 16; ++c8) {
            float tv[8], dv[8];
#pragma unroll
            for (int j = 0; j < 8; ++j) { tv[j] = bf2f(S[(size_t)(c8 * 8 + j) * 8 * 8192]); dv[j] = D[(c8 * 8 + j) * 8]; }
#pragma unroll
            for (int j = 0; j < 8; ++j) { S[(size_t)(c8 * 8 + j) * 8 * 8192] = (bf16)f2bf(run); run = dv[j] * run + tv[j]; }
        }
    }
}
__device__ __forceinline__ void m2_pass2(Frame& F, int l, int task) {
    const int b = task >> 8, c = (task >> 1) & 127, gr = task & 1;
    m2_stage(F, l, b, c, gr);
    LAS bf16* Cs = (LAS bf16*)(F.lds + M2_CS); LAS bf16* Bs = (LAS bf16*)(F.lds + M2_BS); LAS bf16* XT = (LAS bf16*)(F.lds + M2_XT);
    LAS float* Gs = (LAS float*)(F.lds + M2_GS); LAS float* cum = (LAS float*)(F.lds + M2_CUM); LAS float* dtv = (LAS float*)(F.lds + M2_DTV);
    const int lane = F.lane, w = F.wave, fr = lane & 15, fq = lane >> 4;
#pragma unroll
    for (int q = 0; q < 2; ++q) { const int tile = 2 * w + q, it = tile >> 2, jt = tile & 3; f32x4 a = (f32x4){0.f, 0.f, 0.f, 0.f};
#pragma unroll
        for (int kk = 0; kk < 4; ++kk) a = __builtin_amdgcn_mfma_f32_16x16x32_bf16(ldfrag(Cs + (16 * it + fr) * LDP + 32 * kk + 8 * fq), ldfrag(Bs + (16 * jt + fr) * LDP + 32 * kk + 8 * fq), a, 0, 0, 0);
#pragma unroll
        for (int e = 0; e < 4; ++e) Gs[(16 * it + 4 * fq + e) * LDG + 16 * jt + fr] = a[e]; }
    __syncthreads();
    const int hh = w >> 1, half = w & 1, h = 4 * gr + hh;
    f32x4 accd[2][4], acco[2][4];
#pragma unroll
    for (int i = 0; i < 2; ++i)
#pragma unroll
        for (int j = 0; j < 4; ++j) { accd[i][j] = (f32x4){0.f, 0.f, 0.f, 0.f}; acco[i][j] = (f32x4){0.f, 0.f, 0.f, 0.f}; }
#pragma unroll
    for (int ii = 0; ii < 2; ++ii) { const int it = 2 * half + ii; const int i = 16 * it + fr; const float ci = cum[hh * 64 + i];
#pragma unroll
        for (int kk = 0; kk < 2; ++kk) { if (32 * kk > 16 * it + 15) continue;
            float wv[8];
#pragma unroll
            for (int e = 0; e < 8; ++e) { const int j = 32 * kk + 8 * fq + e; const float gv = Gs[i * LDG + j]; wv[e] = (j <= i) ? gv * __expf(ci - cum[hh * 64 + j]) * dtv[hh * 64 + j] : 0.f; }
            u32x4 ww; ww.x = pk2(wv[0], wv[1]); ww.y = pk2(wv[2], wv[3]); ww.z = pk2(wv[4], wv[5]); ww.w = pk2(wv[6], wv[7]);
            const bf16x8 af = __builtin_bit_cast(bf16x8, ww);
#pragma unroll
            for (int pt = 0; pt < 4; ++pt) accd[ii][pt] = __builtin_amdgcn_mfma_f32_16x16x32_bf16(af, ldfrag(XT + (64 * hh + 16 * pt + fr) * LDT + 32 * kk + 8 * fq), accd[ii][pt], 0, 0, 0); } }
    const bf16* S = WSP(const bf16, WS_M2S) + ((((size_t)b * 128 + c) * 8 + h) * 64) * 128;
#pragma unroll
    for (int kk = 0; kk < 4; ++kk) {
        bf16x8 bfr[4];
#pragma unroll
        for (int pt = 0; pt < 4; ++pt) bfr[pt] = *(const bf16x8*)(S + (size_t)(16 * pt + fr) * 128 + 32 * kk + 8 * fq);
#pragma unroll
        for (int ii = 0; ii < 2; ++ii) { const bf16x8 af = ldfrag(Cs + (16 * (2 * half + ii) + fr) * LDP + 32 * kk + 8 * fq);
#pragma unroll
            for (int pt = 0; pt < 4; ++pt) acco[ii][pt] = __builtin_amdgcn_mfma_f32_16x16x32_bf16(af, bfr[pt], acco[ii][pt], 0, 0, 0); }
    }
    const float dpar = INP(23)[l * 8 + h]; const size_t row0 = (size_t)b * SEQ + (size_t)c * 64;
#pragma unroll
    for (int ii = 0; ii < 2; ++ii)
#pragma unroll
        for (int e = 0; e < 4; ++e) { const int i = 16 * (2 * half + ii) + 4 * fq + e; const float ec = __expf(cum[hh * 64 + i]);
#pragma unroll
            for (int pt = 0; pt < 4; ++pt) { const int p = 16 * pt + fr;
                float y = accd[ii][pt][e] + ec * acco[ii][pt][e] + dpar * bf2f(XT[(64 * hh + p) * LDT + i]);
                const float z = bf2f(WSP(const bf16, WS_PROJ)[(row0 + i) * MIXP + PC_M2Z + 64 * h + p]);
                WSP(float, WS_M2Y)[(row0 + i) * 512 + 64 * h + p] = y * siluf_(z); } }
    __syncthreads();
}
__device__ __forceinline__ void m2_norm(Frame& F, int l, int gw, int ngw) {
    f32x4 g0 = *(const f32x4*)(INP(24) + l * 512 + 8 * F.lane), g1 = *(const f32x4*)(INP(24) + l * 512 + 8 * F.lane + 4);
    for (int m = gw; m < MTOK; m += ngw) { const f32x4* yp = (const f32x4*)(WSP(const float, WS_M2Y) + (size_t)m * 512 + 8 * F.lane); const f32x4 a = yp[0], b = yp[1];
        const float ss = wave_sum((a.x * a.x + a.y * a.y) + (a.z * a.z + a.w * a.w) + (b.x * b.x + b.y * b.y) + (b.z * b.z + b.w * b.w));
        const float rs = 1.0f / sqrtf(ss * (1.f / 512.f) + 1e-6f);
        u32x4 w; w.x = pk2(a.x * rs * g0.x, a.y * rs * g0.y); w.y = pk2(a.z * rs * g0.z, a.w * rs * g0.w); w.z = pk2(b.x * rs * g1.x, b.y * rs * g1.y); w.w = pk2(b.z * rs * g1.z, b.w * rs * g1.w);
        *(u32x4*)(WSP(bf16, WS_YK) + (size_t)2 * MTOK * 512 + (size_t)m * 512 + 8 * F.lane) = w; }
}

constexpr int RP_LDA = 72, RP_LDB = 104;
#define RWP_WFRAG(dst, base, ldrow) do { const float* p_ = (base); u32x4 w_; w_.x = pk2(p_[0], p_[512]); w_.y = pk2(p_[1024], p_[1536]); w_.z = pk2(p_[2048], p_[2560]); w_.w = pk2(p_[3072], p_[3584]); dst = __builtin_bit_cast(bf16x8, w_); } while (0)
__device__ __forceinline__ void rw_pre(Frame& F, int l, int task) {
    LAS bf16* SM0 = (LAS bf16*)F.lds;
    const int tid = F.tid, lane = F.lane, hh = F.wave, fr = lane & 15, fq = lane >> 4;
    const float* mu = INP(25) + (size_t)l * RWC;
    const size_t rowb = (size_t)task * 128;
    const bf16* P = WSP(const bf16, WS_PROJ);
    const bool nofirst = (rowb & (SEQ - 1)) != 0;
    const int c4 = 64 * hh + 4 * fr;
    {
        bf16x8 Bw[4], Ba[4];
#pragma unroll
        for (int ct = 0; ct < 4; ++ct) { RWP_WFRAG(Bw[ct], INP(27) + ((size_t)l * 32 + 8 * fq) * 512 + c4 + ct, 512); RWP_WFRAG(Ba[ct], INP(29) + ((size_t)l * 32 + 8 * fq) * 512 + c4 + ct, 512); }
        const float* pw0 = INP(26) + l * 512 + c4; const float* pa0 = INP(28) + l * 512 + c4; const float* pkk = INP(31) + l * 512 + c4; const float* pka = INP(32) + l * 512 + c4; const float* prk = INP(33) + l * 512 + c4;
        const int sj = tid & 63, st0 = tid >> 6, st1 = 8 + (tid >> 6); const float smu = mu[1536 + sj];
        const bf16* sq = P + rowb * MIXP + PC_RW + 1536 + sj;
        bf16 sc0, sp0, sc1, sp1;
        u32x2 rkv[4][3], rkvp[3];
        const bf16* rq = P + (rowb + 4 * fq) * MIXP + PC_RW + c4;
#define RWP_STAGE_LOAD(sb) do { const size_t o_ = (size_t)((sb) * 16) * MIXP; sc0 = sq[o_ + (size_t)st0 * MIXP]; sc1 = sq[o_ + (size_t)st1 * MIXP]; sp1 = sq[o_ + (size_t)(st1 - 1) * MIXP]; \
            sp0 = (nofirst || (sb) > 0 || st0 > 0) ? sq[o_ + (size_t)st0 * MIXP - MIXP] : (bf16)0; } while (0)
#define RWP_STAGE_WRITE(buf) do { { const float pt_ = bf2f(sc0), pp_ = bf2f(sp0); const float pm_ = pt_ + (pp_ - pt_) * smu; SM0[(buf) * 1664 + st0 * RP_LDA + sj] = (bf16)f2bf(sj < 32 ? (1.0f - 2.0f * rcpf_(__expf(2.0f * pm_) + 1.0f)) : pm_); } \
            { const float pt_ = bf2f(sc1), pp_ = bf2f(sp1); const float pm_ = pt_ + (pp_ - pt_) * smu; SM0[(buf) * 1664 + st1 * RP_LDA + sj] = (bf16)f2bf(sj < 32 ? (1.0f - 2.0f * rcpf_(__expf(2.0f * pm_) + 1.0f)) : pm_); } } while (0)
#define RWP_RKV_LOAD(sb, cur, prev) do { const bf16* q_ = rq + (size_t)((sb) * 16) * MIXP; \
            _Pragma("unroll") for (int e_ = 0; e_ < 4; ++e_) _Pragma("unroll") for (int a_ = 0; a_ < 3; ++a_) cur[e_][a_] = *(const u32x2*)(q_ + (size_t)e_ * MIXP + 512 * a_); \
            const bool hp_ = nofirst || (sb) > 0 || fq > 0; \
            _Pragma("unroll") for (int a_ = 0; a_ < 3; ++a_) prev[a_] = hp_ ? *(const u32x2*)(q_ - (ptrdiff_t)MIXP + 512 * a_) : (u32x2){0u, 0u}; } while (0)
        RWP_STAGE_LOAD(0); RWP_RKV_LOAD(0, rkv, rkvp); RWP_STAGE_WRITE(0);
        __syncthreads();
#pragma unroll 1
        for (int sb = 0; sb < 8; ++sb) {
            if (sb < 7) { RWP_STAGE_LOAD(sb + 1); }
            const LAS bf16* SM = SM0 + (sb & 1) * 1664;
            const bf16x8 Aw = ldfrag(SM + fr * RP_LDA + 8 * fq), Aa = ldfrag(SM + fr * RP_LDA + 32 + 8 * fq);
            f32x4 aw[4], aa[4];
#pragma unroll
            for (int ct = 0; ct < 4; ++ct) { const f32x4 z = (f32x4){0.f, 0.f, 0.f, 0.f};
                aw[ct] = __builtin_amdgcn_mfma_f32_16x16x32_bf16(Aw, Bw[ct], z, 0, 0, 0); aa[ct] = __builtin_amdgcn_mfma_f32_16x16x32_bf16(Aa, Ba[ct], z, 0, 0, 0); }
            const size_t r0 = rowb + sb * 16 + 4 * fq;
            asm volatile("" ::: "memory");
            const f32x4 mu_r = *(const f32x4*)(mu + c4), mu_k = *(const f32x4*)(mu + 512 + c4), mu_v = *(const f32x4*)(mu + 1024 + c4);
            const f32x4 w0c = *(const f32x4*)pw0, a0c = *(const f32x4*)pa0, kkc = *(const f32x4*)pkk, kac = *(const f32x4*)pka, rkc = *(const f32x4*)prk;
#pragma unroll
            for (int e = 0; e < 4; ++e) { const size_t row = r0 + e; const size_t o = row * 512 + c4;
                const u32x2 pr_ = e == 0 ? rkvp[0] : rkv[e > 0 ? e - 1 : 0][0], pk_ = e == 0 ? rkvp[1] : rkv[e > 0 ? e - 1 : 0][1], pv_ = e == 0 ? rkvp[2] : rkv[e > 0 ? e - 1 : 0][2];
                const float rc[4] = {lo16(rkv[e][0].x), hi16(rkv[e][0].x), lo16(rkv[e][0].y), hi16(rkv[e][0].y)}, rp[4] = {lo16(pr_.x), hi16(pr_.x), lo16(pr_.y), hi16(pr_.y)};
                const float kc[4] = {lo16(rkv[e][1].x), hi16(rkv[e][1].x), lo16(rkv[e][1].y), hi16(rkv[e][1].y)}, kp[4] = {lo16(pk_.x), hi16(pk_.x), lo16(pk_.y), hi16(pk_.y)};
                const float vc[4] = {lo16(rkv[e][2].x), hi16(rkv[e][2].x), lo16(rkv[e][2].y), hi16(rkv[e][2].y)}, vp[4] = {lo16(pv_.x), hi16(pv_.x), lo16(pv_.y), hi16(pv_.y)};
                float rr[4], kpr[4], vv[4], kk[4], av[4], dec[4]; float ssp = 0.f, bonp = 0.f;
#pragma unroll
                for (int ct = 0; ct < 4; ++ct) {
                    rr[ct] = rc[ct] + (rp[ct] - rc[ct]) * mu_r[ct]; const float k = kc[ct] + (kp[ct] - kc[ct]) * mu_k[ct]; vv[ct] = vc[ct] + (vp[ct] - vc[ct]) * mu_v[ct];
                    const float wlog = -softplusf_(-(aw[ct][e] + w0c[ct])) - 0.5f; dec[ct] = __expf(-__expf(wlog)); av[ct] = sigmoidf_(aa[ct][e] + a0c[ct]);
                    kk[ct] = k * kkc[ct]; ssp += kk[ct] * kk[ct]; kpr[ct] = k * (1.0f + (av[ct] - 1.0f) * kac[ct]); bonp += rr[ct] * kpr[ct] * rkc[ct]; }
                const float ss = row16_sum(ssp), bon = row16_sum(bonp); const float rn = __builtin_amdgcn_rsqf(fmaxf(ss, 1e-24f));
                u32x2 w;
                w.x = pk2(rr[0], rr[1]); w.y = pk2(rr[2], rr[3]); *(u32x2*)(WSP(bf16, WS_RW_R) + o) = w;
                w.x = pk2(kpr[0], kpr[1]); w.y = pk2(kpr[2], kpr[3]); *(u32x2*)(WSP(bf16, WS_RW_K) + o) = w;
                w.x = pk2(vv[0], vv[1]); w.y = pk2(vv[2], vv[3]); *(u32x2*)(WSP(bf16, WS_RW_V) + o) = w;
                w.x = pk2(-kk[0] * rn, -kk[1] * rn); w.y = pk2(-kk[2] * rn, -kk[3] * rn); *(u32x2*)(WSP(bf16, WS_RW_A) + o) = w;
                w.x = pk2(kk[0] * rn * av[0], kk[1] * rn * av[1]); w.y = pk2(kk[2] * rn * av[2], kk[3] * rn * av[3]); *(u32x2*)(WSP(bf16, WS_RW_B) + o) = w;
                *(f32x4*)(WSP(float, WS_RW_DEC) + o) = (f32x4){dec[0], dec[1], dec[2], dec[3]};
                if (fr == 0) WSP(float, WS_RW_BON)[row * 8 + hh] = bon; }
            if (sb < 7) { RWP_RKV_LOAD(sb + 1, rkv, rkvp); RWP_STAGE_WRITE((sb + 1) & 1); }
            __syncthreads();
        }
#undef RWP_STAGE_LOAD
#undef RWP_STAGE_WRITE
#undef RWP_RKV_LOAD
    }
    {
        int tidb = F.tid; asm volatile("" : "+v"(tidb));
        const int tid = tidb, lane = tid & 63, fr = lane & 15, fq = lane >> 4; const int c4 = 64 * hh + 4 * fr;
        bf16x8 Bg[4][3];
#pragma unroll
        for (int ct = 0; ct < 4; ++ct)
#pragma unroll
            for (int kk = 0; kk < 3; ++kk) RWP_WFRAG(Bg[ct][kk], INP(30) + ((size_t)l * 96 + 32 * kk + 8 * fq) * 512 + c4 + ct, 512);
        int stk[3], sjj[3]; float smv[3]; bf16 sc[3], sp[3];
#pragma unroll
        for (int i = 0; i < 3; ++i) { const int idx = tid + 512 * i; stk[i] = idx / 96; sjj[i] = idx % 96; smv[i] = mu[1600 + sjj[i]]; }
        const bf16* sq = P + rowb * MIXP + PC_RW + 1600;
#define RWP_STAGE_LOAD(sb) do { _Pragma("unroll") for (int i_ = 0; i_ < 3; ++i_) { const bf16* q_ = sq + (size_t)((sb) * 16 + stk[i_]) * MIXP + sjj[i_]; sc[i_] = q_[0]; \
            sp[i_] = (nofirst || (sb) > 0 || stk[i_] > 0) ? *(q_ - (ptrdiff_t)MIXP) : (bf16)0; } } while (0)
#define RWP_STAGE_WRITE(buf) do { _Pragma("unroll") for (int i_ = 0; i_ < 3; ++i_) { const float pt_ = bf2f(sc[i_]), pp_ = bf2f(sp[i_]); \
            SM0[(buf) * 1664 + stk[i_] * RP_LDB + sjj[i_]] = (bf16)f2bf(sigmoidf_(pt_ + (pp_ - pt_) * smv[i_])); } } while (0)
        RWP_STAGE_LOAD(0); RWP_STAGE_WRITE(0);
        __syncthreads();
#pragma unroll 1
        for (int sb = 0; sb < 8; ++sb) {
            if (sb < 7) RWP_STAGE_LOAD(sb + 1);
            const LAS bf16* SM = SM0 + (sb & 1) * 1664;
            const bf16x8 Ag0 = ldfrag(SM + fr * RP_LDB + 8 * fq), Ag1 = ldfrag(SM + fr * RP_LDB + 32 + 8 * fq), Ag2 = ldfrag(SM + fr * RP_LDB + 64 + 8 * fq);
            f32x4 ag[4];
#pragma unroll
            for (int ct = 0; ct < 4; ++ct) { f32x4 g = __builtin_amdgcn_mfma_f32_16x16x32_bf16(Ag0, Bg[ct][0], (f32x4){0.f, 0.f, 0.f, 0.f}, 0, 0, 0);
                g = __builtin_amdgcn_mfma_f32_16x16x32_bf16(Ag1, Bg[ct][1], g, 0, 0, 0); ag[ct] = __builtin_amdgcn_mfma_f32_16x16x32_bf16(Ag2, Bg[ct][2], g, 0, 0, 0); }
            const size_t r0 = rowb + sb * 16 + 4 * fq;
#pragma unroll
            for (int e = 0; e < 4; ++e) { u32x2 w; w.x = pk2(ag[0][e], ag[1][e]); w.y = pk2(ag[2][e], ag[3][e]); *(u32x2*)(WSP(bf16, WS_RW_G) + (r0 + e) * 512 + c4) = w; }
            if (sb < 7) RWP_STAGE_WRITE((sb + 1) & 1);
            __syncthreads();
        }
#undef RWP_STAGE_LOAD
#undef RWP_STAGE_WRITE
    }
}
constexpr int RC_G1 = 0, RC_G2 = 8192, RC_Q1 = 10240, RC_Q2 = 12288, RC_GAM = 13312, RC_VT = 13568, RC_BYTES = 16384;
constexpr size_t WS_RWC = WS_PROJ;
constexpr int CP_IMG = 0, CP_MAT = 9216, CP_P2 = 13568, CP_Q2 = 14656;
constexpr int CP_P1I = 0, CP_BGI = 3072, CP_Q1I = 6144;
__device__ __forceinline__ void rw_chunk_prep(Frame& F, int task) {
    int lane = F.lane; asm volatile("" : "+v"(lane)); const int fr = lane & 15, fq = lane >> 4; const int b = task >> 12, h = (task >> 9) & 7, c = task & 511;
    LAS unsigned char* wl = F.lds + F.wave * WAVE_LDS;
    LAS bf16* IMG = (LAS bf16*)(wl + CP_IMG); LAS float* MAT = (LAS float*)(wl + CP_MAT); LAS float* P2m = (LAS float*)(wl + CP_P2); LAS float* Q2m = (LAS float*)(wl + CP_Q2);
    unsigned char* rec = F.ws + WS_RWC + (size_t)task * RC_BYTES;
    const size_t e0 = ((size_t)b * SEQ + (size_t)c * 16) * 512 + 64 * h + lane;
    float At[16], Bt[16], Kt[16], Rt[16]; float gT;
    { float wv[16]; bf16 av[16], bv[16], kv[16], rv[16];
#pragma unroll
      for (int t = 0; t < 16; ++t) { const size_t o = e0 + (size_t)t * 512; wv[t] = WSP(const float, WS_RW_DEC)[o]; av[t] = WSP(const bf16, WS_RW_A)[o]; bv[t] = WSP(const bf16, WS_RW_B)[o]; kv[t] = WSP(const bf16, WS_RW_K)[o]; rv[t] = WSP(const bf16, WS_RW_R)[o]; }
      float g = 1.0f;
#pragma unroll
      for (int t = 0; t < 16; ++t) { const float gp = g; g *= wv[t]; const float inv = rcpf_(g);
          At[t] = bf2f(av[t]) * gp; Bt[t] = bf2f(bv[t]) * inv; Kt[t] = bf2f(kv[t]) * inv; Rt[t] = bf2f(rv[t]) * g;
          IMG[0 * 1152 + t * 72 + lane] = (bf16)f2bf(At[t]); IMG[1 * 1152 + t * 72 + lane] = (bf16)f2bf(Bt[t]); IMG[2 * 1152 + t * 72 + lane] = (bf16)f2bf(Kt[t]); IMG[3 * 1152 + t * 72 + lane] = (bf16)f2bf(Rt[t]); }
      gT = g; }
    { unsigned vp[8];
#pragma unroll
      for (int t = 0; t < 16; t += 2) vp[t >> 1] = (unsigned)WSP(const bf16, WS_RW_V)[e0 + (size_t)t * 512] | ((unsigned)WSP(const bf16, WS_RW_V)[e0 + (size_t)(t + 1) * 512] << 16);
      u32x4* d = (u32x4*)(rec + RC_VT + lane * 32); d[0] = (u32x4){vp[0], vp[1], vp[2], vp[3]}; d[1] = (u32x4){vp[4], vp[5], vp[6], vp[7]};
      ((float*)(rec + RC_GAM))[lane] = gT; }
    { f32x4 nab = (f32x4){0.f, 0.f, 0.f, 0.f}, nak = nab, mbr = nab, mkr = nab;
#pragma unroll
      for (int kk = 0; kk < 2; ++kk) { const int o = fr * 72 + 32 * kk + 8 * fq;
          const bf16x8 fa = ldfrag(IMG + 0 * 1152 + o), fb = ldfrag(IMG + 1 * 1152 + o), fk = ldfrag(IMG + 2 * 1152 + o), frr = ldfrag(IMG + 3 * 1152 + o);
          nab = __builtin_amdgcn_mfma_f32_16x16x32_bf16(fb, fa, nab, 0, 0, 0); nak = __builtin_amdgcn_mfma_f32_16x16x32_bf16(fk, fa, nak, 0, 0, 0);
          mbr = __builtin_amdgcn_mfma_f32_16x16x32_bf16(fb, frr, mbr, 0, 0, 0); mkr = __builtin_amdgcn_mfma_f32_16x16x32_bf16(fk, frr, mkr, 0, 0, 0); }
#pragma unroll
      for (int e = 0; e < 4; ++e) { const int s_ = 4 * fq + e, t_ = fr; const int o = s_ * 17 + t_;
          MAT[0 * 272 + o] = s_ < t_ ? nab[e] : 0.f; MAT[1 * 272 + o] = s_ < t_ ? nak[e] : 0.f; MAT[2 * 272 + o] = s_ <= t_ ? mbr[e] : 0.f; MAT[3 * 272 + o] = s_ <= t_ ? mkr[e] : 0.f; } }
    float P1[16], P2[16];
#pragma unroll
    for (int t = 0; t < 16; ++t) { float p1 = At[t], p2 = MAT[1 * 272 + fr * 17 + t];
#pragma unroll
        for (int s_ = 0; s_ < t; ++s_) { const float n = MAT[0 * 272 + s_ * 17 + t]; p1 += P1[s_] * n; p2 += P2[s_] * n; }
        P1[t] = p1; P2[t] = p2; asm volatile("" ::: "memory"); }
    LAS bf16* Q1I = (LAS bf16*)(wl + CP_Q1I);
#pragma unroll
    for (int t = 0; t < 16; ++t) { float q1 = Rt[t], q2 = MAT[3 * 272 + fr * 17 + t];
#pragma unroll
        for (int s_ = 0; s_ <= t; ++s_) { const float m = MAT[2 * 272 + s_ * 17 + t]; q1 += P1[s_] * m; q2 += P2[s_] * m; }
        Q1I[t * 72 + lane] = (bf16)f2bf(q1); if (lane < 16) { Q2m[lane * 17 + t] = q2; P2m[lane * 17 + t] = P2[t]; }
        asm volatile("" ::: "memory"); }
    { LAS bf16* P1I = (LAS bf16*)(wl + CP_P1I); LAS bf16* BGI = (LAS bf16*)(wl + CP_BGI);
      u32x4 w0, w1;
      w0.x = pk2(P1[0], P1[1]); w0.y = pk2(P1[2], P1[3]); w0.z = pk2(P1[4], P1[5]); w0.w = pk2(P1[6], P1[7]); w1.x = pk2(P1[8], P1[9]); w1.y = pk2(P1[10], P1[11]); w1.z = pk2(P1[12], P1[13]); w1.w = pk2(P1[14], P1[15]);
      *(LAS u32x4*)(P1I + lane * 24) = w0; *(LAS u32x4*)(P1I + lane * 24 + 8) = w1;
      w0.x = pk2(Bt[0] * gT, Bt[1] * gT); w0.y = pk2(Bt[2] * gT, Bt[3] * gT); w0.z = pk2(Bt[4] * gT, Bt[5] * gT); w0.w = pk2(Bt[6] * gT, Bt[7] * gT);
      w1.x = pk2(Bt[8] * gT, Bt[9] * gT); w1.y = pk2(Bt[10] * gT, Bt[11] * gT); w1.z = pk2(Bt[12] * gT, Bt[13] * gT); w1.w = pk2(Bt[14] * gT, Bt[15] * gT);
      *(LAS u32x4*)(BGI + lane * 24) = w0; *(LAS u32x4*)(BGI + lane * 24 + 8) = w1;
      const u32x4 z4 = (u32x4){0u, 0u, 0u, 0u};
      bf16x8 Af[4], Bf[4];
#pragma unroll
      for (int i = 0; i < 4; ++i) { u32x4 ta = z4, tb = z4; if (fq < 2) { ta = *(const LAS u32x4*)(P1I + (16 * i + fr) * 24 + 8 * fq); tb = *(const LAS u32x4*)(BGI + (16 * i + fr) * 24 + 8 * fq); }
          Af[i] = __builtin_bit_cast(bf16x8, ta); Bf[i] = __builtin_bit_cast(bf16x8, tb); }
#pragma unroll
      for (int j = 0; j < 4; ++j)
#pragma unroll
          for (int s_ = 0; s_ < 2; ++s_) { const f32x4 lo = __builtin_amdgcn_mfma_f32_16x16x32_bf16(Af[2 * s_], Bf[j], (f32x4){0.f, 0.f, 0.f, 0.f}, 0, 0, 0);
              const f32x4 hi = __builtin_amdgcn_mfma_f32_16x16x32_bf16(Af[2 * s_ + 1], Bf[j], (f32x4){0.f, 0.f, 0.f, 0.f}, 0, 0, 0);
              u32x4 w; w.x = pk2(lo[0], lo[1]); w.y = pk2(lo[2], lo[3]); w.z = pk2(hi[0], hi[1]); w.w = pk2(hi[2], hi[3]);
              *(u32x4*)(rec + RC_G1 + ((j * 2 + s_) * 64 + lane) * 16) = w; } }
    { float g2v[16];
#pragma unroll
      for (int t = 0; t < 16; ++t) { float acc = Kt[t];
#pragma unroll
          for (int s_ = 0; s_ < 16; ++s_) acc += P2m[t * 17 + s_] * Bt[s_];
          g2v[t] = acc * gT; asm volatile("" ::: "memory"); }
      u32x4 w0, w1; w0.x = pk2(g2v[0], g2v[1]); w0.y = pk2(g2v[2], g2v[3]); w0.z = pk2(g2v[4], g2v[5]); w0.w = pk2(g2v[6], g2v[7]); w1.x = pk2(g2v[8], g2v[9]); w1.y = pk2(g2v[10], g2v[11]); w1.z = pk2(g2v[12], g2v[13]); w1.w = pk2(g2v[14], g2v[15]);
      u32x4* d = (u32x4*)(rec + RC_G2 + lane * 32); d[0] = w0; d[1] = w1; }
    {
#pragma unroll
      for (int s_ = 0; s_ < 2; ++s_) { const u32x2 lo = *(const LAS u32x2*)(Q1I + fr * 72 + 32 * s_ + 4 * fq), hi = *(const LAS u32x2*)(Q1I + fr * 72 + 32 * s_ + 16 + 4 * fq);
          *(u32x4*)(rec + RC_Q1 + (s_ * 64 + lane) * 16) = (u32x4){lo.x, lo.y, hi.x, hi.y}; } }
    { u32x4 w = (u32x4){0u, 0u, 0u, 0u};
      if (fq < 2) { float q[8];
#pragma unroll
          for (int j = 0; j < 8; ++j) q[j] = Q2m[(8 * fq + j) * 17 + fr];
          w.x = pk2(q[0], q[1]); w.y = pk2(q[2], q[3]); w.z = pk2(q[4], q[5]); w.w = pk2(q[6], q[7]); }
      *(u32x4*)(rec + RC_Q2 + lane * 16) = w; }
}
__device__ __forceinline__ void rw_chunk_step(const LAS unsigned char* rc, f32x4 (&X)[4], float* yo, int w, int lane, int fr, int fq) {
    const u32x4 z4 = (u32x4){0u, 0u, 0u, 0u};
    u32x4 b0, b1; b0.x = pk2(X[0][0], X[0][1]); b0.y = pk2(X[0][2], X[0][3]); b0.z = pk2(X[1][0], X[1][1]); b0.w = pk2(X[1][2], X[1][3]);
    b1.x = pk2(X[2][0], X[2][1]); b1.y = pk2(X[2][2], X[2][3]); b1.z = pk2(X[3][0], X[3][1]); b1.w = pk2(X[3][2], X[3][3]);
    const bf16x8 Bx0 = __builtin_bit_cast(bf16x8, b0), Bx1 = __builtin_bit_cast(bf16x8, b1);
    u32x4 vt = z4; if (fq < 2) vt = *(const LAS u32x4*)(rc + RC_VT + (16 * w + fr) * 32 + 16 * fq);
    const bf16x8 Vf = __builtin_bit_cast(bf16x8, vt);
    f32x4 Y = (f32x4){0.f, 0.f, 0.f, 0.f};
    Y = __builtin_amdgcn_mfma_f32_16x16x32_bf16(*(const LAS bf16x8*)(rc + RC_Q1 + (0 * 64 + lane) * 16), Bx0, Y, 0, 0, 0);
    Y = __builtin_amdgcn_mfma_f32_16x16x32_bf16(*(const LAS bf16x8*)(rc + RC_Q1 + (1 * 64 + lane) * 16), Bx1, Y, 0, 0, 0);
    Y = __builtin_amdgcn_mfma_f32_16x16x32_bf16(*(const LAS bf16x8*)(rc + RC_Q2 + lane * 16), Vf, Y, 0, 0, 0);
#pragma unroll
    for (int j = 0; j < 4; ++j) { const f32x4 gm = *(const LAS f32x4*)(rc + RC_GAM + (16 * j + 4 * fq) * 4);
        f32x4 C = X[j] * gm;
        C = __builtin_amdgcn_mfma_f32_16x16x32_bf16(*(const LAS bf16x8*)(rc + RC_G1 + ((j * 2 + 0) * 64 + lane) * 16), Bx0, C, 0, 0, 0);
        C = __builtin_amdgcn_mfma_f32_16x16x32_bf16(*(const LAS bf16x8*)(rc + RC_G1 + ((j * 2 + 1) * 64 + lane) * 16), Bx1, C, 0, 0, 0);
        u32x4 g2 = z4; if (fq < 2) g2 = *(const LAS u32x4*)(rc + RC_G2 + (16 * j + fr) * 32 + 16 * fq);
        C = __builtin_amdgcn_mfma_f32_16x16x32_bf16(__builtin_bit_cast(bf16x8, g2), Vf, C, 0, 0, 0);
        X[j] = C; }
#pragma unroll
    for (int e = 0; e < 4; ++e) yo[(size_t)(4 * fq + e) * 512] = Y[e];
}
__device__ __forceinline__ void rw_scan2(Frame& F, int task) {
    const int tid = F.tid, lane = F.lane, w = F.wave, fr = lane & 15, fq = lane >> 4;
    const unsigned char* recs = F.ws + WS_RWC + (size_t)task * 512 * RC_BYTES;
    constexpr int NP = SEQ / 32;
    if (w >= 4) {
        const int lt = tid - 256;
        const u32x4* src = (const u32x4*)recs + lt;
        u32x4 rg[4][8];
#pragma unroll
        for (int u = 0; u < 4; ++u)
#pragma unroll
            for (int i = 0; i < 8; ++i) rg[u][i] = src[(size_t)u * 2048 + i * 256];
#pragma unroll 1
        for (int g4 = 0; g4 < NP / 4; ++g4) {
#pragma unroll
            for (int u = 0; u < 4; ++u) { const int g = 4 * g4 + u;
                LAS u32x4* dst = (LAS u32x4*)(F.lds + ((2 * g) & 7) * RC_BYTES) + lt;
#pragma unroll
                for (int i = 0; i < 8; ++i) dst[i * 256] = rg[u][i];
                if (g + 4 < NP) {
#pragma unroll
                    for (int i = 0; i < 8; ++i) rg[u][i] = src[(size_t)(g + 4) * 2048 + i * 256]; }
                __syncthreads(); }
        }
        __syncthreads();
    } else {
        const int b = task >> 3, h = task & 7;
        f32x4 X[4];
#pragma unroll
        for (int j = 0; j < 4; ++j) X[j] = (f32x4){0.f, 0.f, 0.f, 0.f};
        float* yo = WSP(float, WS_RW_Y) + ((size_t)b * SEQ) * 512 + 64 * h + 16 * w + fr;
        __syncthreads();
#pragma unroll 1
        for (int g = 0; g < NP; ++g) {
            rw_chunk_step(F.lds + ((2 * g) & 7) * RC_BYTES, X, yo + (size_t)(2 * g) * 16 * 512, w, lane, fr, fq);
            rw_chunk_step(F.lds + ((2 * g + 1) & 7) * RC_BYTES, X, yo + (size_t)(2 * g + 1) * 16 * 512, w, lane, fr, fq);
            __syncthreads();
        }
    }
}
__device__ __forceinline__ void rw_post(Frame& F, int l, int gw, int ngw) {
    const int lane = F.lane;
    const f32x4 g0 = *(const f32x4*)(INP(34) + l * 512 + 8 * lane), g1 = *(const f32x4*)(INP(34) + l * 512 + 8 * lane + 4);
    const f32x4 b0 = *(const f32x4*)(INP(35) + l * 512 + 8 * lane), b1 = *(const f32x4*)(INP(35) + l * 512 + 8 * lane + 4);
    for (int m = gw; m < MTOK; m += ngw) { const size_t o = (size_t)m * 512 + 8 * lane;
        const f32x4 ya = *(const f32x4*)(WSP(const float, WS_RW_Y) + o), yb = *(const f32x4*)(WSP(const float, WS_RW_Y) + o + 4);
        float y[8] = {ya.x, ya.y, ya.z, ya.w, yb.x, yb.y, yb.z, yb.w};
        float s = 0.f;
#pragma unroll
        for (int j = 0; j < 8; ++j) s += y[j];
        s += __shfl_xor(s, 1); s += __shfl_xor(s, 2); s += __shfl_xor(s, 4); const float mean = s * (1.f / 64.f);
        float qv = 0.f;
#pragma unroll
        for (int j = 0; j < 8; ++j) { y[j] -= mean; qv += y[j] * y[j]; }
        qv += __shfl_xor(qv, 1); qv += __shfl_xor(qv, 2); qv += __shfl_xor(qv, 4); const float rs = 1.0f / sqrtf(qv * (1.f / 64.f) + 64e-5f);
        const u32x4 vr = *(const u32x4*)(WSP(const bf16, WS_RW_V) + o), gr_ = *(const u32x4*)(WSP(const bf16, WS_RW_G) + o);
        const float bon = WSP(const float, WS_RW_BON)[(size_t)m * 8 + (lane >> 3)];
        const float vv[8] = {lo16(vr.x), hi16(vr.x), lo16(vr.y), hi16(vr.y), lo16(vr.z), hi16(vr.z), lo16(vr.w), hi16(vr.w)};
        const float gg[8] = {lo16(gr_.x), hi16(gr_.x), lo16(gr_.y), hi16(gr_.y), lo16(gr_.z), hi16(gr_.z), lo16(gr_.w), hi16(gr_.w)};
        const float lg[8] = {g0.x, g0.y, g0.z, g0.w, g1.x, g1.y, g1.z, g1.w}, lb[8] = {b0.x, b0.y, b0.z, b0.w, b1.x, b1.y, b1.z, b1.w};
        float ov[8];
#pragma unroll
        for (int j = 0; j < 8; ++j) ov[j] = (y[j] * rs * lg[j] + lb[j] + bon * vv[j]) * gg[j];
        u32x4 w; w.x = pk2(ov[0], ov[1]); w.y = pk2(ov[2], ov[3]); w.z = pk2(ov[4], ov[5]); w.w = pk2(ov[6], ov[7]);
        *(u32x4*)(WSP(bf16, WS_YK) + (size_t)3 * MTOK * 512 + o) = w; }
}

#ifndef GATE_NA
#define GATE_NA 18
#endif
#ifndef PHMASK
#define PHMASK 0xFFFFFFFFu
#endif
#define PH(n) (((PHMASK) >> (n)) & 1u)
#ifndef REPMASK
#define REPMASK 0u
#endif
#define NREP(n) ((((REPMASK) >> (n)) & 1u) ? 2 : 1)
template <class T> __device__ __forceinline__ T* launder_ptr(T* p) { const unsigned long long w = (unsigned long long)p; unsigned lo = __builtin_amdgcn_readfirstlane((unsigned)w), hi = __builtin_amdgcn_readfirstlane((unsigned)(w >> 32));
    asm volatile("" : "+s"(lo), "+s"(hi)); return (T*)(GAS T*)(((unsigned long long)hi << 32) | lo); }
#define PHASE_BEGIN() do { F.ws = launder_ptr(F.ws); F.out = launder_ptr(F.out); { unsigned la_ = __builtin_amdgcn_readfirstlane((unsigned)(size_t)F.lds); int bk_ = __builtin_amdgcn_readfirstlane(F.blk); asm volatile("" : "+s"(la_), "+s"(bk_)); F.lds = (LAS unsigned char*)(size_t)la_; F.blk = bk_; } asm volatile("" : "+v"(F.tid)); F.lane = F.tid & 63; F.wave = __builtin_amdgcn_readfirstlane(F.tid >> 6); } while (0)
__global__ void __launch_bounds__(NTHR, 2) hybrid_fwd(Args args) {
    extern __shared__ __attribute__((aligned(16))) unsigned char lds_raw[];
    Frame F;
    F.lds = (LAS unsigned char*)lds_raw; F.out = args.out; F.ws = args.ws;
    F.tid = threadIdx.x; F.lane = F.tid & 63; F.wave = __builtin_amdgcn_readfirstlane(F.tid >> 6); F.blk = blockIdx.x; F.G = gridDim.x;
    volatile LAS unsigned* MISC = (volatile LAS unsigned*)(F.lds + LDS_MISC);
    if (F.tid < 64) MISC[F.tid] = 0u;
    if (F.tid < 45) { const unsigned long long p = ((const __attribute__((address_space(4))) unsigned long long*)__builtin_amdgcn_kernarg_segment_ptr())[F.tid]; MISC[64 + 2 * F.tid] = (unsigned)p; MISC[64 + 2 * F.tid + 1] = (unsigned)(p >> 32); }
    __syncthreads();
    XcdBarrier bar = xcd_barrier_post((unsigned*)(F.ws + WS_CTL) + CW_BAR, MISC + 8);
#define gw (F.blk * NWAVES + F.wave)
#define NGW (F.G * NWAVES)
#define glds (F.lds)

#pragma unroll 1
    for (int l = 0; l < DEPTH; ++l) {
        const float* xin = (l == 0) ? INP(0) : F.out;
        PHASE_BEGIN();
        for (int rep_ = 0; rep_ < NREP(0); ++rep_) if (PH(0)) { convert_weights(F, l);
            for (int nb = F.blk; nb < NGATE / 32 + 2 * (FF / 32); nb += F.G) {
                const int seg = nb < NGATE / 32 ? 0 : (nb < NGATE / 32 + FF / 32 ? 1 : 2);
                const float* Wp = seg == 0 ? INP(2) + (size_t)l * DM * INC : (seg == 1 ? INP(39) : INP(40)) + (size_t)l * DM * FF;
                signed char* W8p = seg == 0 ? WSP(signed char, WS_WIN) + (size_t)MIXP * DM * 2 : (seg == 1 ? WSP(signed char, WS_WFG) : WSP(signed char, WS_WFU));
                convert_cols_i8(F, Wp, seg == 0 ? INC : FF, seg == 0 ? MIXC : 0, nb - (seg == 0 ? 0 : (seg == 1 ? NGATE / 32 : NGATE / 32 + FF / 32)), W8p, WSP(float, WS_SB) + 16384 * seg, 0); } }
        PHASE_BEGIN();
        for (int rep_ = 0; rep_ < NREP(1); ++rep_) if (PH(1)) rmsnorm_rows(F, xin, INP(1) + (size_t)l * DM, WSP(bf16, WS_H), nullptr, WSP(unsigned, WS_A8), WSP(float, WS_SA));
        xcd_barrier(bar);
        PHASE_BEGIN();
        for (int rep_ = 0; rep_ < NREP(2); ++rep_) if (PH(2)) { pg8::Gemm g{WSP(const bf16, WS_H), WSP(const bf16, WS_WIN), MTOK, MIXP, DM}; pg8::StaticOrder S; S.init(MTOK, MIXP, F.G, F.blk);
          pg8::EpiStore<0> E{WSP(bf16, WS_PROJ), MIXP}; pg8::gemm_phase(glds, g, S, E, F.tid); }
        xcd_barrier(bar);
        PHASE_BEGIN();
        for (int rep_ = 0; rep_ < NREP(3); ++rep_) if (PH(3)) for (int t = F.blk; t < MTOK / 128; t += F.G) rw_pre(F, l, t);
        PHASE_BEGIN();
        for (int rep_ = 0; rep_ < NREP(4); ++rep_) if (PH(4)) for (int t = F.blk; t < 1024; t += F.G) m2_pass1(F, l, t);
        PHASE_BEGIN();
        for (int rep_ = 0; rep_ < NREP(5); ++rep_) if (PH(5)) for (int t = gw; t < 8192; t += NGW) s5_task<false>(F, l, t);
        PHASE_BEGIN();
        for (int rep_ = 0; rep_ < NREP(6); ++rep_) if (PH(6)) for (int t = gw; t < 2048; t += NGW) lru_task<false>(F, l, t);
        xcd_barrier(bar);
        PHASE_BEGIN();
        for (int rep_ = 0; rep_ < NREP(7); ++rep_) if (PH(7)) m2_carry(F);
        PHASE_BEGIN();
        for (int rep_ = 0; rep_ < NREP(8); ++rep_) if (PH(8)) for (int t = gw; t < 128; t += NGW) s5_carry(F, l, t);
        PHASE_BEGIN();
        for (int rep_ = 0; rep_ < NREP(9); ++rep_) if (PH(9)) for (int t = NGW - 1 - gw; t < 32; t += NGW) lru_carry(F, t);
        xcd_barrier(bar);
        PHASE_BEGIN();
        for (int rep_ = 0; rep_ < NREP(10); ++rep_) if (PH(10)) for (int t = F.blk; t < 1024; t += F.G) m2_pass2(F, l, t);
        PHASE_BEGIN();
        for (int rep_ = 0; rep_ < NREP(11); ++rep_) if (PH(11)) for (int t = gw; t < 8192; t += NGW) s5_task<true>(F, l, t);
        PHASE_BEGIN();
        for (int rep_ = 0; rep_ < NREP(12); ++rep_) if (PH(12)) for (int t = gw; t < 2048; t += NGW) lru_task<true>(F, l, t);
        xcd_barrier(bar);
        PHASE_BEGIN();
        for (int rep_ = 0; rep_ < NREP(14); ++rep_) if (PH(14)) {
            { pg8::Gemm g{WSP(const bf16, WS_S5Z), WSP(const bf16, WS_WGLU), MTOK, 512, 512}; pg8::StaticOrder S; S.init(MTOK, 512, F.G, F.blk);
              pg8::EpiGlu E{WSP(const bf16, WS_S5Z), WSP(bf16, WS_YK)}; pg8::gemm_phase(glds, g, S, E, F.tid); }
            m2_norm(F, l, gw, NGW);
        }
        PHASE_BEGIN();
        for (int rep_ = 0; rep_ < NREP(24); ++rep_) if (PH(24)) for (int t = gw; t < NB * 8 * 512; t += NGW) rw_chunk_prep(F, t);
        xcd_barrier(bar);
        PHASE_BEGIN();
        if (F.blk < 32) { if (PH(13)) rw_scan2(F, F.blk); }
        PHASE_BEGIN();
        if (PH(16)) { pg8::Gemm g{WSP(const bf16, WS_A8), (const bf16*)(WSP(const signed char, WS_WIN) + (size_t)MIXP * DM * 2), MTOK, NGATE, DM / 2};
          pg8::SplitOrder S; if (F.blk >= 32) S.init(MTOK, NGATE, 224, F.blk - 32, 0, GATE_NA); else S.init(MTOK, NGATE, 32, F.blk, 224 * GATE_NA, (4096 - 224 * GATE_NA) / 32);
          pg8::EpiStoreI8<1> E{WSP(bf16, WS_GATES), NGATE, WSP(const float, WS_SA), WSP(const float, WS_SB)}; pg8::gemm_phase(glds, g, S, E, F.tid); }
        xcd_barrier(bar);
        PHASE_BEGIN();
        for (int rep_ = 0; rep_ < NREP(15); ++rep_) if (PH(15)) rw_post(F, l, gw, NGW);
        xcd_barrier(bar);
        PHASE_BEGIN();
        for (int rep_ = 0; rep_ < NREP(17); ++rep_) if (PH(17)) { pg8::Gemm g{WSP(const bf16, WS_YK), WSP(const bf16, WS_WPK), 4 * MTOK, 4 * DM, 512}; pg8::OrderYK S{F.G, F.blk};
          pg8::EpiGateAcc E{WSP(const bf16, WS_GATES), WSP(bf16, WS_MERGED)}; pg8::gemm_phase(glds, g, S, E, F.tid); }
        xcd_barrier(bar);
        PHASE_BEGIN();
        for (int rep_ = 0; rep_ < NREP(18); ++rep_) if (PH(18)) { pg8::Gemm g{WSP(const bf16, WS_MERGED), WSP(const bf16, WS_WOUT), MTOK, DM, DM}; pg8::StaticOrder S; S.init(MTOK, DM, F.G, F.blk);
          pg8::EpiAddF32 E{xin, F.out, DM}; pg8::gemm_phase(glds, g, S, E, F.tid); }
        xcd_barrier(bar);
        PHASE_BEGIN();
        for (int rep_ = 0; rep_ < NREP(19); ++rep_) if (PH(19)) rmsnorm_rows(F, F.out, INP(38) + (size_t)l * DM, nullptr, nullptr, WSP(unsigned, WS_A8), WSP(float, WS_SA));
        xcd_barrier(bar);
        PHASE_BEGIN();
        for (int rep_ = 0; rep_ < NREP(20); ++rep_) if (PH(20)) { pg8::Gemm g{WSP(const bf16, WS_A8), WSP(const bf16, WS_WFG), MTOK, FF, DM / 2}; pg8::StaticOrder S; S.init(MTOK, FF, F.G, F.blk);
          pg8::EpiStoreI8<0> E{WSP(bf16, WS_FG), FF, WSP(const float, WS_SA), WSP(const float, WS_SB) + 16384}; pg8::gemm_phase(glds, g, S, E, F.tid); }
        xcd_barrier(bar);
        PHASE_BEGIN();
        for (int rep_ = 0; rep_ < NREP(21); ++rep_) if (PH(21)) { pg8::Gemm g{WSP(const bf16, WS_A8), WSP(const bf16, WS_WFU), MTOK, FF, DM / 2}; pg8::StaticOrder S; S.init(MTOK, FF, F.G, F.blk);
          pg8::EpiFfnUp<true> E{WSP(const bf16, WS_FG), WSP(bf16, WS_HID), INP(41) + (size_t)l * 3 * FF, INP(42) + (size_t)l * FF, WSP(const float, WS_SA), WSP(const float, WS_SB) + 32768}; pg8::gemm_phase(glds, g, S, E, F.tid); }
        xcd_barrier(bar);
        PHASE_BEGIN();
        for (int rep_ = 0; rep_ < NREP(22); ++rep_) if (PH(22)) { pg8::Gemm g{WSP(const bf16, WS_HID), WSP(const bf16, WS_WFD), MTOK, DM, FF}; pg8::StaticOrder S; S.init(MTOK, DM, F.G, F.blk);
          pg8::EpiAddF32 E{F.out, F.out, DM}; pg8::gemm_phase(glds, g, S, E, F.tid); }
        xcd_barrier(bar);
    }
    PHASE_BEGIN();
    for (int rep_ = 0; rep_ < NREP(23); ++rep_) if (PH(23)) rmsnorm_rows(F, F.out, INP(44), nullptr, F.out);
}

extern "C" void kernel_launch(void* const* d_in, const int* in_sizes, int n_in, void* d_out, int out_size, void* d_ws, size_t ws_size, hipStream_t stream) {
    static int grid = 0;
    if (grid == 0) {
        if (n_in != 45 || in_sizes[0] != MTOK * DM || out_size != MTOK * DM || ws_size < WS_END) {
            fprintf(stderr, "kernel_launch: unexpected shapes/workspace (n_in %d, in0 %d, out %d, ws %zu, need %zu); nothing launched\n", n_in, n_in > 0 ? in_sizes[0] : -1, out_size, ws_size, (size_t)WS_END); grid = -1; return; }
        int dev = 0, cus = 0, per_cu = 0;
        if (hipGetDevice(&dev) != hipSuccess || hipDeviceGetAttribute(&cus, hipDeviceAttributeMultiprocessorCount, dev) != hipSuccess) { grid = -1; return; }
        if (hipFuncSetAttribute((const void*)hybrid_fwd, hipFuncAttributeMaxDynamicSharedMemorySize, LDS_BYTES) != hipSuccess) { fprintf(stderr, "kernel_launch: hipFuncSetAttribute failed\n"); grid = -1; return; }
        if (hipOccupancyMaxActiveBlocksPerMultiprocessor(&per_cu, (const void*)hybrid_fwd, NTHR, LDS_BYTES) != hipSuccess || per_cu < 1) { fprintf(stderr, "kernel_launch: occupancy query says %d\n", per_cu); }
        (void)hipGetLastError();
        grid = cus;
        if (grid != 256) fprintf(stderr, "kernel_launch: note: %d CUs\n", grid);
    }
    if (grid < 0) return;
    if (hipMemsetAsync((char*)d_ws + WS_CTL, 0, CTL_BYTES, stream) != hipSuccess) return;
    Args a{};
    for (int i = 0; i < 45; ++i) a.in[i] = (const float*)d_in[i];
    a.out = (float*)d_out; a.ws = (unsigned char*)d_ws;
    hipLaunchKernelGGL(hybrid_fwd, dim3(grid), dim3(NTHR), LDS_BYTES, stream, a);
}
```

```cpp
#include <hip/hip_runtime.h>
#include <cstdio>
#include <cstdint>

#define LAS __attribute__((address_space(3)))
typedef unsigned short bf16;
typedef short bf16x8 __attribute__((ext_vector_type(8)));
typedef float f32x4 __attribute__((ext_vector_type(4)));
typedef float f32x2 __attribute__((ext_vector_type(2)));
typedef unsigned u32x4 __attribute__((ext_vector_type(4)));
typedef unsigned u32x2 __attribute__((ext_vector_type(2)));
typedef __bf16 bf16v2 __attribute__((ext_vector_type(2)));
typedef int i32x4 __attribute__((ext_vector_type(4)));

constexpr int NB = 4, SEQ = 8192, DM = 2048, MTOK = NB * SEQ, DEPTH = 4;
constexpr int MIXC = 4776, MIXP = 4864, INC = 12968, FF = 6144, NGATE = 8192;
constexpr int RWC = 1696;
constexpr int PC_S5U = 0, PC_LRX = 512, PC_LRG = 1024, PC_M2Z = 1536, PC_XBC = 2048, PC_DT = 3072, PC_RW = 3080;

constexpr size_t MiB = 1u << 20;
constexpr size_t WS_CTL = 0, CTL_BYTES = 1 * MiB;
constexpr size_t WS_WIN = 1 * MiB, WS_WPK = 52 * MiB, WS_WOUT = 60 * MiB, WS_WFG = 68 * MiB, WS_WFU = 92 * MiB, WS_WFD = 116 * MiB, WS_WGLU = 140 * MiB;
constexpr size_t WS_SA = 141 * MiB, WS_SB = 142 * MiB;
constexpr size_t WS_A8 = 1538 * MiB;
constexpr size_t WS_H = 144 * MiB, WS_YK = 272 * MiB, WS_PROJ = 400 * MiB, WS_MERGED = 400 * MiB, WS_GATES = 900 * MiB;
constexpr size_t WS_RW_R = 1216 * MiB, WS_RW_K = 1248 * MiB, WS_RW_V = 1280 * MiB, WS_RW_A = 1312 * MiB, WS_RW_B = 1344 * MiB, WS_RW_G = 1376 * MiB,
                 WS_RW_DEC = 1408 * MiB, WS_RW_Y = 1472 * MiB, WS_RW_BON = 1536 * MiB, WS_END = 1602 * MiB;
constexpr size_t WS_S5Z = 704 * MiB, WS_S5E = 736 * MiB, WS_S5I = 740 * MiB, WS_LRE = 744 * MiB, WS_LRA = 745 * MiB, WS_LRI = 746 * MiB;
constexpr size_t WS_M2S = 752 * MiB, WS_M2D = 816 * MiB, WS_M2Y = 820 * MiB;
constexpr size_t WS_FG = 400 * MiB, WS_HID = 784 * MiB;
constexpr int CW_BAR = 4096;

__device__ __forceinline__ float bf2f(bf16 b) { return __uint_as_float(((unsigned)b) << 16); }
__device__ __forceinline__ unsigned f2bf(float f) { const __bf16 b = (__bf16)f; return (unsigned)__builtin_bit_cast(unsigned short, b); }
__device__ __forceinline__ unsigned pk2(float lo, float hi) { const f32x2 v = {lo, hi}; const bf16v2 b = __builtin_convertvector(v, bf16v2); return __builtin_bit_cast(unsigned, b); }
__device__ __forceinline__ float lo16(unsigned w) { return __uint_as_float(w << 16); }
__device__ __forceinline__ float hi16(unsigned w) { return __uint_as_float(w & 0xffff0000u); }
__device__ __forceinline__ float rcpf_(float x) { return __builtin_amdgcn_rcpf(x); }
__device__ __forceinline__ float sigmoidf_(float x) { return rcpf_(1.0f + __expf(-x)); }
__device__ __forceinline__ float siluf_(float x) { return x * rcpf_(1.0f + __expf(-x)); }
__device__ __forceinline__ float geluf_(float x) { const float u = 0.7978845608028654f * (x + 0.044715f * x * x * x); return x * rcpf_(1.0f + __expf(-2.0f * u)); }
__device__ __forceinline__ float softplusf_(float x) { return fmaxf(x, 0.f) + __logf(1.0f + __expf(-fabsf(x))); }
__device__ __forceinline__ float row16_sum(float v) {
    v += __int_as_float(__builtin_amdgcn_update_dpp(0, __float_as_int(v), 0x128, 0xf, 0xf, true));
    v += __int_as_float(__builtin_amdgcn_update_dpp(0, __float_as_int(v), 0x124, 0xf, 0xf, true));
    v += __int_as_float(__builtin_amdgcn_update_dpp(0, __float_as_int(v), 0x122, 0xf, 0xf, true));
    v += __int_as_float(__builtin_amdgcn_update_dpp(0, __float_as_int(v), 0x121, 0xf, 0xf, true));
    return v;
}
__device__ __forceinline__ float wave_sum(float v) {
    v = row16_sum(v);
    const float a = __int_as_float(__builtin_amdgcn_readlane(__float_as_int(v), 0)), b = __int_as_float(__builtin_amdgcn_readlane(__float_as_int(v), 16));
    const float c = __int_as_float(__builtin_amdgcn_readlane(__float_as_int(v), 32)), d = __int_as_float(__builtin_amdgcn_readlane(__float_as_int(v), 48));
    return (a + b) + (c + d);
}
__device__ __forceinline__ float wave_max(float v) {
    v = fmaxf(v, __int_as_float(__builtin_amdgcn_update_dpp(0, __float_as_int(v), 0x128, 0xf, 0xf, true)));
    v = fmaxf(v, __int_as_float(__builtin_amdgcn_update_dpp(0, __float_as_int(v), 0x124, 0xf, 0xf, true)));
    v = fmaxf(v, __int_as_float(__builtin_amdgcn_update_dpp(0, __float_as_int(v), 0x122, 0xf, 0xf, true)));
    v = fmaxf(v, __int_as_float(__builtin_amdgcn_update_dpp(0, __float_as_int(v), 0x121, 0xf, 0xf, true)));
    const float a = __int_as_float(__builtin_amdgcn_readlane(__float_as_int(v), 0)), b = __int_as_float(__builtin_amdgcn_readlane(__float_as_int(v), 16));
    const float c = __int_as_float(__builtin_amdgcn_readlane(__float_as_int(v), 32)), d = __int_as_float(__builtin_amdgcn_readlane(__float_as_int(v), 48));
    return fmaxf(fmaxf(a, b), fmaxf(c, d));
}
__device__ __forceinline__ unsigned q8x4(float a, float b, float c, float d, float inv) {
    const int q0 = (int)rintf(a * inv), q1 = (int)rintf(b * inv), q2 = (int)rintf(c * inv), q3 = (int)rintf(d * inv);
    return (unsigned)(q0 & 0xff) | ((unsigned)(q1 & 0xff) << 8) | ((unsigned)(q2 & 0xff) << 16) | ((unsigned)q3 << 24);
}
__device__ __forceinline__ float rdlane(float v, int l) { return __int_as_float(__builtin_amdgcn_readlane(__float_as_int(v), l)); }

namespace pg8 {
constexpr int BM = 256, BK = 64, HALF = 128, HTB = HALF * BK * 2, STAGE_BYTES = 8 * HTB, NXCD = 8, WGM = 4;
__host__ __device__ __forceinline__ int lds_byte(int r, int c) { const int st = (r >> 4) * 2 + (c >> 5), rr = r & 15, cc = c & 31, ob = rr * 64 + cc * 2; return st * 1024 + (ob ^ (((ob >> 9) & 1) << 5)); }
__host__ __device__ __forceinline__ void stage_rc(int b, int& R, int& C) { const int st = b / 1024, sb = b % 1024, swz = sb ^ (((sb >> 9) & 1) << 5); R = (st >> 1) * 16 + swz / 64; C = (st & 1) * 32 + (swz % 64) / 2; }
__host__ __device__ __forceinline__ int perm32(int rho) { const int n = rho >> 4, i = rho & 15; return 8 * (i >> 2) + 4 * n + (i & 3); }
struct Unit { int pm, pn; };
struct Gemm { const bf16* A; const bf16* Bt; int M, N, K; };
struct StaticOrder {
    int nM, nN, nwg, G, c;
    __device__ void init(int M, int N, int G_, int c_) { nM = M / BM; nN = N / BM; nwg = nM * nN; G = G_; c = c_; }
    __device__ bool next(int i, Unit& u) const {
        const long L = (long)i * G + c; if (L >= nwg || c < 0) return false;
        int wgid = (int)L; { const int q = nwg / NXCD, r = nwg % NXCD, xcd = wgid % NXCD, off = wgid / NXCD; wgid = (xcd < r ? xcd * (q + 1) : r * (q + 1) + (xcd - r) * q) + off; }
        const int nig = WGM * nN, gid = wgid / nig, fm = gid * WGM, gsz = (nM - fm) < WGM ? (nM - fm) : WGM;
        u.pm = fm + ((wgid % nig) % gsz); u.pn = (wgid % nig) / gsz; return true;
    }
    __device__ __forceinline__ void a_ready(const Unit&) const {}
    __device__ __forceinline__ void done(const Unit&) const {}
};
struct SplitOrder {
    int nM, nN, nwg, G, c, base, n;
    __device__ void init(int M, int N, int G_, int c_, int base_, int n_) { nM = M / BM; nN = N / BM; nwg = nM * nN; G = G_; c = c_; base = base_; n = n_; }
    __device__ bool next(int i, Unit& u) const {
        if (i >= n) return false; const long L = (long)base + (long)i * G + c; if (L >= nwg) return false;
        int wgid = (int)L; { const int q = nwg / NXCD, r = nwg % NXCD, xcd = wgid % NXCD, off = wgid / NXCD; wgid = (xcd < r ? xcd * (q + 1) : r * (q + 1) + (xcd - r) * q) + off; }
        const int nig = WGM * nN, gid = wgid / nig, fm = gid * WGM, gsz = (nM - fm) < WGM ? (nM - fm) : WGM;
        u.pm = fm + ((wgid % nig) % gsz); u.pn = (wgid % nig) / gsz; return true;
    }
    __device__ __forceinline__ void a_ready(const Unit&) const {}
    __device__ __forceinline__ void done(const Unit&) const {}
};
struct OrderYK {
    int G, c;
    __device__ bool next(int i, Unit& u) const {
        const int k = i & 3; const long T = (long)(i >> 2) * G + c; if (T >= 1024) return false;
        int wgid = (int)T; { const int xcd = wgid % 8, off = wgid / 8; wgid = xcd * 128 + off; }
        const int gid = wgid / 32, fm = gid * 4; const int pm = fm + ((wgid % 32) % 4), pn = (wgid % 32) / 4;
        u.pm = k * 128 + pm; u.pn = k * 8 + pn; return true;
    }
    __device__ __forceinline__ void a_ready(const Unit&) const {}
    __device__ __forceinline__ void done(const Unit&) const {}
};
__device__ __forceinline__ unsigned cvt_pk_bf16(float lo, float hi) { return pk2(lo, hi); }

template <bool I8> struct AccOf { typedef f32x4 T; }; template <> struct AccOf<true> { typedef i32x4 T; };
template <int ACT> struct EpiStore {
    static constexpr bool I8 = false; static constexpr bool PERM = true;
    struct Pre {}; __device__ __forceinline__ void prefetch(Pre&, const Unit&, int, int, int, int) const {}
    bf16* O; int ldc;
    __device__ __forceinline__ void operator()(const f32x4 (&acc)[2][2][4][2], const Unit& u, int wr, int wc, int fr, int fq, const Pre&) const {
        const int row0 = u.pm * BM + wr * 64 + fr, col0 = u.pn * BM + wc * 32 + 8 * fq;
#pragma unroll
        for (int ai = 0; ai < 2; ++ai)
#pragma unroll
            for (int m = 0; m < 4; ++m) { bf16* rowp = O + (size_t)(row0 + ai * HALF + m * 16) * ldc + col0;
#pragma unroll
                for (int bj = 0; bj < 2; ++bj) { f32x4 v0 = acc[ai][bj][m][0], v1 = acc[ai][bj][m][1];
                    if (ACT == 1) {
#pragma unroll
                        for (int j = 0; j < 4; ++j) { v0[j] = sigmoidf_(v0[j]); v1[j] = sigmoidf_(v1[j]); } }
                    u32x4 w; w.x = cvt_pk_bf16(v0[0], v0[1]); w.y = cvt_pk_bf16(v0[2], v0[3]); w.z = cvt_pk_bf16(v1[0], v1[1]); w.w = cvt_pk_bf16(v1[2], v1[3]);
                    *(u32x4*)(rowp + bj * HALF) = w; } }
    }
};
template <int ACT> struct EpiStoreI8 {
    static constexpr bool I8 = true; static constexpr bool PERM = true;
    bf16* O; int ldc; const float* sa; const float* sb;
    struct Pre { float sav[4]; f32x4 s[2]; };
    __device__ __forceinline__ void prefetch(Pre& P, const Unit& u, int wr, int wc, int fr, int fq) const {
        const int row0 = u.pm * BM + wr * 64 + fr, col0 = u.pn * BM + wc * 32 + 8 * fq;
#pragma unroll
        for (int i = 0; i < 4; ++i) P.sav[i] = sa[row0 + i * 16];
        P.s[0] = *(const f32x4*)(sb + col0); P.s[1] = *(const f32x4*)(sb + col0 + 4);
    }
    __device__ __forceinline__ void operator()(const i32x4 (&acc)[2][2][4][2], const Unit& u, int wr, int wc, int fr, int fq, const Pre& P) const {
        const int row0 = u.pm * BM + wr * 64 + fr, col0 = u.pn * BM + wc * 32 + 8 * fq;
        float sav[8];
#pragma unroll
        for (int i = 0; i < 8; ++i) { sav[i] = i < 4 ? P.sav[i] : sa[row0 + HALF + (i & 3) * 16]; if (ACT == 1) sav[i] *= -1.4426950408889634f; }
        const f32x4 t0 = *(const f32x4*)(sb + col0 + HALF), t1 = *(const f32x4*)(sb + col0 + HALF + 4);
#pragma unroll
        for (int bj = 0; bj < 2; ++bj) { f32x4 s0 = P.s[0], s1 = P.s[1]; if (bj) { s0 = t0; s1 = t1; }
            const f32x2 sp[4] = {{s0[0], s0[1]}, {s0[2], s0[3]}, {s1[0], s1[1]}, {s1[2], s1[3]}};
#pragma unroll
            for (int ai = 0; ai < 2; ++ai)
#pragma unroll
                for (int m = 0; m < 4; ++m) { const float ra = sav[ai * 4 + m]; const f32x2 rav = {ra, ra}; const i32x4 a0 = acc[ai][bj][m][0], a1 = acc[ai][bj][m][1];
                    f32x2 x[4] = {{(float)a0[0], (float)a0[1]}, {(float)a0[2], (float)a0[3]}, {(float)a1[0], (float)a1[1]}, {(float)a1[2], (float)a1[3]}};
#pragma unroll
                    for (int p = 0; p < 4; ++p) { x[p] = x[p] * (sp[p] * rav);
                        if (ACT == 1) { f32x2 e = {__builtin_amdgcn_exp2f(x[p][0]), __builtin_amdgcn_exp2f(x[p][1])}; e = e + (f32x2){1.0f, 1.0f}; x[p][0] = rcpf_(e[0]); x[p][1] = rcpf_(e[1]); } }
                    u32x4 w; w.x = cvt_pk_bf16(x[0][0], x[0][1]); w.y = cvt_pk_bf16(x[1][0], x[1][1]); w.z = cvt_pk_bf16(x[2][0], x[2][1]); w.w = cvt_pk_bf16(x[3][0], x[3][1]);
                    *(u32x4*)(O + (size_t)(row0 + ai * HALF + m * 16) * ldc + col0 + bj * HALF) = w; } }
    }
};
struct EpiGateU8 {
    static constexpr bool I8 = true; static constexpr bool PERM = true;
    unsigned char* O; const float* sa; const float* sb;
    struct Pre { float sav[2]; f32x4 s[2]; };
    __device__ __forceinline__ void prefetch(Pre& P, const Unit& u, int wr, int wc, int fr, int fq) const {
        const int row0 = u.pm * BM + wr * 64 + fr, col0 = u.pn * BM + wc * 64 + 16 * fq;
#pragma unroll
        for (int i = 0; i < 2; ++i) P.sav[i] = sa[row0 + i * 16];
        P.s[0] = *(const f32x4*)(sb + col0); P.s[1] = *(const f32x4*)(sb + col0 + 4);
    }
    __device__ __forceinline__ void operator()(const i32x4 (&acc)[2][2][4][2], const Unit& u, int wr, int wc, int fr, int fq, const Pre& P) const {
        const int row0 = u.pm * BM + wr * 64 + fr, col0 = u.pn * BM + wc * 64 + 16 * fq;
        float sav[8];
#pragma unroll
        for (int i = 0; i < 8; ++i) sav[i] = (i < 2 ? P.sav[i] : sa[row0 + (i >> 2) * HALF + (i & 3) * 16]) * -1.4426950408889634f;
        const f32x4 t0 = *(const f32x4*)(sb + col0 + 8), t1 = *(const f32x4*)(sb + col0 + 12);
#pragma unroll
        for (int ai = 0; ai < 2; ++ai) { unsigned d[4][4];
#pragma unroll
            for (int bj = 0; bj < 2; ++bj) { f32x4 s0 = P.s[0], s1 = P.s[1]; if (bj) { s0 = t0; s1 = t1; }
                const f32x2 sp[4] = {{s0[0], s0[1]}, {s0[2], s0[3]}, {s1[0], s1[1]}, {s1[2], s1[3]}};
#pragma unroll
                for (int m = 0; m < 4; ++m) { const float ra = sav[ai * 4 + m]; const f32x2 rav = {ra, ra}; const i32x4 a0 = acc[ai][bj][m][0], a1 = acc[ai][bj][m][1];
                    f32x2 x[4] = {{(float)a0[0], (float)a0[1]}, {(float)a0[2], (float)a0[3]}, {(float)a1[0], (float)a1[1]}, {(float)a1[2], (float)a1[3]}};
                    unsigned tb[8];
#pragma unroll
                    for (int p = 0; p < 4; ++p) { x[p] = x[p] * (sp[p] * rav);
#pragma unroll
                        for (int h = 0; h < 2; ++h) { const float e = __builtin_amdgcn_exp2f(x[p][h]); const float r = rcpf_(e * (1.0f / 255.0f) + (1.0f / 255.0f));
                            tb[2 * p + h] = __float_as_uint(r + 8388608.0f); } }
#pragma unroll
                    for (int n = 0; n < 2; ++n) { const unsigned w01 = __builtin_amdgcn_perm(tb[4 * n + 1], tb[4 * n], 0x0c0c0400u), w23 = __builtin_amdgcn_perm(tb[4 * n + 3], tb[4 * n + 2], 0x0c0c0400u);
                        d[m][2 * bj + n] = __builtin_amdgcn_perm(w23, w01, 0x05040100u); } }
                __builtin_amdgcn_sched_barrier(0); }
#pragma unroll
            for (int m = 0; m < 4; ++m) { u32x4 w; w.x = d[m][0]; w.y = d[m][1]; w.z = d[m][2]; w.w = d[m][3];
                *(u32x4*)(O + (size_t)(row0 + ai * HALF + m * 16) * NGATE + col0) = w; } }
    }
};
struct EpiAddX {
    static constexpr bool I8 = false; static constexpr bool PERM = true;
    struct Pre {}; __device__ __forceinline__ void prefetch(Pre&, const Unit&, int, int, int, int) const {}
    const float* basef; const bf16* baseb; bf16* out; int ldc;
    __device__ __forceinline__ void operator()(const f32x4 (&acc)[2][2][4][2], const Unit& u, int wr, int wc, int fr, int fq, const Pre&) const {
        const int row0 = u.pm * BM + wr * 64 + fr, col0 = u.pn * BM + wc * 32 + 8 * fq;
#pragma unroll
        for (int ai = 0; ai < 2; ++ai) { u32x4 w[4][2];
            if (!basef) {
#pragma unroll
                for (int m = 0; m < 4; ++m)
#pragma unroll
                    for (int bj = 0; bj < 2; ++bj) w[m][bj] = *(const u32x4*)(baseb + (size_t)(row0 + ai * HALF + m * 16) * ldc + col0 + bj * HALF); }
            asm volatile("" ::: "memory");
#pragma unroll
            for (int m = 0; m < 4; ++m)
#pragma unroll
                for (int bj = 0; bj < 2; ++bj) { const size_t p = (size_t)(row0 + ai * HALF + m * 16) * ldc + col0 + bj * HALF; f32x4 b0, b1;
                    if (basef) { b0 = *(const f32x4*)(basef + p); b1 = *(const f32x4*)(basef + p + 4); }
                    else { const u32x4 ww = w[m][bj]; b0 = (f32x4){lo16(ww.x), hi16(ww.x), lo16(ww.y), hi16(ww.y)}; b1 = (f32x4){lo16(ww.z), hi16(ww.z), lo16(ww.w), hi16(ww.w)}; }
                    b0 = b0 + acc[ai][bj][m][0]; b1 = b1 + acc[ai][bj][m][1];
                    u32x4 o; o.x = cvt_pk_bf16(b0[0], b0[1]); o.y = cvt_pk_bf16(b0[2], b0[3]); o.z = cvt_pk_bf16(b1[0], b1[1]); o.w = cvt_pk_bf16(b1[2], b1[3]);
                    *(u32x4*)(out + p) = o; }
            asm volatile("" ::: "memory"); }
    }
};
struct EpiGateAcc {
    static constexpr bool I8 = false; static constexpr bool PERM = true;
    struct Pre {}; __device__ __forceinline__ void prefetch(Pre&, const Unit&, int, int, int, int) const {}
    const unsigned char* gates; bf16* merged;
    __device__ __forceinline__ void operator()(const f32x4 (&acc)[2][2][4][2], const Unit& u, int wr, int wc, int fr, int fq, const Pre&) const {
        const int k = u.pn >> 3, pn = u.pn & 7, pm = u.pm & 127;
        const int row0 = pm * BM + wr * 64 + fr, col0 = pn * BM + wc * 32 + 8 * fq;
        u32x2 g[2][4]; u32x4 pv[2][4];
#define GA_LOAD(buf, q_) do { _Pragma("unroll") for (int m_ = 0; m_ < 4; ++m_) { const size_t r_ = (size_t)(row0 + ((q_) >> 1) * HALF + m_ * 16); const int c_ = col0 + ((q_) & 1) * HALF; \
            g[buf][m_] = *(const u32x2*)(gates + r_ * NGATE + k * DM + c_); pv[buf][m_] = (u32x4){0u, 0u, 0u, 0u}; if (k) pv[buf][m_] = *(const u32x4*)(merged + r_ * DM + c_); } } while (0)
        GA_LOAD(0, 0);
#pragma unroll
        for (int q = 0; q < 4; ++q) { const int ai = q >> 1, bj = q & 1, cur = q & 1;
            if (q < 3) GA_LOAD(cur ^ 1, q + 1);
            asm volatile("" ::: "memory");
#pragma unroll
            for (int m = 0; m < 4; ++m) { const size_t r = (size_t)(row0 + ai * HALF + m * 16); const int c = col0 + bj * HALF;
                const f32x4 v0 = acc[ai][bj][m][0], v1 = acc[ai][bj][m][1]; const u32x2 gg = g[cur][m]; const u32x4 pp = pv[cur][m];
                float o[8];
                o[0] = lo16(pp.x) + (float)(gg.x & 0xffu) * v0[0]; o[1] = hi16(pp.x) + (float)((gg.x >> 8) & 0xffu) * v0[1]; o[2] = lo16(pp.y) + (float)((gg.x >> 16) & 0xffu) * v0[2]; o[3] = hi16(pp.y) + (float)(gg.x >> 24) * v0[3];
                o[4] = lo16(pp.z) + (float)(gg.y & 0xffu) * v1[0]; o[5] = hi16(pp.z) + (float)((gg.y >> 8) & 0xffu) * v1[1]; o[6] = lo16(pp.w) + (float)((gg.y >> 16) & 0xffu) * v1[2]; o[7] = hi16(pp.w) + (float)(gg.y >> 24) * v1[3];
                u32x4 w; w.x = cvt_pk_bf16(o[0], o[1]); w.y = cvt_pk_bf16(o[2], o[3]); w.z = cvt_pk_bf16(o[4], o[5]); w.w = cvt_pk_bf16(o[6], o[7]);
                *(u32x4*)(merged + r * DM + c) = w; }
            asm volatile("" ::: "memory"); }
#undef GA_LOAD
    }
};
struct EpiGlu {
    static constexpr bool I8 = false; static constexpr bool PERM = true;
    struct Pre {}; __device__ __forceinline__ void prefetch(Pre&, const Unit&, int, int, int, int) const {}
    const bf16* Z; bf16* O;
    __device__ __forceinline__ void operator()(const f32x4 (&acc)[2][2][4][2], const Unit& u, int wr, int wc, int fr, int fq, const Pre&) const {
        const int row0 = u.pm * BM + wr * 64 + fr, col0 = u.pn * BM + wc * 32 + 8 * fq;
#pragma unroll
        for (int ai = 0; ai < 2; ++ai)
#pragma unroll
            for (int m = 0; m < 4; ++m) { const size_t r = (size_t)(row0 + ai * HALF + m * 16);
#pragma unroll
                for (int bj = 0; bj < 2; ++bj) { const int c = col0 + bj * HALF;
                    const u32x4 z = *(const u32x4*)(Z + r * 512 + c);
                    const f32x4 v0 = acc[ai][bj][m][0], v1 = acc[ai][bj][m][1];
                    float o[8];
                    o[0] = lo16(z.x) * sigmoidf_(v0[0]); o[1] = hi16(z.x) * sigmoidf_(v0[1]); o[2] = lo16(z.y) * sigmoidf_(v0[2]); o[3] = hi16(z.y) * sigmoidf_(v0[3]);
                    o[4] = lo16(z.z) * sigmoidf_(v1[0]); o[5] = hi16(z.z) * sigmoidf_(v1[1]); o[6] = lo16(z.w) * sigmoidf_(v1[2]); o[7] = hi16(z.w) * sigmoidf_(v1[3]);
                    u32x4 w; w.x = cvt_pk_bf16(o[0], o[1]); w.y = cvt_pk_bf16(o[2], o[3]); w.z = cvt_pk_bf16(o[4], o[5]); w.w = cvt_pk_bf16(o[6], o[7]);
                    *(u32x4*)(O + r * 512 + c) = w; }
                asm volatile("" ::: "memory"); }
    }
};
template <bool I8_> struct EpiFfnUp {
    static constexpr bool I8 = I8_; static constexpr bool PERM = true;
    const bf16* G; bf16* O; const unsigned* w01; const unsigned* w2b; const float* sa; const float* sb;
    struct Pre {}; __device__ __forceinline__ void prefetch(Pre&, const Unit&, int, int, int, int) const {}
    __device__ __forceinline__ void operator()(const typename AccOf<I8_>::T (&acc)[2][2][4][2], const Unit& u, int wr, int wc, int fr, int fq, const Pre& P) const {
        const int rowb = u.pm * BM + wr * 64, col0 = u.pn * BM + wc * 32 + 8 * fq; const bool l15 = fr == 15, l14 = fr >= 14;
        u32x4 gb[2][3], wa[2], wb[2]; f32x4 sbv[2]; float sav[8];
#define FU_GLOAD(buf, k_) do { const int base_ = rowb + (((k_) >> 1) & 1) * HALF + 32 * ((k_) & 1), cc_ = col0 + ((k_) >> 2) * HALF; gb[buf][0] = (u32x4){0u, 0u, 0u, 0u}; \
            if (base_ & (SEQ - 1)) gb[buf][0] = *(const u32x4*)(G + (size_t)(base_ - 16 + fr) * FF + cc_); \
            gb[buf][1] = *(const u32x4*)(G + (size_t)(base_ + fr) * FF + cc_); gb[buf][2] = *(const u32x4*)(G + (size_t)(base_ + 16 + fr) * FF + cc_); } while (0)
#define FU_WLOAD(bj_) do { const int cc_ = col0 + (bj_) * HALF; wa[0] = *(const u32x4*)(w01 + cc_); wa[1] = *(const u32x4*)(w01 + cc_ + 4); wb[0] = *(const u32x4*)(w2b + cc_); wb[1] = *(const u32x4*)(w2b + cc_ + 4); \
            if constexpr (I8_) { sbv[0] = *(const f32x4*)(sb + cc_); sbv[1] = *(const f32x4*)(sb + cc_ + 4); } } while (0)
        FU_GLOAD(0, 0); FU_WLOAD(0);
        if constexpr (I8_) {
#pragma unroll
            for (int i = 0; i < 8; ++i) sav[i] = sa[rowb + fr + (i >> 2) * HALF + (i & 3) * 16]; }
#pragma unroll
        for (int k = 0; k < 8; ++k) { const int bj = k >> 2, ai = (k >> 1) & 1, mh = k & 1, cur = k & 1; const int c = col0 + bj * HALF;
            if (k < 7) FU_GLOAD(cur ^ 1, k + 1);
            asm volatile("" ::: "memory");
#pragma unroll
            for (int mm = 0; mm < 2; ++mm) { const int m = 2 * mh + mm; const size_t r = (size_t)(rowb + ai * HALF + m * 16 + fr); const u32x4 gp = gb[cur][mm], gc = gb[cur][mm + 1];
                f32x2 v[4];
#pragma unroll
                for (int p = 0; p < 4; ++p) v[p] = (f32x2){(float)acc[ai][bj][m][p >> 1][2 * (p & 1)], (float)acc[ai][bj][m][p >> 1][2 * (p & 1) + 1]};
                if constexpr (I8_) { const float ra = sav[ai * 4 + m]; const f32x2 rav = {ra, ra}; const f32x4 s0 = sbv[0], s1 = sbv[1];
                    v[0] = v[0] * ((f32x2){s0[0], s0[1]} * rav); v[1] = v[1] * ((f32x2){s0[2], s0[3]} * rav); v[2] = v[2] * ((f32x2){s1[0], s1[1]} * rav); v[3] = v[3] * ((f32x2){s1[2], s1[3]} * rav); }
                float o[8];
#pragma unroll
                for (int w = 0; w < 4; ++w) {
                    const unsigned x1w = (unsigned)__builtin_amdgcn_update_dpp(0, (int)(l15 ? gp[w] : gc[w]), 0x121, 0xf, 0xf, true);
                    const unsigned x0w = (unsigned)__builtin_amdgcn_update_dpp(0, (int)(l14 ? gp[w] : gc[w]), 0x122, 0xf, 0xf, true);
                    const unsigned wa_ = wa[w >> 1][2 * (w & 1)], wa1_ = wa[w >> 1][2 * (w & 1) + 1], wb_ = wb[w >> 1][2 * (w & 1)], wb1_ = wb[w >> 1][2 * (w & 1) + 1];
#pragma unroll
                    for (int h = 0; h < 2; ++h) { const int jj = 2 * w + h; const unsigned sel = h ? 0x07060302u : 0x05040100u;
                        const unsigned p01 = __builtin_amdgcn_perm(x1w, x0w, sel), p2 = __builtin_amdgcn_perm(0x3F803F80u, gc[w], sel);
                        float uu = __builtin_amdgcn_fdot2_f32_bf16(__builtin_bit_cast(bf16v2, p2), __builtin_bit_cast(bf16v2, h ? wb1_ : wb_), 0.0f, false);
                        uu = __builtin_amdgcn_fdot2_f32_bf16(__builtin_bit_cast(bf16v2, p01), __builtin_bit_cast(bf16v2, h ? wa1_ : wa_), uu, false);
                        const float z = uu * (uu * uu * -0.10294324f + -2.3022082f); const float e = __builtin_amdgcn_exp2f(z);
                        o[jj] = (uu * v[jj >> 1][jj & 1]) * rcpf_(1.0f + e); } }
                u32x4 wv; wv.x = cvt_pk_bf16(o[0], o[1]); wv.y = cvt_pk_bf16(o[2], o[3]); wv.z = cvt_pk_bf16(o[4], o[5]); wv.w = cvt_pk_bf16(o[6], o[7]);
                *(u32x4*)(O + r * FF + c) = wv; }
            asm volatile("" ::: "memory");
            if (k == 3) FU_WLOAD(1); }
#undef FU_GLOAD
#undef FU_WLOAD
    }
};

__device__ __forceinline__ f32x4 mma16(bf16x8 b, bf16x8 a, f32x4 c) { return __builtin_amdgcn_mfma_f32_16x16x32_bf16(b, a, c, 0, 0, 0); }
__device__ __forceinline__ i32x4 mma16(bf16x8 b, bf16x8 a, i32x4 c) { return __builtin_amdgcn_mfma_i32_16x16x64_i8(__builtin_bit_cast(i32x4, b), __builtin_bit_cast(i32x4, a), c, 0, 0, 0); }
#ifndef PG8_SP2
#define PG8_SP2 true
#endif
#ifndef PG8_ALIGN
#define PG8_ALIGN true
#endif
template <class E> struct BMode { static constexpr int v = E::PERM ? 1 : 0; }; template <> struct BMode<EpiGateU8> { static constexpr int v = 2; };
template <class Epi, class Sched, bool ALIGN_EPI = PG8_ALIGN, bool SP2 = PG8_SP2>
__device__ __forceinline__ void gemm_phase(LAS unsigned char* lds, const Gemm g, const Sched& S, const Epi& E, int tid_) {
    const int tid = tid_, wid = __builtin_amdgcn_readfirstlane(tid >> 6), lane = tid & 63, wr = wid >> 2, wc = wid & 3, fr = lane & 15, fq = lane >> 4;
    const int K = g.K, nt = K / BK;
    unsigned voffA[2], voffB[2];
#pragma unroll
    for (int i = 0; i < 2; ++i) { int R, C; stage_rc(tid * 16 + i * 8192, R, C); const int Rb = BMode<Epi>::v == 2 ? (64 * (R >> 5) + 16 * ((R >> 2) & 3) + 4 * ((R >> 4) & 1) + (R & 3)) : (BMode<Epi>::v == 1 ? ((R & ~31) + perm32(R & 31)) : R);
        voffA[i] = (unsigned)(R * K + C) * 2u; voffB[i] = (unsigned)(Rb * K + C) * 2u; }
    const size_t kstep = (size_t)(BK * 2);
    const size_t hstep = (size_t)HALF * K * 2;
    const size_t tstep = 2 * hstep;
    const size_t hstepB = BMode<Epi>::v == 2 ? (size_t)8 * K * 2 : hstep;
    const unsigned ldsw = (unsigned)wid * 1024u;
    const int aoff = lds_byte(wr * 64 + fr, fq * 8), boff = lds_byte(wc * 32 + fr, fq * 8);
#define PG8_SA(b, h) (((b) * 2 + (h)) * HTB)
#define PG8_SB(b, h) ((4 + (b) * 2 + (h)) * HTB)
#define PG8_STAGE(bufoff, gbase, voff) do { _Pragma("unroll") for (int _i = 0; _i < 2; ++_i) \
        __builtin_amdgcn_global_load_lds((const unsigned*)((const char*)(gbase) + (voff)[_i]), (LAS unsigned*)(lds + (bufoff) + ldsw + _i * 8192), 16, 0, 0); } while (0)
#define PG8_LDA(dst, b, h) do { _Pragma("unroll") for (int m = 0; m < 4; ++m) _Pragma("unroll") for (int k = 0; k < 2; ++k) dst[m][k] = *(const LAS bf16x8*)(lds + PG8_SA(b, h) + aoff + m * 2048 + k * 1024); } while (0)
#define PG8_LDB(dst, b, h) do { _Pragma("unroll") for (int n = 0; n < 2; ++n) _Pragma("unroll") for (int k = 0; k < 2; ++k) dst[n][k] = *(const LAS bf16x8*)(lds + PG8_SB(b, h) + boff + n * 2048 + k * 1024); } while (0)
#define PG8_MMA(ai, bj, At, Bt) do { __builtin_amdgcn_s_setprio(1); _Pragma("unroll") for (int m = 0; m < 4; ++m) _Pragma("unroll") for (int n = 0; n < 2; ++n) _Pragma("unroll") for (int k = 0; k < 2; ++k) \
        acc[ai][bj][m][n] = mma16(Bt[n][k], At[m][k], acc[ai][bj][m][n]); __builtin_amdgcn_s_setprio(0); } while (0)
#define PG8_WAIT_V(n) asm volatile("s_waitcnt vmcnt(" #n ")" ::: "memory")
#define PG8_WAIT_L(n) asm volatile("s_waitcnt lgkmcnt(" #n ")" ::: "memory")
#define PG8_BAR __builtin_amdgcn_s_barrier()
#define PG8_SCHED __builtin_amdgcn_sched_barrier(0)
    Unit cur, nxt; int ui = 0;
    if (!S.next(0, cur)) return;
    typedef typename AccOf<Epi::I8>::T acc_t;
    acc_t acc[2][2][4][2];
#pragma unroll
    for (int a = 0; a < 2; ++a)
#pragma unroll
        for (int b = 0; b < 2; ++b)
#pragma unroll
            for (int m = 0; m < 4; ++m)
#pragma unroll
                for (int n = 0; n < 2; ++n) acc[a][b][m][n] = (acc_t){0, 0, 0, 0};
    bf16x8 At[4][2], B0[2][2], B1[2][2];
    typename Epi::Pre pre;
    const char* cA = (const char*)g.A + (size_t)cur.pm * tstep; const char* cB = (const char*)g.Bt + (size_t)cur.pn * tstep;
    S.a_ready(cur);
    if constexpr (SP2) {
        PG8_STAGE(PG8_SB(0, 0), cB, voffB); PG8_STAGE(PG8_SB(0, 1), cB + hstepB, voffB); PG8_STAGE(PG8_SA(0, 0), cA, voffA); PG8_STAGE(PG8_SA(0, 1), cA + hstep, voffA);
        if (wr == 1) PG8_BAR;
        PG8_WAIT_V(2); PG8_BAR;
        PG8_STAGE(PG8_SB(1, 0), cB + kstep, voffB); PG8_STAGE(PG8_SA(1, 0), cA + kstep, voffA); PG8_STAGE(PG8_SB(1, 1), cB + hstepB + kstep, voffB);
        PG8_WAIT_V(6); PG8_BAR;
    } else {
    PG8_STAGE(PG8_SB(0, 0), cB, voffB); PG8_STAGE(PG8_SA(0, 0), cA, voffA); PG8_STAGE(PG8_SB(0, 1), cB + hstepB, voffB); PG8_STAGE(PG8_SA(0, 1), cA + hstep, voffA);
    if (wr == 1) PG8_BAR;
    PG8_WAIT_V(4); PG8_BAR;
    PG8_STAGE(PG8_SB(1, 0), cB + kstep, voffB); PG8_STAGE(PG8_SA(1, 0), cA + kstep, voffA); PG8_STAGE(PG8_SB(1, 1), cB + hstepB + kstep, voffB);
    PG8_WAIT_V(6); PG8_BAR;
    }
    for (;;) {
        const bool has_next = S.next(ui + 1, nxt);
        const char* nA = has_next ? (const char*)g.A + (size_t)nxt.pm * tstep : cA; const char* nB = has_next ? (const char*)g.Bt + (size_t)nxt.pn * tstep : cB;
        for (int t = 0; t < nt; t += 2) {
            const bool last = (t == nt - 2);
            const char* a1 = cA + (size_t)(t + 1) * kstep;
            const char* a2 = last ? nA : cA + (size_t)(t + 2) * kstep; const char* b2 = last ? nB : cB + (size_t)(t + 2) * kstep;
            const char* a3 = a2 + kstep; const char* b3 = b2 + kstep;
            if (last && has_next) S.a_ready(nxt);
            if (last) E.prefetch(pre, cur, wr, wc, fr, fq);
            if constexpr (SP2) {
            PG8_LDB(B0, 0, 0); PG8_LDB(B1, 0, 1); PG8_SCHED; PG8_LDA(At, 0, 0); PG8_STAGE(PG8_SA(1, 1), a1 + hstep, voffA);
            PG8_WAIT_V(8); PG8_WAIT_L(0); PG8_BAR; PG8_MMA(0, 0, At, B0); PG8_MMA(0, 1, At, B1); PG8_BAR; PG8_SCHED;
            PG8_LDA(At, 0, 1); PG8_STAGE(PG8_SB(0, 0), b2, voffB); PG8_STAGE(PG8_SB(0, 1), b2 + hstepB, voffB); PG8_STAGE(PG8_SA(0, 0), a2, voffA);
            PG8_WAIT_V(8); PG8_WAIT_L(0); PG8_BAR; PG8_MMA(1, 0, At, B0); PG8_MMA(1, 1, At, B1); PG8_BAR; PG8_SCHED;
            PG8_LDB(B0, 1, 0); PG8_LDB(B1, 1, 1); PG8_SCHED; PG8_LDA(At, 1, 0); PG8_STAGE(PG8_SA(0, 1), a2 + hstep, voffA);
            PG8_WAIT_V(8); PG8_WAIT_L(0); PG8_BAR; PG8_MMA(0, 0, At, B0); PG8_MMA(0, 1, At, B1); PG8_BAR; PG8_SCHED;
            PG8_LDA(At, 1, 1); PG8_STAGE(PG8_SB(1, 0), b3, voffB); PG8_STAGE(PG8_SB(1, 1), b3 + hstepB, voffB); PG8_STAGE(PG8_SA(1, 0), a3, voffA);
            PG8_WAIT_V(8); PG8_WAIT_L(0); PG8_BAR; PG8_MMA(1, 0, At, B0); PG8_MMA(1, 1, At, B1); PG8_BAR; PG8_SCHED;
            } else {
            PG8_LDB(B0, 0, 0); PG8_SCHED; PG8_LDA(At, 0, 0); PG8_STAGE(PG8_SA(1, 1), a1 + hstep, voffA);
            PG8_WAIT_L(8); PG8_BAR; PG8_WAIT_L(0); PG8_MMA(0, 0, At, B0); PG8_BAR; PG8_SCHED;
            PG8_LDB(B1, 0, 1); PG8_STAGE(PG8_SB(0, 0), b2, voffB);
            PG8_BAR; PG8_WAIT_L(0); PG8_MMA(0, 1, At, B1); PG8_BAR;
            PG8_LDA(At, 0, 1); PG8_STAGE(PG8_SA(0, 0), a2, voffA);
            PG8_BAR; PG8_WAIT_L(0); PG8_MMA(1, 0, At, B0); PG8_BAR; PG8_SCHED;
            PG8_STAGE(PG8_SB(0, 1), b2 + hstepB, voffB);
            PG8_WAIT_V(6); PG8_BAR; PG8_MMA(1, 1, At, B1); PG8_BAR;
            PG8_LDB(B0, 1, 0); PG8_SCHED; PG8_LDA(At, 1, 0); PG8_STAGE(PG8_SA(0, 1), a2 + hstep, voffA);
            PG8_WAIT_L(8); PG8_BAR; PG8_WAIT_L(0); PG8_MMA(0, 0, At, B0); PG8_BAR; PG8_SCHED;
            PG8_LDB(B1, 1, 1); PG8_STAGE(PG8_SB(1, 0), b3, voffB);
            PG8_BAR; PG8_WAIT_L(0); PG8_MMA(0, 1, At, B1); PG8_BAR;
            PG8_LDA(At, 1, 1); PG8_STAGE(PG8_SA(1, 0), a3, voffA);
            PG8_BAR; PG8_WAIT_L(0); PG8_MMA(1, 0, At, B0); PG8_BAR; PG8_SCHED;
            PG8_STAGE(PG8_SB(1, 1), b3 + hstepB, voffB);
            PG8_WAIT_V(6); PG8_BAR; PG8_MMA(1, 1, At, B1); PG8_BAR;
            }
        }
        if constexpr (ALIGN_EPI) { if (wr == 0) PG8_BAR; }
        E(acc, cur, wr, wc, fr, fq, pre); S.done(cur);
        if (!has_next) break;
#pragma unroll
        for (int a = 0; a < 2; ++a)
#pragma unroll
            for (int b = 0; b < 2; ++b)
#pragma unroll
                for (int m = 0; m < 4; ++m)
#pragma unroll
                    for (int n = 0; n < 2; ++n) acc[a][b][m][n] = (acc_t){0, 0, 0, 0};
        cur = nxt; cA = nA; cB = nB; ++ui;
        if constexpr (ALIGN_EPI) { if (wr == 1) PG8_BAR; }
    }
    PG8_WAIT_V(0);
    if constexpr (!ALIGN_EPI) { if (wr == 0) PG8_BAR; }
    PG8_BAR;
#undef PG8_SA
#undef PG8_SB
#undef PG8_STAGE
#undef PG8_LDA
#undef PG8_LDB
#undef PG8_MMA
#undef PG8_WAIT_V
#undef PG8_WAIT_L
#undef PG8_BAR
#undef PG8_SCHED
}
}

#define XB_TMO      128
#define XB_XCNT(j)  (256  + 64 * (j))
#define XB_XSUB(j)  (1280 + 64 * (j))
#define XB_XGEN(j)  (2304 + 64 * (j))
#define XB_TOP      3328
#define XB_TOPGEN   3392
#define XCD_BAR_WORDS 3456
#define XB_SPIN_CAP (1u << 22)
__device__ __forceinline__ unsigned xb_ld(unsigned* p)              { return __hip_atomic_load(p, __ATOMIC_RELAXED, __HIP_MEMORY_SCOPE_AGENT); }
__device__ __forceinline__ unsigned xb_add(unsigned* p, unsigned v) { return __hip_atomic_fetch_add(p, v, __ATOMIC_RELAXED, __HIP_MEMORY_SCOPE_AGENT); }
__device__ __forceinline__ unsigned xb_xcc_id() { return (unsigned)__builtin_amdgcn_s_getreg((3 << 11) | 20) & 0xFu; }
#define XB_SPIN(cond, bar) do { unsigned _sp = 0; while (cond) { __builtin_amdgcn_s_sleep(1); \
    if ((++_sp & 255u) == 0u) { if (xb_ld(&(bar)[XB_TMO])) break; if (_sp > XB_SPIN_CAP) { atomicAdd(&(bar)[XB_TMO], 1u); break; } } } } while (0)
struct XcdBarrier { unsigned* bar; unsigned x; volatile LAS unsigned* st; };
__device__ __forceinline__ XcdBarrier xcd_barrier_post(unsigned* bar, volatile LAS unsigned* st) {
    XcdBarrier b; b.bar = bar; b.x = xb_xcc_id(); b.st = st;
    if (threadIdx.x == 0) (void)xb_add(&bar[XB_XCNT(b.x)], 1u);
    return b;
}
__device__ __forceinline__ void xcd_barrier_complete(unsigned* bar, unsigned x, unsigned& nloc, unsigned& nx) {
    const unsigned G = gridDim.x * gridDim.y * gridDim.z;
    unsigned sum, cnt, mine, sp = 0u;
    for (;;) {
        sum = 0u; cnt = 0u; mine = 0u;
#pragma unroll
        for (unsigned j = 0; j < 16; ++j) { const unsigned c = xb_ld(&bar[XB_XCNT(j)]); sum += c; cnt += (c > 0u) ? 1u : 0u; mine = (j == x) ? c : mine; }
        if (sum == G) break;
        __builtin_amdgcn_s_sleep(1);
        if ((++sp & 255u) == 0u) { if (xb_ld(&bar[XB_TMO])) break; if (sp > XB_SPIN_CAP) { atomicAdd(&bar[XB_TMO], 1u); break; } }
    }
    nloc = mine > 0u ? mine : 1u; nx = cnt > 0u ? cnt : 1u;
}
__device__ __forceinline__ void xcd_barrier(const XcdBarrier& b) {
    asm volatile("s_waitcnt vmcnt(0)" ::: "memory");
    __syncthreads();
    if (threadIdx.x == 0) {
        unsigned* bar = b.bar;
        { unsigned long long w_ = (unsigned long long)bar; unsigned lo_ = __builtin_amdgcn_readfirstlane((unsigned)w_), hi_ = __builtin_amdgcn_readfirstlane((unsigned)(w_ >> 32)); asm volatile("" : "+s"(lo_), "+s"(hi_)); bar = (unsigned*)(((unsigned long long)hi_ << 32) | lo_); }
        __builtin_amdgcn_s_waitcnt(0);
        unsigned nloc = b.st[0], nx = b.st[1];
        if (nloc == 0u) { xcd_barrier_complete(bar, b.x, nloc, nx); b.st[0] = nloc; b.st[1] = nx; }
        const unsigned old = xb_add(&bar[XB_XSUB(b.x)], 1u);
        const unsigned gen = old / nloc;
        if (old + 1u == (gen + 1u) * nloc) {
            __builtin_amdgcn_fence(__ATOMIC_RELEASE, "agent");
            asm volatile("s_waitcnt vmcnt(0)" ::: "memory");
            const unsigned og = xb_add(&bar[XB_TOP], 1u);
            const unsigned tg = og / nx;
            if (og + 1u == (tg + 1u) * nx) xb_add(&bar[XB_TOPGEN], 1u);
            else XB_SPIN(xb_ld(&bar[XB_TOPGEN]) == tg, bar);
            __builtin_amdgcn_fence(__ATOMIC_ACQUIRE, "agent");
            xb_add(&bar[XB_XGEN(b.x)], 1u);
            asm volatile("s_waitcnt vmcnt(0)" ::: "memory");
        } else {
            XB_SPIN(xb_ld(&bar[XB_XGEN(b.x)]) == gen, bar);
            __builtin_amdgcn_fence(__ATOMIC_ACQUIRE, "agent");
            asm volatile("s_waitcnt vmcnt(0)" ::: "memory");
        }
    }
    __syncthreads();
}

constexpr int NWAVES = 8, NTHR = 512;
constexpr int LDS_MISC = 131072, LDS_BYTES = 131072 + 1024;
struct Args { const float* in[45]; float* out; unsigned char* ws; };
#define GAS __attribute__((address_space(1)))
struct Frame {
    LAS unsigned char* lds; float* out; unsigned char* ws;
    int tid, lane, wave, blk, G;
};
#define WSP(T, off) ((T*)(F.ws + (off)))
__device__ __forceinline__ const float* inp_(LAS unsigned char* lds, int k) {
    const LAS unsigned* t = (const LAS unsigned*)(lds + 131072 + 256) + 2 * k;
    const unsigned lo = __builtin_amdgcn_readfirstlane(t[0]), hi = __builtin_amdgcn_readfirstlane(t[1]);
    return (const float*)(const GAS float*)(((unsigned long long)hi << 32) | lo);
}
#define INP(k) inp_(F.lds, (k))

__device__ __forceinline__ void tr_item(const float* W, int ld, int col0, int ncv, bf16* WT, int K, int row_off, LAS float* scr, int kb, int nb, int lane, float scale = 1.0f) {
    const int k0 = 64 * kb, n0 = 32 * nb; const int nn = n0 + (lane & 31); const bool ok = nn < ncv;
    { float t[32]; const float* wp = W + (size_t)(k0 + (lane >> 5)) * ld + col0 + (ok ? nn : 0);
#pragma unroll
      for (int i = 0; i < 32; ++i) t[i] = wp[(size_t)(2 * i) * ld];
#pragma unroll
      for (int i = 0; i < 32; ++i) scr[(2 * i + (lane >> 5)) * 33 + (lane & 31)] = ok ? t[i] * scale : 0.f; }
    asm volatile("s_waitcnt lgkmcnt(0)" ::: "memory");
    const int c = lane & 7;
#pragma unroll
    for (int j = 0; j < 4; ++j) { const int n = (lane >> 3) + 8 * j; const LAS float* s = scr + (8 * c) * 33 + n;
        u32x4 o; o.x = pk2(s[0 * 33], s[1 * 33]); o.y = pk2(s[2 * 33], s[3 * 33]); o.z = pk2(s[4 * 33], s[5 * 33]); o.w = pk2(s[6 * 33], s[7 * 33]);
        *(u32x4*)(WT + (size_t)(row_off + n0 + n) * K + k0 + 8 * c) = o; }
    asm volatile("s_waitcnt lgkmcnt(0)" ::: "memory");
}
__device__ __forceinline__ void convert_weights(Frame& F, int l) {
    LAS float* scr = (LAS float*)(F.lds + F.wave * 16384);
    const int gw = F.blk * NWAVES + F.wave, NGW = F.G * NWAVES;
    constexpr int I0 = 32 * 152, I1 = I0, I2 = I1 + 4 * 8 * 64, I3 = I2 + 32 * 64, I4 = I3, I5 = I4, I6 = I5 + 96 * 64, I7 = I6 + 8 * 16;
    const float* win = INP(2) + (size_t)l * DM * INC;
    for (int it = gw; it < I7; it += NGW) {
        if (it < I0) { const int r = it; tr_item(win, INC, 0, MIXC, WSP(bf16, WS_WIN), DM, 0, scr, r / 152, r % 152, F.lane); }
        else if (it < I1) { }
        else if (it < I2) { const int r = it - I1; const int k = r / 512, rr = r % 512; tr_item(INP(36) + ((size_t)l * 4 + k) * 512 * DM, DM, 0, DM, WSP(bf16, WS_WPK), 512, k * DM, scr, rr / 64, rr % 64, F.lane, 1.0f / 255.0f); }
        else if (it < I3) { const int r = it - I2; tr_item(INP(37) + (size_t)l * DM * DM, DM, 0, DM, WSP(bf16, WS_WOUT), DM, 0, scr, r / 64, r % 64, F.lane); }
        else if (it < I4) { const int r = it - I3; tr_item(INP(39) + (size_t)l * DM * FF, FF, 0, FF, WSP(bf16, WS_WFG), DM, 0, scr, r / 192, r % 192, F.lane); }
        else if (it < I5) { const int r = it - I4; tr_item(INP(40) + (size_t)l * DM * FF, FF, 0, FF, WSP(bf16, WS_WFU), DM, 0, scr, r / 192, r % 192, F.lane); }
        else if (it < I6) { const int r = it - I5; tr_item(INP(43) + (size_t)l * FF * DM, DM, 0, DM, WSP(bf16, WS_WFD), FF, 0, scr, r / 64, r % 64, F.lane); }
        else { const int r = it - I6; tr_item(INP(11) + (size_t)l * 512 * 512, 512, 0, 512, WSP(bf16, WS_WGLU), 512, 0, scr, r / 16, r % 16, F.lane); }
    }
}
__device__ __forceinline__ void rmsnorm_rows(Frame& F, const float* x, const bf16* xb, const float* g, bf16* obf, float* of32, unsigned* a8 = nullptr, float* sa = nullptr) {
    const int gw = F.blk * NWAVES + F.wave, NGW = F.G * NWAVES;
    f32x4 gv[8];
#pragma unroll
    for (int j = 0; j < 8; ++j) gv[j] = ((const f32x4*)g)[64 * j + F.lane];
    u32x2 wn[8];
    if (!x && gw < MTOK) { const u32x2* xr = (const u32x2*)(xb + (size_t)gw * DM) + F.lane;
#pragma unroll
        for (int j = 0; j < 8; ++j) wn[j] = xr[64 * j]; }
    for (int m = gw; m < MTOK; m += NGW) {
        f32x4 v[8]; float s = 0.f;
        if (x) { const f32x4* xr = (const f32x4*)(x + (size_t)m * DM) + F.lane;
#pragma unroll
            for (int j = 0; j < 8; ++j) v[j] = xr[64 * j]; }
        else {
#pragma unroll
            for (int j = 0; j < 8; ++j) v[j] = (f32x4){lo16(wn[j].x), hi16(wn[j].x), lo16(wn[j].y), hi16(wn[j].y)};
            const int mn = m + NGW < MTOK ? m + NGW : m; const u32x2* xr = (const u32x2*)(xb + (size_t)mn * DM) + F.lane;
#pragma unroll
            for (int j = 0; j < 8; ++j) wn[j] = xr[64 * j];
            asm volatile("" ::: "memory"); }
#pragma unroll
        for (int j = 0; j < 8; ++j) s += (v[j].x * v[j].x + v[j].y * v[j].y) + (v[j].z * v[j].z + v[j].w * v[j].w);
        const float rs = 1.0f / sqrtf(wave_sum(s) * (1.f / DM) + 1e-6f);
#pragma unroll
        for (int j = 0; j < 8; ++j) v[j] = v[j] * rs * gv[j];
        if (obf) { u32x2* o = (u32x2*)(obf + (size_t)m * DM) + F.lane;
#pragma unroll
            for (int j = 0; j < 8; ++j) { u32x2 w; w.x = pk2(v[j].x, v[j].y); w.y = pk2(v[j].z, v[j].w); o[64 * j] = w; } }
        if (of32) { f32x4* o = (f32x4*)(of32 + (size_t)m * DM) + F.lane;
#pragma unroll
            for (int j = 0; j < 8; ++j) o[64 * j] = v[j]; }
        if (a8) {
            float am = 0.f;
#pragma unroll
            for (int j = 0; j < 8; ++j) am = fmaxf(fmaxf(am, fmaxf(fabsf(v[j].x), fabsf(v[j].y))), fmaxf(fabsf(v[j].z), fabsf(v[j].w)));
            am = fmaxf(wave_max(am), 1e-20f); const float inv = 127.0f / am;
            unsigned* o = a8 + (size_t)m * (DM / 4) + F.lane;
#pragma unroll
            for (int j = 0; j < 8; ++j) o[64 * j] = q8x4(v[j].x, v[j].y, v[j].z, v[j].w, inv);
            if (F.lane == 0) sa[m] = am * (1.0f / 127.0f); }
    }
}
__device__ __forceinline__ void convert_cols_i8(Frame& F, const float* W, int ld, int col0, int nb, signed char* W8, float* sb, int row_off) {
    LAS float* red = (LAS float*)(F.lds + 8 * 16384 - 4096);
    LAS float* scl = red + 512;
    const int tid = F.tid, n = tid & 31, kg = tid >> 5; const float* wp = W + col0 + 32 * nb + n;
    float am = 0.f;
#pragma unroll 1
    for (int i0 = 0; i0 < 128; i0 += 32) { float t[32];
#pragma unroll
        for (int i = 0; i < 32; ++i) t[i] = wp[(size_t)(kg + 16 * (i0 + i)) * ld];
#pragma unroll
        for (int i = 0; i < 32; ++i) am = fmaxf(am, fabsf(t[i])); }
    red[kg * 32 + n] = am;
    __syncthreads();
    if (tid < 32) { float a = 0.f;
#pragma unroll
        for (int q = 0; q < 16; ++q) a = fmaxf(a, red[q * 32 + tid]);
        a = fmaxf(a, 1e-30f); scl[tid] = 127.0f / a; sb[row_off + 32 * nb + tid] = a * (1.0f / 127.0f); }
    __syncthreads();
    LAS float* scr = (LAS float*)(F.lds + F.wave * 16384);
    const int lane = F.lane, rn = lane >> 1, half = lane & 1; const float inv = scl[rn];
#pragma unroll 1
    for (int kb = F.wave; kb < 32; kb += NWAVES) {
        { float t[32];
#pragma unroll
          for (int i = 0; i < 32; ++i) t[i] = W[(size_t)(64 * kb + 2 * i + (lane >> 5)) * ld + col0 + 32 * nb + (lane & 31)];
#pragma unroll
          for (int i = 0; i < 32; ++i) scr[(2 * i + (lane >> 5)) * 33 + (lane & 31)] = t[i]; }
        asm volatile("s_waitcnt lgkmcnt(0)" ::: "memory");
        const LAS float* sp = scr + (32 * half) * 33 + rn;
        u32x4 w0, w1;
        w0.x = q8x4(sp[0 * 33], sp[1 * 33], sp[2 * 33], sp[3 * 33], inv); w0.y = q8x4(sp[4 * 33], sp[5 * 33], sp[6 * 33], sp[7 * 33], inv);
        w0.z = q8x4(sp[8 * 33], sp[9 * 33], sp[10 * 33], sp[11 * 33], inv); w0.w = q8x4(sp[12 * 33], sp[13 * 33], sp[14 * 33], sp[15 * 33], inv);
        w1.x = q8x4(sp[16 * 33], sp[17 * 33], sp[18 * 33], sp[19 * 33], inv); w1.y = q8x4(sp[20 * 33], sp[21 * 33], sp[22 * 33], sp[23 * 33], inv);
        w1.z = q8x4(sp[24 * 33], sp[25 * 33], sp[26 * 33], sp[27 * 33], inv); w1.w = q8x4(sp[28 * 33], sp[29 * 33], sp[30 * 33], sp[31 * 33], inv);
        u32x4* d = (u32x4*)(W8 + (size_t)(row_off + 32 * nb + rn) * DM + 64 * kb + 32 * half); d[0] = w0; d[1] = w1;
        asm volatile("s_waitcnt lgkmcnt(0)" ::: "memory");
    }
    __syncthreads();
}

constexpr int WAVE_LDS = 16384;
constexpr int LR_XLD = 72, LR_FLD = 66, LR_ALD = 132;
constexpr int LR_XF = 16 * LR_XLD * 2, LR_AB = LR_XF + 16 * LR_FLD * 4;
template <bool FINAL> __device__ __forceinline__ void lru_task(Frame& F, int l, int task) {
    const int lane = F.lane, fr = lane & 15, fq = lane >> 4; const int b = task >> 9, h = (task >> 6) & 7, c = task & 63; const int ch = 64 * h + lane;
    LAS unsigned char* wl = F.lds + F.wave * WAVE_LDS;
    LAS bf16* XC = (LAS bf16*)wl; LAS float* XF = (LAS float*)(wl + LR_XF); LAS float* AB = (LAS float*)(wl + LR_AB);
    const float* WA = INP(14) + ((size_t)l * 8 + h) * 4096; const float* WX = INP(16) + ((size_t)l * 8 + h) * 4096;
    bf16x8 Wa[4][2], Wx[4][2];
#pragma unroll
    for (int nt = 0; nt < 4; ++nt)
#pragma unroll
        for (int kk = 0; kk < 2; ++kk) { const float* pa = WA + (size_t)(32 * kk + 8 * fq) * 64 + 16 * nt + fr; const float* px_ = WX + (size_t)(32 * kk + 8 * fq) * 64 + 16 * nt + fr;
            u32x4 wa_, wx_; wa_.x = pk2(pa[0], pa[64]); wa_.y = pk2(pa[128], pa[192]); wa_.z = pk2(pa[256], pa[320]); wa_.w = pk2(pa[384], pa[448]);
            wx_.x = pk2(px_[0], px_[64]); wx_.y = pk2(px_[128], px_[192]); wx_.z = pk2(px_[256], px_[320]); wx_.w = pk2(px_[384], px_[448]);
            Wa[nt][kk] = __builtin_bit_cast(bf16x8, wa_); Wx[nt][kk] = __builtin_bit_cast(bf16x8, wx_); }
    float ba4[4], bx4[4], sp4[4], slp[4];
#pragma unroll
    for (int nt = 0; nt < 4; ++nt) { const int jj = l * 512 + 64 * h + 16 * nt + fr; ba4[nt] = INP(15)[jj]; bx4[nt] = INP(17)[jj]; sp4[nt] = softplusf_(-INP(18)[jj]); slp[nt] = 0.f; }
    const float* cwp = INP(12) + (size_t)l * 4 * 512 + ch;
    const float cw0 = cwp[0], cw1 = cwp[512], cw2 = cwp[1024], cw3 = cwp[1536];
    const float cb = INP(13)[l * 512 + ch];
    const size_t row0 = (size_t)b * SEQ + (size_t)c * 128;
    const bf16* px = WSP(const bf16, WS_PROJ) + row0 * MIXP + PC_LRX + ch;
    const bf16* pg = WSP(const bf16, WS_PROJ) + row0 * MIXP + PC_LRG + ch;
    float xm3 = 0.f, xm2 = 0.f, xm1 = 0.f;
    if (c > 0) { xm3 = bf2f(*(px - 3 * (ptrdiff_t)MIXP)); xm2 = bf2f(*(px - 2 * (ptrdiff_t)MIXP)); xm1 = bf2f(*(px - (ptrdiff_t)MIXP)); }
    float hs = 0.f;
    const size_t cidx = ((size_t)b * 64 + c) * 512 + ch;
    if (FINAL) hs = WSP(const float, WS_LRI)[cidx];
    bf16* yo = WSP(bf16, WS_YK) + (size_t)1 * MTOK * 512 + row0 * 512 + ch;
    bf16 xs[16], gs[16];
#pragma unroll
    for (int j = 0; j < 16; ++j) { xs[j] = px[(size_t)j * MIXP]; if (FINAL) gs[j] = pg[(size_t)j * MIXP]; }
#pragma unroll 1
    for (int sb = 0; sb < 8; ++sb) {
#pragma unroll
        for (int t = 0; t < 16; ++t) { const float xv = bf2f(xs[t]); const float xc = cb + cw0 * xm3 + cw1 * xm2 + cw2 * xm1 + cw3 * xv; xm3 = xm2; xm2 = xm1; xm1 = xv;
            XC[t * LR_XLD + lane] = (bf16)f2bf(xc); XF[t * LR_FLD + lane] = xc; }
        float gl[16];
        if (FINAL) {
#pragma unroll
            for (int t = 0; t < 16; ++t) gl[t] = bf2f(gs[t]); }
        if (sb < 7) {
#pragma unroll
            for (int j = 0; j < 16; ++j) { xs[j] = px[(size_t)((sb + 1) * 16 + j) * MIXP]; if (FINAL) gs[j] = pg[(size_t)((sb + 1) * 16 + j) * MIXP]; } }
        const bf16x8 af0 = *(const LAS bf16x8*)(XC + fr * LR_XLD + 8 * fq), af1 = *(const LAS bf16x8*)(XC + fr * LR_XLD + 32 + 8 * fq);
#pragma unroll
        for (int nt = 0; nt < 4; ++nt) {
            f32x4 aa = (f32x4){0.f, 0.f, 0.f, 0.f}, ax = (f32x4){0.f, 0.f, 0.f, 0.f};
            aa = __builtin_amdgcn_mfma_f32_16x16x32_bf16(af0, Wa[nt][0], aa, 0, 0, 0); aa = __builtin_amdgcn_mfma_f32_16x16x32_bf16(af1, Wa[nt][1], aa, 0, 0, 0);
            ax = __builtin_amdgcn_mfma_f32_16x16x32_bf16(af0, Wx[nt][0], ax, 0, 0, 0); ax = __builtin_amdgcn_mfma_f32_16x16x32_bf16(af1, Wx[nt][1], ax, 0, 0, 0);
#pragma unroll
            for (int e = 0; e < 4; ++e) { const int t = 4 * fq + e, jj = 16 * nt + fr; const float xc = XF[t * LR_FLD + jj];
                const float r = sigmoidf_(aa[e] + ba4[nt]), ig = sigmoidf_(ax[e] + bx4[nt]); const float la = -8.0f * r * sp4[nt]; const float av = __expf(la);
                const float mult = __builtin_amdgcn_sqrtf(fmaxf(1.0f - av * av, 0.f));
                AB[t * LR_ALD + jj] = av; AB[t * LR_ALD + 64 + jj] = xc * ig * mult; if (!FINAL) slp[nt] += la; }
        }
#pragma unroll
        for (int t = 0; t < 16; ++t) { const float av = AB[t * LR_ALD + lane], bv = AB[t * LR_ALD + 64 + lane]; hs = av * hs + bv;
            if (FINAL) yo[(size_t)(sb * 16 + t) * 512] = (bf16)f2bf(hs * geluf_(gl[t])); }
    }
    if (!FINAL) { WSP(float, WS_LRE)[cidx] = hs;
#pragma unroll
        for (int nt = 0; nt < 4; ++nt) { float v = slp[nt]; v += __shfl_xor(v, 16); v += __shfl_xor(v, 32); if (fq == 0) WSP(float, WS_LRA)[((size_t)b * 64 + c) * 512 + 64 * h + 16 * nt + fr] = v; } }
}
__device__ __forceinline__ void lru_carry(Frame& F, int task) {
    const int b = task >> 3, ch = (task & 7) * 64 + F.lane; float run = 0.f;
    const float* A = WSP(const float, WS_LRA) + (size_t)b * 64 * 512 + ch; const float* E = WSP(const float, WS_LRE) + (size_t)b * 64 * 512 + ch; float* I = WSP(float, WS_LRI) + (size_t)b * 64 * 512 + ch;
#pragma unroll 1
    for (int c0 = 0; c0 < 64; c0 += 32) { float av[32], ev[32];
#pragma unroll
        for (int j = 0; j < 32; ++j) { av[j] = A[(size_t)(c0 + j) * 512]; ev[j] = E[(size_t)(c0 + j) * 512]; }
#pragma unroll
        for (int j = 0; j < 32; ++j) { I[(size_t)(c0 + j) * 512] = run; run = __expf(av[j]) * run + ev[j]; } }
}

constexpr int S5_XLD = 132, S5_SLD = 136, S5_SB = 16 * S5_XLD * 4;
template <bool FINAL> __device__ __forceinline__ void s5_task(Frame& F, int l, int task) {
    const int lane = F.lane, fr = lane & 15, fq = lane >> 4; const int b = task >> 11, g = (task >> 6) & 31, c = task & 63; const int p = lane;
    LAS unsigned char* wl = F.lds + F.wave * WAVE_LDS;
    LAS float* X = (LAS float*)wl; LAS bf16* Sb = (LAS bf16*)(wl + S5_SB);
    const int lg = l * 32 + g;
    const float lr = INP(3)[lg * 64 + p], li = INP(4)[lg * 64 + p]; const float dt = expf(INP(10)[lg]);
    const float mag = expf(lr * dt); float sn, cs; sincosf(li * dt, &sn, &cs); const float abr = mag * cs, abi = mag * sn;
    const float den = lr * lr + li * li, nr = abr - 1.0f, ni = abi; const float fre = (nr * lr + ni * li) / den, fim = (ni * lr - nr * li) / den;
    bf16x8 Bf[8];
#pragma unroll
    for (int nq = 0; nq < 4; ++nq) { const int pp = 16 * nq + fr; const float fr_ = __shfl(fre, pp), fi_ = __shfl(fim, pp);
        u32x4 wr_ = (u32x4){0u, 0u, 0u, 0u}, wi_ = (u32x4){0u, 0u, 0u, 0u};
        if (fq < 2) { const f32x4* br = (const f32x4*)(INP(5) + ((size_t)lg * 64 + pp) * 16 + 8 * fq); const f32x4* bi = (const f32x4*)(INP(6) + ((size_t)lg * 64 + pp) * 16 + 8 * fq);
            const f32x4 r0 = br[0], r1 = br[1], i0 = bi[0], i1 = bi[1];
            wr_.x = pk2(fr_ * r0[0] - fi_ * i0[0], fr_ * r0[1] - fi_ * i0[1]); wr_.y = pk2(fr_ * r0[2] - fi_ * i0[2], fr_ * r0[3] - fi_ * i0[3]);
            wr_.z = pk2(fr_ * r1[0] - fi_ * i1[0], fr_ * r1[1] - fi_ * i1[1]); wr_.w = pk2(fr_ * r1[2] - fi_ * i1[2], fr_ * r1[3] - fi_ * i1[3]);
            wi_.x = pk2(fr_ * i0[0] + fi_ * r0[0], fr_ * i0[1] + fi_ * r0[1]); wi_.y = pk2(fr_ * i0[2] + fi_ * r0[2], fr_ * i0[3] + fi_ * r0[3]);
            wi_.z = pk2(fr_ * i1[0] + fi_ * r1[0], fr_ * i1[1] + fi_ * r1[1]); wi_.w = pk2(fr_ * i1[2] + fi_ * r1[2], fr_ * i1[3] + fi_ * r1[3]); }
        Bf[nq] = __builtin_bit_cast(bf16x8, wr_); Bf[nq + 4] = __builtin_bit_cast(bf16x8, wi_); }
    bf16x8 Cf[4], Df;
    if (FINAL) {
#pragma unroll
        for (int kk = 0; kk < 4; ++kk) { const float* src = (kk < 2 ? INP(7) : INP(8)) + ((size_t)lg * 16 + fr) * 64 + 32 * (kk & 1) + 8 * fq; const float sg = kk < 2 ? 1.0f : -1.0f;
            const f32x4 c0 = *(const f32x4*)src, c1 = *(const f32x4*)(src + 4);
            u32x4 w; w.x = pk2(sg * c0[0], sg * c0[1]); w.y = pk2(sg * c0[2], sg * c0[3]); w.z = pk2(sg * c1[0], sg * c1[1]); w.w = pk2(sg * c1[2], sg * c1[3]); Cf[kk] = __builtin_bit_cast(bf16x8, w); }
        const float dv = INP(9)[l * 512 + 16 * g + fr]; float dd[8];
#pragma unroll
        for (int j = 0; j < 8; ++j) dd[j] = (8 * fq + j == fr) ? dv : 0.f;
        u32x4 w; w.x = pk2(dd[0], dd[1]); w.y = pk2(dd[2], dd[3]); w.z = pk2(dd[4], dd[5]); w.w = pk2(dd[6], dd[7]); Df = __builtin_bit_cast(bf16x8, w);
    }
    float sre = 0.f, sim = 0.f;
    const size_t sidx = (((size_t)b * 32 + g) * 64 + c) * 128 + p;
    if (FINAL) { sre = WSP(const float, WS_S5I)[sidx]; sim = WSP(const float, WS_S5I)[sidx + 64]; }
    const size_t row0 = (size_t)b * SEQ + (size_t)c * 128;
    const bf16* up = WSP(const bf16, WS_PROJ) + (row0 + fr) * MIXP + PC_S5U + 16 * g + 8 * (fq & 1);
    u32x4 aun = *(const u32x4*)up;
#pragma unroll 1
    for (int sb = 0; sb < 8; ++sb) {
        u32x4 au_ = aun; if (fq >= 2) au_ = (u32x4){0u, 0u, 0u, 0u};
        const bf16x8 au = __builtin_bit_cast(bf16x8, au_);
        if (sb < 7) aun = *(const u32x4*)(up + (size_t)(sb + 1) * 16 * MIXP);
#pragma unroll
        for (int nt = 0; nt < 8; ++nt) { const f32x4 a = __builtin_amdgcn_mfma_f32_16x16x32_bf16(au, Bf[nt], (f32x4){0.f, 0.f, 0.f, 0.f}, 0, 0, 0);
#pragma unroll
            for (int e = 0; e < 4; ++e) X[(4 * fq + e) * S5_XLD + 16 * nt + fr] = a[e]; }
#pragma unroll
        for (int t = 0; t < 16; ++t) { const float xr = X[t * S5_XLD + p], xi = X[t * S5_XLD + 64 + p];
            const float nre = abr * sre - abi * sim + xr, nim = abr * sim + abi * sre + xi; sre = nre; sim = nim;
            if (FINAL) { Sb[t * S5_SLD + p] = (bf16)f2bf(sre); Sb[t * S5_SLD + 64 + p] = (bf16)f2bf(sim); } }
        if (FINAL) {
            f32x4 y = (f32x4){0.f, 0.f, 0.f, 0.f};
#pragma unroll
            for (int kk = 0; kk < 4; ++kk) y = __builtin_amdgcn_mfma_f32_16x16x32_bf16(*(const LAS bf16x8*)(Sb + fr * S5_SLD + 32 * kk + 8 * fq), Cf[kk], y, 0, 0, 0);
            y = __builtin_amdgcn_mfma_f32_16x16x32_bf16(au, Df, y, 0, 0, 0);
#pragma unroll
            for (int e = 0; e < 4; ++e) WSP(bf16, WS_S5Z)[(row0 + sb * 16 + 4 * fq + e) * 512 + 16 * g + fr] = (bf16)f2bf(geluf_(y[e]));
        }
    }
    if (!FINAL) { WSP(float, WS_S5E)[sidx] = sre; WSP(float, WS_S5E)[sidx + 64] = sim; }
}
__device__ __forceinline__ void s5_carry(Frame& F, int l, int task) {
    const int b = task >> 5, g = task & 31, p = F.lane;
    const float lr = INP(3)[(l * 32 + g) * 64 + p], li = INP(4)[(l * 32 + g) * 64 + p]; const float dt = expf(INP(10)[l * 32 + g]);
    const float mag = expf(lr * dt); float sn, cs; sincosf(li * dt, &sn, &cs); float ar = mag * cs, ai = mag * sn;
#pragma unroll
    for (int i = 0; i < 7; ++i) { const float nr = ar * ar - ai * ai, ni = (ar + ar) * ai; ar = nr; ai = ni; }
    float rr = 0.f, ri = 0.f;
    const float* E = WSP(const float, WS_S5E) + (((size_t)b * 32 + g) * 64) * 128 + p; float* I = WSP(float, WS_S5I) + (((size_t)b * 32 + g) * 64) * 128 + p;
#pragma unroll 1
    for (int c0 = 0; c0 < 64; c0 += 32) { float er[32], ei[32];
#pragma unroll
        for (int j = 0; j < 32; ++j) { er[j] = E[(size_t)(c0 + j) * 128]; ei[j] = E[(size_t)(c0 + j) * 128 + 64]; }
#pragma unroll
        for (int j = 0; j < 32; ++j) { I[(size_t)(c0 + j) * 128] = rr; I[(size_t)(c0 + j) * 128 + 64] = ri;
            const float nr = ar * rr - ai * ri + er[j], ni = ar * ri + ai * rr + ei[j]; rr = nr; ri = ni; } }
}

constexpr int M2_CS = 0, M2_BS = 17408, M2_BST = 34816, M2_XT = 53248, M2_GS = 90112, M2_CUM = 107520, M2_DTV = 108544, M2_END = 109568;
constexpr int LDP = 136, LDT = 72, LDG = 68;
__device__ __forceinline__ void m2_stage(Frame& F, int l, int b, int c, int gr) {
    LAS bf16* Cs = (LAS bf16*)(F.lds + M2_CS); LAS bf16* Bs = (LAS bf16*)(F.lds + M2_BS); LAS bf16* BsT = (LAS bf16*)(F.lds + M2_BST); LAS bf16* XT = (LAS bf16*)(F.lds + M2_XT);
    LAS float* cum = (LAS float*)(F.lds + M2_CUM); LAS float* dtv = (LAS float*)(F.lds + M2_DTV);
    const int tid = F.tid; const size_t row0 = (size_t)b * SEQ + (size_t)c * 64;
    {
        const int kind = tid < 256 ? 0 : (tid < 384 ? 1 : 2); const int idx = kind == 0 ? tid : (kind == 1 ? tid - 256 : tid - 384);
        const int col = kind == 0 ? 256 * gr + idx : (kind == 1 ? 512 + 128 * gr + idx : 768 + 128 * gr + idx);
        const float* cwp = INP(19) + (size_t)l * 4 * 1024 + col; const float cw0 = cwp[0], cw1 = cwp[1024], cw2 = cwp[2048], cw3 = cwp[3072]; const float cb = INP(20)[l * 1024 + col];
        const bf16* px = WSP(const bf16, WS_PROJ) + row0 * MIXP + PC_XBC + col;
        float xm3 = 0.f, xm2 = 0.f, xm1 = 0.f;
        if (c > 0) { xm3 = bf2f(*(px - 3 * (ptrdiff_t)MIXP)); xm2 = bf2f(*(px - 2 * (ptrdiff_t)MIXP)); xm1 = bf2f(*(px - (ptrdiff_t)MIXP)); }
        bf16 xall[64];
#pragma unroll
        for (int j = 0; j < 64; ++j) xall[j] = px[(size_t)j * MIXP];
#pragma unroll
        for (int tb = 0; tb < 8; ++tb) {
            float vv[8];
#pragma unroll
            for (int j = 0; j < 8; ++j) { const float xv = bf2f(xall[tb * 8 + j]);
                vv[j] = siluf_(cb + cw0 * xm3 + cw1 * xm2 + cw2 * xm1 + cw3 * xv); xm3 = xm2; xm2 = xm1; xm1 = xv; }
            u32x4 w; w.x = pk2(vv[0], vv[1]); w.y = pk2(vv[2], vv[3]); w.z = pk2(vv[4], vv[5]); w.w = pk2(vv[6], vv[7]);
            if (kind == 0) *(LAS u32x4*)(XT + idx * LDT + tb * 8) = w;
            else if (kind == 1) { *(LAS u32x4*)(BsT + idx * LDT + tb * 8) = w;
#pragma unroll
                for (int j = 0; j < 8; ++j) Bs[(tb * 8 + j) * LDP + idx] = (bf16)f2bf(vv[j]); }
            else {
#pragma unroll
                for (int j = 0; j < 8; ++j) Cs[(tb * 8 + j) * LDP + idx] = (bf16)f2bf(vv[j]); }
        }
    }
    if (tid < 256) { const int hh = tid >> 6, t = tid & 63, h = 4 * gr + hh;
        const float dtr = bf2f(WSP(const bf16, WS_PROJ)[(row0 + t) * MIXP + PC_DT + h]);
        const float dt = softplusf_(dtr + INP(21)[l * 8 + h]); const float a = -expf(INP(22)[l * 8 + h]);
        float s = dt * a;
#pragma unroll
        for (int o = 1; o < 64; o <<= 1) { const float n = __shfl_up(s, o); if (t >= o) s += n; }
        dtv[hh * 64 + t] = dt; cum[hh * 64 + t] = s; }
    __syncthreads();
}
__device__ __forceinline__ bf16x8 ldfrag(const LAS bf16* p) { return *(const LAS bf16x8*)p; }
__device__ __forceinline__ void m2_pass1(Frame& F, int l, int task) {
    const int b = task >> 8, c = (task >> 1) & 127, gr = task & 1;
    m2_stage(F, l, b, c, gr);
    LAS bf16* BsT = (LAS bf16*)(F.lds + M2_BST); LAS bf16* XT = (LAS bf16*)(F.lds + M2_XT); LAS float* cum = (LAS float*)(F.lds + M2_CUM); LAS float* dtv = (LAS float*)(F.lds + M2_DTV);
    const int lane = F.lane, hh = F.wave >> 1, half = F.wave & 1, h = 4 * gr + hh; const int fr = lane & 15, fq = lane >> 4;
    const float clast = cum[hh * 64 + 63];
    f32x4 acc[2][8];
#pragma unroll
    for (int i = 0; i < 2; ++i)
#pragma unroll
        for (int j = 0; j < 8; ++j) acc[i][j] = (f32x4){0.f, 0.f, 0.f, 0.f};
#pragma unroll
    for (int kk = 0; kk < 2; ++kk) {
        float fj[8];
#pragma unroll
        for (int e = 0; e < 8; ++e) { const int j = 32 * kk + 8 * fq + e; fj[e] = dtv[hh * 64 + j] * __expf(clast - cum[hh * 64 + j]); }
        bf16x8 af[2];
#pragma unroll
        for (int pi = 0; pi < 2; ++pi) { const int p = 16 * (2 * half + pi) + fr; const u32x4 raw = *(const LAS u32x4*)(XT + (64 * hh + p) * LDT + 32 * kk + 8 * fq);
            u32x4 w; w.x = pk2(lo16(raw.x) * fj[0], hi16(raw.x) * fj[1]); w.y = pk2(lo16(raw.y) * fj[2], hi16(raw.y) * fj[3]); w.z = pk2(lo16(raw.z) * fj[4], hi16(raw.z) * fj[5]); w.w = pk2(lo16(raw.w) * fj[6], hi16(raw.w) * fj[7]);
            af[pi] = __builtin_bit_cast(bf16x8, w); }
#pragma unroll
        for (int nt = 0; nt < 8; ++nt) { const bf16x8 bfr = ldfrag(BsT + (16 * nt + fr) * LDT + 32 * kk + 8 * fq);
#pragma unroll
            for (int pi = 0; pi < 2; ++pi) acc[pi][nt] = __builtin_amdgcn_mfma_f32_16x16x32_bf16(af[pi], bfr, acc[pi][nt], 0, 0, 0); }
    }
    bf16* S = WSP(bf16, WS_M2S) + ((((size_t)b * 128 + c) * 8 + h) * 64) * 128;
#pragma unroll
    for (int pi = 0; pi < 2; ++pi)
#pragma unroll
        for (int nt = 0; nt < 8; ++nt)
#pragma unroll
            for (int e = 0; e < 4; ++e) S[(size_t)(16 * (2 * half + pi) + 4 * fq + e) * 128 + 16 * nt + fr] = (bf16)f2bf(acc[pi][nt][e]);
    if (half == 0 && lane == 0) WSP(float, WS_M2D)[((size_t)b * 128 + c) * 8 + h] = __expf(clast);
    __syncthreads();
}
__device__ __forceinline__ void m2_carry(Frame& F) {
    const int gt = F.blk * NTHR + F.tid, stride = F.G * NTHR, NE = NB * 8 * 8192;
    int vz; asm volatile("v_mov_b32 %0, 0" : "=v"(vz));
    for (int e0 = gt; e0 < NE; e0 += 2 * stride) {
        const int e1 = (e0 + stride < NE) ? e0 + stride : e0; const bool two = e1 != e0;
        bf16* S0 = WSP(bf16, WS_M2S) + (((size_t)(e0 >> 16) * 128) * 8 + ((e0 >> 13) & 7)) * 8192 + (e0 & 8191); const float* D0 = WSP(const float, WS_M2D) + (size_t)(e0 >> 16) * 128 * 8 + ((e0 >> 13) & 7) + vz;
        bf16* S1 = WSP(bf16, WS_M2S) + (((size_t)(e1 >> 16) * 128) * 8 + ((e1 >> 13) & 7)) * 8192 + (e1 & 8191); const float* D1 = WSP(const float, WS_M2D) + (size_t)(e1 >> 16) * 128 * 8 + ((e1 >> 13) & 7) + vz;
        float run0 = 0.f, run1 = 0.f;
#pragma unroll 1
        for (int c0 = 0; c0 < 128; c0 += 16) {
            bf16 t0[16], t1[16]; float d0[16], d1[16];
#pragma unroll
            for (int j = 0; j < 16; ++j) { t0[j] = S0[(size_t)(c0 + j) * 8 * 8192]; d0[j] = D0[(c0 + j) * 8]; t1[j] = S1[(size_t)(c0 + j) * 8 * 8192]; d1[j] = D1[(c0 + j) * 8]; }
#pragma unroll
            for (int j = 0; j < 16; ++j) { S0[(size_t)(c0 + j) * 8 * 8192] = (bf16)f2bf(run0); run0 = d0[j] * run0 + bf2f(t0[j]);
                if (two) S1[(size_t)(c0 + j) * 8 * 8192] = (bf16)f2bf(run1); run1 = d1[j] * run1 + bf2f(t1[j]); }
        }
    }
}
__device__ __forceinline__ void m2_pass2(Frame& F, int l, int task) {
    const int b = task >> 8, c = (task >> 1) & 127, gr = task & 1;
    m2_stage(F, l, b, c, gr);
    LAS bf16* Cs = (LAS bf16*)(F.lds + M2_CS); LAS bf16* Bs = (LAS bf16*)(F.lds + M2_BS); LAS bf16* XT = (LAS bf16*)(F.lds + M2_XT);
    LAS float* Gs = (LAS float*)(F.lds + M2_GS); LAS float* cum = (LAS float*)(F.lds + M2_CUM); LAS float* dtv = (LAS float*)(F.lds + M2_DTV);
    const int lane = F.lane, w = F.wave, fr = lane & 15, fq = lane >> 4;
#pragma unroll
    for (int q = 0; q < 2; ++q) { const int tile = 2 * w + q, it = tile >> 2, jt = tile & 3; f32x4 a = (f32x4){0.f, 0.f, 0.f, 0.f};
#pragma unroll
        for (int kk = 0; kk < 4; ++kk) a = __builtin_amdgcn_mfma_f32_16x16x32_bf16(ldfrag(Cs + (16 * it + fr) * LDP + 32 * kk + 8 * fq), ldfrag(Bs + (16 * jt + fr) * LDP + 32 * kk + 8 * fq), a, 0, 0, 0);
#pragma unroll
        for (int e = 0; e < 4; ++e) Gs[(16 * it + 4 * fq + e) * LDG + 16 * jt + fr] = a[e]; }
    __syncthreads();
    const int hh = w >> 1, half = w & 1, h = 4 * gr + hh;
    f32x4 accd[2][4], acco[2][4];
#pragma unroll
    for (int i = 0; i < 2; ++i)
#pragma unroll
        for (int j = 0; j < 4; ++j) { accd[i][j] = (f32x4){0.f, 0.f, 0.f, 0.f}; acco[i][j] = (f32x4){0.f, 0.f, 0.f, 0.f}; }
#pragma unroll
    for (int ii = 0; ii < 2; ++ii) { const int it = 2 * half + ii; const int i = 16 * it + fr; const float ci = cum[hh * 64 + i];
#pragma unroll
        for (int kk = 0; kk < 2; ++kk) { if (32 * kk > 16 * it + 15) continue;
            float wv[8];
#pragma unroll
            for (int e = 0; e < 8; ++e) { const int j = 32 * kk + 8 * fq + e; const float gv = Gs[i * LDG + j]; wv[e] = (j <= i) ? gv * __expf(ci - cum[hh * 64 + j]) * dtv[hh * 64 + j] : 0.f; }
            u32x4 ww; ww.x = pk2(wv[0], wv[1]); ww.y = pk2(wv[2], wv[3]); ww.z = pk2(wv[4], wv[5]); ww.w = pk2(wv[6], wv[7]);
            const bf16x8 af = __builtin_bit_cast(bf16x8, ww);
#pragma unroll
            for (int pt = 0; pt < 4; ++pt) accd[ii][pt] = __builtin_amdgcn_mfma_f32_16x16x32_bf16(af, ldfrag(XT + (64 * hh + 16 * pt + fr) * LDT + 32 * kk + 8 * fq), accd[ii][pt], 0, 0, 0); } }
    const bf16* S = WSP(const bf16, WS_M2S) + ((((size_t)b * 128 + c) * 8 + h) * 64) * 128;
#pragma unroll
    for (int kk = 0; kk < 4; ++kk) {
        bf16x8 bfr[4];
#pragma unroll
        for (int pt = 0; pt < 4; ++pt) bfr[pt] = *(const bf16x8*)(S + (size_t)(16 * pt + fr) * 128 + 32 * kk + 8 * fq);
#pragma unroll
        for (int ii = 0; ii < 2; ++ii) { const bf16x8 af = ldfrag(Cs + (16 * (2 * half + ii) + fr) * LDP + 32 * kk + 8 * fq);
#pragma unroll
            for (int pt = 0; pt < 4; ++pt) acco[ii][pt] = __builtin_amdgcn_mfma_f32_16x16x32_bf16(af, bfr[pt], acco[ii][pt], 0, 0, 0); }
    }
    const float dpar = INP(23)[l * 8 + h]; const size_t row0 = (size_t)b * SEQ + (size_t)c * 64;
#pragma unroll
    for (int ii = 0; ii < 2; ++ii)
#pragma unroll
        for (int e = 0; e < 4; ++e) { const int i = 16 * (2 * half + ii) + 4 * fq + e; const float ec = __expf(cum[hh * 64 + i]);
#pragma unroll
            for (int pt = 0; pt < 4; ++pt) { const int p = 16 * pt + fr;
                float y = accd[ii][pt][e] + ec * acco[ii][pt][e] + dpar * bf2f(XT[(64 * hh + p) * LDT + i]);
                const float z = bf2f(WSP(const bf16, WS_PROJ)[(row0 + i) * MIXP + PC_M2Z + 64 * h + p]);
                WSP(float, WS_M2Y)[(row0 + i) * 512 + 64 * h + p] = y * siluf_(z); } }
    __syncthreads();
}
__device__ __forceinline__ void m2_norm(Frame& F, int l, int gw, int ngw) {
    f32x4 g0 = *(const f32x4*)(INP(24) + l * 512 + 8 * F.lane), g1 = *(const f32x4*)(INP(24) + l * 512 + 8 * F.lane + 4);
    for (int m0 = gw; m0 < MTOK; m0 += 4 * ngw) { f32x4 a[4], b[4];
#pragma unroll
        for (int q = 0; q < 4; ++q) { const int m = m0 + q * ngw < MTOK ? m0 + q * ngw : m0; const f32x4* yp = (const f32x4*)(WSP(const float, WS_M2Y) + (size_t)m * 512 + 8 * F.lane); a[q] = yp[0]; b[q] = yp[1]; }
        asm volatile("" ::: "memory");
#pragma unroll
        for (int q = 0; q < 4; ++q) { const int m = m0 + q * ngw; if (m >= MTOK) break;
            const float ss = wave_sum((a[q].x * a[q].x + a[q].y * a[q].y) + (a[q].z * a[q].z + a[q].w * a[q].w) + (b[q].x * b[q].x + b[q].y * b[q].y) + (b[q].z * b[q].z + b[q].w * b[q].w));
            const float rs = 1.0f / sqrtf(ss * (1.f / 512.f) + 1e-6f);
            u32x4 w; w.x = pk2(a[q].x * rs * g0.x, a[q].y * rs * g0.y); w.y = pk2(a[q].z * rs * g0.z, a[q].w * rs * g0.w); w.z = pk2(b[q].x * rs * g1.x, b[q].y * rs * g1.y); w.w = pk2(b[q].z * rs * g1.z, b[q].w * rs * g1.w);
            *(u32x4*)(WSP(bf16, WS_YK) + (size_t)2 * MTOK * 512 + (size_t)m * 512 + 8 * F.lane) = w; }
        asm volatile("" ::: "memory"); }
}

constexpr int RP_LDA = 72, RP_LDB = 104;
#define RWP_WFRAG(dst, base, ldrow) do { const float* p_ = (base); u32x4 w_; w_.x = pk2(p_[0], p_[512]); w_.y = pk2(p_[1024], p_[1536]); w_.z = pk2(p_[2048], p_[2560]); w_.w = pk2(p_[3072], p_[3584]); dst = __builtin_bit_cast(bf16x8, w_); } while (0)
__device__ __forceinline__ void rw_pre(Frame& F, int l, int task) {
    LAS bf16* SM0 = (LAS bf16*)F.lds;
    const int tid = F.tid, lane = F.lane, hh = F.wave, fr = lane & 15, fq = lane >> 4;
    const float* mu = INP(25) + (size_t)l * RWC;
    const size_t rowb = (size_t)task * 128;
    const bf16* P = WSP(const bf16, WS_PROJ);
    const bool nofirst = (rowb & (SEQ - 1)) != 0;
    const int c4 = 64 * hh + 4 * fr;
    {
        bf16x8 Bw[4], Ba[4];
#pragma unroll
        for (int ct = 0; ct < 4; ++ct) { RWP_WFRAG(Bw[ct], INP(27) + ((size_t)l * 32 + 8 * fq) * 512 + c4 + ct, 512); RWP_WFRAG(Ba[ct], INP(29) + ((size_t)l * 32 + 8 * fq) * 512 + c4 + ct, 512); }
        const float* pw0 = INP(26) + l * 512 + c4; const float* pa0 = INP(28) + l * 512 + c4; const float* pkk = INP(31) + l * 512 + c4; const float* pka = INP(32) + l * 512 + c4; const float* prk = INP(33) + l * 512 + c4;
        const int sj = tid & 63, st0 = tid >> 6, st1 = 8 + (tid >> 6); const float smu = mu[1536 + sj];
        const bf16* sq = P + rowb * MIXP + PC_RW + 1536 + sj;
        bf16 sc0, sp0, sc1, sp1;
        u32x2 rkv[4][3], rkvp[3];
        const bf16* rq = P + (rowb + 4 * fq) * MIXP + PC_RW + c4;
#define RWP_STAGE_LOAD(sb) do { const size_t o_ = (size_t)((sb) * 16) * MIXP; sc0 = sq[o_ + (size_t)st0 * MIXP]; sc1 = sq[o_ + (size_t)st1 * MIXP]; sp1 = sq[o_ + (size_t)(st1 - 1) * MIXP]; \
            sp0 = (nofirst || (sb) > 0 || st0 > 0) ? sq[o_ + (size_t)st0 * MIXP - MIXP] : (bf16)0; } while (0)
#define RWP_STAGE_WRITE(buf) do { { const float pt_ = bf2f(sc0), pp_ = bf2f(sp0); const float pm_ = pt_ + (pp_ - pt_) * smu; SM0[(buf) * 1664 + st0 * RP_LDA + sj] = (bf16)f2bf(sj < 32 ? (1.0f - 2.0f * rcpf_(__expf(2.0f * pm_) + 1.0f)) : pm_); } \
            { const float pt_ = bf2f(sc1), pp_ = bf2f(sp1); const float pm_ = pt_ + (pp_ - pt_) * smu; SM0[(buf) * 1664 + st1 * RP_LDA + sj] = (bf16)f2bf(sj < 32 ? (1.0f - 2.0f * rcpf_(__expf(2.0f * pm_) + 1.0f)) : pm_); } } while (0)
#define RWP_RKV_LOAD(sb, cur, prev) do { const bf16* q_ = rq + (size_t)((sb) * 16) * MIXP; \
            _Pragma("unroll") for (int e_ = 0; e_ < 4; ++e_) _Pragma("unroll") for (int a_ = 0; a_ < 3; ++a_) cur[e_][a_] = *(const u32x2*)(q_ + (size_t)e_ * MIXP + 512 * a_); \
            const bool hp_ = nofirst || (sb) > 0 || fq > 0; \
            _Pragma("unroll") for (int a_ = 0; a_ < 3; ++a_) prev[a_] = hp_ ? *(const u32x2*)(q_ - (ptrdiff_t)MIXP + 512 * a_) : (u32x2){0u, 0u}; } while (0)
        RWP_STAGE_LOAD(0); RWP_RKV_LOAD(0, rkv, rkvp); RWP_STAGE_WRITE(0);
        __syncthreads();
#pragma unroll 1
        for (int sb = 0; sb < 8; ++sb) {
            if (sb < 7) { RWP_STAGE_LOAD(sb + 1); }
            const LAS bf16* SM = SM0 + (sb & 1) * 1664;
            const bf16x8 Aw = ldfrag(SM + fr * RP_LDA + 8 * fq), Aa = ldfrag(SM + fr * RP_LDA + 32 + 8 * fq);
            f32x4 aw[4], aa[4];
#pragma unroll
            for (int ct = 0; ct < 4; ++ct) { const f32x4 z = (f32x4){0.f, 0.f, 0.f, 0.f};
                aw[ct] = __builtin_amdgcn_mfma_f32_16x16x32_bf16(Aw, Bw[ct], z, 0, 0, 0); aa[ct] = __builtin_amdgcn_mfma_f32_16x16x32_bf16(Aa, Ba[ct], z, 0, 0, 0); }
            const size_t r0 = rowb + sb * 16 + 4 * fq;
            asm volatile("" ::: "memory");
            const f32x4 mu_r = *(const f32x4*)(mu + c4), mu_k = *(const f32x4*)(mu + 512 + c4), mu_v = *(const f32x4*)(mu + 1024 + c4);
            const f32x4 w0c = *(const f32x4*)pw0, a0c = *(const f32x4*)pa0, kkc = *(const f32x4*)pkk, kac = *(const f32x4*)pka, rkc = *(const f32x4*)prk;
#pragma unroll
            for (int e = 0; e < 4; ++e) { const size_t row = r0 + e; const size_t o = row * 512 + c4;
                const u32x2 pr_ = e == 0 ? rkvp[0] : rkv[e > 0 ? e - 1 : 0][0], pk_ = e == 0 ? rkvp[1] : rkv[e > 0 ? e - 1 : 0][1], pv_ = e == 0 ? rkvp[2] : rkv[e > 0 ? e - 1 : 0][2];
                const float rc[4] = {lo16(rkv[e][0].x), hi16(rkv[e][0].x), lo16(rkv[e][0].y), hi16(rkv[e][0].y)}, rp[4] = {lo16(pr_.x), hi16(pr_.x), lo16(pr_.y), hi16(pr_.y)};
                const float kc[4] = {lo16(rkv[e][1].x), hi16(rkv[e][1].x), lo16(rkv[e][1].y), hi16(rkv[e][1].y)}, kp[4] = {lo16(pk_.x), hi16(pk_.x), lo16(pk_.y), hi16(pk_.y)};
                const float vc[4] = {lo16(rkv[e][2].x), hi16(rkv[e][2].x), lo16(rkv[e][2].y), hi16(rkv[e][2].y)}, vp[4] = {lo16(pv_.x), hi16(pv_.x), lo16(pv_.y), hi16(pv_.y)};
                float rr[4], kpr[4], vv[4], kk[4], av[4], dec[4]; float ssp = 0.f, bonp = 0.f;
#pragma unroll
                for (int ct = 0; ct < 4; ++ct) {
                    rr[ct] = rc[ct] + (rp[ct] - rc[ct]) * mu_r[ct]; const float k = kc[ct] + (kp[ct] - kc[ct]) * mu_k[ct]; vv[ct] = vc[ct] + (vp[ct] - vc[ct]) * mu_v[ct];
                    const float wlog = -softplusf_(-(aw[ct][e] + w0c[ct])) - 0.5f; dec[ct] = __expf(-__expf(wlog)); av[ct] = sigmoidf_(aa[ct][e] + a0c[ct]);
                    kk[ct] = k * kkc[ct]; ssp += kk[ct] * kk[ct]; kpr[ct] = k * (1.0f + (av[ct] - 1.0f) * kac[ct]); bonp += rr[ct] * kpr[ct] * rkc[ct]; }
                const float ss = row16_sum(ssp), bon = row16_sum(bonp); const float rn = __builtin_amdgcn_rsqf(fmaxf(ss, 1e-24f));
                u32x2 w;
                w.x = pk2(rr[0], rr[1]); w.y = pk2(rr[2], rr[3]); *(u32x2*)(WSP(bf16, WS_RW_R) + o) = w;
                w.x = pk2(kpr[0], kpr[1]); w.y = pk2(kpr[2], kpr[3]); *(u32x2*)(WSP(bf16, WS_RW_K) + o) = w;
                w.x = pk2(vv[0], vv[1]); w.y = pk2(vv[2], vv[3]); *(u32x2*)(WSP(bf16, WS_RW_V) + o) = w;
                w.x = pk2(-kk[0] * rn, -kk[1] * rn); w.y = pk2(-kk[2] * rn, -kk[3] * rn); *(u32x2*)(WSP(bf16, WS_RW_A) + o) = w;
                w.x = pk2(kk[0] * rn * av[0], kk[1] * rn * av[1]); w.y = pk2(kk[2] * rn * av[2], kk[3] * rn * av[3]); *(u32x2*)(WSP(bf16, WS_RW_B) + o) = w;
                *(f32x4*)(WSP(float, WS_RW_DEC) + o) = (f32x4){dec[0], dec[1], dec[2], dec[3]};
                if (fr == 0) WSP(float, WS_RW_BON)[row * 8 + hh] = bon; }
            if (sb < 7) { RWP_RKV_LOAD(sb + 1, rkv, rkvp); RWP_STAGE_WRITE((sb + 1) & 1); }
            __syncthreads();
        }
#undef RWP_STAGE_LOAD
#undef RWP_STAGE_WRITE
#undef RWP_RKV_LOAD
    }
    {
        int tidb = F.tid; asm volatile("" : "+v"(tidb));
        const int tid = tidb, lane = tid & 63, fr = lane & 15, fq = lane >> 4; const int c4 = 64 * hh + 4 * fr;
        bf16x8 Bg[4][3];
#pragma unroll
        for (int ct = 0; ct < 4; ++ct)
#pragma unroll
            for (int kk = 0; kk < 3; ++kk) RWP_WFRAG(Bg[ct][kk], INP(30) + ((size_t)l * 96 + 32 * kk + 8 * fq) * 512 + c4 + ct, 512);
        int stk[3], sjj[3]; float smv[3]; bf16 sc[3], sp[3];
#pragma unroll
        for (int i = 0; i < 3; ++i) { const int idx = tid + 512 * i; stk[i] = idx / 96; sjj[i] = idx % 96; smv[i] = mu[1600 + sjj[i]]; }
        const bf16* sq = P + rowb * MIXP + PC_RW + 1600;
#define RWP_STAGE_LOAD(sb) do { _Pragma("unroll") for (int i_ = 0; i_ < 3; ++i_) { const bf16* q_ = sq + (size_t)((sb) * 16 + stk[i_]) * MIXP + sjj[i_]; sc[i_] = q_[0]; \
            sp[i_] = (nofirst || (sb) > 0 || stk[i_] > 0) ? *(q_ - (ptrdiff_t)MIXP) : (bf16)0; } } while (0)
#define RWP_STAGE_WRITE(buf) do { _Pragma("unroll") for (int i_ = 0; i_ < 3; ++i_) { const float pt_ = bf2f(sc[i_]), pp_ = bf2f(sp[i_]); \
            SM0[(buf) * 1664 + stk[i_] * RP_LDB + sjj[i_]] = (bf16)f2bf(sigmoidf_(pt_ + (pp_ - pt_) * smv[i_])); } } while (0)
        RWP_STAGE_LOAD(0); RWP_STAGE_WRITE(0);
        __syncthreads();
#pragma unroll 1
        for (int sb = 0; sb < 8; ++sb) {
            if (sb < 7) RWP_STAGE_LOAD(sb + 1);
            const LAS bf16* SM = SM0 + (sb & 1) * 1664;
            const bf16x8 Ag0 = ldfrag(SM + fr * RP_LDB + 8 * fq), Ag1 = ldfrag(SM + fr * RP_LDB + 32 + 8 * fq), Ag2 = ldfrag(SM + fr * RP_LDB + 64 + 8 * fq);
            f32x4 ag[4];
#pragma unroll
            for (int ct = 0; ct < 4; ++ct) { f32x4 g = __builtin_amdgcn_mfma_f32_16x16x32_bf16(Ag0, Bg[ct][0], (f32x4){0.f, 0.f, 0.f, 0.f}, 0, 0, 0);
                g = __builtin_amdgcn_mfma_f32_16x16x32_bf16(Ag1, Bg[ct][1], g, 0, 0, 0); ag[ct] = __builtin_amdgcn_mfma_f32_16x16x32_bf16(Ag2, Bg[ct][2], g, 0, 0, 0); }
            const size_t r0 = rowb + sb * 16 + 4 * fq;
#pragma unroll
            for (int e = 0; e < 4; ++e) { u32x2 w; w.x = pk2(ag[0][e], ag[1][e]); w.y = pk2(ag[2][e], ag[3][e]); *(u32x2*)(WSP(bf16, WS_RW_G) + (r0 + e) * 512 + c4) = w; }
            if (sb < 7) RWP_STAGE_WRITE((sb + 1) & 1);
            __syncthreads();
        }
#undef RWP_STAGE_LOAD
#undef RWP_STAGE_WRITE
    }
}
constexpr int RC_G1 = 0, RC_G2 = 8192, RC_Q1 = 10240, RC_Q2 = 12288, RC_GAM = 13312, RC_VT = 13568, RC_BYTES = 16384;
constexpr size_t WS_RWC = WS_PROJ;
constexpr int CP_IMG = 0, CP_MAT = 9216, CP_P2 = 13568, CP_Q2 = 14656;
constexpr int CP_P1I = 0, CP_BGI = 3072, CP_Q1I = 6144;
__device__ __forceinline__ void rw_chunk_prep(Frame& F, int task) {
    int lane = F.lane; asm volatile("" : "+v"(lane)); const int fr = lane & 15, fq = lane >> 4; const int b = task >> 12, h = (task >> 9) & 7, c = task & 511;
    LAS unsigned char* wl = F.lds + F.wave * WAVE_LDS;
    LAS bf16* IMG = (LAS bf16*)(wl + CP_IMG); LAS float* MAT = (LAS float*)(wl + CP_MAT); LAS float* P2m = (LAS float*)(wl + CP_P2); LAS float* Q2m = (LAS float*)(wl + CP_Q2);
    unsigned char* rec = F.ws + WS_RWC + (size_t)task * RC_BYTES;
    const size_t e0 = ((size_t)b * SEQ + (size_t)c * 16) * 512 + 64 * h + lane;
    float At[16], Bt[16], Kt[16], Rt[16]; float gT;
    { float wv[16]; bf16 av[16], bv[16], kv[16], rv[16];
#pragma unroll
      for (int t = 0; t < 16; ++t) { const size_t o = e0 + (size_t)t * 512; wv[t] = WSP(const float, WS_RW_DEC)[o]; av[t] = WSP(const bf16, WS_RW_A)[o]; bv[t] = WSP(const bf16, WS_RW_B)[o]; kv[t] = WSP(const bf16, WS_RW_K)[o]; rv[t] = WSP(const bf16, WS_RW_R)[o]; }
      float g = 1.0f;
#pragma unroll
      for (int t = 0; t < 16; ++t) { const float gp = g; g *= wv[t]; const float inv = rcpf_(g);
          At[t] = bf2f(av[t]) * gp; Bt[t] = bf2f(bv[t]) * inv; Kt[t] = bf2f(kv[t]) * inv; Rt[t] = bf2f(rv[t]) * g;
          IMG[0 * 1152 + t * 72 + lane] = (bf16)f2bf(At[t]); IMG[1 * 1152 + t * 72 + lane] = (bf16)f2bf(Bt[t]); IMG[2 * 1152 + t * 72 + lane] = (bf16)f2bf(Kt[t]); IMG[3 * 1152 + t * 72 + lane] = (bf16)f2bf(Rt[t]); }
      gT = g; }
    { unsigned vp[8];
#pragma unroll
      for (int t = 0; t < 16; t += 2) vp[t >> 1] = (unsigned)WSP(const bf16, WS_RW_V)[e0 + (size_t)t * 512] | ((unsigned)WSP(const bf16, WS_RW_V)[e0 + (size_t)(t + 1) * 512] << 16);
      u32x4* d = (u32x4*)(rec + RC_VT + lane * 32); d[0] = (u32x4){vp[0], vp[1], vp[2], vp[3]}; d[1] = (u32x4){vp[4], vp[5], vp[6], vp[7]};
      ((float*)(rec + RC_GAM))[lane] = gT; }
    { f32x4 nab = (f32x4){0.f, 0.f, 0.f, 0.f}, nak = nab, mbr = nab, mkr = nab;
#pragma unroll
      for (int kk = 0; kk < 2; ++kk) { const int o = fr * 72 + 32 * kk + 8 * fq;
          const bf16x8 fa = ldfrag(IMG + 0 * 1152 + o), fb = ldfrag(IMG + 1 * 1152 + o), fk = ldfrag(IMG + 2 * 1152 + o), frr = ldfrag(IMG + 3 * 1152 + o);
          nab = __builtin_amdgcn_mfma_f32_16x16x32_bf16(fb, fa, nab, 0, 0, 0); nak = __builtin_amdgcn_mfma_f32_16x16x32_bf16(fk, fa, nak, 0, 0, 0);
          mbr = __builtin_amdgcn_mfma_f32_16x16x32_bf16(fb, frr, mbr, 0, 0, 0); mkr = __builtin_amdgcn_mfma_f32_16x16x32_bf16(fk, frr, mkr, 0, 0, 0); }
#pragma unroll
      for (int e = 0; e < 4; ++e) { const int s_ = 4 * fq + e, t_ = fr; const int o = s_ * 17 + t_;
          MAT[0 * 272 + o] = s_ < t_ ? nab[e] : 0.f; MAT[1 * 272 + o] = s_ < t_ ? nak[e] : 0.f; MAT[2 * 272 + o] = s_ <= t_ ? mbr[e] : 0.f; MAT[3 * 272 + o] = s_ <= t_ ? mkr[e] : 0.f; } }
    float P1[16], P2[16];
#pragma unroll
    for (int t = 0; t < 16; ++t) { float p1 = At[t], p2 = MAT[1 * 272 + fr * 17 + t];
#pragma unroll
        for (int s_ = 0; s_ < t; ++s_) { const float n = MAT[0 * 272 + s_ * 17 + t]; p1 += P1[s_] * n; p2 += P2[s_] * n; }
        P1[t] = p1; P2[t] = p2; asm volatile("" ::: "memory"); }
    LAS bf16* Q1I = (LAS bf16*)(wl + CP_Q1I);
#pragma unroll
    for (int t = 0; t < 16; ++t) { float q1 = Rt[t], q2 = MAT[3 * 272 + fr * 17 + t];
#pragma unroll
        for (int s_ = 0; s_ <= t; ++s_) { const float m = MAT[2 * 272 + s_ * 17 + t]; q1 += P1[s_] * m; q2 += P2[s_] * m; }
        Q1I[t * 72 + lane] = (bf16)f2bf(q1); if (lane < 16) { Q2m[lane * 17 + t] = q2; P2m[lane * 17 + t] = P2[t]; }
        asm volatile("" ::: "memory"); }
    { LAS bf16* P1I = (LAS bf16*)(wl + CP_P1I); LAS bf16* BGI = (LAS bf16*)(wl + CP_BGI);
      u32x4 w0, w1;
      w0.x = pk2(P1[0], P1[1]); w0.y = pk2(P1[2], P1[3]); w0.z = pk2(P1[4], P1[5]); w0.w = pk2(P1[6], P1[7]); w1.x = pk2(P1[8], P1[9]); w1.y = pk2(P1[10], P1[11]); w1.z = pk2(P1[12], P1[13]); w1.w = pk2(P1[14], P1[15]);
      *(LAS u32x4*)(P1I + lane * 24) = w0; *(LAS u32x4*)(P1I + lane * 24 + 8) = w1;
      w0.x = pk2(Bt[0] * gT, Bt[1] * gT); w0.y = pk2(Bt[2] * gT, Bt[3] * gT); w0.z = pk2(Bt[4] * gT, Bt[5] * gT); w0.w = pk2(Bt[6] * gT, Bt[7] * gT);
      w1.x = pk2(Bt[8] * gT, Bt[9] * gT); w1.y = pk2(Bt[10] * gT, Bt[11] * gT); w1.z = pk2(Bt[12] * gT, Bt[13] * gT); w1.w = pk2(Bt[14] * gT, Bt[15] * gT);
      *(LAS u32x4*)(BGI + lane * 24) = w0; *(LAS u32x4*)(BGI + lane * 24 + 8) = w1;
      const u32x4 z4 = (u32x4){0u, 0u, 0u, 0u};
      bf16x8 Af[4], Bf[4];
#pragma unroll
      for (int i = 0; i < 4; ++i) { u32x4 ta = z4, tb = z4; if (fq < 2) { ta = *(const LAS u32x4*)(P1I + (16 * i + fr) * 24 + 8 * fq); tb = *(const LAS u32x4*)(BGI + (16 * i + fr) * 24 + 8 * fq); }
          Af[i] = __builtin_bit_cast(bf16x8, ta); Bf[i] = __builtin_bit_cast(bf16x8, tb); }
#pragma unroll
      for (int j = 0; j < 4; ++j)
#pragma unroll
          for (int s_ = 0; s_ < 2; ++s_) { const f32x4 lo = __builtin_amdgcn_mfma_f32_16x16x32_bf16(Af[2 * s_], Bf[j], (f32x4){0.f, 0.f, 0.f, 0.f}, 0, 0, 0);
              const f32x4 hi = __builtin_amdgcn_mfma_f32_16x16x32_bf16(Af[2 * s_ + 1], Bf[j], (f32x4){0.f, 0.f, 0.f, 0.f}, 0, 0, 0);
              u32x4 w; w.x = pk2(lo[0], lo[1]); w.y = pk2(lo[2], lo[3]); w.z = pk2(hi[0], hi[1]); w.w = pk2(hi[2], hi[3]);
              *(u32x4*)(rec + RC_G1 + ((j * 2 + s_) * 64 + lane) * 16) = w; } }
    { float g2v[16];
#pragma unroll
      for (int t = 0; t < 16; ++t) { float acc = Kt[t];
#pragma unroll
          for (int s_ = 0; s_ < 16; ++s_) acc += P2m[t * 17 + s_] * Bt[s_];
          g2v[t] = acc * gT; asm volatile("" ::: "memory"); }
      u32x4 w0, w1; w0.x = pk2(g2v[0], g2v[1]); w0.y = pk2(g2v[2], g2v[3]); w0.z = pk2(g2v[4], g2v[5]); w0.w = pk2(g2v[6], g2v[7]); w1.x = pk2(g2v[8], g2v[9]); w1.y = pk2(g2v[10], g2v[11]); w1.z = pk2(g2v[12], g2v[13]); w1.w = pk2(g2v[14], g2v[15]);
      u32x4* d = (u32x4*)(rec + RC_G2 + lane * 32); d[0] = w0; d[1] = w1; }
    {
#pragma unroll
      for (int s_ = 0; s_ < 2; ++s_) { const u32x2 lo = *(const LAS u32x2*)(Q1I + fr * 72 + 32 * s_ + 4 * fq), hi = *(const LAS u32x2*)(Q1I + fr * 72 + 32 * s_ + 16 + 4 * fq);
          *(u32x4*)(rec + RC_Q1 + (s_ * 64 + lane) * 16) = (u32x4){lo.x, lo.y, hi.x, hi.y}; } }
    { u32x4 w = (u32x4){0u, 0u, 0u, 0u};
      if (fq < 2) { float q[8];
#pragma unroll
          for (int j = 0; j < 8; ++j) q[j] = Q2m[(8 * fq + j) * 17 + fr];
          w.x = pk2(q[0], q[1]); w.y = pk2(q[2], q[3]); w.z = pk2(q[4], q[5]); w.w = pk2(q[6], q[7]); }
      *(u32x4*)(rec + RC_Q2 + lane * 16) = w; }
}
__device__ __forceinline__ void rw_chunk_step(const LAS unsigned char* rc, f32x4 (&X)[4], float* yo, int w, int lane, int fr, int fq) {
    const u32x4 z4 = (u32x4){0u, 0u, 0u, 0u};
    u32x4 b0, b1; b0.x = pk2(X[0][0], X[0][1]); b0.y = pk2(X[0][2], X[0][3]); b0.z = pk2(X[1][0], X[1][1]); b0.w = pk2(X[1][2], X[1][3]);
    b1.x = pk2(X[2][0], X[2][1]); b1.y = pk2(X[2][2], X[2][3]); b1.z = pk2(X[3][0], X[3][1]); b1.w = pk2(X[3][2], X[3][3]);
    const bf16x8 Bx0 = __builtin_bit_cast(bf16x8, b0), Bx1 = __builtin_bit_cast(bf16x8, b1);
    u32x4 vt = z4; if (fq < 2) vt = *(const LAS u32x4*)(rc + RC_VT + (16 * w + fr) * 32 + 16 * fq);
    const bf16x8 Vf = __builtin_bit_cast(bf16x8, vt);
    f32x4 Y = (f32x4){0.f, 0.f, 0.f, 0.f};
    Y = __builtin_amdgcn_mfma_f32_16x16x32_bf16(*(const LAS bf16x8*)(rc + RC_Q1 + (0 * 64 + lane) * 16), Bx0, Y, 0, 0, 0);
    Y = __builtin_amdgcn_mfma_f32_16x16x32_bf16(*(const LAS bf16x8*)(rc + RC_Q1 + (1 * 64 + lane) * 16), Bx1, Y, 0, 0, 0);
    Y = __builtin_amdgcn_mfma_f32_16x16x32_bf16(*(const LAS bf16x8*)(rc + RC_Q2 + lane * 16), Vf, Y, 0, 0, 0);
#pragma unroll
    for (int j = 0; j < 4; ++j) { const f32x4 gm = *(const LAS f32x4*)(rc + RC_GAM + (16 * j + 4 * fq) * 4);
        f32x4 C = X[j] * gm;
        C = __builtin_amdgcn_mfma_f32_16x16x32_bf16(*(const LAS bf16x8*)(rc + RC_G1 + ((j * 2 + 0) * 64 + lane) * 16), Bx0, C, 0, 0, 0);
        C = __builtin_amdgcn_mfma_f32_16x16x32_bf16(*(const LAS bf16x8*)(rc + RC_G1 + ((j * 2 + 1) * 64 + lane) * 16), Bx1, C, 0, 0, 0);
        u32x4 g2 = z4; if (fq < 2) g2 = *(const LAS u32x4*)(rc + RC_G2 + (16 * j + fr) * 32 + 16 * fq);
        C = __builtin_amdgcn_mfma_f32_16x16x32_bf16(__builtin_bit_cast(bf16x8, g2), Vf, C, 0, 0, 0);
        X[j] = C; }
#pragma unroll
    for (int e = 0; e < 4; ++e) yo[(size_t)(4 * fq + e) * 512] = Y[e];
}
__device__ __forceinline__ void rw_scan2(Frame& F, int task) {
    const int tid = F.tid, lane = F.lane, w = F.wave, fr = lane & 15, fq = lane >> 4;
    const unsigned char* recs = F.ws + WS_RWC + (size_t)task * 512 * RC_BYTES;
    constexpr int NP = SEQ / 32;
    if (w >= 4) {
        const int lt = tid - 256;
        const u32x4* src = (const u32x4*)recs + lt;
        u32x4 rg[4][8];
#pragma unroll
        for (int u = 0; u < 4; ++u)
#pragma unroll
            for (int i = 0; i < 8; ++i) rg[u][i] = src[(size_t)u * 2048 + i * 256];
#pragma unroll 1
        for (int g4 = 0; g4 < NP / 4; ++g4) {
#pragma unroll
            for (int u = 0; u < 4; ++u) { const int g = 4 * g4 + u;
                LAS u32x4* dst = (LAS u32x4*)(F.lds + ((2 * g) & 7) * RC_BYTES) + lt;
#pragma unroll
                for (int i = 0; i < 8; ++i) dst[i * 256] = rg[u][i];
                if (g + 4 < NP) {
#pragma unroll
                    for (int i = 0; i < 8; ++i) rg[u][i] = src[(size_t)(g + 4) * 2048 + i * 256]; }
                __syncthreads(); }
        }
        __syncthreads();
    } else {
        const int b = task >> 3, h = task & 7;
        f32x4 X[4];
#pragma unroll
        for (int j = 0; j < 4; ++j) X[j] = (f32x4){0.f, 0.f, 0.f, 0.f};
        float* yo = WSP(float, WS_RW_Y) + ((size_t)b * SEQ) * 512 + 64 * h + 16 * w + fr;
        __syncthreads();
#pragma unroll 1
        for (int g = 0; g < NP; ++g) {
            rw_chunk_step(F.lds + ((2 * g) & 7) * RC_BYTES, X, yo + (size_t)(2 * g) * 16 * 512, w, lane, fr, fq);
            rw_chunk_step(F.lds + ((2 * g + 1) & 7) * RC_BYTES, X, yo + (size_t)(2 * g + 1) * 16 * 512, w, lane, fr, fq);
            __syncthreads();
        }
    }
}
__device__ __forceinline__ void rw_post(Frame& F, int l, int gw, int ngw) {
    const int lane = F.lane;
    const f32x4 g0 = *(const f32x4*)(INP(34) + l * 512 + 8 * lane), g1 = *(const f32x4*)(INP(34) + l * 512 + 8 * lane + 4);
    const f32x4 b0 = *(const f32x4*)(INP(35) + l * 512 + 8 * lane), b1 = *(const f32x4*)(INP(35) + l * 512 + 8 * lane + 4);
    for (int m0 = gw; m0 < MTOK; m0 += 4 * ngw) { f32x4 ya4[4], yb4[4]; u32x4 vr4[4], gr4[4]; float bon4[4];
#pragma unroll
        for (int q = 0; q < 4; ++q) { const int m = m0 + q * ngw < MTOK ? m0 + q * ngw : m0; const size_t o = (size_t)m * 512 + 8 * lane;
            ya4[q] = *(const f32x4*)(WSP(const float, WS_RW_Y) + o); yb4[q] = *(const f32x4*)(WSP(const float, WS_RW_Y) + o + 4);
            vr4[q] = *(const u32x4*)(WSP(const bf16, WS_RW_V) + o); gr4[q] = *(const u32x4*)(WSP(const bf16, WS_RW_G) + o); bon4[q] = WSP(const float, WS_RW_BON)[(size_t)m * 8 + (lane >> 3)]; }
        asm volatile("" ::: "memory");
#pragma unroll
        for (int q = 0; q < 4; ++q) { const int m = m0 + q * ngw; if (m >= MTOK) break; const size_t o = (size_t)m * 512 + 8 * lane;
            const f32x4 ya = ya4[q], yb = yb4[q];
            float y[8] = {ya.x, ya.y, ya.z, ya.w, yb.x, yb.y, yb.z, yb.w};
            float s = 0.f;
#pragma unroll
            for (int j = 0; j < 8; ++j) s += y[j];
            s += __shfl_xor(s, 1); s += __shfl_xor(s, 2); s += __shfl_xor(s, 4); const float mean = s * (1.f / 64.f);
            float qv = 0.f;
#pragma unroll
            for (int j = 0; j < 8; ++j) { y[j] -= mean; qv += y[j] * y[j]; }
            qv += __shfl_xor(qv, 1); qv += __shfl_xor(qv, 2); qv += __shfl_xor(qv, 4); const float rs = 1.0f / sqrtf(qv * (1.f / 64.f) + 64e-5f);
            const u32x4 vr = vr4[q], gr_ = gr4[q]; const float bon = bon4[q];
            const float vv[8] = {lo16(vr.x), hi16(vr.x), lo16(vr.y), hi16(vr.y), lo16(vr.z), hi16(vr.z), lo16(vr.w), hi16(vr.w)};
            const float gg[8] = {lo16(gr_.x), hi16(gr_.x), lo16(gr_.y), hi16(gr_.y), lo16(gr_.z), hi16(gr_.z), lo16(gr_.w), hi16(gr_.w)};
            const float lg[8] = {g0.x, g0.y, g0.z, g0.w, g1.x, g1.y, g1.z, g1.w}, lb[8] = {b0.x, b0.y, b0.z, b0.w, b1.x, b1.y, b1.z, b1.w};
            float ov[8];
#pragma unroll
            for (int j = 0; j < 8; ++j) ov[j] = (y[j] * rs * lg[j] + lb[j] + bon * vv[j]) * gg[j];
            u32x4 w; w.x = pk2(ov[0], ov[1]); w.y = pk2(ov[2], ov[3]); w.z = pk2(ov[4], ov[5]); w.w = pk2(ov[6], ov[7]);
            *(u32x4*)(WSP(bf16, WS_YK) + (size_t)3 * MTOK * 512 + o) = w; }
        asm volatile("" ::: "memory"); }
}

#ifndef GATE_NA
#define GATE_NA 17
#endif
#ifndef PHMASK
#define PHMASK 0xFFFFFFFFu
#endif
#define PH(n) (((PHMASK) >> (n)) & 1u)
#ifndef REPMASK
#define REPMASK 0u
#endif
#define NREP(n) ((((REPMASK) >> (n)) & 1u) ? 2 : 1)
#ifndef TPSMASK
#define TPSMASK 0u
#endif
#define TPS_B(n) unsigned long long tps_##n = 0ull; if (((TPSMASK) >> (n)) & 1u) tps_##n = __builtin_amdgcn_s_memrealtime()
#define TPS_E(n) do { if (((TPSMASK) >> (n)) & 1u) { const unsigned long long t1_ = __builtin_amdgcn_s_memrealtime(); const unsigned long long d_ = t1_ - tps_##n; while (__builtin_amdgcn_s_memrealtime() - t1_ < d_) __builtin_amdgcn_s_sleep(8); } } while (0)
#ifndef TPMASK
#define TPMASK 0u
#endif
#define TP(n) do { if (((TPMASK) >> (n)) & 1u) { const unsigned long long t1_ = __builtin_amdgcn_s_memrealtime(); const unsigned long long d_ = t1_ - tp0; while (__builtin_amdgcn_s_memrealtime() - t1_ < d_) __builtin_amdgcn_s_sleep(8); tp0 = __builtin_amdgcn_s_memrealtime(); } else if (TPMASK) tp0 = __builtin_amdgcn_s_memrealtime(); } while (0)
template <class T> __device__ __forceinline__ T* launder_ptr(T* p) { const unsigned long long w = (unsigned long long)p; unsigned lo = __builtin_amdgcn_readfirstlane((unsigned)w), hi = __builtin_amdgcn_readfirstlane((unsigned)(w >> 32));
    asm volatile("" : "+s"(lo), "+s"(hi)); return (T*)(GAS T*)(((unsigned long long)hi << 32) | lo); }
#define PHASE_BEGIN() do { F.ws = launder_ptr(F.ws); F.out = launder_ptr(F.out); { unsigned la_ = __builtin_amdgcn_readfirstlane((unsigned)(size_t)F.lds); int bk_ = __builtin_amdgcn_readfirstlane(F.blk); asm volatile("" : "+s"(la_), "+s"(bk_)); F.lds = (LAS unsigned char*)(size_t)la_; F.blk = bk_; } { int wv_ = __builtin_amdgcn_readfirstlane(F.wave); asm volatile("" : "+s"(wv_)); F.wave = wv_; } { int ln_; asm volatile("v_mbcnt_lo_u32_b32 %0, -1, 0\n\tv_mbcnt_hi_u32_b32 %0, -1, %0\n\ts_nop 1" : "=v"(ln_)); F.tid = F.wave * 64 + ln_; } F.lane = F.tid & 63; } while (0)
__global__ void __launch_bounds__(NTHR, 2) hybrid_fwd(Args args) {
    extern __shared__ __attribute__((aligned(16))) unsigned char lds_raw[];
    Frame F;
    F.lds = (LAS unsigned char*)lds_raw; F.out = args.out; F.ws = args.ws;
    F.tid = threadIdx.x; F.lane = F.tid & 63; F.wave = __builtin_amdgcn_readfirstlane(F.tid >> 6); F.blk = blockIdx.x; F.G = gridDim.x;
    volatile LAS unsigned* MISC = (volatile LAS unsigned*)(F.lds + LDS_MISC);
    if (F.tid < 64) MISC[F.tid] = 0u;
    if (F.tid < 45) { const unsigned long long p = ((const __attribute__((address_space(4))) unsigned long long*)__builtin_amdgcn_kernarg_segment_ptr())[F.tid]; MISC[64 + 2 * F.tid] = (unsigned)p; MISC[64 + 2 * F.tid + 1] = (unsigned)(p >> 32); }
    __syncthreads();
    XcdBarrier bar = xcd_barrier_post((unsigned*)(F.ws + WS_CTL) + CW_BAR, MISC + 8);
#define gw (F.blk * NWAVES + F.wave)
#define NGW (F.G * NWAVES)
#define glds (F.lds)

    unsigned long long tp0 = TPMASK ? __builtin_amdgcn_s_memrealtime() : 0ull;
#pragma unroll 1
    for (int l = 0; l < DEPTH; ++l) {
        const float* xin = (l == 0) ? INP(0) : F.out;
        PHASE_BEGIN();
        for (int rep_ = 0; rep_ < NREP(0); ++rep_) if (PH(0)) { convert_weights(F, l);
            for (int nb = F.blk; nb < NGATE / 32 + 2 * (FF / 32); nb += F.G) {
                const int seg = nb < NGATE / 32 ? 0 : (nb < NGATE / 32 + FF / 32 ? 1 : 2);
                const float* Wp = seg == 0 ? INP(2) + (size_t)l * DM * INC : (seg == 1 ? INP(39) : INP(40)) + (size_t)l * DM * FF;
                signed char* W8p = seg == 0 ? WSP(signed char, WS_WIN) + (size_t)MIXP * DM * 2 : (seg == 1 ? WSP(signed char, WS_WFG) : WSP(signed char, WS_WFU));
                convert_cols_i8(F, Wp, seg == 0 ? INC : FF, seg == 0 ? MIXC : 0, nb - (seg == 0 ? 0 : (seg == 1 ? NGATE / 32 : NGATE / 32 + FF / 32)), W8p, WSP(float, WS_SB) + 16384 * seg, 0); }
            { const float* cw = INP(41) + (size_t)l * 3 * FF; const float* cb = INP(42) + (size_t)l * FF;
              for (int c = F.blk * 512 + F.tid; c < FF; c += F.G * 512) { WSP(unsigned, WS_SB)[65536 + c] = pk2(cw[c], cw[FF + c]); WSP(unsigned, WS_SB)[65536 + 8192 + c] = pk2(cw[2 * FF + c], cb[c]); } } }
        PHASE_BEGIN();
        for (int rep_ = 0; rep_ < NREP(1); ++rep_) if (PH(1)) rmsnorm_rows(F, l == 0 ? INP(0) : nullptr, (const bf16*)F.out, INP(1) + (size_t)l * DM, WSP(bf16, WS_H), nullptr, WSP(unsigned, WS_A8), WSP(float, WS_SA));
        xcd_barrier(bar); TP(0);
        PHASE_BEGIN();
        for (int rep_ = 0; rep_ < NREP(2); ++rep_) if (PH(2)) { pg8::Gemm g{WSP(const bf16, WS_H), WSP(const bf16, WS_WIN), MTOK, MIXP, DM}; pg8::StaticOrder S; S.init(MTOK, MIXP, F.G, F.blk);
          pg8::EpiStore<0> E{WSP(bf16, WS_PROJ), MIXP}; pg8::gemm_phase(glds, g, S, E, F.tid); }
        PHASE_BEGIN();
        if (PH(2) && F.blk >= 128) {
          pg8::Gemm g{WSP(const bf16, WS_A8), (const bf16*)(WSP(const signed char, WS_WIN) + (size_t)MIXP * DM * 2), MTOK, NGATE, DM / 2};
          pg8::SplitOrder S; S.init(MTOK, NGATE, 128, F.blk - 128, 4096 - 256, 2);
          pg8::EpiGateU8 E{WSP(unsigned char, WS_GATES), WSP(const float, WS_SA), WSP(const float, WS_SB)}; pg8::gemm_phase(glds, g, S, E, F.tid); }
        xcd_barrier(bar); TP(1);
        PHASE_BEGIN();
        TPS_B(3); for (int rep_ = 0; rep_ < NREP(3); ++rep_) if (PH(3)) for (int t = F.blk; t < MTOK / 128; t += F.G) rw_pre(F, l, t); TPS_E(3);
        PHASE_BEGIN();
        TPS_B(4); for (int rep_ = 0; rep_ < NREP(4); ++rep_) if (PH(4)) for (int t = F.blk; t < 1024; t += F.G) m2_pass1(F, l, t); TPS_E(4);
        PHASE_BEGIN();
        TPS_B(5); for (int rep_ = 0; rep_ < NREP(5); ++rep_) if (PH(5)) for (int t = gw; t < 8192; t += NGW) s5_task<false>(F, l, t); TPS_E(5);
        PHASE_BEGIN();
        TPS_B(6); for (int rep_ = 0; rep_ < NREP(6); ++rep_) if (PH(6)) for (int t = gw; t < 2048; t += NGW) lru_task<false>(F, l, t); TPS_E(6);
        xcd_barrier(bar); TP(2);
        PHASE_BEGIN();
        for (int rep_ = 0; rep_ < NREP(7); ++rep_) if (PH(7)) m2_carry(F);
        PHASE_BEGIN();
        for (int rep_ = 0; rep_ < NREP(8); ++rep_) if (PH(8)) for (int t = gw; t < 128; t += NGW) s5_carry(F, l, t);
        PHASE_BEGIN();
        for (int rep_ = 0; rep_ < NREP(9); ++rep_) if (PH(9)) for (int t = NGW - 1 - gw; t < 32; t += NGW) lru_carry(F, t);
        xcd_barrier(bar); TP(3);
        PHASE_BEGIN();
        TPS_B(10); for (int rep_ = 0; rep_ < NREP(10); ++rep_) if (PH(10)) for (int t = F.blk; t < 1024; t += F.G) m2_pass2(F, l, t); TPS_E(10);
        PHASE_BEGIN();
        TPS_B(11); for (int rep_ = 0; rep_ < NREP(11); ++rep_) if (PH(11)) for (int t = gw; t < 8192; t += NGW) s5_task<true>(F, l, t); TPS_E(11);
        PHASE_BEGIN();
        TPS_B(12); for (int rep_ = 0; rep_ < NREP(12); ++rep_) if (PH(12)) for (int t = gw; t < 2048; t += NGW) lru_task<true>(F, l, t); TPS_E(12);
        xcd_barrier(bar); TP(4);
        PHASE_BEGIN();
        for (int rep_ = 0; rep_ < NREP(14); ++rep_) if (PH(14)) {
            { pg8::Gemm g{WSP(const bf16, WS_S5Z), WSP(const bf16, WS_WGLU), MTOK, 512, 512}; pg8::StaticOrder S; S.init(MTOK, 512, F.G, F.blk);
              pg8::EpiGlu E{WSP(const bf16, WS_S5Z), WSP(bf16, WS_YK)}; pg8::gemm_phase(glds, g, S, E, F.tid); }
            m2_norm(F, l, gw, NGW);
        }
        PHASE_BEGIN();
        TPS_B(24); for (int rep_ = 0; rep_ < NREP(24); ++rep_) if (PH(24)) for (int t = gw; t < NB * 8 * 512; t += NGW) rw_chunk_prep(F, t); TPS_E(24);
        xcd_barrier(bar); TP(5);
        PHASE_BEGIN();
        if (F.blk < 32) { if (PH(13)) rw_scan2(F, F.blk); }
        PHASE_BEGIN();
        if (PH(16)) { pg8::Gemm g{WSP(const bf16, WS_A8), (const bf16*)(WSP(const signed char, WS_WIN) + (size_t)MIXP * DM * 2), MTOK, NGATE, DM / 2};
          pg8::SplitOrder S; if (F.blk >= 32) S.init(MTOK, NGATE, 224, F.blk - 32, 0, GATE_NA); else S.init(MTOK, NGATE, 32, F.blk, 224 * GATE_NA, (4096 - 256 - 224 * GATE_NA) / 32);
          pg8::EpiGateU8 E{WSP(unsigned char, WS_GATES), WSP(const float, WS_SA), WSP(const float, WS_SB)}; pg8::gemm_phase(glds, g, S, E, F.tid); }
        xcd_barrier(bar); TP(6);
        PHASE_BEGIN();
        for (int rep_ = 0; rep_ < NREP(15); ++rep_) if (PH(15)) rw_post(F, l, gw, NGW);
        xcd_barrier(bar); TP(7);
        PHASE_BEGIN();
        for (int rep_ = 0; rep_ < NREP(17); ++rep_) if (PH(17)) { pg8::Gemm g{WSP(const bf16, WS_YK), WSP(const bf16, WS_WPK), 4 * MTOK, 4 * DM, 512}; pg8::OrderYK S{F.G, F.blk};
          pg8::EpiGateAcc E{WSP(const unsigned char, WS_GATES), WSP(bf16, WS_MERGED)}; pg8::gemm_phase(glds, g, S, E, F.tid); }
        xcd_barrier(bar); TP(8);
        PHASE_BEGIN();
        for (int rep_ = 0; rep_ < NREP(18); ++rep_) if (PH(18)) { pg8::Gemm g{WSP(const bf16, WS_MERGED), WSP(const bf16, WS_WOUT), MTOK, DM, DM}; pg8::StaticOrder S; S.init(MTOK, DM, F.G, F.blk);
          pg8::EpiAddX E{l == 0 ? INP(0) : nullptr, (const bf16*)F.out, (bf16*)F.out, DM}; pg8::gemm_phase(glds, g, S, E, F.tid); }
        xcd_barrier(bar); TP(9);
        PHASE_BEGIN();
        for (int rep_ = 0; rep_ < NREP(19); ++rep_) if (PH(19)) rmsnorm_rows(F, nullptr, (const bf16*)F.out, INP(38) + (size_t)l * DM, nullptr, nullptr, WSP(unsigned, WS_A8), WSP(float, WS_SA));
        xcd_barrier(bar); TP(10);
        PHASE_BEGIN();
        for (int rep_ = 0; rep_ < NREP(20); ++rep_) if (PH(20)) { pg8::Gemm g{WSP(const bf16, WS_A8), WSP(const bf16, WS_WFG), MTOK, FF, DM / 2}; pg8::StaticOrder S; S.init(MTOK, FF, F.G, F.blk);
          pg8::EpiStoreI8<0> E{WSP(bf16, WS_FG), FF, WSP(const float, WS_SA), WSP(const float, WS_SB) + 16384}; pg8::gemm_phase(glds, g, S, E, F.tid); }
        xcd_barrier(bar); TP(11);
        PHASE_BEGIN();
        for (int rep_ = 0; rep_ < NREP(21); ++rep_) if (PH(21)) { pg8::Gemm g{WSP(const bf16, WS_A8), WSP(const bf16, WS_WFU), MTOK, FF, DM / 2}; pg8::StaticOrder S; S.init(MTOK, FF, F.G, F.blk);
          pg8::EpiFfnUp<true> E{WSP(const bf16, WS_FG), WSP(bf16, WS_HID), WSP(const unsigned, WS_SB) + 65536, WSP(const unsigned, WS_SB) + 65536 + 8192, WSP(const float, WS_SA), WSP(const float, WS_SB) + 32768}; pg8::gemm_phase(glds, g, S, E, F.tid); }
        xcd_barrier(bar); TP(12);
        PHASE_BEGIN();
        for (int rep_ = 0; rep_ < NREP(22); ++rep_) if (PH(22)) { pg8::Gemm g{WSP(const bf16, WS_HID), WSP(const bf16, WS_WFD), MTOK, DM, FF}; pg8::StaticOrder S; S.init(MTOK, DM, F.G, F.blk);
          pg8::EpiAddX E{nullptr, (const bf16*)F.out, l == DEPTH - 1 ? WSP(bf16, WS_H) : (bf16*)F.out, DM}; pg8::gemm_phase(glds, g, S, E, F.tid); }
        xcd_barrier(bar); TP(13);
    }
    PHASE_BEGIN();
    for (int rep_ = 0; rep_ < NREP(23); ++rep_) if (PH(23)) rmsnorm_rows(F, nullptr, WSP(const bf16, WS_H), INP(44), nullptr, F.out);
}

extern "C" void kernel_launch(void* const* d_in, const int* in_sizes, int n_in, void* d_out, int out_size, void* d_ws, size_t ws_size, hipStream_t stream) {
    static int grid = 0;
    if (grid == 0) {
        if (n_in != 45 || in_sizes[0] != MTOK * DM || out_size != MTOK * DM || ws_size < WS_END) {
            fprintf(stderr, "kernel_launch: unexpected shapes/workspace (n_in %d, in0 %d, out %d, ws %zu, need %zu); nothing launched\n", n_in, n_in > 0 ? in_sizes[0] : -1, out_size, ws_size, (size_t)WS_END); grid = -1; return; }
        int dev = 0, cus = 0, per_cu = 0;
        if (hipGetDevice(&dev) != hipSuccess || hipDeviceGetAttribute(&cus, hipDeviceAttributeMultiprocessorCount, dev) != hipSuccess) { grid = -1; return; }
        if (hipFuncSetAttribute((const void*)hybrid_fwd, hipFuncAttributeMaxDynamicSharedMemorySize, LDS_BYTES) != hipSuccess) { fprintf(stderr, "kernel_launch: hipFuncSetAttribute failed\n"); grid = -1; return; }
        if (hipOccupancyMaxActiveBlocksPerMultiprocessor(&per_cu, (const void*)hybrid_fwd, NTHR, LDS_BYTES) != hipSuccess || per_cu < 1) { fprintf(stderr, "kernel_launch: occupancy query says %d\n", per_cu); }
        (void)hipGetLastError();
        grid = cus;
        if (grid != 256) fprintf(stderr, "kernel_launch: note: %d CUs\n", grid);
    }
    if (grid < 0) return;
    if (hipMemsetAsync((char*)d_ws + WS_CTL, 0, CTL_BYTES, stream) != hipSuccess) return;
    Args a{};
    for (int i = 0; i < 45; ++i) a.in[i] = (const float*)d_in[i];
    a.out = (float*)d_out; a.ws = (unsigned char*)d_ws;
    hipLaunchKernelGGL(hybrid_fwd, dim3(grid), dim3(NTHR), LDS_BYTES, stream, a);
}
```

```cpp
#include <hip/hip_runtime.h>
#include <cstdio>
#include <cstdint>

#define LAS __attribute__((address_space(3)))
typedef unsigned short bf16;
typedef short bf16x8 __attribute__((ext_vector_type(8)));
typedef float f32x4 __attribute__((ext_vector_type(4)));
typedef float f32x2 __attribute__((ext_vector_type(2)));
typedef unsigned u32x4 __attribute__((ext_vector_type(4)));
typedef unsigned u32x2 __attribute__((ext_vector_type(2)));
typedef __bf16 bf16v2 __attribute__((ext_vector_type(2)));
typedef int i32x4 __attribute__((ext_vector_type(4)));

constexpr int NB = 4, SEQ = 8192, DM = 2048, MTOK = NB * SEQ, DEPTH = 4;
constexpr int MIXC = 4776, MIXP = 4864, INC = 12968, FF = 6144, NGATE = 8192;
constexpr int RWC = 1696;
constexpr int PC_S5U = 0, PC_LRX = 512, PC_LRG = 1024, PC_M2Z = 1536, PC_XBC = 2048, PC_DT = 3072, PC_RW = 3080;

constexpr size_t MiB = 1u << 20;
constexpr size_t WS_CTL = 0, CTL_BYTES = 1 * MiB;
constexpr size_t WS_WIN = 1 * MiB, WS_WPK = 52 * MiB, WS_WOUT = 60 * MiB, WS_WFG = 68 * MiB, WS_WFU = 92 * MiB, WS_WFD = 116 * MiB, WS_WGLU = 140 * MiB;
constexpr size_t WS_SA = 141 * MiB, WS_SB = 142 * MiB;
constexpr size_t WS_A8 = 1538 * MiB;
constexpr size_t WS_H = 144 * MiB, WS_YK = 272 * MiB, WS_PROJ = 400 * MiB, WS_MERGED = 400 * MiB, WS_GATES = 900 * MiB;
constexpr size_t WS_RW_R = 1216 * MiB, WS_RW_K = 1248 * MiB, WS_RW_V = 1280 * MiB, WS_RW_A = 1312 * MiB, WS_RW_B = 1344 * MiB, WS_RW_G = 1376 * MiB,
                 WS_RW_DEC = 1408 * MiB, WS_RW_Y = 1472 * MiB, WS_RW_BON = 1536 * MiB, WS_END = 1602 * MiB;
constexpr size_t WS_S5Z = 704 * MiB, WS_S5E = 736 * MiB, WS_S5I = 740 * MiB, WS_LRE = 744 * MiB, WS_LRA = 745 * MiB, WS_LRI = 746 * MiB;
constexpr size_t WS_M2S = 752 * MiB, WS_M2D = 816 * MiB, WS_M2Y = 820 * MiB;
constexpr size_t WS_FG = 400 * MiB, WS_HID = 784 * MiB;
constexpr int CW_BAR = 4096;

__device__ __forceinline__ float bf2f(bf16 b) { return __uint_as_float(((unsigned)b) << 16); }
__device__ __forceinline__ unsigned f2bf(float f) { const __bf16 b = (__bf16)f; return (unsigned)__builtin_bit_cast(unsigned short, b); }
__device__ __forceinline__ unsigned pk2(float lo, float hi) { const f32x2 v = {lo, hi}; const bf16v2 b = __builtin_convertvector(v, bf16v2); return __builtin_bit_cast(unsigned, b); }
__device__ __forceinline__ float lo16(unsigned w) { return __uint_as_float(w << 16); }
__device__ __forceinline__ float hi16(unsigned w) { return __uint_as_float(w & 0xffff0000u); }
__device__ __forceinline__ float rcpf_(float x) { return __builtin_amdgcn_rcpf(x); }
__device__ __forceinline__ float sigmoidf_(float x) { return rcpf_(1.0f + __expf(-x)); }
__device__ __forceinline__ float siluf_(float x) { return x * rcpf_(1.0f + __expf(-x)); }
__device__ __forceinline__ float geluf_(float x) { const float u = 0.7978845608028654f * (x + 0.044715f * x * x * x); return x * rcpf_(1.0f + __expf(-2.0f * u)); }
__device__ __forceinline__ float softplusf_(float x) { return fmaxf(x, 0.f) + __logf(1.0f + __expf(-fabsf(x))); }
__device__ __forceinline__ float row16_sum(float v) {
    v += __int_as_float(__builtin_amdgcn_update_dpp(0, __float_as_int(v), 0x128, 0xf, 0xf, true));
    v += __int_as_float(__builtin_amdgcn_update_dpp(0, __float_as_int(v), 0x124, 0xf, 0xf, true));
    v += __int_as_float(__builtin_amdgcn_update_dpp(0, __float_as_int(v), 0x122, 0xf, 0xf, true));
    v += __int_as_float(__builtin_amdgcn_update_dpp(0, __float_as_int(v), 0x121, 0xf, 0xf, true));
    return v;
}
__device__ __forceinline__ float wave_sum(float v) {
    v = row16_sum(v);
    const float a = __int_as_float(__builtin_amdgcn_readlane(__float_as_int(v), 0)), b = __int_as_float(__builtin_amdgcn_readlane(__float_as_int(v), 16));
    const float c = __int_as_float(__builtin_amdgcn_readlane(__float_as_int(v), 32)), d = __int_as_float(__builtin_amdgcn_readlane(__float_as_int(v), 48));
    return (a + b) + (c + d);
}
__device__ __forceinline__ float wave_max(float v) {
    v = fmaxf(v, __int_as_float(__builtin_amdgcn_update_dpp(0, __float_as_int(v), 0x128, 0xf, 0xf, true)));
    v = fmaxf(v, __int_as_float(__builtin_amdgcn_update_dpp(0, __float_as_int(v), 0x124, 0xf, 0xf, true)));
    v = fmaxf(v, __int_as_float(__builtin_amdgcn_update_dpp(0, __float_as_int(v), 0x122, 0xf, 0xf, true)));
    v = fmaxf(v, __int_as_float(__builtin_amdgcn_update_dpp(0, __float_as_int(v), 0x121, 0xf, 0xf, true)));
    const float a = __int_as_float(__builtin_amdgcn_readlane(__float_as_int(v), 0)), b = __int_as_float(__builtin_amdgcn_readlane(__float_as_int(v), 16));
    const float c = __int_as_float(__builtin_amdgcn_readlane(__float_as_int(v), 32)), d = __int_as_float(__builtin_amdgcn_readlane(__float_as_int(v), 48));
    return fmaxf(fmaxf(a, b), fmaxf(c, d));
}
__device__ __forceinline__ unsigned q8x4(float a, float b, float c, float d, float inv) {
    const int q0 = (int)rintf(a * inv), q1 = (int)rintf(b * inv), q2 = (int)rintf(c * inv), q3 = (int)rintf(d * inv);
    return (unsigned)(q0 & 0xff) | ((unsigned)(q1 & 0xff) << 8) | ((unsigned)(q2 & 0xff) << 16) | ((unsigned)q3 << 24);
}
__device__ __forceinline__ float rdlane(float v, int l) { return __int_as_float(__builtin_amdgcn_readlane(__float_as_int(v), l)); }

namespace pg8 {
constexpr int BM = 256, BK = 64, HALF = 128, HTB = HALF * BK * 2, STAGE_BYTES = 8 * HTB, NXCD = 8, WGM = 4;
__host__ __device__ __forceinline__ int lds_byte(int r, int c) { const int st = (r >> 4) * 2 + (c >> 5), rr = r & 15, cc = c & 31, ob = rr * 64 + cc * 2; return st * 1024 + (ob ^ (((ob >> 9) & 1) << 5)); }
__host__ __device__ __forceinline__ void stage_rc(int b, int& R, int& C) { const int st = b / 1024, sb = b % 1024, swz = sb ^ (((sb >> 9) & 1) << 5); R = (st >> 1) * 16 + swz / 64; C = (st & 1) * 32 + (swz % 64) / 2; }
__host__ __device__ __forceinline__ int perm32(int rho) { const int n = rho >> 4, i = rho & 15; return 8 * (i >> 2) + 4 * n + (i & 3); }
struct Unit { int pm, pn; };
struct Gemm { const bf16* A; const bf16* Bt; int M, N, K; };
struct StaticOrder {
    int nM, nN, nwg, G, c;
    __device__ void init(int M, int N, int G_, int c_) { nM = M / BM; nN = N / BM; nwg = nM * nN; G = G_; c = c_; }
    __device__ bool next(int i, Unit& u) const {
        const long L = (long)i * G + c; if (L >= nwg || c < 0) return false;
        int wgid = (int)L; { const int q = nwg / NXCD, r = nwg % NXCD, xcd = wgid % NXCD, off = wgid / NXCD; wgid = (xcd < r ? xcd * (q + 1) : r * (q + 1) + (xcd - r) * q) + off; }
        const int nig = WGM * nN, gid = wgid / nig, fm = gid * WGM, gsz = (nM - fm) < WGM ? (nM - fm) : WGM;
        u.pm = fm + ((wgid % nig) % gsz); u.pn = (wgid % nig) / gsz; return true;
    }
    __device__ __forceinline__ void a_ready(const Unit&) const {}
    __device__ __forceinline__ void done(const Unit&) const {}
};
struct SplitOrder {
    int nM, nN, nwg, G, c, base, n;
    __device__ void init(int M, int N, int G_, int c_, int base_, int n_) { nM = M / BM; nN = N / BM; nwg = nM * nN; G = G_; c = c_; base = base_; n = n_; }
    __device__ bool next(int i, Unit& u) const {
        if (i >= n) return false; const long L = (long)base + (long)i * G + c; if (L >= nwg) return false;
        int wgid = (int)L; { const int q = nwg / NXCD, r = nwg % NXCD, xcd = wgid % NXCD, off = wgid / NXCD; wgid = (xcd < r ? xcd * (q + 1) : r * (q + 1) + (xcd - r) * q) + off; }
        const int nig = WGM * nN, gid = wgid / nig, fm = gid * WGM, gsz = (nM - fm) < WGM ? (nM - fm) : WGM;
        u.pm = fm + ((wgid % nig) % gsz); u.pn = (wgid % nig) / gsz; return true;
    }
    __device__ __forceinline__ void a_ready(const Unit&) const {}
    __device__ __forceinline__ void done(const Unit&) const {}
};
struct OrderYK {
    int G, c;
    __device__ bool next(int i, Unit& u) const {
        const int k = i & 3; const long T = (long)(i >> 2) * G + c; if (T >= 1024) return false;
        int wgid = (int)T; { const int xcd = wgid % 8, off = wgid / 8; wgid = xcd * 128 + off; }
        const int gid = wgid / 32, fm = gid * 4; const int pm = fm + ((wgid % 32) % 4), pn = (wgid % 32) / 4;
        u.pm = k * 128 + pm; u.pn = k * 8 + pn; return true;
    }
    __device__ __forceinline__ void a_ready(const Unit&) const {}
    __device__ __forceinline__ void done(const Unit&) const {}
};
__device__ __forceinline__ unsigned cvt_pk_bf16(float lo, float hi) { return pk2(lo, hi); }

template <bool I8> struct AccOf { typedef f32x4 T; }; template <> struct AccOf<true> { typedef i32x4 T; };
template <int ACT> struct EpiStore {
    static constexpr bool I8 = false; static constexpr bool PERM = true;
    struct Pre {}; __device__ __forceinline__ void prefetch(Pre&, const Unit&, int, int, int, int) const {}
    bf16* O; int ldc;
    __device__ __forceinline__ void operator()(const f32x4 (&acc)[2][2][4][2], const Unit& u, int wr, int wc, int fr, int fq, const Pre&) const {
        const int row0 = u.pm * BM + wr * 64 + fr, col0 = u.pn * BM + wc * 32 + 8 * fq;
#pragma unroll
        for (int ai = 0; ai < 2; ++ai)
#pragma unroll
            for (int m = 0; m < 4; ++m) { bf16* rowp = O + (size_t)(row0 + ai * HALF + m * 16) * ldc + col0;
#pragma unroll
                for (int bj = 0; bj < 2; ++bj) { f32x4 v0 = acc[ai][bj][m][0], v1 = acc[ai][bj][m][1];
                    if (ACT == 1) {
#pragma unroll
                        for (int j = 0; j < 4; ++j) { v0[j] = sigmoidf_(v0[j]); v1[j] = sigmoidf_(v1[j]); } }
                    u32x4 w; w.x = cvt_pk_bf16(v0[0], v0[1]); w.y = cvt_pk_bf16(v0[2], v0[3]); w.z = cvt_pk_bf16(v1[0], v1[1]); w.w = cvt_pk_bf16(v1[2], v1[3]);
                    *(u32x4*)(rowp + bj * HALF) = w; } }
    }
};
template <int ACT> struct EpiStoreI8 {
    static constexpr bool I8 = true; static constexpr bool PERM = true;
    bf16* O; int ldc; const float* sa; const float* sb;
    struct Pre { float sav[4]; f32x4 s[2]; };
    __device__ __forceinline__ void prefetch(Pre& P, const Unit& u, int wr, int wc, int fr, int fq) const {
        const int row0 = u.pm * BM + wr * 64 + fr, col0 = u.pn * BM + wc * 32 + 8 * fq;
#pragma unroll
        for (int i = 0; i < 4; ++i) P.sav[i] = sa[row0 + i * 16];
        P.s[0] = *(const f32x4*)(sb + col0); P.s[1] = *(const f32x4*)(sb + col0 + 4);
    }
    __device__ __forceinline__ void operator()(const i32x4 (&acc)[2][2][4][2], const Unit& u, int wr, int wc, int fr, int fq, const Pre& P) const {
        const int row0 = u.pm * BM + wr * 64 + fr, col0 = u.pn * BM + wc * 32 + 8 * fq;
        float sav[8];
#pragma unroll
        for (int i = 0; i < 8; ++i) { sav[i] = i < 4 ? P.sav[i] : sa[row0 + HALF + (i & 3) * 16]; if (ACT == 1) sav[i] *= -1.4426950408889634f; }
        const f32x4 t0 = *(const f32x4*)(sb + col0 + HALF), t1 = *(const f32x4*)(sb + col0 + HALF + 4);
#pragma unroll
        for (int bj = 0; bj < 2; ++bj) { f32x4 s0 = P.s[0], s1 = P.s[1]; if (bj) { s0 = t0; s1 = t1; }
            const f32x2 sp[4] = {{s0[0], s0[1]}, {s0[2], s0[3]}, {s1[0], s1[1]}, {s1[2], s1[3]}};
#pragma unroll
            for (int ai = 0; ai < 2; ++ai)
#pragma unroll
                for (int m = 0; m < 4; ++m) { const float ra = sav[ai * 4 + m]; const f32x2 rav = {ra, ra}; const i32x4 a0 = acc[ai][bj][m][0], a1 = acc[ai][bj][m][1];
                    f32x2 x[4] = {{(float)a0[0], (float)a0[1]}, {(float)a0[2], (float)a0[3]}, {(float)a1[0], (float)a1[1]}, {(float)a1[2], (float)a1[3]}};
#pragma unroll
                    for (int p = 0; p < 4; ++p) { x[p] = x[p] * (sp[p] * rav);
                        if (ACT == 1) { f32x2 e = {__builtin_amdgcn_exp2f(x[p][0]), __builtin_amdgcn_exp2f(x[p][1])}; e = e + (f32x2){1.0f, 1.0f}; x[p][0] = rcpf_(e[0]); x[p][1] = rcpf_(e[1]); } }
                    u32x4 w; w.x = cvt_pk_bf16(x[0][0], x[0][1]); w.y = cvt_pk_bf16(x[1][0], x[1][1]); w.z = cvt_pk_bf16(x[2][0], x[2][1]); w.w = cvt_pk_bf16(x[3][0], x[3][1]);
                    *(u32x4*)(O + (size_t)(row0 + ai * HALF + m * 16) * ldc + col0 + bj * HALF) = w; } }
    }
};
struct EpiGateU8 {
    static constexpr bool I8 = true; static constexpr bool PERM = true;
    unsigned char* O; const float* sa; const float* sb;
    struct Pre { float sav[2]; f32x4 s[2]; };
    __device__ __forceinline__ void prefetch(Pre& P, const Unit& u, int wr, int wc, int fr, int fq) const {
        const int row0 = u.pm * BM + wr * 64 + fr, col0 = u.pn * BM + wc * 64 + 16 * fq;
#pragma unroll
        for (int i = 0; i < 2; ++i) P.sav[i] = sa[row0 + i * 16];
        P.s[0] = *(const f32x4*)(sb + col0); P.s[1] = *(const f32x4*)(sb + col0 + 4);
    }
    __device__ __forceinline__ void operator()(const i32x4 (&acc)[2][2][4][2], const Unit& u, int wr, int wc, int fr, int fq, const Pre& P) const {
        const int row0 = u.pm * BM + wr * 64 + fr, col0 = u.pn * BM + wc * 64 + 16 * fq;
        float sav[8];
#pragma unroll
        for (int i = 0; i < 8; ++i) sav[i] = (i < 2 ? P.sav[i] : sa[row0 + (i >> 2) * HALF + (i & 3) * 16]) * -1.4426950408889634f;
        const f32x4 t0 = *(const f32x4*)(sb + col0 + 8), t1 = *(const f32x4*)(sb + col0 + 12);
#pragma unroll
        for (int ai = 0; ai < 2; ++ai) { unsigned d[4][4];
#pragma unroll
            for (int bj = 0; bj < 2; ++bj) { f32x4 s0 = P.s[0], s1 = P.s[1]; if (bj) { s0 = t0; s1 = t1; }
                const f32x2 sp[4] = {{s0[0], s0[1]}, {s0[2], s0[3]}, {s1[0], s1[1]}, {s1[2], s1[3]}};
#pragma unroll
                for (int m = 0; m < 4; ++m) { const float ra = sav[ai * 4 + m]; const f32x2 rav = {ra, ra}; const i32x4 a0 = acc[ai][bj][m][0], a1 = acc[ai][bj][m][1];
                    f32x2 x[4] = {{(float)a0[0], (float)a0[1]}, {(float)a0[2], (float)a0[3]}, {(float)a1[0], (float)a1[1]}, {(float)a1[2], (float)a1[3]}};
                    unsigned tb[8];
#pragma unroll
                    for (int p = 0; p < 4; ++p) { x[p] = x[p] * (sp[p] * rav);
#pragma unroll
                        for (int h = 0; h < 2; ++h) { const float e = __builtin_amdgcn_exp2f(x[p][h]); const float r = rcpf_(e * (1.0f / 255.0f) + (1.0f / 255.0f));
                            tb[2 * p + h] = __float_as_uint(r + 8388608.0f); } }
#pragma unroll
                    for (int n = 0; n < 2; ++n) { const unsigned w01 = __builtin_amdgcn_perm(tb[4 * n + 1], tb[4 * n], 0x0c0c0400u), w23 = __builtin_amdgcn_perm(tb[4 * n + 3], tb[4 * n + 2], 0x0c0c0400u);
                        d[m][2 * bj + n] = __builtin_amdgcn_perm(w23, w01, 0x05040100u); } }
                __builtin_amdgcn_sched_barrier(0); }
#pragma unroll
            for (int m = 0; m < 4; ++m) { u32x4 w; w.x = d[m][0]; w.y = d[m][1]; w.z = d[m][2]; w.w = d[m][3];
                *(u32x4*)(O + (size_t)(row0 + ai * HALF + m * 16) * NGATE + col0) = w; } }
    }
};
struct EpiAddX {
    static constexpr bool I8 = false; static constexpr bool PERM = true;
    struct Pre {}; __device__ __forceinline__ void prefetch(Pre&, const Unit&, int, int, int, int) const {}
    const float* basef; const bf16* baseb; bf16* out; int ldc;
    __device__ __forceinline__ void operator()(const f32x4 (&acc)[2][2][4][2], const Unit& u, int wr, int wc, int fr, int fq, const Pre&) const {
        const int row0 = u.pm * BM + wr * 64 + fr, col0 = u.pn * BM + wc * 32 + 8 * fq;
#pragma unroll
        for (int ai = 0; ai < 2; ++ai) { u32x4 w[4][2];
            if (!basef) {
#pragma unroll
                for (int m = 0; m < 4; ++m)
#pragma unroll
                    for (int bj = 0; bj < 2; ++bj) w[m][bj] = *(const u32x4*)(baseb + (size_t)(row0 + ai * HALF + m * 16) * ldc + col0 + bj * HALF); }
            asm volatile("" ::: "memory");
#pragma unroll
            for (int m = 0; m < 4; ++m)
#pragma unroll
                for (int bj = 0; bj < 2; ++bj) { const size_t p = (size_t)(row0 + ai * HALF + m * 16) * ldc + col0 + bj * HALF; f32x4 b0, b1;
                    if (basef) { b0 = *(const f32x4*)(basef + p); b1 = *(const f32x4*)(basef + p + 4); }
                    else { const u32x4 ww = w[m][bj]; b0 = (f32x4){lo16(ww.x), hi16(ww.x), lo16(ww.y), hi16(ww.y)}; b1 = (f32x4){lo16(ww.z), hi16(ww.z), lo16(ww.w), hi16(ww.w)}; }
                    b0 = b0 + acc[ai][bj][m][0]; b1 = b1 + acc[ai][bj][m][1];
                    u32x4 o; o.x = cvt_pk_bf16(b0[0], b0[1]); o.y = cvt_pk_bf16(b0[2], b0[3]); o.z = cvt_pk_bf16(b1[0], b1[1]); o.w = cvt_pk_bf16(b1[2], b1[3]);
                    *(u32x4*)(out + p) = o; }
            asm volatile("" ::: "memory"); }
    }
};
struct EpiGateAcc {
    static constexpr bool I8 = false; static constexpr bool PERM = true;
    struct Pre {}; __device__ __forceinline__ void prefetch(Pre&, const Unit&, int, int, int, int) const {}
    const unsigned char* gates; bf16* merged;
    __device__ __forceinline__ void operator()(const f32x4 (&acc)[2][2][4][2], const Unit& u, int wr, int wc, int fr, int fq, const Pre&) const {
        const int k = u.pn >> 3, pn = u.pn & 7, pm = u.pm & 127;
        const int row0 = pm * BM + wr * 64 + fr, col0 = pn * BM + wc * 32 + 8 * fq;
        u32x2 g[2][4]; u32x4 pv[2][4];
#define GA_LOAD(buf, q_) do { _Pragma("unroll") for (int m_ = 0; m_ < 4; ++m_) { const size_t r_ = (size_t)(row0 + ((q_) >> 1) * HALF + m_ * 16); const int c_ = col0 + ((q_) & 1) * HALF; \
            g[buf][m_] = *(const u32x2*)(gates + r_ * NGATE + k * DM + c_); pv[buf][m_] = (u32x4){0u, 0u, 0u, 0u}; if (k) pv[buf][m_] = *(const u32x4*)(merged + r_ * DM + c_); } } while (0)
        GA_LOAD(0, 0);
#pragma unroll
        for (int q = 0; q < 4; ++q) { const int ai = q >> 1, bj = q & 1, cur = q & 1;
            if (q < 3) GA_LOAD(cur ^ 1, q + 1);
            asm volatile("" ::: "memory");
#pragma unroll
            for (int m = 0; m < 4; ++m) { const size_t r = (size_t)(row0 + ai * HALF + m * 16); const int c = col0 + bj * HALF;
                const f32x4 v0 = acc[ai][bj][m][0], v1 = acc[ai][bj][m][1]; const u32x2 gg = g[cur][m]; const u32x4 pp = pv[cur][m];
                float o[8];
                o[0] = lo16(pp.x) + (float)(gg.x & 0xffu) * v0[0]; o[1] = hi16(pp.x) + (float)((gg.x >> 8) & 0xffu) * v0[1]; o[2] = lo16(pp.y) + (float)((gg.x >> 16) & 0xffu) * v0[2]; o[3] = hi16(pp.y) + (float)(gg.x >> 24) * v0[3];
                o[4] = lo16(pp.z) + (float)(gg.y & 0xffu) * v1[0]; o[5] = hi16(pp.z) + (float)((gg.y >> 8) & 0xffu) * v1[1]; o[6] = lo16(pp.w) + (float)((gg.y >> 16) & 0xffu) * v1[2]; o[7] = hi16(pp.w) + (float)(gg.y >> 24) * v1[3];
                u32x4 w; w.x = cvt_pk_bf16(o[0], o[1]); w.y = cvt_pk_bf16(o[2], o[3]); w.z = cvt_pk_bf16(o[4], o[5]); w.w = cvt_pk_bf16(o[6], o[7]);
                *(u32x4*)(merged + r * DM + c) = w; }
            asm volatile("" ::: "memory"); }
#undef GA_LOAD
    }
};
struct EpiGlu {
    static constexpr bool I8 = false; static constexpr bool PERM = true;
    struct Pre {}; __device__ __forceinline__ void prefetch(Pre&, const Unit&, int, int, int, int) const {}
    const bf16* Z; bf16* O;
    __device__ __forceinline__ void operator()(const f32x4 (&acc)[2][2][4][2], const Unit& u, int wr, int wc, int fr, int fq, const Pre&) const {
        const int row0 = u.pm * BM + wr * 64 + fr, col0 = u.pn * BM + wc * 32 + 8 * fq;
#pragma unroll
        for (int ai = 0; ai < 2; ++ai)
#pragma unroll
            for (int m = 0; m < 4; ++m) { const size_t r = (size_t)(row0 + ai * HALF + m * 16);
#pragma unroll
                for (int bj = 0; bj < 2; ++bj) { const int c = col0 + bj * HALF;
                    const u32x4 z = *(const u32x4*)(Z + r * 512 + c);
                    const f32x4 v0 = acc[ai][bj][m][0], v1 = acc[ai][bj][m][1];
                    float o[8];
                    o[0] = lo16(z.x) * sigmoidf_(v0[0]); o[1] = hi16(z.x) * sigmoidf_(v0[1]); o[2] = lo16(z.y) * sigmoidf_(v0[2]); o[3] = hi16(z.y) * sigmoidf_(v0[3]);
                    o[4] = lo16(z.z) * sigmoidf_(v1[0]); o[5] = hi16(z.z) * sigmoidf_(v1[1]); o[6] = lo16(z.w) * sigmoidf_(v1[2]); o[7] = hi16(z.w) * sigmoidf_(v1[3]);
                    u32x4 w; w.x = cvt_pk_bf16(o[0], o[1]); w.y = cvt_pk_bf16(o[2], o[3]); w.z = cvt_pk_bf16(o[4], o[5]); w.w = cvt_pk_bf16(o[6], o[7]);
                    *(u32x4*)(O + r * 512 + c) = w; }
                asm volatile("" ::: "memory"); }
    }
};
template <bool I8_> struct EpiFfnUp {
    static constexpr bool I8 = I8_; static constexpr bool PERM = true;
    const bf16* G; bf16* O; const unsigned* w01; const unsigned* w2b; const float* sa; const float* sb;
    struct Pre {}; __device__ __forceinline__ void prefetch(Pre&, const Unit&, int, int, int, int) const {}
    __device__ __forceinline__ void operator()(const typename AccOf<I8_>::T (&acc)[2][2][4][2], const Unit& u, int wr, int wc, int fr, int fq, const Pre& P) const {
        const int rowb = u.pm * BM + wr * 64, col0 = u.pn * BM + wc * 32 + 8 * fq; const bool l15 = fr == 15, l14 = fr >= 14;
        u32x4 gb[2][3], wa[2], wb[2]; f32x4 sbv[2]; float sav[8];
#define FU_GLOAD(buf, k_) do { const int base_ = rowb + (((k_) >> 1) & 1) * HALF + 32 * ((k_) & 1), cc_ = col0 + ((k_) >> 2) * HALF; gb[buf][0] = (u32x4){0u, 0u, 0u, 0u}; \
            if (base_ & (SEQ - 1)) gb[buf][0] = *(const u32x4*)(G + (size_t)(base_ - 16 + fr) * FF + cc_); \
            gb[buf][1] = *(const u32x4*)(G + (size_t)(base_ + fr) * FF + cc_); gb[buf][2] = *(const u32x4*)(G + (size_t)(base_ + 16 + fr) * FF + cc_); } while (0)
#define FU_WLOAD(bj_) do { const int cc_ = col0 + (bj_) * HALF; wa[0] = *(const u32x4*)(w01 + cc_); wa[1] = *(const u32x4*)(w01 + cc_ + 4); wb[0] = *(const u32x4*)(w2b + cc_); wb[1] = *(const u32x4*)(w2b + cc_ + 4); \
            if constexpr (I8_) { sbv[0] = *(const f32x4*)(sb + cc_); sbv[1] = *(const f32x4*)(sb + cc_ + 4); } } while (0)
        FU_GLOAD(0, 0); FU_WLOAD(0);
        if constexpr (I8_) {
#pragma unroll
            for (int i = 0; i < 8; ++i) sav[i] = sa[rowb + fr + (i >> 2) * HALF + (i & 3) * 16]; }
#pragma unroll
        for (int k = 0; k < 8; ++k) { const int bj = k >> 2, ai = (k >> 1) & 1, mh = k & 1, cur = k & 1; const int c = col0 + bj * HALF;
            if (k < 7) FU_GLOAD(cur ^ 1, k + 1);
            asm volatile("" ::: "memory");
#pragma unroll
            for (int mm = 0; mm < 2; ++mm) { const int m = 2 * mh + mm; const size_t r = (size_t)(rowb + ai * HALF + m * 16 + fr); const u32x4 gp = gb[cur][mm], gc = gb[cur][mm + 1];
                f32x2 v[4];
#pragma unroll
                for (int p = 0; p < 4; ++p) v[p] = (f32x2){(float)acc[ai][bj][m][p >> 1][2 * (p & 1)], (float)acc[ai][bj][m][p >> 1][2 * (p & 1) + 1]};
                if constexpr (I8_) { const float ra = sav[ai * 4 + m]; const f32x2 rav = {ra, ra}; const f32x4 s0 = sbv[0], s1 = sbv[1];
                    v[0] = v[0] * ((f32x2){s0[0], s0[1]} * rav); v[1] = v[1] * ((f32x2){s0[2], s0[3]} * rav); v[2] = v[2] * ((f32x2){s1[0], s1[1]} * rav); v[3] = v[3] * ((f32x2){s1[2], s1[3]} * rav); }
                float o[8];
#pragma unroll
                for (int w = 0; w < 4; ++w) {
                    const unsigned x1w = (unsigned)__builtin_amdgcn_update_dpp(0, (int)(l15 ? gp[w] : gc[w]), 0x121, 0xf, 0xf, true);
                    const unsigned x0w = (unsigned)__builtin_amdgcn_update_dpp(0, (int)(l14 ? gp[w] : gc[w]), 0x122, 0xf, 0xf, true);
                    const unsigned wa_ = wa[w >> 1][2 * (w & 1)], wa1_ = wa[w >> 1][2 * (w & 1) + 1], wb_ = wb[w >> 1][2 * (w & 1)], wb1_ = wb[w >> 1][2 * (w & 1) + 1];
#pragma unroll
                    for (int h = 0; h < 2; ++h) { const int jj = 2 * w + h; const unsigned sel = h ? 0x07060302u : 0x05040100u;
                        const unsigned p01 = __builtin_amdgcn_perm(x1w, x0w, sel), p2 = __builtin_amdgcn_perm(0x3F803F80u, gc[w], sel);
                        float uu = __builtin_amdgcn_fdot2_f32_bf16(__builtin_bit_cast(bf16v2, p2), __builtin_bit_cast(bf16v2, h ? wb1_ : wb_), 0.0f, false);
                        uu = __builtin_amdgcn_fdot2_f32_bf16(__builtin_bit_cast(bf16v2, p01), __builtin_bit_cast(bf16v2, h ? wa1_ : wa_), uu, false);
                        const float z = uu * (uu * uu * -0.10294324f + -2.3022082f); const float e = __builtin_amdgcn_exp2f(z);
                        o[jj] = (uu * v[jj >> 1][jj & 1]) * rcpf_(1.0f + e); } }
                u32x4 wv; wv.x = cvt_pk_bf16(o[0], o[1]); wv.y = cvt_pk_bf16(o[2], o[3]); wv.z = cvt_pk_bf16(o[4], o[5]); wv.w = cvt_pk_bf16(o[6], o[7]);
                *(u32x4*)(O + r * FF + c) = wv; }
            asm volatile("" ::: "memory");
            if (k == 3) FU_WLOAD(1); }
#undef FU_GLOAD
#undef FU_WLOAD
    }
};

__device__ __forceinline__ f32x4 mma16(bf16x8 b, bf16x8 a, f32x4 c) { return __builtin_amdgcn_mfma_f32_16x16x32_bf16(b, a, c, 0, 0, 0); }
__device__ __forceinline__ i32x4 mma16(bf16x8 b, bf16x8 a, i32x4 c) { return __builtin_amdgcn_mfma_i32_16x16x64_i8(__builtin_bit_cast(i32x4, b), __builtin_bit_cast(i32x4, a), c, 0, 0, 0); }
#ifndef PG8_SP2
#define PG8_SP2 true
#endif
#ifndef PG8_ALIGN
#define PG8_ALIGN true
#endif
template <class E> struct BMode { static constexpr int v = E::PERM ? 1 : 0; }; template <> struct BMode<EpiGateU8> { static constexpr int v = 2; };
template <class Epi, class Sched, bool ALIGN_EPI = PG8_ALIGN, bool SP2 = PG8_SP2>
__device__ __forceinline__ void gemm_phase(LAS unsigned char* lds, const Gemm g, const Sched& S, const Epi& E, int tid_) {
    const int tid = tid_, wid = __builtin_amdgcn_readfirstlane(tid >> 6), lane = tid & 63, wr = wid >> 2, wc = wid & 3, fr = lane & 15, fq = lane >> 4;
    const int K = g.K, nt = K / BK;
    unsigned voffA[2], voffB[2];
#pragma unroll
    for (int i = 0; i < 2; ++i) { int R, C; stage_rc(tid * 16 + i * 8192, R, C); const int Rb = BMode<Epi>::v == 2 ? (64 * (R >> 5) + 16 * ((R >> 2) & 3) + 4 * ((R >> 4) & 1) + (R & 3)) : (BMode<Epi>::v == 1 ? ((R & ~31) + perm32(R & 31)) : R);
        voffA[i] = (unsigned)(R * K + C) * 2u; voffB[i] = (unsigned)(Rb * K + C) * 2u; }
    const size_t kstep = (size_t)(BK * 2);
    const size_t hstep = (size_t)HALF * K * 2;
    const size_t tstep = 2 * hstep;
    const size_t hstepB = BMode<Epi>::v == 2 ? (size_t)8 * K * 2 : hstep;
    const unsigned ldsw = (unsigned)wid * 1024u;
    const int aoff = lds_byte(wr * 64 + fr, fq * 8), boff = lds_byte(wc * 32 + fr, fq * 8);
#define PG8_SA(b, h) (((b) * 2 + (h)) * HTB)
#define PG8_SB(b, h) ((4 + (b) * 2 + (h)) * HTB)
#define PG8_STAGE(bufoff, gbase, voff) do { _Pragma("unroll") for (int _i = 0; _i < 2; ++_i) \
        __builtin_amdgcn_global_load_lds((const unsigned*)((const char*)(gbase) + (voff)[_i]), (LAS unsigned*)(lds + (bufoff) + ldsw + _i * 8192), 16, 0, 0); } while (0)
#define PG8_LDA(dst, b, h) do { _Pragma("unroll") for (int m = 0; m < 4; ++m) _Pragma("unroll") for (int k = 0; k < 2; ++k) dst[m][k] = *(const LAS bf16x8*)(lds + PG8_SA(b, h) + aoff + m * 2048 + k * 1024); } while (0)
#define PG8_LDB(dst, b, h) do { _Pragma("unroll") for (int n = 0; n < 2; ++n) _Pragma("unroll") for (int k = 0; k < 2; ++k) dst[n][k] = *(const LAS bf16x8*)(lds + PG8_SB(b, h) + boff + n * 2048 + k * 1024); } while (0)
#define PG8_MMA(ai, bj, At, Bt) do { __builtin_amdgcn_s_setprio(1); _Pragma("unroll") for (int m = 0; m < 4; ++m) _Pragma("unroll") for (int n = 0; n < 2; ++n) _Pragma("unroll") for (int k = 0; k < 2; ++k) \
        acc[ai][bj][m][n] = mma16(Bt[n][k], At[m][k], acc[ai][bj][m][n]); __builtin_amdgcn_s_setprio(0); } while (0)
#define PG8_WAIT_V(n) asm volatile("s_waitcnt vmcnt(" #n ")" ::: "memory")
#define PG8_WAIT_L(n) asm volatile("s_waitcnt lgkmcnt(" #n ")" ::: "memory")
#define PG8_BAR __builtin_amdgcn_s_barrier()
#define PG8_SCHED __builtin_amdgcn_sched_barrier(0)
    Unit cur, nxt; int ui = 0;
    if (!S.next(0, cur)) return;
    typedef typename AccOf<Epi::I8>::T acc_t;
    acc_t acc[2][2][4][2];
#pragma unroll
    for (int a = 0; a < 2; ++a)
#pragma unroll
        for (int b = 0; b < 2; ++b)
#pragma unroll
            for (int m = 0; m < 4; ++m)
#pragma unroll
                for (int n = 0; n < 2; ++n) acc[a][b][m][n] = (acc_t){0, 0, 0, 0};
    bf16x8 At[4][2], B0[2][2], B1[2][2];
    typename Epi::Pre pre;
    const char* cA = (const char*)g.A + (size_t)cur.pm * tstep; const char* cB = (const char*)g.Bt + (size_t)cur.pn * tstep;
    S.a_ready(cur);
    if constexpr (SP2) {
        PG8_STAGE(PG8_SB(0, 0), cB, voffB); PG8_STAGE(PG8_SB(0, 1), cB + hstepB, voffB); PG8_STAGE(PG8_SA(0, 0), cA, voffA); PG8_STAGE(PG8_SA(0, 1), cA + hstep, voffA);
        if (wr == 1) PG8_BAR;
        PG8_WAIT_V(2); PG8_BAR;
        PG8_STAGE(PG8_SB(1, 0), cB + kstep, voffB); PG8_STAGE(PG8_SA(1, 0), cA + kstep, voffA); PG8_STAGE(PG8_SB(1, 1), cB + hstepB + kstep, voffB);
        PG8_WAIT_V(6); PG8_BAR;
    } else {
    PG8_STAGE(PG8_SB(0, 0), cB, voffB); PG8_STAGE(PG8_SA(0, 0), cA, voffA); PG8_STAGE(PG8_SB(0, 1), cB + hstepB, voffB); PG8_STAGE(PG8_SA(0, 1), cA + hstep, voffA);
    if (wr == 1) PG8_BAR;
    PG8_WAIT_V(4); PG8_BAR;
    PG8_STAGE(PG8_SB(1, 0), cB + kstep, voffB); PG8_STAGE(PG8_SA(1, 0), cA + kstep, voffA); PG8_STAGE(PG8_SB(1, 1), cB + hstepB + kstep, voffB);
    PG8_WAIT_V(6); PG8_BAR;
    }
    for (;;) {
        const bool has_next = S.next(ui + 1, nxt);
        const char* nA = has_next ? (const char*)g.A + (size_t)nxt.pm * tstep : cA; const char* nB = has_next ? (const char*)g.Bt + (size_t)nxt.pn * tstep : cB;
        for (int t = 0; t < nt; t += 2) {
            const bool last = (t == nt - 2);
            const char* a1 = cA + (size_t)(t + 1) * kstep;
            const char* a2 = last ? nA : cA + (size_t)(t + 2) * kstep; const char* b2 = last ? nB : cB + (size_t)(t + 2) * kstep;
            const char* a3 = a2 + kstep; const char* b3 = b2 + kstep;
            if (last && has_next) S.a_ready(nxt);
            if (last) E.prefetch(pre, cur, wr, wc, fr, fq);
            if constexpr (SP2) {
            PG8_LDB(B0, 0, 0); PG8_LDB(B1, 0, 1); PG8_SCHED; PG8_LDA(At, 0, 0); PG8_STAGE(PG8_SA(1, 1), a1 + hstep, voffA);
            PG8_WAIT_V(8); PG8_WAIT_L(0); PG8_BAR; PG8_MMA(0, 0, At, B0); PG8_MMA(0, 1, At, B1); PG8_BAR; PG8_SCHED;
            PG8_LDA(At, 0, 1); PG8_STAGE(PG8_SB(0, 0), b2, voffB); PG8_STAGE(PG8_SB(0, 1), b2 + hstepB, voffB); PG8_STAGE(PG8_SA(0, 0), a2, voffA);
            PG8_WAIT_V(8); PG8_WAIT_L(0); PG8_BAR; PG8_MMA(1, 0, At, B0); PG8_MMA(1, 1, At, B1); PG8_BAR; PG8_SCHED;
            PG8_LDB(B0, 1, 0); PG8_LDB(B1, 1, 1); PG8_SCHED; PG8_LDA(At, 1, 0); PG8_STAGE(PG8_SA(0, 1), a2 + hstep, voffA);
            PG8_WAIT_V(8); PG8_WAIT_L(0); PG8_BAR; PG8_MMA(0, 0, At, B0); PG8_MMA(0, 1, At, B1); PG8_BAR; PG8_SCHED;
            PG8_LDA(At, 1, 1); PG8_STAGE(PG8_SB(1, 0), b3, voffB); PG8_STAGE(PG8_SB(1, 1), b3 + hstepB, voffB); PG8_STAGE(PG8_SA(1, 0), a3, voffA);
            PG8_WAIT_V(8); PG8_WAIT_L(0); PG8_BAR; PG8_MMA(1, 0, At, B0); PG8_MMA(1, 1, At, B1); PG8_BAR; PG8_SCHED;
            } else {
            PG8_LDB(B0, 0, 0); PG8_SCHED; PG8_LDA(At, 0, 0); PG8_STAGE(PG8_SA(1, 1), a1 + hstep, voffA);
            PG8_WAIT_L(8); PG8_BAR; PG8_WAIT_L(0); PG8_MMA(0, 0, At, B0); PG8_BAR; PG8_SCHED;
            PG8_LDB(B1, 0, 1); PG8_STAGE(PG8_SB(0, 0), b2, voffB);
            PG8_BAR; PG8_WAIT_L(0); PG8_MMA(0, 1, At, B1); PG8_BAR;
            PG8_LDA(At, 0, 1); PG8_STAGE(PG8_SA(0, 0), a2, voffA);
            PG8_BAR; PG8_WAIT_L(0); PG8_MMA(1, 0, At, B0); PG8_BAR; PG8_SCHED;
            PG8_STAGE(PG8_SB(0, 1), b2 + hstepB, voffB);
            PG8_WAIT_V(6); PG8_BAR; PG8_MMA(1, 1, At, B1); PG8_BAR;
            PG8_LDB(B0, 1, 0); PG8_SCHED; PG8_LDA(At, 1, 0); PG8_STAGE(PG8_SA(0, 1), a2 + hstep, voffA);
            PG8_WAIT_L(8); PG8_BAR; PG8_WAIT_L(0); PG8_MMA(0, 0, At, B0); PG8_BAR; PG8_SCHED;
            PG8_LDB(B1, 1, 1); PG8_STAGE(PG8_SB(1, 0), b3, voffB);
            PG8_BAR; PG8_WAIT_L(0); PG8_MMA(0, 1, At, B1); PG8_BAR;
            PG8_LDA(At, 1, 1); PG8_STAGE(PG8_SA(1, 0), a3, voffA);
            PG8_BAR; PG8_WAIT_L(0); PG8_MMA(1, 0, At, B0); PG8_BAR; PG8_SCHED;
            PG8_STAGE(PG8_SB(1, 1), b3 + hstepB, voffB);
            PG8_WAIT_V(6); PG8_BAR; PG8_MMA(1, 1, At, B1); PG8_BAR;
            }
        }
        if constexpr (ALIGN_EPI) { if (wr == 0) PG8_BAR; }
        E(acc, cur, wr, wc, fr, fq, pre); S.done(cur);
        if (!has_next) break;
#pragma unroll
        for (int a = 0; a < 2; ++a)
#pragma unroll
            for (int b = 0; b < 2; ++b)
#pragma unroll
                for (int m = 0; m < 4; ++m)
#pragma unroll
                    for (int n = 0; n < 2; ++n) acc[a][b][m][n] = (acc_t){0, 0, 0, 0};
        cur = nxt; cA = nA; cB = nB; ++ui;
        if constexpr (ALIGN_EPI) { if (wr == 1) PG8_BAR; }
    }
    PG8_WAIT_V(0);
    if constexpr (!ALIGN_EPI) { if (wr == 0) PG8_BAR; }
    PG8_BAR;
#undef PG8_SA
#undef PG8_SB
#undef PG8_STAGE
#undef PG8_LDA
#undef PG8_LDB
#undef PG8_MMA
#undef PG8_WAIT_V
#undef PG8_WAIT_L
#undef PG8_BAR
#undef PG8_SCHED
}
}

#define XB_TMO      128
#define XB_XCNT(j)  (256  + 64 * (j))
#define XB_XSUB(j)  (1280 + 64 * (j))
#define XB_XGEN(j)  (2304 + 64 * (j))
#define XB_TOP      3328
#define XB_TOPGEN   3392
#define XCD_BAR_WORDS 3456
#define XB_SPIN_CAP (1u << 22)
__device__ __forceinline__ unsigned xb_ld(unsigned* p)              { return __hip_atomic_load(p, __ATOMIC_RELAXED, __HIP_MEMORY_SCOPE_AGENT); }
__device__ __forceinline__ unsigned xb_add(unsigned* p, unsigned v) { return __hip_atomic_fetch_add(p, v, __ATOMIC_RELAXED, __HIP_MEMORY_SCOPE_AGENT); }
__device__ __forceinline__ unsigned xb_xcc_id() { return (unsigned)__builtin_amdgcn_s_getreg((3 << 11) | 20) & 0xFu; }
#define XB_SPIN(cond, bar) do { unsigned _sp = 0; while (cond) { __builtin_amdgcn_s_sleep(1); \
    if ((++_sp & 255u) == 0u) { if (xb_ld(&(bar)[XB_TMO])) break; if (_sp > XB_SPIN_CAP) { atomicAdd(&(bar)[XB_TMO], 1u); break; } } } } while (0)
struct XcdBarrier { unsigned* bar; unsigned x; volatile LAS unsigned* st; };
__device__ __forceinline__ XcdBarrier xcd_barrier_post(unsigned* bar, volatile LAS unsigned* st) {
    XcdBarrier b; b.bar = bar; b.x = xb_xcc_id(); b.st = st;
    if (threadIdx.x == 0) (void)xb_add(&bar[XB_XCNT(b.x)], 1u);
    return b;
}
__device__ __forceinline__ void xcd_barrier_complete(unsigned* bar, unsigned x, unsigned& nloc, unsigned& nx) {
    const unsigned G = gridDim.x * gridDim.y * gridDim.z;
    unsigned sum, cnt, mine, sp = 0u;
    for (;;) {
        sum = 0u; cnt = 0u; mine = 0u;
#pragma unroll
        for (unsigned j = 0; j < 16; ++j) { const unsigned c = xb_ld(&bar[XB_XCNT(j)]); sum += c; cnt += (c > 0u) ? 1u : 0u; mine = (j == x) ? c : mine; }
        if (sum == G) break;
        __builtin_amdgcn_s_sleep(1);
        if ((++sp & 255u) == 0u) { if (xb_ld(&bar[XB_TMO])) break; if (sp > XB_SPIN_CAP) { atomicAdd(&bar[XB_TMO], 1u); break; } }
    }
    nloc = mine > 0u ? mine : 1u; nx = cnt > 0u ? cnt : 1u;
}
__device__ __forceinline__ void xcd_barrier(const XcdBarrier& b) {
    asm volatile("s_waitcnt vmcnt(0)" ::: "memory");
    __syncthreads();
    if (threadIdx.x == 0) {
        unsigned* bar = b.bar;
        { unsigned long long w_ = (unsigned long long)bar; unsigned lo_ = __builtin_amdgcn_readfirstlane((unsigned)w_), hi_ = __builtin_amdgcn_readfirstlane((unsigned)(w_ >> 32)); asm volatile("" : "+s"(lo_), "+s"(hi_)); bar = (unsigned*)(((unsigned long long)hi_ << 32) | lo_); }
        __builtin_amdgcn_s_waitcnt(0);
        unsigned nloc = b.st[0], nx = b.st[1];
        if (nloc == 0u) { xcd_barrier_complete(bar, b.x, nloc, nx); b.st[0] = nloc; b.st[1] = nx; }
        const unsigned old = xb_add(&bar[XB_XSUB(b.x)], 1u);
        const unsigned gen = old / nloc;
        if (old + 1u == (gen + 1u) * nloc) {
            __builtin_amdgcn_fence(__ATOMIC_RELEASE, "agent");
            asm volatile("s_waitcnt vmcnt(0)" ::: "memory");
            const unsigned og = xb_add(&bar[XB_TOP], 1u);
            const unsigned tg = og / nx;
            if (og + 1u == (tg + 1u) * nx) xb_add(&bar[XB_TOPGEN], 1u);
            else XB_SPIN(xb_ld(&bar[XB_TOPGEN]) == tg, bar);
            __builtin_amdgcn_fence(__ATOMIC_ACQUIRE, "agent");
            xb_add(&bar[XB_XGEN(b.x)], 1u);
            asm volatile("s_waitcnt vmcnt(0)" ::: "memory");
        } else {
            XB_SPIN(xb_ld(&bar[XB_XGEN(b.x)]) == gen, bar);
            __builtin_amdgcn_fence(__ATOMIC_ACQUIRE, "agent");
            asm volatile("s_waitcnt vmcnt(0)" ::: "memory");
        }
    }
    __syncthreads();
}

constexpr int NWAVES = 8, NTHR = 512;
constexpr int LDS_MISC = 131072, LDS_BYTES = 131072 + 1024;
struct Args { const float* in[45]; float* out; unsigned char* ws; };
#define GAS __attribute__((address_space(1)))
struct Frame {
    LAS unsigned char* lds; float* out; unsigned char* ws;
    int tid, lane, wave, blk, G;
};
#define WSP(T, off) ((T*)(F.ws + (off)))
__device__ __forceinline__ const float* inp_(LAS unsigned char* lds, int k) {
    const LAS unsigned* t = (const LAS unsigned*)(lds + 131072 + 256) + 2 * k;
    const unsigned lo = __builtin_amdgcn_readfirstlane(t[0]), hi = __builtin_amdgcn_readfirstlane(t[1]);
    return (const float*)(const GAS float*)(((unsigned long long)hi << 32) | lo);
}
#define INP(k) inp_(F.lds, (k))

__device__ __forceinline__ void tr_item(const float* W, int ld, int col0, int ncv, bf16* WT, int K, int row_off, LAS float* scr, int kb, int nb, int lane, float scale = 1.0f) {
    const int k0 = 64 * kb, n0 = 32 * nb; const int nn = n0 + (lane & 31); const bool ok = nn < ncv;
    { float t[32]; const float* wp = W + (size_t)(k0 + (lane >> 5)) * ld + col0 + (ok ? nn : 0);
#pragma unroll
      for (int i = 0; i < 32; ++i) t[i] = wp[(size_t)(2 * i) * ld];
#pragma unroll
      for (int i = 0; i < 32; ++i) scr[(2 * i + (lane >> 5)) * 33 + (lane & 31)] = ok ? t[i] * scale : 0.f; }
    asm volatile("s_waitcnt lgkmcnt(0)" ::: "memory");
    const int c = lane & 7;
#pragma unroll
    for (int j = 0; j < 4; ++j) { const int n = (lane >> 3) + 8 * j; const LAS float* s = scr + (8 * c) * 33 + n;
        u32x4 o; o.x = pk2(s[0 * 33], s[1 * 33]); o.y = pk2(s[2 * 33], s[3 * 33]); o.z = pk2(s[4 * 33], s[5 * 33]); o.w = pk2(s[6 * 33], s[7 * 33]);
        *(u32x4*)(WT + (size_t)(row_off + n0 + n) * K + k0 + 8 * c) = o; }
    asm volatile("s_waitcnt lgkmcnt(0)" ::: "memory");
}
__device__ __forceinline__ void convert_weights(Frame& F, int l) {
    LAS float* scr = (LAS float*)(F.lds + F.wave * 16384);
    const int gw = F.blk * NWAVES + F.wave, NGW = F.G * NWAVES;
    constexpr int I0 = 32 * 152, I1 = I0, I2 = I1 + 4 * 8 * 64, I3 = I2 + 32 * 64, I4 = I3, I5 = I4, I6 = I5 + 96 * 64, I7 = I6 + 8 * 16;
    const float* win = INP(2) + (size_t)l * DM * INC;
    for (int it = gw; it < I7; it += NGW) {
        if (it < I0) { const int r = it; tr_item(win, INC, 0, MIXC, WSP(bf16, WS_WIN), DM, 0, scr, r / 152, r % 152, F.lane); }
        else if (it < I1) { }
        else if (it < I2) { const int r = it - I1; const int k = r / 512, rr = r % 512; tr_item(INP(36) + ((size_t)l * 4 + k) * 512 * DM, DM, 0, DM, WSP(bf16, WS_WPK), 512, k * DM, scr, rr / 64, rr % 64, F.lane, 1.0f / 255.0f); }
        else if (it < I3) { const int r = it - I2; tr_item(INP(37) + (size_t)l * DM * DM, DM, 0, DM, WSP(bf16, WS_WOUT), DM, 0, scr, r / 64, r % 64, F.lane); }
        else if (it < I4) { const int r = it - I3; tr_item(INP(39) + (size_t)l * DM * FF, FF, 0, FF, WSP(bf16, WS_WFG), DM, 0, scr, r / 192, r % 192, F.lane); }
        else if (it < I5) { const int r = it - I4; tr_item(INP(40) + (size_t)l * DM * FF, FF, 0, FF, WSP(bf16, WS_WFU), DM, 0, scr, r / 192, r % 192, F.lane); }
        else if (it < I6) { const int r = it - I5; tr_item(INP(43) + (size_t)l * FF * DM, DM, 0, DM, WSP(bf16, WS_WFD), FF, 0, scr, r / 64, r % 64, F.lane); }
        else { const int r = it - I6; tr_item(INP(11) + (size_t)l * 512 * 512, 512, 0, 512, WSP(bf16, WS_WGLU), 512, 0, scr, r / 16, r % 16, F.lane); }
    }
}
__device__ __forceinline__ void rmsnorm_rows(Frame& F, const float* x, const bf16* xb, const float* g, bf16* obf, float* of32, unsigned* a8 = nullptr, float* sa = nullptr) {
    const int gw = F.blk * NWAVES + F.wave, NGW = F.G * NWAVES;
    f32x4 gv[8];
#pragma unroll
    for (int j = 0; j < 8; ++j) gv[j] = ((const f32x4*)g)[64 * j + F.lane];
    u32x2 wn[8];
    if (!x && gw < MTOK) { const u32x2* xr = (const u32x2*)(xb + (size_t)gw * DM) + F.lane;
#pragma unroll
        for (int j = 0; j < 8; ++j) wn[j] = xr[64 * j]; }
    for (int m = gw; m < MTOK; m += NGW) {
        f32x4 v[8]; float s = 0.f;
        if (x) { const f32x4* xr = (const f32x4*)(x + (size_t)m * DM) + F.lane;
#pragma unroll
            for (int j = 0; j < 8; ++j) v[j] = xr[64 * j]; }
        else {
#pragma unroll
            for (int j = 0; j < 8; ++j) v[j] = (f32x4){lo16(wn[j].x), hi16(wn[j].x), lo16(wn[j].y), hi16(wn[j].y)};
            const int mn = m + NGW < MTOK ? m + NGW : m; const u32x2* xr = (const u32x2*)(xb + (size_t)mn * DM) + F.lane;
#pragma unroll
            for (int j = 0; j < 8; ++j) wn[j] = xr[64 * j];
            asm volatile("" ::: "memory"); }
#pragma unroll
        for (int j = 0; j < 8; ++j) s += (v[j].x * v[j].x + v[j].y * v[j].y) + (v[j].z * v[j].z + v[j].w * v[j].w);
        const float rs = 1.0f / sqrtf(wave_sum(s) * (1.f / DM) + 1e-6f);
#pragma unroll
        for (int j = 0; j < 8; ++j) v[j] = v[j] * rs * gv[j];
        if (obf) { u32x2* o = (u32x2*)(obf + (size_t)m * DM) + F.lane;
#pragma unroll
            for (int j = 0; j < 8; ++j) { u32x2 w; w.x = pk2(v[j].x, v[j].y); w.y = pk2(v[j].z, v[j].w); o[64 * j] = w; } }
        if (of32) { f32x4* o = (f32x4*)(of32 + (size_t)m * DM) + F.lane;
#pragma unroll
            for (int j = 0; j < 8; ++j) o[64 * j] = v[j]; }
        if (a8) {
            float am = 0.f;
#pragma unroll
            for (int j = 0; j < 8; ++j) am = fmaxf(fmaxf(am, fmaxf(fabsf(v[j].x), fabsf(v[j].y))), fmaxf(fabsf(v[j].z), fabsf(v[j].w)));
            am = fmaxf(wave_max(am), 1e-20f); const float inv = 127.0f / am;
            unsigned* o = a8 + (size_t)m * (DM / 4) + F.lane;
#pragma unroll
            for (int j = 0; j < 8; ++j) o[64 * j] = q8x4(v[j].x, v[j].y, v[j].z, v[j].w, inv);
            if (F.lane == 0) sa[m] = am * (1.0f / 127.0f); }
    }
}
__device__ __forceinline__ void convert_cols_i8(Frame& F, const float* W, int ld, int col0, int nb, signed char* W8, float* sb, int row_off) {
    LAS float* red = (LAS float*)(F.lds + 8 * 16384 - 4096);
    LAS float* scl = red + 512;
    const int tid = F.tid, n = tid & 31, kg = tid >> 5; const float* wp = W + col0 + 32 * nb + n;
    float am = 0.f;
#pragma unroll 1
    for (int i0 = 0; i0 < 128; i0 += 32) { float t[32];
#pragma unroll
        for (int i = 0; i < 32; ++i) t[i] = wp[(size_t)(kg + 16 * (i0 + i)) * ld];
#pragma unroll
        for (int i = 0; i < 32; ++i) am = fmaxf(am, fabsf(t[i])); }
    red[kg * 32 + n] = am;
    __syncthreads();
    if (tid < 32) { float a = 0.f;
#pragma unroll
        for (int q = 0; q < 16; ++q) a = fmaxf(a, red[q * 32 + tid]);
        a = fmaxf(a, 1e-30f); scl[tid] = 127.0f / a; sb[row_off + 32 * nb + tid] = a * (1.0f / 127.0f); }
    __syncthreads();
    LAS float* scr = (LAS float*)(F.lds + F.wave * 16384);
    const int lane = F.lane, rn = lane >> 1, half = lane & 1; const float inv = scl[rn];
#pragma unroll 1
    for (int kb = F.wave; kb < 32; kb += NWAVES) {
        { float t[32];
#pragma unroll
          for (int i = 0; i < 32; ++i) t[i] = W[(size_t)(64 * kb + 2 * i + (lane >> 5)) * ld + col0 + 32 * nb + (lane & 31)];
#pragma unroll
          for (int i = 0; i < 32; ++i) scr[(2 * i + (lane >> 5)) * 33 + (lane & 31)] = t[i]; }
        asm volatile("s_waitcnt lgkmcnt(0)" ::: "memory");
        const LAS float* sp = scr + (32 * half) * 33 + rn;
        u32x4 w0, w1;
        w0.x = q8x4(sp[0 * 33], sp[1 * 33], sp[2 * 33], sp[3 * 33], inv); w0.y = q8x4(sp[4 * 33], sp[5 * 33], sp[6 * 33], sp[7 * 33], inv);
        w0.z = q8x4(sp[8 * 33], sp[9 * 33], sp[10 * 33], sp[11 * 33], inv); w0.w = q8x4(sp[12 * 33], sp[13 * 33], sp[14 * 33], sp[15 * 33], inv);
        w1.x = q8x4(sp[16 * 33], sp[17 * 33], sp[18 * 33], sp[19 * 33], inv); w1.y = q8x4(sp[20 * 33], sp[21 * 33], sp[22 * 33], sp[23 * 33], inv);
        w1.z = q8x4(sp[24 * 33], sp[25 * 33], sp[26 * 33], sp[27 * 33], inv); w1.w = q8x4(sp[28 * 33], sp[29 * 33], sp[30 * 33], sp[31 * 33], inv);
        u32x4* d = (u32x4*)(W8 + (size_t)(row_off + 32 * nb + rn) * DM + 64 * kb + 32 * half); d[0] = w0; d[1] = w1;
        asm volatile("s_waitcnt lgkmcnt(0)" ::: "memory");
    }
    __syncthreads();
}

constexpr int WAVE_LDS = 16384;
constexpr int LR_XLD = 72, LR_FLD = 66, LR_ALD = 132;
constexpr int LR_XF = 16 * LR_XLD * 2, LR_AB = LR_XF + 16 * LR_FLD * 4;
template <bool FINAL> __device__ __forceinline__ void lru_task(Frame& F, int l, int task) {
    const int lane = F.lane, fr = lane & 15, fq = lane >> 4; const int b = task >> 9, h = (task >> 6) & 7, c = task & 63; const int ch = 64 * h + lane;
    LAS unsigned char* wl = F.lds + F.wave * WAVE_LDS;
    LAS bf16* XC = (LAS bf16*)wl; LAS float* XF = (LAS float*)(wl + LR_XF); LAS float* AB = (LAS float*)(wl + LR_AB);
    const float* WA = INP(14) + ((size_t)l * 8 + h) * 4096; const float* WX = INP(16) + ((size_t)l * 8 + h) * 4096;
    bf16x8 Wa[4][2], Wx[4][2];
#pragma unroll
    for (int nt = 0; nt < 4; ++nt)
#pragma unroll
        for (int kk = 0; kk < 2; ++kk) { const float* pa = WA + (size_t)(32 * kk + 8 * fq) * 64 + 16 * nt + fr; const float* px_ = WX + (size_t)(32 * kk + 8 * fq) * 64 + 16 * nt + fr;
            u32x4 wa_, wx_; wa_.x = pk2(pa[0], pa[64]); wa_.y = pk2(pa[128], pa[192]); wa_.z = pk2(pa[256], pa[320]); wa_.w = pk2(pa[384], pa[448]);
            wx_.x = pk2(px_[0], px_[64]); wx_.y = pk2(px_[128], px_[192]); wx_.z = pk2(px_[256], px_[320]); wx_.w = pk2(px_[384], px_[448]);
            Wa[nt][kk] = __builtin_bit_cast(bf16x8, wa_); Wx[nt][kk] = __builtin_bit_cast(bf16x8, wx_); }
    float ba4[4], bx4[4], sp4[4], slp[4];
#pragma unroll
    for (int nt = 0; nt < 4; ++nt) { const int jj = l * 512 + 64 * h + 16 * nt + fr; ba4[nt] = INP(15)[jj]; bx4[nt] = INP(17)[jj]; sp4[nt] = softplusf_(-INP(18)[jj]); slp[nt] = 0.f; }
    const float* cwp = INP(12) + (size_t)l * 4 * 512 + ch;
    const float cw0 = cwp[0], cw1 = cwp[512], cw2 = cwp[1024], cw3 = cwp[1536];
    const float cb = INP(13)[l * 512 + ch];
    const size_t row0 = (size_t)b * SEQ + (size_t)c * 128;
    const bf16* px = WSP(const bf16, WS_PROJ) + row0 * MIXP + PC_LRX + ch;
    const bf16* pg = WSP(const bf16, WS_PROJ) + row0 * MIXP + PC_LRG + ch;
    float xm3 = 0.f, xm2 = 0.f, xm1 = 0.f;
    if (c > 0) { xm3 = bf2f(*(px - 3 * (ptrdiff_t)MIXP)); xm2 = bf2f(*(px - 2 * (ptrdiff_t)MIXP)); xm1 = bf2f(*(px - (ptrdiff_t)MIXP)); }
    float hs = 0.f;
    const size_t cidx = ((size_t)b * 64 + c) * 512 + ch;
    if (FINAL) hs = WSP(const float, WS_LRI)[cidx];
    bf16* yo = WSP(bf16, WS_YK) + (size_t)1 * MTOK * 512 + row0 * 512 + ch;
    bf16 xs[16], gs[16];
#pragma unroll
    for (int j = 0; j < 16; ++j) { xs[j] = px[(size_t)j * MIXP]; if (FINAL) gs[j] = pg[(size_t)j * MIXP]; }
#pragma unroll 1
    for (int sb = 0; sb < 8; ++sb) {
#pragma unroll
        for (int t = 0; t < 16; ++t) { const float xv = bf2f(xs[t]); const float xc = cb + cw0 * xm3 + cw1 * xm2 + cw2 * xm1 + cw3 * xv; xm3 = xm2; xm2 = xm1; xm1 = xv;
            XC[t * LR_XLD + lane] = (bf16)f2bf(xc); XF[t * LR_FLD + lane] = xc; }
        float gl[16];
        if (FINAL) {
#pragma unroll
            for (int t = 0; t < 16; ++t) gl[t] = bf2f(gs[t]); }
        if (sb < 7) {
#pragma unroll
            for (int j = 0; j < 16; ++j) { xs[j] = px[(size_t)((sb + 1) * 16 + j) * MIXP]; if (FINAL) gs[j] = pg[(size_t)((sb + 1) * 16 + j) * MIXP]; } }
        const bf16x8 af0 = *(const LAS bf16x8*)(XC + fr * LR_XLD + 8 * fq), af1 = *(const LAS bf16x8*)(XC + fr * LR_XLD + 32 + 8 * fq);
#pragma unroll
        for (int nt = 0; nt < 4; ++nt) {
            f32x4 aa = (f32x4){0.f, 0.f, 0.f, 0.f}, ax = (f32x4){0.f, 0.f, 0.f, 0.f};
            aa = __builtin_amdgcn_mfma_f32_16x16x32_bf16(af0, Wa[nt][0], aa, 0, 0, 0); aa = __builtin_amdgcn_mfma_f32_16x16x32_bf16(af1, Wa[nt][1], aa, 0, 0, 0);
            ax = __builtin_amdgcn_mfma_f32_16x16x32_bf16(af0, Wx[nt][0], ax, 0, 0, 0); ax = __builtin_amdgcn_mfma_f32_16x16x32_bf16(af1, Wx[nt][1], ax, 0, 0, 0);
#pragma unroll
            for (int e = 0; e < 4; ++e) { const int t = 4 * fq + e, jj = 16 * nt + fr; const float xc = XF[t * LR_FLD + jj];
                const float r = sigmoidf_(aa[e] + ba4[nt]), ig = sigmoidf_(ax[e] + bx4[nt]); const float la = -8.0f * r * sp4[nt]; const float av = __expf(la);
                const float mult = __builtin_amdgcn_sqrtf(fmaxf(1.0f - av * av, 0.f));
                AB[t * LR_ALD + jj] = av; AB[t * LR_ALD + 64 + jj] = xc * ig * mult; if (!FINAL) slp[nt] += la; }
        }
#pragma unroll
        for (int t = 0; t < 16; ++t) { const float av = AB[t * LR_ALD + lane], bv = AB[t * LR_ALD + 64 + lane]; hs = av * hs + bv;
            if (FINAL) yo[(size_t)(sb * 16 + t) * 512] = (bf16)f2bf(hs * geluf_(gl[t])); }
    }
    if (!FINAL) { WSP(float, WS_LRE)[cidx] = hs;
#pragma unroll
        for (int nt = 0; nt < 4; ++nt) { float v = slp[nt]; v += __shfl_xor(v, 16); v += __shfl_xor(v, 32); if (fq == 0) WSP(float, WS_LRA)[((size_t)b * 64 + c) * 512 + 64 * h + 16 * nt + fr] = v; } }
}
__device__ __forceinline__ void lru_carry(Frame& F, int task) {
    const int b = task >> 3, ch = (task & 7) * 64 + F.lane; float run = 0.f;
    const float* A = WSP(const float, WS_LRA) + (size_t)b * 64 * 512 + ch; const float* E = WSP(const float, WS_LRE) + (size_t)b * 64 * 512 + ch; float* I = WSP(float, WS_LRI) + (size_t)b * 64 * 512 + ch;
#pragma unroll 1
    for (int c0 = 0; c0 < 64; c0 += 32) { float av[32], ev[32];
#pragma unroll
        for (int j = 0; j < 32; ++j) { av[j] = A[(size_t)(c0 + j) * 512]; ev[j] = E[(size_t)(c0 + j) * 512]; }
#pragma unroll
        for (int j = 0; j < 32; ++j) { I[(size_t)(c0 + j) * 512] = run; run = __expf(av[j]) * run + ev[j]; } }
}

constexpr int S5_XLD = 132, S5_SLD = 136, S5_SB = 16 * S5_XLD * 4;
template <bool FINAL> __device__ __forceinline__ void s5_task(Frame& F, int l, int task) {
    const int lane = F.lane, fr = lane & 15, fq = lane >> 4; const int b = task >> 11, g = (task >> 6) & 31, c = task & 63; const int p = lane;
    LAS unsigned char* wl = F.lds + F.wave * WAVE_LDS;
    LAS float* X = (LAS float*)wl; LAS bf16* Sb = (LAS bf16*)(wl + S5_SB);
    const int lg = l * 32 + g;
    const float lr = INP(3)[lg * 64 + p], li = INP(4)[lg * 64 + p]; const float dt = expf(INP(10)[lg]);
    const float mag = expf(lr * dt); float sn, cs; sincosf(li * dt, &sn, &cs); const float abr = mag * cs, abi = mag * sn;
    const float den = lr * lr + li * li, nr = abr - 1.0f, ni = abi; const float fre = (nr * lr + ni * li) / den, fim = (ni * lr - nr * li) / den;
    bf16x8 Bf[8];
#pragma unroll
    for (int nq = 0; nq < 4; ++nq) { const int pp = 16 * nq + fr; const float fr_ = __shfl(fre, pp), fi_ = __shfl(fim, pp);
        u32x4 wr_ = (u32x4){0u, 0u, 0u, 0u}, wi_ = (u32x4){0u, 0u, 0u, 0u};
        if (fq < 2) { const f32x4* br = (const f32x4*)(INP(5) + ((size_t)lg * 64 + pp) * 16 + 8 * fq); const f32x4* bi = (const f32x4*)(INP(6) + ((size_t)lg * 64 + pp) * 16 + 8 * fq);
            const f32x4 r0 = br[0], r1 = br[1], i0 = bi[0], i1 = bi[1];
            wr_.x = pk2(fr_ * r0[0] - fi_ * i0[0], fr_ * r0[1] - fi_ * i0[1]); wr_.y = pk2(fr_ * r0[2] - fi_ * i0[2], fr_ * r0[3] - fi_ * i0[3]);
            wr_.z = pk2(fr_ * r1[0] - fi_ * i1[0], fr_ * r1[1] - fi_ * i1[1]); wr_.w = pk2(fr_ * r1[2] - fi_ * i1[2], fr_ * r1[3] - fi_ * i1[3]);
            wi_.x = pk2(fr_ * i0[0] + fi_ * r0[0], fr_ * i0[1] + fi_ * r0[1]); wi_.y = pk2(fr_ * i0[2] + fi_ * r0[2], fr_ * i0[3] + fi_ * r0[3]);
            wi_.z = pk2(fr_ * i1[0] + fi_ * r1[0], fr_ * i1[1] + fi_ * r1[1]); wi_.w = pk2(fr_ * i1[2] + fi_ * r1[2], fr_ * i1[3] + fi_ * r1[3]); }
        Bf[nq] = __builtin_bit_cast(bf16x8, wr_); Bf[nq + 4] = __builtin_bit_cast(bf16x8, wi_); }
    bf16x8 Cf[4], Df;
    if (FINAL) {
#pragma unroll
        for (int kk = 0; kk < 4; ++kk) { const float* src = (kk < 2 ? INP(7) : INP(8)) + ((size_t)lg * 16 + fr) * 64 + 32 * (kk & 1) + 8 * fq; const float sg = kk < 2 ? 1.0f : -1.0f;
            const f32x4 c0 = *(const f32x4*)src, c1 = *(const f32x4*)(src + 4);
            u32x4 w; w.x = pk2(sg * c0[0], sg * c0[1]); w.y = pk2(sg * c0[2], sg * c0[3]); w.z = pk2(sg * c1[0], sg * c1[1]); w.w = pk2(sg * c1[2], sg * c1[3]); Cf[kk] = __builtin_bit_cast(bf16x8, w); }
        const float dv = INP(9)[l * 512 + 16 * g + fr]; float dd[8];
#pragma unroll
        for (int j = 0; j < 8; ++j) dd[j] = (8 * fq + j == fr) ? dv : 0.f;
        u32x4 w; w.x = pk2(dd[0], dd[1]); w.y = pk2(dd[2], dd[3]); w.z = pk2(dd[4], dd[5]); w.w = pk2(dd[6], dd[7]); Df = __builtin_bit_cast(bf16x8, w);
    }
    float sre = 0.f, sim = 0.f;
    const size_t sidx = (((size_t)b * 32 + g) * 64 + c) * 128 + p;
    if (FINAL) { sre = WSP(const float, WS_S5I)[sidx]; sim = WSP(const float, WS_S5I)[sidx + 64]; }
    const size_t row0 = (size_t)b * SEQ + (size_t)c * 128;
    const bf16* up = WSP(const bf16, WS_PROJ) + (row0 + fr) * MIXP + PC_S5U + 16 * g + 8 * (fq & 1);
    u32x4 aun = *(const u32x4*)up;
#pragma unroll 1
    for (int sb = 0; sb < 8; ++sb) {
        u32x4 au_ = aun; if (fq >= 2) au_ = (u32x4){0u, 0u, 0u, 0u};
        const bf16x8 au = __builtin_bit_cast(bf16x8, au_);
        if (sb < 7) aun = *(const u32x4*)(up + (size_t)(sb + 1) * 16 * MIXP);
#pragma unroll
        for (int nt = 0; nt < 8; ++nt) { const f32x4 a = __builtin_amdgcn_mfma_f32_16x16x32_bf16(au, Bf[nt], (f32x4){0.f, 0.f, 0.f, 0.f}, 0, 0, 0);
#pragma unroll
            for (int e = 0; e < 4; ++e) X[(4 * fq + e) * S5_XLD + 16 * nt + fr] = a[e]; }
#pragma unroll
        for (int t = 0; t < 16; ++t) { const float xr = X[t * S5_XLD + p], xi = X[t * S5_XLD + 64 + p];
            const float nre = abr * sre - abi * sim + xr, nim = abr * sim + abi * sre + xi; sre = nre; sim = nim;
            if (FINAL) { Sb[t * S5_SLD + p] = (bf16)f2bf(sre); Sb[t * S5_SLD + 64 + p] = (bf16)f2bf(sim); } }
        if (FINAL) {
            f32x4 y = (f32x4){0.f, 0.f, 0.f, 0.f};
#pragma unroll
            for (int kk = 0; kk < 4; ++kk) y = __builtin_amdgcn_mfma_f32_16x16x32_bf16(*(const LAS bf16x8*)(Sb + fr * S5_SLD + 32 * kk + 8 * fq), Cf[kk], y, 0, 0, 0);
            y = __builtin_amdgcn_mfma_f32_16x16x32_bf16(au, Df, y, 0, 0, 0);
#pragma unroll
            for (int e = 0; e < 4; ++e) WSP(bf16, WS_S5Z)[(row0 + sb * 16 + 4 * fq + e) * 512 + 16 * g + fr] = (bf16)f2bf(geluf_(y[e]));
        }
    }
    if (!FINAL) { WSP(float, WS_S5E)[sidx] = sre; WSP(float, WS_S5E)[sidx + 64] = sim; }
}
__device__ __forceinline__ void s5_carry(Frame& F, int l, int task) {
    const int b = task >> 5, g = task & 31, p = F.lane;
    const float lr = INP(3)[(l * 32 + g) * 64 + p], li = INP(4)[(l * 32 + g) * 64 + p]; const float dt = expf(INP(10)[l * 32 + g]);
    const float mag = expf(lr * dt); float sn, cs; sincosf(li * dt, &sn, &cs); float ar = mag * cs, ai = mag * sn;
#pragma unroll
    for (int i = 0; i < 7; ++i) { const float nr = ar * ar - ai * ai, ni = (ar + ar) * ai; ar = nr; ai = ni; }
    float rr = 0.f, ri = 0.f;
    const float* E = WSP(const float, WS_S5E) + (((size_t)b * 32 + g) * 64) * 128 + p; float* I = WSP(float, WS_S5I) + (((size_t)b * 32 + g) * 64) * 128 + p;
#pragma unroll 1
    for (int c0 = 0; c0 < 64; c0 += 32) { float er[32], ei[32];
#pragma unroll
        for (int j = 0; j < 32; ++j) { er[j] = E[(size_t)(c0 + j) * 128]; ei[j] = E[(size_t)(c0 + j) * 128 + 64]; }
#pragma unroll
        for (int j = 0; j < 32; ++j) { I[(size_t)(c0 + j) * 128] = rr; I[(size_t)(c0 + j) * 128 + 64] = ri;
            const float nr = ar * rr - ai * ri + er[j], ni = ar * ri + ai * rr + ei[j]; rr = nr; ri = ni; } }
}

constexpr int M2_CS = 0, M2_BS = 17408, M2_BST = 34816, M2_XT = 53248, M2_GS = 90112, M2_CUM = 107520, M2_DTV = 108544, M2_END = 109568;
constexpr int LDP = 136, LDT = 72, LDG = 68;
__device__ __forceinline__ void m2_stage(Frame& F, int l, int b, int c, int gr) {
    LAS bf16* Cs = (LAS bf16*)(F.lds + M2_CS); LAS bf16* Bs = (LAS bf16*)(F.lds + M2_BS); LAS bf16* BsT = (LAS bf16*)(F.lds + M2_BST); LAS bf16* XT = (LAS bf16*)(F.lds + M2_XT);
    LAS float* cum = (LAS float*)(F.lds + M2_CUM); LAS float* dtv = (LAS float*)(F.lds + M2_DTV);
    const int tid = F.tid; const size_t row0 = (size_t)b * SEQ + (size_t)c * 64;
    {
        const int kind = tid < 256 ? 0 : (tid < 384 ? 1 : 2); const int idx = kind == 0 ? tid : (kind == 1 ? tid - 256 : tid - 384);
        const int col = kind == 0 ? 256 * gr + idx : (kind == 1 ? 512 + 128 * gr + idx : 768 + 128 * gr + idx);
        const float* cwp = INP(19) + (size_t)l * 4 * 1024 + col; const float cw0 = cwp[0], cw1 = cwp[1024], cw2 = cwp[2048], cw3 = cwp[3072]; const float cb = INP(20)[l * 1024 + col];
        const bf16* px = WSP(const bf16, WS_PROJ) + row0 * MIXP + PC_XBC + col;
        float xm3 = 0.f, xm2 = 0.f, xm1 = 0.f;
        if (c > 0) { xm3 = bf2f(*(px - 3 * (ptrdiff_t)MIXP)); xm2 = bf2f(*(px - 2 * (ptrdiff_t)MIXP)); xm1 = bf2f(*(px - (ptrdiff_t)MIXP)); }
        bf16 xall[64];
#pragma unroll
        for (int j = 0; j < 64; ++j) xall[j] = px[(size_t)j * MIXP];
#pragma unroll
        for (int tb = 0; tb < 8; ++tb) {
            float vv[8];
#pragma unroll
            for (int j = 0; j < 8; ++j) { const float xv = bf2f(xall[tb * 8 + j]);
                vv[j] = siluf_(cb + cw0 * xm3 + cw1 * xm2 + cw2 * xm1 + cw3 * xv); xm3 = xm2; xm2 = xm1; xm1 = xv; }
            u32x4 w; w.x = pk2(vv[0], vv[1]); w.y = pk2(vv[2], vv[3]); w.z = pk2(vv[4], vv[5]); w.w = pk2(vv[6], vv[7]);
            if (kind == 0) *(LAS u32x4*)(XT + idx * LDT + tb * 8) = w;
            else if (kind == 1) { *(LAS u32x4*)(BsT + idx * LDT + tb * 8) = w;
#pragma unroll
                for (int j = 0; j < 8; ++j) Bs[(tb * 8 + j) * LDP + idx] = (bf16)f2bf(vv[j]); }
            else {
#pragma unroll
                for (int j = 0; j < 8; ++j) Cs[(tb * 8 + j) * LDP + idx] = (bf16)f2bf(vv[j]); }
        }
    }
    if (tid < 256) { const int hh = tid >> 6, t = tid & 63, h = 4 * gr + hh;
        const float dtr = bf2f(WSP(const bf16, WS_PROJ)[(row0 + t) * MIXP + PC_DT + h]);
        const float dt = softplusf_(dtr + INP(21)[l * 8 + h]); const float a = -expf(INP(22)[l * 8 + h]);
        float s = dt * a;
#pragma unroll
        for (int o = 1; o < 64; o <<= 1) { const float n = __shfl_up(s, o); if (t >= o) s += n; }
        dtv[hh * 64 + t] = dt; cum[hh * 64 + t] = s; }
    __syncthreads();
}
__device__ __forceinline__ bf16x8 ldfrag(const LAS bf16* p) { return *(const LAS bf16x8*)p; }
__device__ __forceinline__ void m2_pass1(Frame& F, int l, int task) {
    const int b = task >> 8, c = (task >> 1) & 127, gr = task & 1;
    m2_stage(F, l, b, c, gr);
    LAS bf16* BsT = (LAS bf16*)(F.lds + M2_BST); LAS bf16* XT = (LAS bf16*)(F.lds + M2_XT); LAS float* cum = (LAS float*)(F.lds + M2_CUM); LAS float* dtv = (LAS float*)(F.lds + M2_DTV);
    const int lane = F.lane, hh = F.wave >> 1, half = F.wave & 1, h = 4 * gr + hh; const int fr = lane & 15, fq = lane >> 4;
    const float clast = cum[hh * 64 + 63];
    f32x4 acc[2][8];
#pragma unroll
    for (int i = 0; i < 2; ++i)
#pragma unroll
        for (int j = 0; j < 8; ++j) acc[i][j] = (f32x4){0.f, 0.f, 0.f, 0.f};
#pragma unroll
    for (int kk = 0; kk < 2; ++kk) {
        float fj[8];
#pragma unroll
        for (int e = 0; e < 8; ++e) { const int j = 32 * kk + 8 * fq + e; fj[e] = dtv[hh * 64 + j] * __expf(clast - cum[hh * 64 + j]); }
        bf16x8 af[2];
#pragma unroll
        for (int pi = 0; pi < 2; ++pi) { const int p = 16 * (2 * half + pi) + fr; const u32x4 raw = *(const LAS u32x4*)(XT + (64 * hh + p) * LDT + 32 * kk + 8 * fq);
            u32x4 w; w.x = pk2(lo16(raw.x) * fj[0], hi16(raw.x) * fj[1]); w.y = pk2(lo16(raw.y) * fj[2], hi16(raw.y) * fj[3]); w.z = pk2(lo16(raw.z) * fj[4], hi16(raw.z) * fj[5]); w.w = pk2(lo16(raw.w) * fj[6], hi16(raw.w) * fj[7]);
            af[pi] = __builtin_bit_cast(bf16x8, w); }
#pragma unroll
        for (int nt = 0; nt < 8; ++nt) { const bf16x8 bfr = ldfrag(BsT + (16 * nt + fr) * LDT + 32 * kk + 8 * fq);
#pragma unroll
            for (int pi = 0; pi < 2; ++pi) acc[pi][nt] = __builtin_amdgcn_mfma_f32_16x16x32_bf16(af[pi], bfr, acc[pi][nt], 0, 0, 0); }
    }
    bf16* S = WSP(bf16, WS_M2S) + ((((size_t)b * 128 + c) * 8 + h) * 64) * 128;
#pragma unroll
    for (int pi = 0; pi < 2; ++pi)
#pragma unroll
        for (int nt = 0; nt < 8; ++nt)
#pragma unroll
            for (int e = 0; e < 4; ++e) S[(size_t)(16 * (2 * half + pi) + 4 * fq + e) * 128 + 16 * nt + fr] = (bf16)f2bf(acc[pi][nt][e]);
    if (half == 0 && lane == 0) WSP(float, WS_M2D)[((size_t)b * 128 + c) * 8 + h] = __expf(clast);
    __syncthreads();
}
__device__ __forceinline__ void m2_carry(Frame& F) {
    const int gt = F.blk * NTHR + F.tid, stride = F.G * NTHR, NE = NB * 8 * 8192;
    int vz; asm volatile("v_mov_b32 %0, 0" : "=v"(vz));
    for (int e0 = gt; e0 < NE; e0 += 2 * stride) {
        const int e1 = (e0 + stride < NE) ? e0 + stride : e0; const bool two = e1 != e0;
        bf16* S0 = WSP(bf16, WS_M2S) + (((size_t)(e0 >> 16) * 128) * 8 + ((e0 >> 13) & 7)) * 8192 + (e0 & 8191); const float* D0 = WSP(const float, WS_M2D) + (size_t)(e0 >> 16) * 128 * 8 + ((e0 >> 13) & 7) + vz;
        bf16* S1 = WSP(bf16, WS_M2S) + (((size_t)(e1 >> 16) * 128) * 8 + ((e1 >> 13) & 7)) * 8192 + (e1 & 8191); const float* D1 = WSP(const float, WS_M2D) + (size_t)(e1 >> 16) * 128 * 8 + ((e1 >> 13) & 7) + vz;
        float run0 = 0.f, run1 = 0.f;
#pragma unroll 1
        for (int c0 = 0; c0 < 128; c0 += 16) {
            bf16 t0[16], t1[16]; float d0[16], d1[16];
#pragma unroll
            for (int j = 0; j < 16; ++j) { t0[j] = S0[(size_t)(c0 + j) * 8 * 8192]; d0[j] = D0[(c0 + j) * 8]; t1[j] = S1[(size_t)(c0 + j) * 8 * 8192]; d1[j] = D1[(c0 + j) * 8]; }
#pragma unroll
            for (int j = 0; j < 16; ++j) { S0[(size_t)(c0 + j) * 8 * 8192] = (bf16)f2bf(run0); run0 = d0[j] * run0 + bf2f(t0[j]);
                if (two) S1[(size_t)(c0 + j) * 8 * 8192] = (bf16)f2bf(run1); run1 = d1[j] * run1 + bf2f(t1[j]); }
        }
    }
}
__device__ __forceinline__ void m2_pass2(Frame& F, int l, int task) {
    const int b = task >> 8, c = (task >> 1) & 127, gr = task & 1;
    m2_stage(F, l, b, c, gr);
    LAS bf16* Cs = (LAS bf16*)(F.lds + M2_CS); LAS bf16* Bs = (LAS bf16*)(F.lds + M2_BS); LAS bf16* XT = (LAS bf16*)(F.lds + M2_XT);
    LAS float* Gs = (LAS float*)(F.lds + M2_GS); LAS float* cum = (LAS float*)(F.lds + M2_CUM); LAS float* dtv = (LAS float*)(F.lds + M2_DTV);
    const int lane = F.lane, w = F.wave, fr = lane & 15, fq = lane >> 4;
#pragma unroll
    for (int q = 0; q < 2; ++q) { const int tile = 2 * w + q, it = tile >> 2, jt = tile & 3; f32x4 a = (f32x4){0.f, 0.f, 0.f, 0.f};
#pragma unroll
        for (int kk = 0; kk < 4; ++kk) a = __builtin_amdgcn_mfma_f32_16x16x32_bf16(ldfrag(Cs + (16 * it + fr) * LDP + 32 * kk + 8 * fq), ldfrag(Bs + (16 * jt + fr) * LDP + 32 * kk + 8 * fq), a, 0, 0, 0);
#pragma unroll
        for (int e = 0; e < 4; ++e) Gs[(16 * it + 4 * fq + e) * LDG + 16 * jt + fr] = a[e]; }
    __syncthreads();
    const int hh = w >> 1, half = w & 1, h = 4 * gr + hh;
    f32x4 accd[2][4], acco[2][4];
#pragma unroll
    for (int i = 0; i < 2; ++i)
#pragma unroll
        for (int j = 0; j < 4; ++j) { accd[i][j] = (f32x4){0.f, 0.f, 0.f, 0.f}; acco[i][j] = (f32x4){0.f, 0.f, 0.f, 0.f}; }
#pragma unroll
    for (int ii = 0; ii < 2; ++ii) { const int it = 2 * half + ii; const int i = 16 * it + fr; const float ci = cum[hh * 64 + i];
#pragma unroll
        for (int kk = 0; kk < 2; ++kk) { if (32 * kk > 16 * it + 15) continue;
            float wv[8];
#pragma unroll
            for (int e = 0; e < 8; ++e) { const int j = 32 * kk + 8 * fq + e; const float gv = Gs[i * LDG + j]; wv[e] = (j <= i) ? gv * __expf(ci - cum[hh * 64 + j]) * dtv[hh * 64 + j] : 0.f; }
            u32x4 ww; ww.x = pk2(wv[0], wv[1]); ww.y = pk2(wv[2], wv[3]); ww.z = pk2(wv[4], wv[5]); ww.w = pk2(wv[6], wv[7]);
            const bf16x8 af = __builtin_bit_cast(bf16x8, ww);
#pragma unroll
            for (int pt = 0; pt < 4; ++pt) accd[ii][pt] = __builtin_amdgcn_mfma_f32_16x16x32_bf16(af, ldfrag(XT + (64 * hh + 16 * pt + fr) * LDT + 32 * kk + 8 * fq), accd[ii][pt], 0, 0, 0); } }
    const bf16* S = WSP(const bf16, WS_M2S) + ((((size_t)b * 128 + c) * 8 + h) * 64) * 128;
#pragma unroll
    for (int kk = 0; kk < 4; ++kk) {
        bf16x8 bfr[4];
#pragma unroll
        for (int pt = 0; pt < 4; ++pt) bfr[pt] = *(const bf16x8*)(S + (size_t)(16 * pt + fr) * 128 + 32 * kk + 8 * fq);
#pragma unroll
        for (int ii = 0; ii < 2; ++ii) { const bf16x8 af = ldfrag(Cs + (16 * (2 * half + ii) + fr) * LDP + 32 * kk + 8 * fq);
#pragma unroll
            for (int pt = 0; pt < 4; ++pt) acco[ii][pt] = __builtin_amdgcn_mfma_f32_16x16x32_bf16(af, bfr[pt], acco[ii][pt], 0, 0, 0); }
    }
    const float dpar = INP(23)[l * 8 + h]; const size_t row0 = (size_t)b * SEQ + (size_t)c * 64;
#pragma unroll
    for (int ii = 0; ii < 2; ++ii)
#pragma unroll
        for (int e = 0; e < 4; ++e) { const int i = 16 * (2 * half + ii) + 4 * fq + e; const float ec = __expf(cum[hh * 64 + i]);
#pragma unroll
            for (int pt = 0; pt < 4; ++pt) { const int p = 16 * pt + fr;
                float y = accd[ii][pt][e] + ec * acco[ii][pt][e] + dpar * bf2f(XT[(64 * hh + p) * LDT + i]);
                const float z = bf2f(WSP(const bf16, WS_PROJ)[(row0 + i) * MIXP + PC_M2Z + 64 * h + p]);
                WSP(float, WS_M2Y)[(row0 + i) * 512 + 64 * h + p] = y * siluf_(z); } }
    __syncthreads();
}
__device__ __forceinline__ void m2_norm(Frame& F, int l, int gw, int ngw) {
    f32x4 g0 = *(const f32x4*)(INP(24) + l * 512 + 8 * F.lane), g1 = *(const f32x4*)(INP(24) + l * 512 + 8 * F.lane + 4);
    for (int m0 = gw; m0 < MTOK; m0 += 4 * ngw) { f32x4 a[4], b[4];
#pragma unroll
        for (int q = 0; q < 4; ++q) { const int m = m0 + q * ngw < MTOK ? m0 + q * ngw : m0; const f32x4* yp = (const f32x4*)(WSP(const float, WS_M2Y) + (size_t)m * 512 + 8 * F.lane); a[q] = yp[0]; b[q] = yp[1]; }
        asm volatile("" ::: "memory");
#pragma unroll
        for (int q = 0; q < 4; ++q) { const int m = m0 + q * ngw; if (m >= MTOK) break;
            const float ss = wave_sum((a[q].x * a[q].x + a[q].y * a[q].y) + (a[q].z * a[q].z + a[q].w * a[q].w) + (b[q].x * b[q].x + b[q].y * b[q].y) + (b[q].z * b[q].z + b[q].w * b[q].w));
            const float rs = 1.0f / sqrtf(ss * (1.f / 512.f) + 1e-6f);
            u32x4 w; w.x = pk2(a[q].x * rs * g0.x, a[q].y * rs * g0.y); w.y = pk2(a[q].z * rs * g0.z, a[q].w * rs * g0.w); w.z = pk2(b[q].x * rs * g1.x, b[q].y * rs * g1.y); w.w = pk2(b[q].z * rs * g1.z, b[q].w * rs * g1.w);
            *(u32x4*)(WSP(bf16, WS_YK) + (size_t)2 * MTOK * 512 + (size_t)m * 512 + 8 * F.lane) = w; }
        asm volatile("" ::: "memory"); }
}

constexpr int RP_LDA = 72, RP_LDB = 104;
#define RWP_WFRAG(dst, base, ldrow) do { const float* p_ = (base); u32x4 w_; w_.x = pk2(p_[0], p_[512]); w_.y = pk2(p_[1024], p_[1536]); w_.z = pk2(p_[2048], p_[2560]); w_.w = pk2(p_[3072], p_[3584]); dst = __builtin_bit_cast(bf16x8, w_); } while (0)
__device__ __forceinline__ void rw_pre(Frame& F, int l, int task) {
    LAS bf16* SM0 = (LAS bf16*)F.lds;
    const int tid = F.tid, lane = F.lane, hh = F.wave, fr = lane & 15, fq = lane >> 4;
    const float* mu = INP(25) + (size_t)l * RWC;
    const size_t rowb = (size_t)task * 128;
    const bf16* P = WSP(const bf16, WS_PROJ);
    const bool nofirst = (rowb & (SEQ - 1)) != 0;
    const int c4 = 64 * hh + 4 * fr;
    {
        bf16x8 Bw[4], Ba[4];
#pragma unroll
        for (int ct = 0; ct < 4; ++ct) { RWP_WFRAG(Bw[ct], INP(27) + ((size_t)l * 32 + 8 * fq) * 512 + c4 + ct, 512); RWP_WFRAG(Ba[ct], INP(29) + ((size_t)l * 32 + 8 * fq) * 512 + c4 + ct, 512); }
        const float* pw0 = INP(26) + l * 512 + c4; const float* pa0 = INP(28) + l * 512 + c4; const float* pkk = INP(31) + l * 512 + c4; const float* pka = INP(32) + l * 512 + c4; const float* prk = INP(33) + l * 512 + c4;
        const int sj = tid & 63, st0 = tid >> 6, st1 = 8 + (tid >> 6); const float smu = mu[1536 + sj];
        const bf16* sq = P + rowb * MIXP + PC_RW + 1536 + sj;
        bf16 sc0, sp0, sc1, sp1;
        u32x2 rkv[4][3], rkvp[3];
        const bf16* rq = P + (rowb + 4 * fq) * MIXP + PC_RW + c4;
#define RWP_STAGE_LOAD(sb) do { const size_t o_ = (size_t)((sb) * 16) * MIXP; sc0 = sq[o_ + (size_t)st0 * MIXP]; sc1 = sq[o_ + (size_t)st1 * MIXP]; sp1 = sq[o_ + (size_t)(st1 - 1) * MIXP]; \
            sp0 = (nofirst || (sb) > 0 || st0 > 0) ? sq[o_ + (size_t)st0 * MIXP - MIXP] : (bf16)0; } while (0)
#define RWP_STAGE_WRITE(buf) do { { const float pt_ = bf2f(sc0), pp_ = bf2f(sp0); const float pm_ = pt_ + (pp_ - pt_) * smu; SM0[(buf) * 1664 + st0 * RP_LDA + sj] = (bf16)f2bf(sj < 32 ? (1.0f - 2.0f * rcpf_(__expf(2.0f * pm_) + 1.0f)) : pm_); } \
            { const float pt_ = bf2f(sc1), pp_ = bf2f(sp1); const float pm_ = pt_ + (pp_ - pt_) * smu; SM0[(buf) * 1664 + st1 * RP_LDA + sj] = (bf16)f2bf(sj < 32 ? (1.0f - 2.0f * rcpf_(__expf(2.0f * pm_) + 1.0f)) : pm_); } } while (0)
#define RWP_RKV_LOAD(sb, cur, prev) do { const bf16* q_ = rq + (size_t)((sb) * 16) * MIXP; \
            _Pragma("unroll") for (int e_ = 0; e_ < 4; ++e_) _Pragma("unroll") for (int a_ = 0; a_ < 3; ++a_) cur[e_][a_] = *(const u32x2*)(q_ + (size_t)e_ * MIXP + 512 * a_); \
            const bool hp_ = nofirst || (sb) > 0 || fq > 0; \
            _Pragma("unroll") for (int a_ = 0; a_ < 3; ++a_) prev[a_] = hp_ ? *(const u32x2*)(q_ - (ptrdiff_t)MIXP + 512 * a_) : (u32x2){0u, 0u}; } while (0)
        RWP_STAGE_LOAD(0); RWP_RKV_LOAD(0, rkv, rkvp); RWP_STAGE_WRITE(0);
        __syncthreads();
#pragma unroll 1
        for (int sb = 0; sb < 8; ++sb) {
            if (sb < 7) { RWP_STAGE_LOAD(sb + 1); }
            const LAS bf16* SM = SM0 + (sb & 1) * 1664;
            const bf16x8 Aw = ldfrag(SM + fr * RP_LDA + 8 * fq), Aa = ldfrag(SM + fr * RP_LDA + 32 + 8 * fq);
            f32x4 aw[4], aa[4];
#pragma unroll
            for (int ct = 0; ct < 4; ++ct) { const f32x4 z = (f32x4){0.f, 0.f, 0.f, 0.f};
                aw[ct] = __builtin_amdgcn_mfma_f32_16x16x32_bf16(Aw, Bw[ct], z, 0, 0, 0); aa[ct] = __builtin_amdgcn_mfma_f32_16x16x32_bf16(Aa, Ba[ct], z, 0, 0, 0); }
            const size_t r0 = rowb + sb * 16 + 4 * fq;
            asm volatile("" ::: "memory");
            const f32x4 mu_r = *(const f32x4*)(mu + c4), mu_k = *(const f32x4*)(mu + 512 + c4), mu_v = *(const f32x4*)(mu + 1024 + c4);
            const f32x4 w0c = *(const f32x4*)pw0, a0c = *(const f32x4*)pa0, kkc = *(const f32x4*)pkk, kac = *(const f32x4*)pka, rkc = *(const f32x4*)prk;
#pragma unroll
            for (int e = 0; e < 4; ++e) { const size_t row = r0 + e; const size_t o = row * 512 + c4;
                const u32x2 pr_ = e == 0 ? rkvp[0] : rkv[e > 0 ? e - 1 : 0][0], pk_ = e == 0 ? rkvp[1] : rkv[e > 0 ? e - 1 : 0][1], pv_ = e == 0 ? rkvp[2] : rkv[e > 0 ? e - 1 : 0][2];
                const float rc[4] = {lo16(rkv[e][0].x), hi16(rkv[e][0].x), lo16(rkv[e][0].y), hi16(rkv[e][0].y)}, rp[4] = {lo16(pr_.x), hi16(pr_.x), lo16(pr_.y), hi16(pr_.y)};
                const float kc[4] = {lo16(rkv[e][1].x), hi16(rkv[e][1].x), lo16(rkv[e][1].y), hi16(rkv[e][1].y)}, kp[4] = {lo16(pk_.x), hi16(pk_.x), lo16(pk_.y), hi16(pk_.y)};
                const float vc[4] = {lo16(rkv[e][2].x), hi16(rkv[e][2].x), lo16(rkv[e][2].y), hi16(rkv[e][2].y)}, vp[4] = {lo16(pv_.x), hi16(pv_.x), lo16(pv_.y), hi16(pv_.y)};
                float rr[4], kpr[4], vv[4], kk[4], av[4], dec[4]; float ssp = 0.f, bonp = 0.f;
#pragma unroll
                for (int ct = 0; ct < 4; ++ct) {
                    rr[ct] = rc[ct] + (rp[ct] - rc[ct]) * mu_r[ct]; const float k = kc[ct] + (kp[ct] - kc[ct]) * mu_k[ct]; vv[ct] = vc[ct] + (vp[ct] - vc[ct]) * mu_v[ct];
                    const float wlog = -softplusf_(-(aw[ct][e] + w0c[ct])) - 0.5f; dec[ct] = __expf(-__expf(wlog)); av[ct] = sigmoidf_(aa[ct][e] + a0c[ct]);
                    kk[ct] = k * kkc[ct]; ssp += kk[ct] * kk[ct]; kpr[ct] = k * (1.0f + (av[ct] - 1.0f) * kac[ct]); bonp += rr[ct] * kpr[ct] * rkc[ct]; }
                const float ss = row16_sum(ssp), bon = row16_sum(bonp); const float rn = __builtin_amdgcn_rsqf(fmaxf(ss, 1e-24f));
                u32x2 w;
                w.x = pk2(rr[0], rr[1]); w.y = pk2(rr[2], rr[3]); *(u32x2*)(WSP(bf16, WS_RW_R) + o) = w;
                w.x = pk2(kpr[0], kpr[1]); w.y = pk2(kpr[2], kpr[3]); *(u32x2*)(WSP(bf16, WS_RW_K) + o) = w;
                w.x = pk2(vv[0], vv[1]); w.y = pk2(vv[2], vv[3]); *(u32x2*)(WSP(bf16, WS_RW_V) + o) = w;
                w.x = pk2(-kk[0] * rn, -kk[1] * rn); w.y = pk2(-kk[2] * rn, -kk[3] * rn); *(u32x2*)(WSP(bf16, WS_RW_A) + o) = w;
                w.x = pk2(kk[0] * rn * av[0], kk[1] * rn * av[1]); w.y = pk2(kk[2] * rn * av[2], kk[3] * rn * av[3]); *(u32x2*)(WSP(bf16, WS_RW_B) + o) = w;
                *(f32x4*)(WSP(float, WS_RW_DEC) + o) = (f32x4){dec[0], dec[1], dec[2], dec[3]};
                if (fr == 0) WSP(float, WS_RW_BON)[row * 8 + hh] = bon; }
            if (sb < 7) { RWP_RKV_LOAD(sb + 1, rkv, rkvp); RWP_STAGE_WRITE((sb + 1) & 1); }
            __syncthreads();
        }
#undef RWP_STAGE_LOAD
#undef RWP_STAGE_WRITE
#undef RWP_RKV_LOAD
    }
    {
        int tidb = F.tid; asm volatile("" : "+v"(tidb));
        const int tid = tidb, lane = tid & 63, fr = lane & 15, fq = lane >> 4; const int c4 = 64 * hh + 4 * fr;
        bf16x8 Bg[4][3];
#pragma unroll
        for (int ct = 0; ct < 4; ++ct)
#pragma unroll
            for (int kk = 0; kk < 3; ++kk) RWP_WFRAG(Bg[ct][kk], INP(30) + ((size_t)l * 96 + 32 * kk + 8 * fq) * 512 + c4 + ct, 512);
        int stk[3], sjj[3]; float smv[3]; bf16 sc[3], sp[3];
#pragma unroll
        for (int i = 0; i < 3; ++i) { const int idx = tid + 512 * i; stk[i] = idx / 96; sjj[i] = idx % 96; smv[i] = mu[1600 + sjj[i]]; }
        const bf16* sq = P + rowb * MIXP + PC_RW + 1600;
#define RWP_STAGE_LOAD(sb) do { _Pragma("unroll") for (int i_ = 0; i_ < 3; ++i_) { const bf16* q_ = sq + (size_t)((sb) * 16 + stk[i_]) * MIXP + sjj[i_]; sc[i_] = q_[0]; \
            sp[i_] = (nofirst || (sb) > 0 || stk[i_] > 0) ? *(q_ - (ptrdiff_t)MIXP) : (bf16)0; } } while (0)
#define RWP_STAGE_WRITE(buf) do { _Pragma("unroll") for (int i_ = 0; i_ < 3; ++i_) { const float pt_ = bf2f(sc[i_]), pp_ = bf2f(sp[i_]); \
            SM0[(buf) * 1664 + stk[i_] * RP_LDB + sjj[i_]] = (bf16)f2bf(sigmoidf_(pt_ + (pp_ - pt_) * smv[i_])); } } while (0)
        RWP_STAGE_LOAD(0); RWP_STAGE_WRITE(0);
        __syncthreads();
#pragma unroll 1
        for (int sb = 0; sb < 8; ++sb) {
            if (sb < 7) RWP_STAGE_LOAD(sb + 1);
            const LAS bf16* SM = SM0 + (sb & 1) * 1664;
            const bf16x8 Ag0 = ldfrag(SM + fr * RP_LDB + 8 * fq), Ag1 = ldfrag(SM + fr * RP_LDB + 32 + 8 * fq), Ag2 = ldfrag(SM + fr * RP_LDB + 64 + 8 * fq);
            f32x4 ag[4];
#pragma unroll
            for (int ct = 0; ct < 4; ++ct) { f32x4 g = __builtin_amdgcn_mfma_f32_16x16x32_bf16(Ag0, Bg[ct][0], (f32x4){0.f, 0.f, 0.f, 0.f}, 0, 0, 0);
                g = __builtin_amdgcn_mfma_f32_16x16x32_bf16(Ag1, Bg[ct][1], g, 0, 0, 0); ag[ct] = __builtin_amdgcn_mfma_f32_16x16x32_bf16(Ag2, Bg[ct][2], g, 0, 0, 0); }
            const size_t r0 = rowb + sb * 16 + 4 * fq;
#pragma unroll
            for (int e = 0; e < 4; ++e) { u32x2 w; w.x = pk2(ag[0][e], ag[1][e]); w.y = pk2(ag[2][e], ag[3][e]); *(u32x2*)(WSP(bf16, WS_RW_G) + (r0 + e) * 512 + c4) = w; }
            if (sb < 7) RWP_STAGE_WRITE((sb + 1) & 1);
            __syncthreads();
        }
#undef RWP_STAGE_LOAD
#undef RWP_STAGE_WRITE
    }
}
constexpr int RC_G1 = 0, RC_G2 = 8192, RC_Q1 = 10240, RC_Q2 = 12288, RC_GAM = 13312, RC_VT = 13568, RC_BYTES = 16384;
constexpr size_t WS_RWC = WS_PROJ;
constexpr int CP_IMG = 0, CP_MAT = 9216, CP_P2 = 13568, CP_Q2 = 14656;
constexpr int CP_P1I = 0, CP_BGI = 3072, CP_Q1I = 6144;
__device__ __forceinline__ void rw_chunk_prep(Frame& F, int task) {
    int lane = F.lane; asm volatile("" : "+v"(lane)); const int fr = lane & 15, fq = lane >> 4; const int b = task >> 12, h = (task >> 9) & 7, c = task & 511;
    LAS unsigned char* wl = F.lds + F.wave * WAVE_LDS;
    LAS bf16* IMG = (LAS bf16*)(wl + CP_IMG); LAS float* MAT = (LAS float*)(wl + CP_MAT); LAS float* P2m = (LAS float*)(wl + CP_P2); LAS float* Q2m = (LAS float*)(wl + CP_Q2);
    unsigned char* rec = F.ws + WS_RWC + (size_t)task * RC_BYTES;
    const size_t e0 = ((size_t)b * SEQ + (size_t)c * 16) * 512 + 64 * h + lane;
    float At[16], Bt[16], Kt[16], Rt[16]; float gT;
    { float wv[16]; bf16 av[16], bv[16], kv[16], rv[16];
#pragma unroll
      for (int t = 0; t < 16; ++t) { const size_t o = e0 + (size_t)t * 512; wv[t] = WSP(const float, WS_RW_DEC)[o]; av[t] = WSP(const bf16, WS_RW_A)[o]; bv[t] = WSP(const bf16, WS_RW_B)[o]; kv[t] = WSP(const bf16, WS_RW_K)[o]; rv[t] = WSP(const bf16, WS_RW_R)[o]; }
      float g = 1.0f;
#pragma unroll
      for (int t = 0; t < 16; ++t) { const float gp = g; g *= wv[t]; const float inv = rcpf_(g);
          At[t] = bf2f(av[t]) * gp; Bt[t] = bf2f(bv[t]) * inv; Kt[t] = bf2f(kv[t]) * inv; Rt[t] = bf2f(rv[t]) * g;
          IMG[0 * 1152 + t * 72 + lane] = (bf16)f2bf(At[t]); IMG[1 * 1152 + t * 72 + lane] = (bf16)f2bf(Bt[t]); IMG[2 * 1152 + t * 72 + lane] = (bf16)f2bf(Kt[t]); IMG[3 * 1152 + t * 72 + lane] = (bf16)f2bf(Rt[t]); }
      gT = g; }
    { unsigned vp[8];
#pragma unroll
      for (int t = 0; t < 16; t += 2) vp[t >> 1] = (unsigned)WSP(const bf16, WS_RW_V)[e0 + (size_t)t * 512] | ((unsigned)WSP(const bf16, WS_RW_V)[e0 + (size_t)(t + 1) * 512] << 16);
      u32x4* d = (u32x4*)(rec + RC_VT + lane * 32); d[0] = (u32x4){vp[0], vp[1], vp[2], vp[3]}; d[1] = (u32x4){vp[4], vp[5], vp[6], vp[7]};
      ((float*)(rec + RC_GAM))[lane] = gT; }
    { f32x4 nab = (f32x4){0.f, 0.f, 0.f, 0.f}, nak = nab, mbr = nab, mkr = nab;
#pragma unroll
      for (int kk = 0; kk < 2; ++kk) { const int o = fr * 72 + 32 * kk + 8 * fq;
          const bf16x8 fa = ldfrag(IMG + 0 * 1152 + o), fb = ldfrag(IMG + 1 * 1152 + o), fk = ldfrag(IMG + 2 * 1152 + o), frr = ldfrag(IMG + 3 * 1152 + o);
          nab = __builtin_amdgcn_mfma_f32_16x16x32_bf16(fb, fa, nab, 0, 0, 0); nak = __builtin_amdgcn_mfma_f32_16x16x32_bf16(fk, fa, nak, 0, 0, 0);
          mbr = __builtin_amdgcn_mfma_f32_16x16x32_bf16(fb, frr, mbr, 0, 0, 0); mkr = __builtin_amdgcn_mfma_f32_16x16x32_bf16(fk, frr, mkr, 0, 0, 0); }
#pragma unroll
      for (int e = 0; e < 4; ++e) { const int s_ = 4 * fq + e, t_ = fr; const int o = s_ * 17 + t_;
          MAT[0 * 272 + o] = s_ < t_ ? nab[e] : 0.f; MAT[1 * 272 + o] = s_ < t_ ? nak[e] : 0.f; MAT[2 * 272 + o] = s_ <= t_ ? mbr[e] : 0.f; MAT[3 * 272 + o] = s_ <= t_ ? mkr[e] : 0.f; } }
    float P1[16], P2[16];
#pragma unroll
    for (int t = 0; t < 16; ++t) { float p1 = At[t], p2 = MAT[1 * 272 + fr * 17 + t];
#pragma unroll
        for (int s_ = 0; s_ < t; ++s_) { const float n = MAT[0 * 272 + s_ * 17 + t]; p1 += P1[s_] * n; p2 += P2[s_] * n; }
        P1[t] = p1; P2[t] = p2; asm volatile("" ::: "memory"); }
    LAS bf16* Q1I = (LAS bf16*)(wl + CP_Q1I);
#pragma unroll
    for (int t = 0; t < 16; ++t) { float q1 = Rt[t], q2 = MAT[3 * 272 + fr * 17 + t];
#pragma unroll
        for (int s_ = 0; s_ <= t; ++s_) { const float m = MAT[2 * 272 + s_ * 17 + t]; q1 += P1[s_] * m; q2 += P2[s_] * m; }
        Q1I[t * 72 + lane] = (bf16)f2bf(q1); if (lane < 16) { Q2m[lane * 17 + t] = q2; P2m[lane * 17 + t] = P2[t]; }
        asm volatile("" ::: "memory"); }
    { LAS bf16* P1I = (LAS bf16*)(wl + CP_P1I); LAS bf16* BGI = (LAS bf16*)(wl + CP_BGI);
      u32x4 w0, w1;
      w0.x = pk2(P1[0], P1[1]); w0.y = pk2(P1[2], P1[3]); w0.z = pk2(P1[4], P1[5]); w0.w = pk2(P1[6], P1[7]); w1.x = pk2(P1[8], P1[9]); w1.y = pk2(P1[10], P1[11]); w1.z = pk2(P1[12], P1[13]); w1.w = pk2(P1[14], P1[15]);
      *(LAS u32x4*)(P1I + lane * 24) = w0; *(LAS u32x4*)(P1I + lane * 24 + 8) = w1;
      w0.x = pk2(Bt[0] * gT, Bt[1] * gT); w0.y = pk2(Bt[2] * gT, Bt[3] * gT); w0.z = pk2(Bt[4] * gT, Bt[5] * gT); w0.w = pk2(Bt[6] * gT, Bt[7] * gT);
      w1.x = pk2(Bt[8] * gT, Bt[9] * gT); w1.y = pk2(Bt[10] * gT, Bt[11] * gT); w1.z = pk2(Bt[12] * gT, Bt[13] * gT); w1.w = pk2(Bt[14] * gT, Bt[15] * gT);
      *(LAS u32x4*)(BGI + lane * 24) = w0; *(LAS u32x4*)(BGI + lane * 24 + 8) = w1;
      const u32x4 z4 = (u32x4){0u, 0u, 0u, 0u};
      bf16x8 Af[4], Bf[4];
#pragma unroll
      for (int i = 0; i < 4; ++i) { u32x4 ta = z4, tb = z4; if (fq < 2) { ta = *(const LAS u32x4*)(P1I + (16 * i + fr) * 24 + 8 * fq); tb = *(const LAS u32x4*)(BGI + (16 * i + fr) * 24 + 8 * fq); }
          Af[i] = __builtin_bit_cast(bf16x8, ta); Bf[i] = __builtin_bit_cast(bf16x8, tb); }
#pragma unroll
      for (int j = 0; j < 4; ++j)
#pragma unroll
          for (int s_ = 0; s_ < 2; ++s_) { const f32x4 lo = __builtin_amdgcn_mfma_f32_16x16x32_bf16(Af[2 * s_], Bf[j], (f32x4){0.f, 0.f, 0.f, 0.f}, 0, 0, 0);
              const f32x4 hi = __builtin_amdgcn_mfma_f32_16x16x32_bf16(Af[2 * s_ + 1], Bf[j], (f32x4){0.f, 0.f, 0.f, 0.f}, 0, 0, 0);
              u32x4 w; w.x = pk2(lo[0], lo[1]); w.y = pk2(lo[2], lo[3]); w.z = pk2(hi[0], hi[1]); w.w = pk2(hi[2], hi[3]);
              *(u32x4*)(rec + RC_G1 + ((j * 2 + s_) * 64 + lane) * 16) = w; } }
    { float g2v[16];
#pragma unroll
      for (int t = 0; t < 16; ++t) { float acc = Kt[t];
#pragma unroll
          for (int s_ = 0; s_ < 16; ++s_) acc += P2m[t * 17 + s_] * Bt[s_];
          g2v[t] = acc * gT; asm volatile("" ::: "memory"); }
      u32x4 w0, w1; w0.x = pk2(g2v[0], g2v[1]); w0.y = pk2(g2v[2], g2v[3]); w0.z = pk2(g2v[4], g2v[5]); w0.w = pk2(g2v[6], g2v[7]); w1.x = pk2(g2v[8], g2v[9]); w1.y = pk2(g2v[10], g2v[11]); w1.z = pk2(g2v[12], g2v[13]); w1.w = pk2(g2v[14], g2v[15]);
      u32x4* d = (u32x4*)(rec + RC_G2 + lane * 32); d[0] = w0; d[1] = w1; }
    {
#pragma unroll
      for (int s_ = 0; s_ < 2; ++s_) { const u32x2 lo = *(const LAS u32x2*)(Q1I + fr * 72 + 32 * s_ + 4 * fq), hi = *(const LAS u32x2*)(Q1I + fr * 72 + 32 * s_ + 16 + 4 * fq);
          *(u32x4*)(rec + RC_Q1 + (s_ * 64 + lane) * 16) = (u32x4){lo.x, lo.y, hi.x, hi.y}; } }
    { u32x4 w = (u32x4){0u, 0u, 0u, 0u};
      if (fq < 2) { float q[8];
#pragma unroll
          for (int j = 0; j < 8; ++j) q[j] = Q2m[(8 * fq + j) * 17 + fr];
          w.x = pk2(q[0], q[1]); w.y = pk2(q[2], q[3]); w.z = pk2(q[4], q[5]); w.w = pk2(q[6], q[7]); }
      *(u32x4*)(rec + RC_Q2 + lane * 16) = w; }
}
__device__ __forceinline__ void rw_chunk_step(const LAS unsigned char* rc, f32x4 (&X)[4], float* yo, int w, int lane, int fr, int fq) {
    const u32x4 z4 = (u32x4){0u, 0u, 0u, 0u};
    u32x4 b0, b1; b0.x = pk2(X[0][0], X[0][1]); b0.y = pk2(X[0][2], X[0][3]); b0.z = pk2(X[1][0], X[1][1]); b0.w = pk2(X[1][2], X[1][3]);
    b1.x = pk2(X[2][0], X[2][1]); b1.y = pk2(X[2][2], X[2][3]); b1.z = pk2(X[3][0], X[3][1]); b1.w = pk2(X[3][2], X[3][3]);
    const bf16x8 Bx0 = __builtin_bit_cast(bf16x8, b0), Bx1 = __builtin_bit_cast(bf16x8, b1);
    u32x4 vt = z4; if (fq < 2) vt = *(const LAS u32x4*)(rc + RC_VT + (16 * w + fr) * 32 + 16 * fq);
    const bf16x8 Vf = __builtin_bit_cast(bf16x8, vt);
    f32x4 Y = (f32x4){0.f, 0.f, 0.f, 0.f};
    Y = __builtin_amdgcn_mfma_f32_16x16x32_bf16(*(const LAS bf16x8*)(rc + RC_Q1 + (0 * 64 + lane) * 16), Bx0, Y, 0, 0, 0);
    Y = __builtin_amdgcn_mfma_f32_16x16x32_bf16(*(const LAS bf16x8*)(rc + RC_Q1 + (1 * 64 + lane) * 16), Bx1, Y, 0, 0, 0);
    Y = __builtin_amdgcn_mfma_f32_16x16x32_bf16(*(const LAS bf16x8*)(rc + RC_Q2 + lane * 16), Vf, Y, 0, 0, 0);
#pragma unroll
    for (int j = 0; j < 4; ++j) { const f32x4 gm = *(const LAS f32x4*)(rc + RC_GAM + (16 * j + 4 * fq) * 4);
        f32x4 C = X[j] * gm;
        C = __builtin_amdgcn_mfma_f32_16x16x32_bf16(*(const LAS bf16x8*)(rc + RC_G1 + ((j * 2 + 0) * 64 + lane) * 16), Bx0, C, 0, 0, 0);
        C = __builtin_amdgcn_mfma_f32_16x16x32_bf16(*(const LAS bf16x8*)(rc + RC_G1 + ((j * 2 + 1) * 64 + lane) * 16), Bx1, C, 0, 0, 0);
        u32x4 g2 = z4; if (fq < 2) g2 = *(const LAS u32x4*)(rc + RC_G2 + (16 * j + fr) * 32 + 16 * fq);
        C = __builtin_amdgcn_mfma_f32_16x16x32_bf16(__builtin_bit_cast(bf16x8, g2), Vf, C, 0, 0, 0);
        X[j] = C; }
#pragma unroll
    for (int e = 0; e < 4; ++e) yo[(size_t)(4 * fq + e) * 512] = Y[e];
}
__device__ __forceinline__ void rw_scan2(Frame& F, int task) {
    const int tid = F.tid, lane = F.lane, w = F.wave, fr = lane & 15, fq = lane >> 4;
    const unsigned char* recs = F.ws + WS_RWC + (size_t)task * 512 * RC_BYTES;
    constexpr int NP = SEQ / 32;
    if (w >= 4) {
        const int lt = tid - 256;
        const u32x4* src = (const u32x4*)recs + lt;
        u32x4 rg[4][8];
#pragma unroll
        for (int u = 0; u < 4; ++u)
#pragma unroll
            for (int i = 0; i < 8; ++i) rg[u][i] = src[(size_t)u * 2048 + i * 256];
#pragma unroll 1
        for (int g4 = 0; g4 < NP / 4; ++g4) {
#pragma unroll
            for (int u = 0; u < 4; ++u) { const int g = 4 * g4 + u;
                LAS u32x4* dst = (LAS u32x4*)(F.lds + ((2 * g) & 7) * RC_BYTES) + lt;
#pragma unroll
                for (int i = 0; i < 8; ++i) dst[i * 256] = rg[u][i];
                if (g + 4 < NP) {
#pragma unroll
                    for (int i = 0; i < 8; ++i) rg[u][i] = src[(size_t)(g + 4) * 2048 + i * 256]; }
                __syncthreads(); }
        }
        __syncthreads();
    } else {
        const int b = task >> 3, h = task & 7;
        f32x4 X[4];
#pragma unroll
        for (int j = 0; j < 4; ++j) X[j] = (f32x4){0.f, 0.f, 0.f, 0.f};
        float* yo = WSP(float, WS_RW_Y) + ((size_t)b * SEQ) * 512 + 64 * h + 16 * w + fr;
        __syncthreads();
#pragma unroll 1
        for (int g = 0; g < NP; ++g) {
            rw_chunk_step(F.lds + ((2 * g) & 7) * RC_BYTES, X, yo + (size_t)(2 * g) * 16 * 512, w, lane, fr, fq);
            rw_chunk_step(F.lds + ((2 * g + 1) & 7) * RC_BYTES, X, yo + (size_t)(2 * g + 1) * 16 * 512, w, lane, fr, fq);
            __syncthreads();
        }
    }
}
__device__ __forceinline__ void rw_post(Frame& F, int l, int gw, int ngw) {
    const int lane = F.lane;
    const f32x4 g0 = *(const f32x4*)(INP(34) + l * 512 + 8 * lane), g1 = *(const f32x4*)(INP(34) + l * 512 + 8 * lane + 4);
    const f32x4 b0 = *(const f32x4*)(INP(35) + l * 512 + 8 * lane), b1 = *(const f32x4*)(INP(35) + l * 512 + 8 * lane + 4);
    for (int m0 = gw; m0 < MTOK; m0 += 4 * ngw) { f32x4 ya4[4], yb4[4]; u32x4 vr4[4], gr4[4]; float bon4[4];
#pragma unroll
        for (int q = 0; q < 4; ++q) { const int m = m0 + q * ngw < MTOK ? m0 + q * ngw : m0; const size_t o = (size_t)m * 512 + 8 * lane;
            ya4[q] = *(const f32x4*)(WSP(const float, WS_RW_Y) + o); yb4[q] = *(const f32x4*)(WSP(const float, WS_RW_Y) + o + 4);
            vr4[q] = *(const u32x4*)(WSP(const bf16, WS_RW_V) + o); gr4[q] = *(const u32x4*)(WSP(const bf16, WS_RW_G) + o); bon4[q] = WSP(const float, WS_RW_BON)[(size_t)m * 8 + (lane >> 3)]; }
        asm volatile("" ::: "memory");
#pragma unroll
        for (int q = 0; q < 4; ++q) { const int m = m0 + q * ngw; if (m >= MTOK) break; const size_t o = (size_t)m * 512 + 8 * lane;
            const f32x4 ya = ya4[q], yb = yb4[q];
            float y[8] = {ya.x, ya.y, ya.z, ya.w, yb.x, yb.y, yb.z, yb.w};
            float s = 0.f;
#pragma unroll
            for (int j = 0; j < 8; ++j) s += y[j];
            s += __shfl_xor(s, 1); s += __shfl_xor(s, 2); s += __shfl_xor(s, 4); const float mean = s * (1.f / 64.f);
            float qv = 0.f;
#pragma unroll
            for (int j = 0; j < 8; ++j) { y[j] -= mean; qv += y[j] * y[j]; }
            qv += __shfl_xor(qv, 1); qv += __shfl_xor(qv, 2); qv += __shfl_xor(qv, 4); const float rs = 1.0f / sqrtf(qv * (1.f / 64.f) + 64e-5f);
            const u32x4 vr = vr4[q], gr_ = gr4[q]; const float bon = bon4[q];
            const float vv[8] = {lo16(vr.x), hi16(vr.x), lo16(vr.y), hi16(vr.y), lo16(vr.z), hi16(vr.z), lo16(vr.w), hi16(vr.w)};
            const float gg[8] = {lo16(gr_.x), hi16(gr_.x), lo16(gr_.y), hi16(gr_.y), lo16(gr_.z), hi16(gr_.z), lo16(gr_.w), hi16(gr_.w)};
            const float lg[8] = {g0.x, g0.y, g0.z, g0.w, g1.x, g1.y, g1.z, g1.w}, lb[8] = {b0.x, b0.y, b0.z, b0.w, b1.x, b1.y, b1.z, b1.w};
            float ov[8];
#pragma unroll
            for (int j = 0; j < 8; ++j) ov[j] = (y[j] * rs * lg[j] + lb[j] + bon * vv[j]) * gg[j];
            u32x4 w; w.x = pk2(ov[0], ov[1]); w.y = pk2(ov[2], ov[3]); w.z = pk2(ov[4], ov[5]); w.w = pk2(ov[6], ov[7]);
            *(u32x4*)(WSP(bf16, WS_YK) + (size_t)3 * MTOK * 512 + o) = w; }
        asm volatile("" ::: "memory"); }
}

#ifndef GATE_NA
#define GATE_NA 17
#endif
#ifndef PHMASK
#define PHMASK 0xFFFFFFFFu
#endif
#define PH(n) (((PHMASK) >> (n)) & 1u)
#ifndef REPMASK
#define REPMASK 0u
#endif
#define NREP(n) ((((REPMASK) >> (n)) & 1u) ? 2 : 1)
#ifndef TPSMASK
#define TPSMASK 0u
#endif
#define TPS_B(n) unsigned long long tps_##n = 0ull; if (((TPSMASK) >> (n)) & 1u) tps_##n = __builtin_amdgcn_s_memrealtime()
#define TPS_E(n) do { if (((TPSMASK) >> (n)) & 1u) { const unsigned long long t1_ = __builtin_amdgcn_s_memrealtime(); const unsigned long long d_ = t1_ - tps_##n; while (__builtin_amdgcn_s_memrealtime() - t1_ < d_) __builtin_amdgcn_s_sleep(8); } } while (0)
#ifndef TPMASK
#define TPMASK 0u
#endif
#define TP(n) do { if (((TPMASK) >> (n)) & 1u) { const unsigned long long t1_ = __builtin_amdgcn_s_memrealtime(); const unsigned long long d_ = t1_ - tp0; while (__builtin_amdgcn_s_memrealtime() - t1_ < d_) __builtin_amdgcn_s_sleep(8); tp0 = __builtin_amdgcn_s_memrealtime(); } else if (TPMASK) tp0 = __builtin_amdgcn_s_memrealtime(); } while (0)
template <class T> __device__ __forceinline__ T* launder_ptr(T* p) { const unsigned long long w = (unsigned long long)p; unsigned lo = __builtin_amdgcn_readfirstlane((unsigned)w), hi = __builtin_amdgcn_readfirstlane((unsigned)(w >> 32));
    asm volatile("" : "+s"(lo), "+s"(hi)); return (T*)(GAS T*)(((unsigned long long)hi << 32) | lo); }
#define PHASE_BEGIN() do { F.ws = launder_ptr(F.ws); F.out = launder_ptr(F.out); { unsigned la_ = __builtin_amdgcn_readfirstlane((unsigned)(size_t)F.lds); int bk_ = __builtin_amdgcn_readfirstlane(F.blk); asm volatile("" : "+s"(la_), "+s"(bk_)); F.lds = (LAS unsigned char*)(size_t)la_; F.blk = bk_; } { int wv_ = __builtin_amdgcn_readfirstlane(F.wave); asm volatile("" : "+s"(wv_)); F.wave = wv_; } { int ln_; asm volatile("v_mbcnt_lo_u32_b32 %0, -1, 0\n\tv_mbcnt_hi_u32_b32 %0, -1, %0\n\ts_nop 1" : "=v"(ln_)); F.tid = F.wave * 64 + ln_; } F.lane = F.tid & 63; } while (0)
__global__ void __launch_bounds__(NTHR, 2) hybrid_fwd(Args args) {
    extern __shared__ __attribute__((aligned(16))) unsigned char lds_raw[];
    Frame F;
    F.lds = (LAS unsigned char*)lds_raw; F.out = args.out; F.ws = args.ws;
    F.tid = threadIdx.x; F.lane = F.tid & 63; F.wave = __builtin_amdgcn_readfirstlane(F.tid >> 6); F.blk = blockIdx.x; F.G = gridDim.x;
    volatile LAS unsigned* MISC = (volatile LAS unsigned*)(F.lds + LDS_MISC);
    if (F.tid < 64) MISC[F.tid] = 0u;
    if (F.tid < 45) { const unsigned long long p = ((const __attribute__((address_space(4))) unsigned long long*)__builtin_amdgcn_kernarg_segment_ptr())[F.tid]; MISC[64 + 2 * F.tid] = (unsigned)p; MISC[64 + 2 * F.tid + 1] = (unsigned)(p >> 32); }
    __syncthreads();
    XcdBarrier bar = xcd_barrier_post((unsigned*)(F.ws + WS_CTL) + CW_BAR, MISC + 8);
#define gw (F.blk * NWAVES + F.wave)
#define NGW (F.G * NWAVES)
#define glds (F.lds)

    unsigned long long tp0 = TPMASK ? __builtin_amdgcn_s_memrealtime() : 0ull;
#pragma unroll 1
    for (int l = 0; l < DEPTH; ++l) {
        const float* xin = (l == 0) ? INP(0) : F.out;
        PHASE_BEGIN();
        for (int rep_ = 0; rep_ < NREP(0); ++rep_) if (PH(0)) { convert_weights(F, l);
            for (int nb = F.blk; nb < NGATE / 32 + 2 * (FF / 32); nb += F.G) {
                const int seg = nb < NGATE / 32 ? 0 : (nb < NGATE / 32 + FF / 32 ? 1 : 2);
                const float* Wp = seg == 0 ? INP(2) + (size_t)l * DM * INC : (seg == 1 ? INP(39) : INP(40)) + (size_t)l * DM * FF;
                signed char* W8p = seg == 0 ? WSP(signed char, WS_WIN) + (size_t)MIXP * DM * 2 : (seg == 1 ? WSP(signed char, WS_WFG) : WSP(signed char, WS_WFU));
                convert_cols_i8(F, Wp, seg == 0 ? INC : FF, seg == 0 ? MIXC : 0, nb - (seg == 0 ? 0 : (seg == 1 ? NGATE / 32 : NGATE / 32 + FF / 32)), W8p, WSP(float, WS_SB) + 16384 * seg, 0); }
            { const float* cw = INP(41) + (size_t)l * 3 * FF; const float* cb = INP(42) + (size_t)l * FF;
              for (int c = F.blk * 512 + F.tid; c < FF; c += F.G * 512) { WSP(unsigned, WS_SB)[65536 + c] = pk2(cw[c], cw[FF + c]); WSP(unsigned, WS_SB)[65536 + 8192 + c] = pk2(cw[2 * FF + c], cb[c]); } } }
        PHASE_BEGIN();
        for (int rep_ = 0; rep_ < NREP(1); ++rep_) if (PH(1)) rmsnorm_rows(F, l == 0 ? INP(0) : nullptr, (const bf16*)F.out, INP(1) + (size_t)l * DM, WSP(bf16, WS_H), nullptr, WSP(unsigned, WS_A8), WSP(float, WS_SA));
        xcd_barrier(bar); TP(0);
        PHASE_BEGIN();
        for (int rep_ = 0; rep_ < NREP(2); ++rep_) if (PH(2)) { pg8::Gemm g{WSP(const bf16, WS_H), WSP(const bf16, WS_WIN), MTOK, MIXP, DM}; pg8::StaticOrder S; S.init(MTOK, MIXP, F.G, F.blk);
          pg8::EpiStore<0> E{WSP(bf16, WS_PROJ), MIXP}; pg8::gemm_phase(glds, g, S, E, F.tid); }
        PHASE_BEGIN();
        if (PH(2) && F.blk >= 128) {
          pg8::Gemm g{WSP(const bf16, WS_A8), (const bf16*)(WSP(const signed char, WS_WIN) + (size_t)MIXP * DM * 2), MTOK, NGATE, DM / 2};
          pg8::SplitOrder S; S.init(MTOK, NGATE, 128, F.blk - 128, 4096 - 256, 2);
          pg8::EpiGateU8 E{WSP(unsigned char, WS_GATES), WSP(const float, WS_SA), WSP(const float, WS_SB)}; pg8::gemm_phase(glds, g, S, E, F.tid); }
        xcd_barrier(bar); TP(1);
        PHASE_BEGIN();
        TPS_B(3); for (int rep_ = 0; rep_ < NREP(3); ++rep_) if (PH(3)) for (int t = F.blk; t < MTOK / 128; t += F.G) rw_pre(F, l, t); TPS_E(3);
        PHASE_BEGIN();
        TPS_B(4); for (int rep_ = 0; rep_ < NREP(4); ++rep_) if (PH(4)) for (int t = F.blk; t < 1024; t += F.G) m2_pass1(F, l, t); TPS_E(4);
        PHASE_BEGIN();
#pragma unroll 1
        for (int st = 0; st < 2; ++st) {
            if (st) PHASE_BEGIN();
            if (((st ^ F.wave) & 1) == 0) { if (PH(5)) for (int t = gw; t < 8192; t += NGW) s5_task<false>(F, l, t); }
            else { if (PH(6)) for (int t = gw; t < 2048; t += NGW) lru_task<false>(F, l, t); } }
        xcd_barrier(bar); TP(2);
        PHASE_BEGIN();
        for (int rep_ = 0; rep_ < NREP(7); ++rep_) if (PH(7)) m2_carry(F);
        PHASE_BEGIN();
        for (int rep_ = 0; rep_ < NREP(8); ++rep_) if (PH(8)) for (int t = gw; t < 128; t += NGW) s5_carry(F, l, t);
        PHASE_BEGIN();
        for (int rep_ = 0; rep_ < NREP(9); ++rep_) if (PH(9)) for (int t = NGW - 1 - gw; t < 32; t += NGW) lru_carry(F, t);
        xcd_barrier(bar); TP(3);
        PHASE_BEGIN();
        TPS_B(10); for (int rep_ = 0; rep_ < NREP(10); ++rep_) if (PH(10)) for (int t = F.blk; t < 1024; t += F.G) m2_pass2(F, l, t); TPS_E(10);
        PHASE_BEGIN();
#pragma unroll 1
        for (int st = 0; st < 2; ++st) {
            if (st) PHASE_BEGIN();
            if (((st ^ F.wave) & 1) == 0) { if (PH(11)) for (int t = gw; t < 8192; t += NGW) s5_task<true>(F, l, t); }
            else { if (PH(12)) for (int t = gw; t < 2048; t += NGW) lru_task<true>(F, l, t); } }
        xcd_barrier(bar); TP(4);
        PHASE_BEGIN();
        for (int rep_ = 0; rep_ < NREP(14); ++rep_) if (PH(14)) {
            { pg8::Gemm g{WSP(const bf16, WS_S5Z), WSP(const bf16, WS_WGLU), MTOK, 512, 512}; pg8::StaticOrder S; S.init(MTOK, 512, F.G, F.blk);
              pg8::EpiGlu E{WSP(const bf16, WS_S5Z), WSP(bf16, WS_YK)}; pg8::gemm_phase(glds, g, S, E, F.tid); }
            m2_norm(F, l, gw, NGW);
        }
        PHASE_BEGIN();
        TPS_B(24); for (int rep_ = 0; rep_ < NREP(24); ++rep_) if (PH(24)) for (int t = gw; t < NB * 8 * 512; t += NGW) rw_chunk_prep(F, t); TPS_E(24);
        xcd_barrier(bar); TP(5);
        PHASE_BEGIN();
        if (F.blk < 32) { if (PH(13)) rw_scan2(F, F.blk); }
        PHASE_BEGIN();
        if (PH(16)) { pg8::Gemm g{WSP(const bf16, WS_A8), (const bf16*)(WSP(const signed char, WS_WIN) + (size_t)MIXP * DM * 2), MTOK, NGATE, DM / 2};
          pg8::SplitOrder S; if (F.blk >= 32) S.init(MTOK, NGATE, 224, F.blk - 32, 0, GATE_NA); else S.init(MTOK, NGATE, 32, F.blk, 224 * GATE_NA, (4096 - 256 - 224 * GATE_NA) / 32);
          pg8::EpiGateU8 E{WSP(unsigned char, WS_GATES), WSP(const float, WS_SA), WSP(const float, WS_SB)}; pg8::gemm_phase(glds, g, S, E, F.tid); }
        xcd_barrier(bar); TP(6);
        PHASE_BEGIN();
        for (int rep_ = 0; rep_ < NREP(15); ++rep_) if (PH(15)) rw_post(F, l, gw, NGW);
        xcd_barrier(bar); TP(7);
        PHASE_BEGIN();
        for (int rep_ = 0; rep_ < NREP(17); ++rep_) if (PH(17)) { pg8::Gemm g{WSP(const bf16, WS_YK), WSP(const bf16, WS_WPK), 4 * MTOK, 4 * DM, 512}; pg8::OrderYK S{F.G, F.blk};
          pg8::EpiGateAcc E{WSP(const unsigned char, WS_GATES), WSP(bf16, WS_MERGED)}; pg8::gemm_phase(glds, g, S, E, F.tid); }
        xcd_barrier(bar); TP(8);
        PHASE_BEGIN();
        for (int rep_ = 0; rep_ < NREP(18); ++rep_) if (PH(18)) { pg8::Gemm g{WSP(const bf16, WS_MERGED), WSP(const bf16, WS_WOUT), MTOK, DM, DM}; pg8::StaticOrder S; S.init(MTOK, DM, F.G, F.blk);
          pg8::EpiAddX E{l == 0 ? INP(0) : nullptr, (const bf16*)F.out, (bf16*)F.out, DM}; pg8::gemm_phase(glds, g, S, E, F.tid); }
        xcd_barrier(bar); TP(9);
        PHASE_BEGIN();
        for (int rep_ = 0; rep_ < NREP(19); ++rep_) if (PH(19)) rmsnorm_rows(F, nullptr, (const bf16*)F.out, INP(38) + (size_t)l * DM, nullptr, nullptr, WSP(unsigned, WS_A8), WSP(float, WS_SA));
        xcd_barrier(bar); TP(10);
        PHASE_BEGIN();
        for (int rep_ = 0; rep_ < NREP(20); ++rep_) if (PH(20)) { pg8::Gemm g{WSP(const bf16, WS_A8), WSP(const bf16, WS_WFG), MTOK, FF, DM / 2}; pg8::StaticOrder S; S.init(MTOK, FF, F.G, F.blk);
          pg8::EpiStoreI8<0> E{WSP(bf16, WS_FG), FF, WSP(const float, WS_SA), WSP(const float, WS_SB) + 16384}; pg8::gemm_phase(glds, g, S, E, F.tid); }
        xcd_barrier(bar); TP(11);
        PHASE_BEGIN();
        for (int rep_ = 0; rep_ < NREP(21); ++rep_) if (PH(21)) { pg8::Gemm g{WSP(const bf16, WS_A8), WSP(const bf16, WS_WFU), MTOK, FF, DM / 2}; pg8::StaticOrder S; S.init(MTOK, FF, F.G, F.blk);
          pg8::EpiFfnUp<true> E{WSP(const bf16, WS_FG), WSP(bf16, WS_HID), WSP(const unsigned, WS_SB) + 65536, WSP(const unsigned, WS_SB) + 65536 + 8192, WSP(const float, WS_SA), WSP(const float, WS_SB) + 32768}; pg8::gemm_phase(glds, g, S, E, F.tid); }
        xcd_barrier(bar); TP(12);
        PHASE_BEGIN();
        for (int rep_ = 0; rep_ < NREP(22); ++rep_) if (PH(22)) { pg8::Gemm g{WSP(const bf16, WS_HID), WSP(const bf16, WS_WFD), MTOK, DM, FF}; pg8::StaticOrder S; S.init(MTOK, DM, F.G, F.blk);
          pg8::EpiAddX E{nullptr, (const bf16*)F.out, l == DEPTH - 1 ? WSP(bf16, WS_H) : (bf16*)F.out, DM}; pg8::gemm_phase(glds, g, S, E, F.tid); }
        xcd_barrier(bar); TP(13);
    }
    PHASE_BEGIN();
    for (int rep_ = 0; rep_ < NREP(23); ++rep_) if (PH(23)) rmsnorm_rows(F, nullptr, WSP(const bf16, WS_H), INP(44), nullptr, F.out);
}

extern "C" void kernel_launch(void* const* d_in, const int* in_sizes, int n_in, void* d_out, int out_size, void* d_ws, size_t ws_size, hipStream_t stream) {
    static int grid = 0;
    if (grid == 0) {
        if (n_in != 45 || in_sizes[0] != MTOK * DM || out_size != MTOK * DM || ws_size < WS_END) {
            fprintf(stderr, "kernel_launch: unexpected shapes/workspace (n_in %d, in0 %d, out %d, ws %zu, need %zu); nothing launched\n", n_in, n_in > 0 ? in_sizes[0] : -1, out_size, ws_size, (size_t)WS_END); grid = -1; return; }
        int dev = 0, cus = 0, per_cu = 0;
        if (hipGetDevice(&dev) != hipSuccess || hipDeviceGetAttribute(&cus, hipDeviceAttributeMultiprocessorCount, dev) != hipSuccess) { grid = -1; return; }
        if (hipFuncSetAttribute((const void*)hybrid_fwd, hipFuncAttributeMaxDynamicSharedMemorySize, LDS_BYTES) != hipSuccess) { fprintf(stderr, "kernel_launch: hipFuncSetAttribute failed\n"); grid = -1; return; }
        if (hipOccupancyMaxActiveBlocksPerMultiprocessor(&per_cu, (const void*)hybrid_fwd, NTHR, LDS_BYTES) != hipSuccess || per_cu < 1) { fprintf(stderr, "kernel_launch: occupancy query says %d\n", per_cu); }
        (void)hipGetLastError();
        grid = cus;
        if (grid != 256) fprintf(stderr, "kernel_launch: note: %d CUs\n", grid);
    }
    if (grid < 0) return;
    if (hipMemsetAsync((char*)d_ws + WS_CTL, 0, CTL_BYTES, stream) != hipSuccess) return;
    Args a{};
    for (int i = 0; i < 45; ++i) a.in[i] = (const float*)d_in[i];
    a.out = (float*)d_out; a.ws = (unsigned char*)d_ws;
    hipLaunchKernelGGL(hybrid_fwd, dim3(grid), dim3(NTHR), LDS_BYTES, stream, a);
}
```

```cpp
#include <hip/hip_runtime.h>
#include <cstdio>
#include <cstdint>

#define LAS __attribute__((address_space(3)))
typedef unsigned short bf16;
typedef short bf16x8 __attribute__((ext_vector_type(8)));
typedef float f32x4 __attribute__((ext_vector_type(4)));
typedef float f32x2 __attribute__((ext_vector_type(2)));
typedef unsigned u32x4 __attribute__((ext_vector_type(4)));
typedef unsigned u32x2 __attribute__((ext_vector_type(2)));
typedef __bf16 bf16v2 __attribute__((ext_vector_type(2)));
typedef int i32x4 __attribute__((ext_vector_type(4)));

constexpr int NB = 4, SEQ = 8192, DM = 2048, MTOK = NB * SEQ, DEPTH = 4;
constexpr int MIXC = 4776, MIXP = 4864, INC = 12968, FF = 6144, NGATE = 8192;
constexpr int RWC = 1696;
constexpr int PC_S5U = 0, PC_LRX = 512, PC_LRG = 1024, PC_M2Z = 1536, PC_XBC = 2048, PC_DT = 3072, PC_RW = 3080;

constexpr size_t MiB = 1u << 20;
constexpr size_t WS_CTL = 0, CTL_BYTES = 1 * MiB;
constexpr size_t WS_WIN = 1 * MiB, WS_WPK = 52 * MiB, WS_WOUT = 60 * MiB, WS_WFG = 68 * MiB, WS_WFU = 92 * MiB, WS_WFD = 116 * MiB, WS_WGLU = 140 * MiB;
constexpr size_t WS_SA = 141 * MiB, WS_SB = 142 * MiB;
constexpr size_t WS_A8 = 1538 * MiB;
constexpr size_t WS_H = 144 * MiB, WS_YK = 272 * MiB, WS_PROJ = 400 * MiB, WS_MERGED = 400 * MiB, WS_GATES = 900 * MiB;
constexpr size_t WS_RW_R = 1216 * MiB, WS_RW_K = 1248 * MiB, WS_RW_V = 1280 * MiB, WS_RW_A = 1312 * MiB, WS_RW_B = 1344 * MiB, WS_RW_G = 1376 * MiB,
                 WS_RW_DEC = 1408 * MiB, WS_RW_Y = 1472 * MiB, WS_RW_BON = 1536 * MiB, WS_END = 1602 * MiB;
constexpr size_t WS_S5Z = 704 * MiB, WS_S5E = 736 * MiB, WS_S5I = 740 * MiB, WS_LRE = 744 * MiB, WS_LRA = 745 * MiB, WS_LRI = 746 * MiB;
constexpr size_t WS_M2S = 752 * MiB, WS_M2D = 816 * MiB, WS_M2Y = 820 * MiB;
constexpr size_t WS_FG = 400 * MiB, WS_HID = 784 * MiB;
constexpr int CW_BAR = 4096;

__device__ __forceinline__ float bf2f(bf16 b) { return __uint_as_float(((unsigned)b) << 16); }
__device__ __forceinline__ unsigned f2bf(float f) { const __bf16 b = (__bf16)f; return (unsigned)__builtin_bit_cast(unsigned short, b); }
__device__ __forceinline__ unsigned pk2(float lo, float hi) { const f32x2 v = {lo, hi}; const bf16v2 b = __builtin_convertvector(v, bf16v2); return __builtin_bit_cast(unsigned, b); }
__device__ __forceinline__ float lo16(unsigned w) { return __uint_as_float(w << 16); }
__device__ __forceinline__ float hi16(unsigned w) { return __uint_as_float(w & 0xffff0000u); }
__device__ __forceinline__ float rcpf_(float x) { return __builtin_amdgcn_rcpf(x); }
__device__ __forceinline__ float sigmoidf_(float x) { return rcpf_(1.0f + __expf(-x)); }
__device__ __forceinline__ float siluf_(float x) { return x * rcpf_(1.0f + __expf(-x)); }
__device__ __forceinline__ float geluf_(float x) { const float u = 0.7978845608028654f * (x + 0.044715f * x * x * x); return x * rcpf_(1.0f + __expf(-2.0f * u)); }
__device__ __forceinline__ float softplusf_(float x) { return fmaxf(x, 0.f) + __logf(1.0f + __expf(-fabsf(x))); }
__device__ __forceinline__ float row16_sum(float v) {
    v += __int_as_float(__builtin_amdgcn_update_dpp(0, __float_as_int(v), 0x128, 0xf, 0xf, true));
    v += __int_as_float(__builtin_amdgcn_update_dpp(0, __float_as_int(v), 0x124, 0xf, 0xf, true));
    v += __int_as_float(__builtin_amdgcn_update_dpp(0, __float_as_int(v), 0x122, 0xf, 0xf, true));
    v += __int_as_float(__builtin_amdgcn_update_dpp(0, __float_as_int(v), 0x121, 0xf, 0xf, true));
    return v;
}
__device__ __forceinline__ float wave_sum(float v) {
    v = row16_sum(v);
    const float a = __int_as_float(__builtin_amdgcn_readlane(__float_as_int(v), 0)), b = __int_as_float(__builtin_amdgcn_readlane(__float_as_int(v), 16));
    const float c = __int_as_float(__builtin_amdgcn_readlane(__float_as_int(v), 32)), d = __int_as_float(__builtin_amdgcn_readlane(__float_as_int(v), 48));
    return (a + b) + (c + d);
}
__device__ __forceinline__ float wave_max(float v) {
    v = fmaxf(v, __int_as_float(__builtin_amdgcn_update_dpp(0, __float_as_int(v), 0x128, 0xf, 0xf, true)));
    v = fmaxf(v, __int_as_float(__builtin_amdgcn_update_dpp(0, __float_as_int(v), 0x124, 0xf, 0xf, true)));
    v = fmaxf(v, __int_as_float(__builtin_amdgcn_update_dpp(0, __float_as_int(v), 0x122, 0xf, 0xf, true)));
    v = fmaxf(v, __int_as_float(__builtin_amdgcn_update_dpp(0, __float_as_int(v), 0x121, 0xf, 0xf, true)));
    const float a = __int_as_float(__builtin_amdgcn_readlane(__float_as_int(v), 0)), b = __int_as_float(__builtin_amdgcn_readlane(__float_as_int(v), 16));
    const float c = __int_as_float(__builtin_amdgcn_readlane(__float_as_int(v), 32)), d = __int_as_float(__builtin_amdgcn_readlane(__float_as_int(v), 48));
    return fmaxf(fmaxf(a, b), fmaxf(c, d));
}
__device__ __forceinline__ unsigned q8x4(float a, float b, float c, float d, float inv) {
    const int q0 = (int)rintf(a * inv), q1 = (int)rintf(b * inv), q2 = (int)rintf(c * inv), q3 = (int)rintf(d * inv);
    return (unsigned)(q0 & 0xff) | ((unsigned)(q1 & 0xff) << 8) | ((unsigned)(q2 & 0xff) << 16) | ((unsigned)q3 << 24);
}
__device__ __forceinline__ float rdlane(float v, int l) { return __int_as_float(__builtin_amdgcn_readlane(__float_as_int(v), l)); }

namespace pg8 {
constexpr int BM = 256, BK = 64, HALF = 128, HTB = HALF * BK * 2, STAGE_BYTES = 8 * HTB, NXCD = 8, WGM = 4;
__host__ __device__ __forceinline__ int lds_byte(int r, int c) { const int st = (r >> 4) * 2 + (c >> 5), rr = r & 15, cc = c & 31, ob = rr * 64 + cc * 2; return st * 1024 + (ob ^ (((ob >> 9) & 1) << 5)); }
__host__ __device__ __forceinline__ void stage_rc(int b, int& R, int& C) { const int st = b / 1024, sb = b % 1024, swz = sb ^ (((sb >> 9) & 1) << 5); R = (st >> 1) * 16 + swz / 64; C = (st & 1) * 32 + (swz % 64) / 2; }
__host__ __device__ __forceinline__ int perm32(int rho) { const int n = rho >> 4, i = rho & 15; return 8 * (i >> 2) + 4 * n + (i & 3); }
struct Unit { int pm, pn; };
struct Gemm { const bf16* A; const bf16* Bt; int M, N, K; };
struct StaticOrder {
    int nM, nN, nwg, G, c;
    __device__ void init(int M, int N, int G_, int c_) { nM = M / BM; nN = N / BM; nwg = nM * nN; G = G_; c = c_; }
    __device__ bool next(int i, Unit& u) const {
        const long L = (long)i * G + c; if (L >= nwg || c < 0) return false;
        int wgid = (int)L; { const int q = nwg / NXCD, r = nwg % NXCD, xcd = wgid % NXCD, off = wgid / NXCD; wgid = (xcd < r ? xcd * (q + 1) : r * (q + 1) + (xcd - r) * q) + off; }
        const int nig = WGM * nN, gid = wgid / nig, fm = gid * WGM, gsz = (nM - fm) < WGM ? (nM - fm) : WGM;
        u.pm = fm + ((wgid % nig) % gsz); u.pn = (wgid % nig) / gsz; return true;
    }
    __device__ __forceinline__ void a_ready(const Unit&) const {}
    __device__ __forceinline__ void done(const Unit&) const {}
};
struct SplitOrder {
    int nM, nN, nwg, G, c, base, n;
    __device__ void init(int M, int N, int G_, int c_, int base_, int n_) { nM = M / BM; nN = N / BM; nwg = nM * nN; G = G_; c = c_; base = base_; n = n_; }
    __device__ bool next(int i, Unit& u) const {
        if (i >= n) return false; const long L = (long)base + (long)i * G + c; if (L >= nwg) return false;
        int wgid = (int)L; { const int q = nwg / NXCD, r = nwg % NXCD, xcd = wgid % NXCD, off = wgid / NXCD; wgid = (xcd < r ? xcd * (q + 1) : r * (q + 1) + (xcd - r) * q) + off; }
        const int nig = WGM * nN, gid = wgid / nig, fm = gid * WGM, gsz = (nM - fm) < WGM ? (nM - fm) : WGM;
        u.pm = fm + ((wgid % nig) % gsz); u.pn = (wgid % nig) / gsz; return true;
    }
    __device__ __forceinline__ void a_ready(const Unit&) const {}
    __device__ __forceinline__ void done(const Unit&) const {}
};
struct OrderYK {
    int G, c;
    __device__ bool next(int i, Unit& u) const {
        const int k = i & 3; const long T = (long)(i >> 2) * G + c; if (T >= 1024) return false;
        int wgid = (int)T; { const int xcd = wgid % 8, off = wgid / 8; wgid = xcd * 128 + off; }
        const int gid = wgid / 32, fm = gid * 4; const int pm = fm + ((wgid % 32) % 4), pn = (wgid % 32) / 4;
        u.pm = k * 128 + pm; u.pn = k * 8 + pn; return true;
    }
    __device__ __forceinline__ void a_ready(const Unit&) const {}
    __device__ __forceinline__ void done(const Unit&) const {}
};
__device__ __forceinline__ unsigned cvt_pk_bf16(float lo, float hi) { return pk2(lo, hi); }

template <bool I8> struct AccOf { typedef f32x4 T; }; template <> struct AccOf<true> { typedef i32x4 T; };
template <int ACT> struct EpiStore {
    static constexpr bool I8 = false; static constexpr bool PERM = true;
    struct Pre {}; __device__ __forceinline__ void prefetch(Pre&, const Unit&, int, int, int, int) const {}
    bf16* O; int ldc;
    __device__ __forceinline__ void operator()(const f32x4 (&acc)[2][2][4][2], const Unit& u, int wr, int wc, int fr, int fq, const Pre&) const {
        const int row0 = u.pm * BM + wr * 64 + fr, col0 = u.pn * BM + wc * 32 + 8 * fq;
#pragma unroll
        for (int ai = 0; ai < 2; ++ai)
#pragma unroll
            for (int m = 0; m < 4; ++m) { bf16* rowp = O + (size_t)(row0 + ai * HALF + m * 16) * ldc + col0;
#pragma unroll
                for (int bj = 0; bj < 2; ++bj) { f32x4 v0 = acc[ai][bj][m][0], v1 = acc[ai][bj][m][1];
                    if (ACT == 1) {
#pragma unroll
                        for (int j = 0; j < 4; ++j) { v0[j] = sigmoidf_(v0[j]); v1[j] = sigmoidf_(v1[j]); } }
                    u32x4 w; w.x = cvt_pk_bf16(v0[0], v0[1]); w.y = cvt_pk_bf16(v0[2], v0[3]); w.z = cvt_pk_bf16(v1[0], v1[1]); w.w = cvt_pk_bf16(v1[2], v1[3]);
                    *(u32x4*)(rowp + bj * HALF) = w; } }
    }
};
template <int ACT> struct EpiStoreI8 {
    static constexpr bool I8 = true; static constexpr bool PERM = true;
    bf16* O; int ldc; const float* sa; const float* sb;
    struct Pre { float sav[4]; f32x4 s[2]; };
    __device__ __forceinline__ void prefetch(Pre& P, const Unit& u, int wr, int wc, int fr, int fq) const {
        const int row0 = u.pm * BM + wr * 64 + fr, col0 = u.pn * BM + wc * 32 + 8 * fq;
#pragma unroll
        for (int i = 0; i < 4; ++i) P.sav[i] = sa[row0 + i * 16];
        P.s[0] = *(const f32x4*)(sb + col0); P.s[1] = *(const f32x4*)(sb + col0 + 4);
    }
    __device__ __forceinline__ void operator()(const i32x4 (&acc)[2][2][4][2], const Unit& u, int wr, int wc, int fr, int fq, const Pre& P) const {
        const int row0 = u.pm * BM + wr * 64 + fr, col0 = u.pn * BM + wc * 32 + 8 * fq;
        float sav[8];
#pragma unroll
        for (int i = 0; i < 8; ++i) { sav[i] = i < 4 ? P.sav[i] : sa[row0 + HALF + (i & 3) * 16]; if (ACT == 1) sav[i] *= -1.4426950408889634f; }
        const f32x4 t0 = *(const f32x4*)(sb + col0 + HALF), t1 = *(const f32x4*)(sb + col0 + HALF + 4);
#pragma unroll
        for (int bj = 0; bj < 2; ++bj) { f32x4 s0 = P.s[0], s1 = P.s[1]; if (bj) { s0 = t0; s1 = t1; }
            const f32x2 sp[4] = {{s0[0], s0[1]}, {s0[2], s0[3]}, {s1[0], s1[1]}, {s1[2], s1[3]}};
#pragma unroll
            for (int ai = 0; ai < 2; ++ai)
#pragma unroll
                for (int m = 0; m < 4; ++m) { const float ra = sav[ai * 4 + m]; const f32x2 rav = {ra, ra}; const i32x4 a0 = acc[ai][bj][m][0], a1 = acc[ai][bj][m][1];
                    f32x2 x[4] = {{(float)a0[0], (float)a0[1]}, {(float)a0[2], (float)a0[3]}, {(float)a1[0], (float)a1[1]}, {(float)a1[2], (float)a1[3]}};
#pragma unroll
                    for (int p = 0; p < 4; ++p) { x[p] = x[p] * (sp[p] * rav);
                        if (ACT == 1) { f32x2 e = {__builtin_amdgcn_exp2f(x[p][0]), __builtin_amdgcn_exp2f(x[p][1])}; e = e + (f32x2){1.0f, 1.0f}; x[p][0] = rcpf_(e[0]); x[p][1] = rcpf_(e[1]); } }
                    u32x4 w; w.x = cvt_pk_bf16(x[0][0], x[0][1]); w.y = cvt_pk_bf16(x[1][0], x[1][1]); w.z = cvt_pk_bf16(x[2][0], x[2][1]); w.w = cvt_pk_bf16(x[3][0], x[3][1]);
                    *(u32x4*)(O + (size_t)(row0 + ai * HALF + m * 16) * ldc + col0 + bj * HALF) = w; } }
    }
};
struct EpiGateU8 {
    static constexpr bool I8 = true; static constexpr bool PERM = true;
    unsigned char* O; const float* sa; const float* sb;
    struct Pre { float sav[2]; f32x4 s[2]; };
    __device__ __forceinline__ void prefetch(Pre& P, const Unit& u, int wr, int wc, int fr, int fq) const {
        const int row0 = u.pm * BM + wr * 64 + fr, col0 = u.pn * BM + wc * 64 + 16 * fq;
#pragma unroll
        for (int i = 0; i < 2; ++i) P.sav[i] = sa[row0 + i * 16];
        P.s[0] = *(const f32x4*)(sb + col0); P.s[1] = *(const f32x4*)(sb + col0 + 4);
    }
    __device__ __forceinline__ void operator()(const i32x4 (&acc)[2][2][4][2], const Unit& u, int wr, int wc, int fr, int fq, const Pre& P) const {
        const int row0 = u.pm * BM + wr * 64 + fr, col0 = u.pn * BM + wc * 64 + 16 * fq;
        float sav[8];
#pragma unroll
        for (int i = 0; i < 8; ++i) sav[i] = (i < 2 ? P.sav[i] : sa[row0 + (i >> 2) * HALF + (i & 3) * 16]) * -1.4426950408889634f;
        const f32x4 t0 = *(const f32x4*)(sb + col0 + 8), t1 = *(const f32x4*)(sb + col0 + 12);
#pragma unroll
        for (int ai = 0; ai < 2; ++ai) { unsigned d[4][4];
#pragma unroll
            for (int bj = 0; bj < 2; ++bj) { f32x4 s0 = P.s[0], s1 = P.s[1]; if (bj) { s0 = t0; s1 = t1; }
                const f32x2 sp[4] = {{s0[0], s0[1]}, {s0[2], s0[3]}, {s1[0], s1[1]}, {s1[2], s1[3]}};
#pragma unroll
                for (int m = 0; m < 4; ++m) { const float ra = sav[ai * 4 + m]; const f32x2 rav = {ra, ra}; const i32x4 a0 = acc[ai][bj][m][0], a1 = acc[ai][bj][m][1];
                    f32x2 x[4] = {{(float)a0[0], (float)a0[1]}, {(float)a0[2], (float)a0[3]}, {(float)a1[0], (float)a1[1]}, {(float)a1[2], (float)a1[3]}};
                    unsigned tb[8];
#pragma unroll
                    for (int p = 0; p < 4; ++p) { x[p] = x[p] * (sp[p] * rav);
#pragma unroll
                        for (int h = 0; h < 2; ++h) { const float e = __builtin_amdgcn_exp2f(x[p][h]); const float r = rcpf_(e * (1.0f / 255.0f) + (1.0f / 255.0f));
                            tb[2 * p + h] = __float_as_uint(fmaxf(r, 1.0f) + 8388608.0f); } }
#pragma unroll
                    for (int n = 0; n < 2; ++n) { const unsigned w01 = __builtin_amdgcn_perm(tb[4 * n + 1], tb[4 * n], 0x0c0c0400u), w23 = __builtin_amdgcn_perm(tb[4 * n + 3], tb[4 * n + 2], 0x0c0c0400u);
                        d[m][2 * bj + n] = __builtin_amdgcn_perm(w23, w01, 0x05040100u); } }
                __builtin_amdgcn_sched_barrier(0); }
#pragma unroll
            for (int m = 0; m < 4; ++m) { u32x4 w; w.x = d[m][0]; w.y = d[m][1]; w.z = d[m][2]; w.w = d[m][3];
                *(u32x4*)(O + (size_t)(row0 + ai * HALF + m * 16) * NGATE + col0) = w; } }
    }
};
struct EpiAddX {
    static constexpr bool I8 = false; static constexpr bool PERM = true;
    struct Pre {}; __device__ __forceinline__ void prefetch(Pre&, const Unit&, int, int, int, int) const {}
    const float* basef; const bf16* baseb; bf16* out; int ldc;
    __device__ __forceinline__ void operator()(const f32x4 (&acc)[2][2][4][2], const Unit& u, int wr, int wc, int fr, int fq, const Pre&) const {
        const int row0 = u.pm * BM + wr * 64 + fr, col0 = u.pn * BM + wc * 32 + 8 * fq;
#pragma unroll
        for (int ai = 0; ai < 2; ++ai) { u32x4 w[4][2];
            if (!basef) {
#pragma unroll
                for (int m = 0; m < 4; ++m)
#pragma unroll
                    for (int bj = 0; bj < 2; ++bj) w[m][bj] = *(const u32x4*)(baseb + (size_t)(row0 + ai * HALF + m * 16) * ldc + col0 + bj * HALF); }
            asm volatile("" ::: "memory");
#pragma unroll
            for (int m = 0; m < 4; ++m)
#pragma unroll
                for (int bj = 0; bj < 2; ++bj) { const size_t p = (size_t)(row0 + ai * HALF + m * 16) * ldc + col0 + bj * HALF; f32x4 b0, b1;
                    if (basef) { b0 = *(const f32x4*)(basef + p); b1 = *(const f32x4*)(basef + p + 4); }
                    else { const u32x4 ww = w[m][bj]; b0 = (f32x4){lo16(ww.x), hi16(ww.x), lo16(ww.y), hi16(ww.y)}; b1 = (f32x4){lo16(ww.z), hi16(ww.z), lo16(ww.w), hi16(ww.w)}; }
                    b0 = b0 + acc[ai][bj][m][0]; b1 = b1 + acc[ai][bj][m][1];
                    u32x4 o; o.x = cvt_pk_bf16(b0[0], b0[1]); o.y = cvt_pk_bf16(b0[2], b0[3]); o.z = cvt_pk_bf16(b1[0], b1[1]); o.w = cvt_pk_bf16(b1[2], b1[3]);
                    *(u32x4*)(out + p) = o; }
            asm volatile("" ::: "memory"); }
    }
};
struct EpiGateAcc {
    static constexpr bool I8 = false; static constexpr bool PERM = true; static constexpr bool CHAIN = true;
    struct Pre {}; __device__ __forceinline__ void prefetch(Pre&, const Unit&, int, int, int, int) const {}
    const unsigned char* gates; bf16* merged;
    __device__ __forceinline__ bool is_last(const Unit& u) const { return (u.pn >> 3) == 3; }
    __device__ __forceinline__ void rescale(f32x4 (&acc)[2][2][4][2], const Unit& u, bool carry, int wr, int wc, int fr, int fq) const {
        const int k = u.pn >> 3, pn = u.pn & 7, pm = u.pm & 127;
        const int row0 = pm * BM + wr * 64 + fr, col0 = pn * BM + wc * 32 + 8 * fq;
#pragma unroll
        for (int ai = 0; ai < 2; ++ai) { u32x2 ga[4][2], gb[4][2];
#pragma unroll
            for (int m = 0; m < 4; ++m)
#pragma unroll
                for (int bj = 0; bj < 2; ++bj) { ga[m][bj] = (u32x2){0u, 0u}; gb[m][bj] = (u32x2){0x01010101u, 0x01010101u}; }
            if (carry) {
#pragma unroll
                for (int m = 0; m < 4; ++m)
#pragma unroll
                    for (int bj = 0; bj < 2; ++bj) { const unsigned char* gp = gates + (size_t)(row0 + ai * HALF + m * 16) * NGATE + k * DM + col0 + bj * HALF; ga[m][bj] = *(const u32x2*)gp; gb[m][bj] = *(const u32x2*)(gp + DM); } }
            asm volatile("" ::: "memory");
#pragma unroll
            for (int m = 0; m < 4; ++m)
#pragma unroll
                for (int bj = 0; bj < 2; ++bj) { const u32x2 a = ga[m][bj], b = gb[m][bj];
#pragma unroll
                    for (int n = 0; n < 2; ++n) { const unsigned aw = n ? a.y : a.x, bw = n ? b.y : b.x;
                        const f32x4 f = {(float)(aw & 0xffu) * rcpf_((float)(bw & 0xffu)), (float)((aw >> 8) & 0xffu) * rcpf_((float)((bw >> 8) & 0xffu)),
                                         (float)((aw >> 16) & 0xffu) * rcpf_((float)((bw >> 16) & 0xffu)), (float)(aw >> 24) * rcpf_((float)(bw >> 24))};
                        acc[ai][bj][m][n] = acc[ai][bj][m][n] * f; }
                    __builtin_amdgcn_sched_barrier(0); } }
    }
    __device__ __forceinline__ void operator()(const f32x4 (&acc)[2][2][4][2], const Unit& u, int wr, int wc, int fr, int fq, const Pre&) const {
        const int k = u.pn >> 3, pn = u.pn & 7, pm = u.pm & 127;
        const int row0 = pm * BM + wr * 64 + fr, col0 = pn * BM + wc * 32 + 8 * fq;
#pragma unroll
        for (int ai = 0; ai < 2; ++ai) { u32x2 g[4][2];
#pragma unroll
            for (int m = 0; m < 4; ++m)
#pragma unroll
                for (int bj = 0; bj < 2; ++bj) g[m][bj] = *(const u32x2*)(gates + (size_t)(row0 + ai * HALF + m * 16) * NGATE + k * DM + col0 + bj * HALF);
            asm volatile("" ::: "memory");
#pragma unroll
            for (int m = 0; m < 4; ++m)
#pragma unroll
                for (int bj = 0; bj < 2; ++bj) { const size_t r = (size_t)(row0 + ai * HALF + m * 16); const int c = col0 + bj * HALF;
                    const f32x4 v0 = acc[ai][bj][m][0], v1 = acc[ai][bj][m][1]; const u32x2 gg = g[m][bj];
                    float o[8];
                    o[0] = (float)(gg.x & 0xffu) * v0[0]; o[1] = (float)((gg.x >> 8) & 0xffu) * v0[1]; o[2] = (float)((gg.x >> 16) & 0xffu) * v0[2]; o[3] = (float)(gg.x >> 24) * v0[3];
                    o[4] = (float)(gg.y & 0xffu) * v1[0]; o[5] = (float)((gg.y >> 8) & 0xffu) * v1[1]; o[6] = (float)((gg.y >> 16) & 0xffu) * v1[2]; o[7] = (float)(gg.y >> 24) * v1[3];
                    u32x4 w; w.x = cvt_pk_bf16(o[0], o[1]); w.y = cvt_pk_bf16(o[2], o[3]); w.z = cvt_pk_bf16(o[4], o[5]); w.w = cvt_pk_bf16(o[6], o[7]);
                    *(u32x4*)(merged + r * DM + c) = w; } }
    }
};
struct EpiGlu {
    static constexpr bool I8 = false; static constexpr bool PERM = true;
    struct Pre {}; __device__ __forceinline__ void prefetch(Pre&, const Unit&, int, int, int, int) const {}
    const bf16* Z; bf16* O;
    __device__ __forceinline__ void operator()(const f32x4 (&acc)[2][2][4][2], const Unit& u, int wr, int wc, int fr, int fq, const Pre&) const {
        const int row0 = u.pm * BM + wr * 64 + fr, col0 = u.pn * BM + wc * 32 + 8 * fq;
#pragma unroll
        for (int ai = 0; ai < 2; ++ai)
#pragma unroll
            for (int m = 0; m < 4; ++m) { const size_t r = (size_t)(row0 + ai * HALF + m * 16);
#pragma unroll
                for (int bj = 0; bj < 2; ++bj) { const int c = col0 + bj * HALF;
                    const u32x4 z = *(const u32x4*)(Z + r * 512 + c);
                    const f32x4 v0 = acc[ai][bj][m][0], v1 = acc[ai][bj][m][1];
                    float o[8];
                    o[0] = lo16(z.x) * sigmoidf_(v0[0]); o[1] = hi16(z.x) * sigmoidf_(v0[1]); o[2] = lo16(z.y) * sigmoidf_(v0[2]); o[3] = hi16(z.y) * sigmoidf_(v0[3]);
                    o[4] = lo16(z.z) * sigmoidf_(v1[0]); o[5] = hi16(z.z) * sigmoidf_(v1[1]); o[6] = lo16(z.w) * sigmoidf_(v1[2]); o[7] = hi16(z.w) * sigmoidf_(v1[3]);
                    u32x4 w; w.x = cvt_pk_bf16(o[0], o[1]); w.y = cvt_pk_bf16(o[2], o[3]); w.z = cvt_pk_bf16(o[4], o[5]); w.w = cvt_pk_bf16(o[6], o[7]);
                    *(u32x4*)(O + r * 512 + c) = w; }
                asm volatile("" ::: "memory"); }
    }
};
template <bool I8_> struct EpiFfnUp {
    static constexpr bool I8 = I8_; static constexpr bool PERM = true;
    const bf16* G; bf16* O; const unsigned* w01; const unsigned* w2b; const float* sa; const float* sb;
    struct Pre {}; __device__ __forceinline__ void prefetch(Pre&, const Unit&, int, int, int, int) const {}
    __device__ __forceinline__ void operator()(const typename AccOf<I8_>::T (&acc)[2][2][4][2], const Unit& u, int wr, int wc, int fr, int fq, const Pre& P) const {
        const int rowb = u.pm * BM + wr * 64, col0 = u.pn * BM + wc * 32 + 8 * fq; const bool l15 = fr == 15, l14 = fr >= 14;
        u32x4 gb[2][3], wa[2], wb[2]; f32x4 sbv[2]; float sav[8];
#define FU_GLOAD(buf, k_) do { const int base_ = rowb + (((k_) >> 1) & 1) * HALF + 32 * ((k_) & 1), cc_ = col0 + ((k_) >> 2) * HALF; gb[buf][0] = (u32x4){0u, 0u, 0u, 0u}; \
            if (base_ & (SEQ - 1)) gb[buf][0] = *(const u32x4*)(G + (size_t)(base_ - 16 + fr) * FF + cc_); \
            gb[buf][1] = *(const u32x4*)(G + (size_t)(base_ + fr) * FF + cc_); gb[buf][2] = *(const u32x4*)(G + (size_t)(base_ + 16 + fr) * FF + cc_); } while (0)
#define FU_WLOAD(bj_) do { const int cc_ = col0 + (bj_) * HALF; wa[0] = *(const u32x4*)(w01 + cc_); wa[1] = *(const u32x4*)(w01 + cc_ + 4); wb[0] = *(const u32x4*)(w2b + cc_); wb[1] = *(const u32x4*)(w2b + cc_ + 4); \
            if constexpr (I8_) { sbv[0] = *(const f32x4*)(sb + cc_); sbv[1] = *(const f32x4*)(sb + cc_ + 4); } } while (0)
        FU_GLOAD(0, 0); FU_WLOAD(0);
        if constexpr (I8_) {
#pragma unroll
            for (int i = 0; i < 8; ++i) sav[i] = sa[rowb + fr + (i >> 2) * HALF + (i & 3) * 16]; }
#pragma unroll
        for (int k = 0; k < 8; ++k) { const int bj = k >> 2, ai = (k >> 1) & 1, mh = k & 1, cur = k & 1; const int c = col0 + bj * HALF;
            if (k < 7) FU_GLOAD(cur ^ 1, k + 1);
            asm volatile("" ::: "memory");
#pragma unroll
            for (int mm = 0; mm < 2; ++mm) { const int m = 2 * mh + mm; const size_t r = (size_t)(rowb + ai * HALF + m * 16 + fr); const u32x4 gp = gb[cur][mm], gc = gb[cur][mm + 1];
                f32x2 v[4];
#pragma unroll
                for (int p = 0; p < 4; ++p) v[p] = (f32x2){(float)acc[ai][bj][m][p >> 1][2 * (p & 1)], (float)acc[ai][bj][m][p >> 1][2 * (p & 1) + 1]};
                if constexpr (I8_) { const float ra = sav[ai * 4 + m]; const f32x2 rav = {ra, ra}; const f32x4 s0 = sbv[0], s1 = sbv[1];
                    v[0] = v[0] * ((f32x2){s0[0], s0[1]} * rav); v[1] = v[1] * ((f32x2){s0[2], s0[3]} * rav); v[2] = v[2] * ((f32x2){s1[0], s1[1]} * rav); v[3] = v[3] * ((f32x2){s1[2], s1[3]} * rav); }
                float o[8];
#pragma unroll
                for (int w = 0; w < 4; ++w) {
                    const unsigned x1w = (unsigned)__builtin_amdgcn_update_dpp(0, (int)(l15 ? gp[w] : gc[w]), 0x121, 0xf, 0xf, true);
                    const unsigned x0w = (unsigned)__builtin_amdgcn_update_dpp(0, (int)(l14 ? gp[w] : gc[w]), 0x122, 0xf, 0xf, true);
                    const unsigned wa_ = wa[w >> 1][2 * (w & 1)], wa1_ = wa[w >> 1][2 * (w & 1) + 1], wb_ = wb[w >> 1][2 * (w & 1)], wb1_ = wb[w >> 1][2 * (w & 1) + 1];
#pragma unroll
                    for (int h = 0; h < 2; ++h) { const int jj = 2 * w + h; const unsigned sel = h ? 0x07060302u : 0x05040100u;
                        const unsigned p01 = __builtin_amdgcn_perm(x1w, x0w, sel), p2 = __builtin_amdgcn_perm(0x3F803F80u, gc[w], sel);
                        float uu = __builtin_amdgcn_fdot2_f32_bf16(__builtin_bit_cast(bf16v2, p2), __builtin_bit_cast(bf16v2, h ? wb1_ : wb_), 0.0f, false);
                        uu = __builtin_amdgcn_fdot2_f32_bf16(__builtin_bit_cast(bf16v2, p01), __builtin_bit_cast(bf16v2, h ? wa1_ : wa_), uu, false);
                        const float z = uu * (uu * uu * -0.10294324f + -2.3022082f); const float e = __builtin_amdgcn_exp2f(z);
                        o[jj] = (uu * v[jj >> 1][jj & 1]) * rcpf_(1.0f + e); } }
                u32x4 wv; wv.x = cvt_pk_bf16(o[0], o[1]); wv.y = cvt_pk_bf16(o[2], o[3]); wv.z = cvt_pk_bf16(o[4], o[5]); wv.w = cvt_pk_bf16(o[6], o[7]);
                *(u32x4*)(O + r * FF + c) = wv; }
            asm volatile("" ::: "memory");
            if (k == 3) FU_WLOAD(1); }
#undef FU_GLOAD
#undef FU_WLOAD
    }
};

__device__ __forceinline__ f32x4 mma16(bf16x8 b, bf16x8 a, f32x4 c) { return __builtin_amdgcn_mfma_f32_16x16x32_bf16(b, a, c, 0, 0, 0); }
__device__ __forceinline__ i32x4 mma16(bf16x8 b, bf16x8 a, i32x4 c) { return __builtin_amdgcn_mfma_i32_16x16x64_i8(__builtin_bit_cast(i32x4, b), __builtin_bit_cast(i32x4, a), c, 0, 0, 0); }
#ifndef PG8_SP2
#define PG8_SP2 true
#endif
#ifndef PG8_ALIGN
#define PG8_ALIGN true
#endif
template <class E, class = void> struct IsChain { static constexpr bool v = false; }; template <> struct IsChain<EpiGateAcc> { static constexpr bool v = true; };
template <class E> struct BMode { static constexpr int v = E::PERM ? 1 : 0; }; template <> struct BMode<EpiGateU8> { static constexpr int v = 2; };
template <class Epi, class Sched, bool ALIGN_EPI = PG8_ALIGN, bool SP2 = PG8_SP2>
__device__ __forceinline__ void gemm_phase(LAS unsigned char* lds, const Gemm g, const Sched& S, const Epi& E, int tid_) {
    const int tid = tid_, wid = __builtin_amdgcn_readfirstlane(tid >> 6), lane = tid & 63, wr = wid >> 2, wc = wid & 3, fr = lane & 15, fq = lane >> 4;
    const int K = g.K, nt = K / BK;
    unsigned voffA[2], voffB[2];
#pragma unroll
    for (int i = 0; i < 2; ++i) { int R, C; stage_rc(tid * 16 + i * 8192, R, C); const int Rb = BMode<Epi>::v == 2 ? (64 * (R >> 5) + 16 * ((R >> 2) & 3) + 4 * ((R >> 4) & 1) + (R & 3)) : (BMode<Epi>::v == 1 ? ((R & ~31) + perm32(R & 31)) : R);
        voffA[i] = (unsigned)(R * K + C) * 2u; voffB[i] = (unsigned)(Rb * K + C) * 2u; }
    const size_t kstep = (size_t)(BK * 2);
    const size_t hstep = (size_t)HALF * K * 2;
    const size_t tstep = 2 * hstep;
    const size_t hstepB = BMode<Epi>::v == 2 ? (size_t)8 * K * 2 : hstep;
    const unsigned ldsw = (unsigned)wid * 1024u;
    const int aoff = lds_byte(wr * 64 + fr, fq * 8), boff = lds_byte(wc * 32 + fr, fq * 8);
#define PG8_SA(b, h) (((b) * 2 + (h)) * HTB)
#define PG8_SB(b, h) ((4 + (b) * 2 + (h)) * HTB)
#define PG8_STAGE(bufoff, gbase, voff) do { _Pragma("unroll") for (int _i = 0; _i < 2; ++_i) \
        __builtin_amdgcn_global_load_lds((const unsigned*)((const char*)(gbase) + (voff)[_i]), (LAS unsigned*)(lds + (bufoff) + ldsw + _i * 8192), 16, 0, 0); } while (0)
#define PG8_LDA(dst, b, h) do { _Pragma("unroll") for (int m = 0; m < 4; ++m) _Pragma("unroll") for (int k = 0; k < 2; ++k) dst[m][k] = *(const LAS bf16x8*)(lds + PG8_SA(b, h) + aoff + m * 2048 + k * 1024); } while (0)
#define PG8_LDB(dst, b, h) do { _Pragma("unroll") for (int n = 0; n < 2; ++n) _Pragma("unroll") for (int k = 0; k < 2; ++k) dst[n][k] = *(const LAS bf16x8*)(lds + PG8_SB(b, h) + boff + n * 2048 + k * 1024); } while (0)
#define PG8_MMA(ai, bj, At, Bt) do { __builtin_amdgcn_s_setprio(1); _Pragma("unroll") for (int m = 0; m < 4; ++m) _Pragma("unroll") for (int n = 0; n < 2; ++n) _Pragma("unroll") for (int k = 0; k < 2; ++k) \
        acc[ai][bj][m][n] = mma16(Bt[n][k], At[m][k], acc[ai][bj][m][n]); __builtin_amdgcn_s_setprio(0); } while (0)
#define PG8_WAIT_V(n) asm volatile("s_waitcnt vmcnt(" #n ")" ::: "memory")
#define PG8_WAIT_L(n) asm volatile("s_waitcnt lgkmcnt(" #n ")" ::: "memory")
#define PG8_BAR __builtin_amdgcn_s_barrier()
#define PG8_SCHED __builtin_amdgcn_sched_barrier(0)
    Unit cur, nxt; int ui = 0;
    if (!S.next(0, cur)) return;
    typedef typename AccOf<Epi::I8>::T acc_t;
    acc_t acc[2][2][4][2];
#pragma unroll
    for (int a = 0; a < 2; ++a)
#pragma unroll
        for (int b = 0; b < 2; ++b)
#pragma unroll
            for (int m = 0; m < 4; ++m)
#pragma unroll
                for (int n = 0; n < 2; ++n) acc[a][b][m][n] = (acc_t){0, 0, 0, 0};
    bf16x8 At[4][2], B0[2][2], B1[2][2];
    typename Epi::Pre pre;
    const char* cA = (const char*)g.A + (size_t)cur.pm * tstep; const char* cB = (const char*)g.Bt + (size_t)cur.pn * tstep;
    S.a_ready(cur);
    if constexpr (SP2) {
        PG8_STAGE(PG8_SB(0, 0), cB, voffB); PG8_STAGE(PG8_SB(0, 1), cB + hstepB, voffB); PG8_STAGE(PG8_SA(0, 0), cA, voffA); PG8_STAGE(PG8_SA(0, 1), cA + hstep, voffA);
        if (wr == 1) PG8_BAR;
        PG8_WAIT_V(2); PG8_BAR;
        PG8_STAGE(PG8_SB(1, 0), cB + kstep, voffB); PG8_STAGE(PG8_SA(1, 0), cA + kstep, voffA); PG8_STAGE(PG8_SB(1, 1), cB + hstepB + kstep, voffB);
        PG8_WAIT_V(6); PG8_BAR;
    } else {
    PG8_STAGE(PG8_SB(0, 0), cB, voffB); PG8_STAGE(PG8_SA(0, 0), cA, voffA); PG8_STAGE(PG8_SB(0, 1), cB + hstepB, voffB); PG8_STAGE(PG8_SA(0, 1), cA + hstep, voffA);
    if (wr == 1) PG8_BAR;
    PG8_WAIT_V(4); PG8_BAR;
    PG8_STAGE(PG8_SB(1, 0), cB + kstep, voffB); PG8_STAGE(PG8_SA(1, 0), cA + kstep, voffA); PG8_STAGE(PG8_SB(1, 1), cB + hstepB + kstep, voffB);
    PG8_WAIT_V(6); PG8_BAR;
    }
    for (;;) {
        const bool has_next = S.next(ui + 1, nxt);
        const char* nA = has_next ? (const char*)g.A + (size_t)nxt.pm * tstep : cA; const char* nB = has_next ? (const char*)g.Bt + (size_t)nxt.pn * tstep : cB;
        for (int t = 0; t < nt; t += 2) {
            const bool last = (t == nt - 2);
            const char* a1 = cA + (size_t)(t + 1) * kstep;
            const char* a2 = last ? nA : cA + (size_t)(t + 2) * kstep; const char* b2 = last ? nB : cB + (size_t)(t + 2) * kstep;
            const char* a3 = a2 + kstep; const char* b3 = b2 + kstep;
            if (last && has_next) S.a_ready(nxt);
            if (last) E.prefetch(pre, cur, wr, wc, fr, fq);
            if constexpr (SP2) {
            PG8_LDB(B0, 0, 0); PG8_LDB(B1, 0, 1); PG8_SCHED; PG8_LDA(At, 0, 0); PG8_STAGE(PG8_SA(1, 1), a1 + hstep, voffA);
            PG8_WAIT_V(8); PG8_WAIT_L(0); PG8_BAR; PG8_MMA(0, 0, At, B0); PG8_MMA(0, 1, At, B1); PG8_BAR; PG8_SCHED;
            PG8_LDA(At, 0, 1); PG8_STAGE(PG8_SB(0, 0), b2, voffB); PG8_STAGE(PG8_SB(0, 1), b2 + hstepB, voffB); PG8_STAGE(PG8_SA(0, 0), a2, voffA);
            PG8_WAIT_V(8); PG8_WAIT_L(0); PG8_BAR; PG8_MMA(1, 0, At, B0); PG8_MMA(1, 1, At, B1); PG8_BAR; PG8_SCHED;
            PG8_LDB(B0, 1, 0); PG8_LDB(B1, 1, 1); PG8_SCHED; PG8_LDA(At, 1, 0); PG8_STAGE(PG8_SA(0, 1), a2 + hstep, voffA);
            PG8_WAIT_V(8); PG8_WAIT_L(0); PG8_BAR; PG8_MMA(0, 0, At, B0); PG8_MMA(0, 1, At, B1); PG8_BAR; PG8_SCHED;
            PG8_LDA(At, 1, 1); PG8_STAGE(PG8_SB(1, 0), b3, voffB); PG8_STAGE(PG8_SB(1, 1), b3 + hstepB, voffB); PG8_STAGE(PG8_SA(1, 0), a3, voffA);
            PG8_WAIT_V(8); PG8_WAIT_L(0); PG8_BAR; PG8_MMA(1, 0, At, B0); PG8_MMA(1, 1, At, B1); PG8_BAR; PG8_SCHED;
            } else {
            PG8_LDB(B0, 0, 0); PG8_SCHED; PG8_LDA(At, 0, 0); PG8_STAGE(PG8_SA(1, 1), a1 + hstep, voffA);
            PG8_WAIT_L(8); PG8_BAR; PG8_WAIT_L(0); PG8_MMA(0, 0, At, B0); PG8_BAR; PG8_SCHED;
            PG8_LDB(B1, 0, 1); PG8_STAGE(PG8_SB(0, 0), b2, voffB);
            PG8_BAR; PG8_WAIT_L(0); PG8_MMA(0, 1, At, B1); PG8_BAR;
            PG8_LDA(At, 0, 1); PG8_STAGE(PG8_SA(0, 0), a2, voffA);
            PG8_BAR; PG8_WAIT_L(0); PG8_MMA(1, 0, At, B0); PG8_BAR; PG8_SCHED;
            PG8_STAGE(PG8_SB(0, 1), b2 + hstepB, voffB);
            PG8_WAIT_V(6); PG8_BAR; PG8_MMA(1, 1, At, B1); PG8_BAR;
            PG8_LDB(B0, 1, 0); PG8_SCHED; PG8_LDA(At, 1, 0); PG8_STAGE(PG8_SA(0, 1), a2 + hstep, voffA);
            PG8_WAIT_L(8); PG8_BAR; PG8_WAIT_L(0); PG8_MMA(0, 0, At, B0); PG8_BAR; PG8_SCHED;
            PG8_LDB(B1, 1, 1); PG8_STAGE(PG8_SB(1, 0), b3, voffB);
            PG8_BAR; PG8_WAIT_L(0); PG8_MMA(0, 1, At, B1); PG8_BAR;
            PG8_LDA(At, 1, 1); PG8_STAGE(PG8_SA(1, 0), a3, voffA);
            PG8_BAR; PG8_WAIT_L(0); PG8_MMA(1, 0, At, B0); PG8_BAR; PG8_SCHED;
            PG8_STAGE(PG8_SB(1, 1), b3 + hstepB, voffB);
            PG8_WAIT_V(6); PG8_BAR; PG8_MMA(1, 1, At, B1); PG8_BAR;
            }
        }
        if constexpr (ALIGN_EPI) { if (wr == 0) PG8_BAR; }
        if constexpr (IsChain<Epi>::v) { const bool carry = !E.is_last(cur); if (!carry) E(acc, cur, wr, wc, fr, fq, pre); E.rescale(acc, cur, carry, wr, wc, fr, fq); }
        else E(acc, cur, wr, wc, fr, fq, pre);
        S.done(cur);
        if (!has_next) break;
        if constexpr (!IsChain<Epi>::v) {
#pragma unroll
        for (int a = 0; a < 2; ++a)
#pragma unroll
            for (int b = 0; b < 2; ++b)
#pragma unroll
                for (int m = 0; m < 4; ++m)
#pragma unroll
                    for (int n = 0; n < 2; ++n) acc[a][b][m][n] = (acc_t){0, 0, 0, 0};
        }
        cur = nxt; cA = nA; cB = nB; ++ui;
        if constexpr (ALIGN_EPI) { if (wr == 1) PG8_BAR; }
    }
    PG8_WAIT_V(0);
    if constexpr (!ALIGN_EPI) { if (wr == 0) PG8_BAR; }
    PG8_BAR;
#undef PG8_SA
#undef PG8_SB
#undef PG8_STAGE
#undef PG8_LDA
#undef PG8_LDB
#undef PG8_MMA
#undef PG8_WAIT_V
#undef PG8_WAIT_L
#undef PG8_BAR
#undef PG8_SCHED
}
}

#define XB_TMO      128
#define XB_XCNT(j)  (256  + 64 * (j))
#define XB_XSUB(j)  (1280 + 64 * (j))
#define XB_XGEN(j)  (2304 + 64 * (j))
#define XB_TOP      3328
#define XB_TOPGEN   3392
#define XCD_BAR_WORDS 3456
#define XB_SPIN_CAP (1u << 22)
__device__ __forceinline__ unsigned xb_ld(unsigned* p)              { return __hip_atomic_load(p, __ATOMIC_RELAXED, __HIP_MEMORY_SCOPE_AGENT); }
__device__ __forceinline__ unsigned xb_add(unsigned* p, unsigned v) { return __hip_atomic_fetch_add(p, v, __ATOMIC_RELAXED, __HIP_MEMORY_SCOPE_AGENT); }
__device__ __forceinline__ unsigned xb_xcc_id() { return (unsigned)__builtin_amdgcn_s_getreg((3 << 11) | 20) & 0xFu; }
#define XB_SPIN(cond, bar) do { unsigned _sp = 0; while (cond) { __builtin_amdgcn_s_sleep(1); \
    if ((++_sp & 255u) == 0u) { if (xb_ld(&(bar)[XB_TMO])) break; if (_sp > XB_SPIN_CAP) { atomicAdd(&(bar)[XB_TMO], 1u); break; } } } } while (0)
struct XcdBarrier { unsigned* bar; unsigned x; volatile LAS unsigned* st; };
__device__ __forceinline__ XcdBarrier xcd_barrier_post(unsigned* bar, volatile LAS unsigned* st) {
    XcdBarrier b; b.bar = bar; b.x = xb_xcc_id(); b.st = st;
    if (threadIdx.x == 0) (void)xb_add(&bar[XB_XCNT(b.x)], 1u);
    return b;
}
__device__ __forceinline__ void xcd_barrier_complete(unsigned* bar, unsigned x, unsigned& nloc, unsigned& nx) {
    const unsigned G = gridDim.x * gridDim.y * gridDim.z;
    unsigned sum, cnt, mine, sp = 0u;
    for (;;) {
        sum = 0u; cnt = 0u; mine = 0u;
#pragma unroll
        for (unsigned j = 0; j < 16; ++j) { const unsigned c = xb_ld(&bar[XB_XCNT(j)]); sum += c; cnt += (c > 0u) ? 1u : 0u; mine = (j == x) ? c : mine; }
        if (sum == G) break;
        __builtin_amdgcn_s_sleep(1);
        if ((++sp & 255u) == 0u) { if (xb_ld(&bar[XB_TMO])) break; if (sp > XB_SPIN_CAP) { atomicAdd(&bar[XB_TMO], 1u); break; } }
    }
    nloc = mine > 0u ? mine : 1u; nx = cnt > 0u ? cnt : 1u;
}
__device__ __forceinline__ void xcd_barrier(const XcdBarrier& b) {
    asm volatile("s_waitcnt vmcnt(0)" ::: "memory");
    __syncthreads();
    if (threadIdx.x == 0) {
        unsigned* bar = b.bar;
        { unsigned long long w_ = (unsigned long long)bar; unsigned lo_ = __builtin_amdgcn_readfirstlane((unsigned)w_), hi_ = __builtin_amdgcn_readfirstlane((unsigned)(w_ >> 32)); asm volatile("" : "+s"(lo_), "+s"(hi_)); bar = (unsigned*)(((unsigned long long)hi_ << 32) | lo_); }
        __builtin_amdgcn_s_waitcnt(0);
        unsigned nloc = b.st[0], nx = b.st[1];
        if (nloc == 0u) { xcd_barrier_complete(bar, b.x, nloc, nx); b.st[0] = nloc; b.st[1] = nx; }
        const unsigned old = xb_add(&bar[XB_XSUB(b.x)], 1u);
        const unsigned gen = old / nloc;
        if (old + 1u == (gen + 1u) * nloc) {
            __builtin_amdgcn_fence(__ATOMIC_RELEASE, "agent");
            asm volatile("s_waitcnt vmcnt(0)" ::: "memory");
            const unsigned og = xb_add(&bar[XB_TOP], 1u);
            const unsigned tg = og / nx;
            if (og + 1u == (tg + 1u) * nx) xb_add(&bar[XB_TOPGEN], 1u);
            else XB_SPIN(xb_ld(&bar[XB_TOPGEN]) == tg, bar);
            __builtin_amdgcn_fence(__ATOMIC_ACQUIRE, "agent");
            xb_add(&bar[XB_XGEN(b.x)], 1u);
            asm volatile("s_waitcnt vmcnt(0)" ::: "memory");
        } else {
            XB_SPIN(xb_ld(&bar[XB_XGEN(b.x)]) == gen, bar);
            __builtin_amdgcn_fence(__ATOMIC_ACQUIRE, "agent");
            asm volatile("s_waitcnt vmcnt(0)" ::: "memory");
        }
    }
    __syncthreads();
}

constexpr int NWAVES = 8, NTHR = 512;
constexpr int LDS_MISC = 131072, LDS_BYTES = 131072 + 1024;
struct Args { const float* in[45]; float* out; unsigned char* ws; };
#define GAS __attribute__((address_space(1)))
struct Frame {
    LAS unsigned char* lds; float* out; unsigned char* ws;
    int tid, lane, wave, blk, G;
};
#define WSP(T, off) ((T*)(F.ws + (off)))
__device__ __forceinline__ const float* inp_(LAS unsigned char* lds, int k) {
    const LAS unsigned* t = (const LAS unsigned*)(lds + 131072 + 256) + 2 * k;
    const unsigned lo = __builtin_amdgcn_readfirstlane(t[0]), hi = __builtin_amdgcn_readfirstlane(t[1]);
    return (const float*)(const GAS float*)(((unsigned long long)hi << 32) | lo);
}
#define INP(k) inp_(F.lds, (k))

__device__ __forceinline__ void tr_item(const float* W, int ld, int col0, int ncv, bf16* WT, int K, int row_off, LAS float* scr, int kb, int nb, int lane, float scale = 1.0f) {
    const int k0 = 64 * kb, n0 = 32 * nb; const int nn = n0 + (lane & 31); const bool ok = nn < ncv;
    { float t[32]; const float* wp = W + (size_t)(k0 + (lane >> 5)) * ld + col0 + (ok ? nn : 0);
#pragma unroll
      for (int i = 0; i < 32; ++i) t[i] = wp[(size_t)(2 * i) * ld];
#pragma unroll
      for (int i = 0; i < 32; ++i) scr[(2 * i + (lane >> 5)) * 33 + (lane & 31)] = ok ? t[i] * scale : 0.f; }
    asm volatile("s_waitcnt lgkmcnt(0)" ::: "memory");
    const int c = lane & 7;
#pragma unroll
    for (int j = 0; j < 4; ++j) { const int n = (lane >> 3) + 8 * j; const LAS float* s = scr + (8 * c) * 33 + n;
        u32x4 o; o.x = pk2(s[0 * 33], s[1 * 33]); o.y = pk2(s[2 * 33], s[3 * 33]); o.z = pk2(s[4 * 33], s[5 * 33]); o.w = pk2(s[6 * 33], s[7 * 33]);
        *(u32x4*)(WT + (size_t)(row_off + n0 + n) * K + k0 + 8 * c) = o; }
    asm volatile("s_waitcnt lgkmcnt(0)" ::: "memory");
}
__device__ __forceinline__ void convert_weights(Frame& F, int l) {
    LAS float* scr = (LAS float*)(F.lds + F.wave * 16384);
    const int gw = F.blk * NWAVES + F.wave, NGW = F.G * NWAVES;
    constexpr int I0 = 32 * 152, I1 = I0, I2 = I1 + 4 * 8 * 64, I3 = I2 + 32 * 64, I4 = I3, I5 = I4, I6 = I5 + 96 * 64, I7 = I6 + 8 * 16;
    const float* win = INP(2) + (size_t)l * DM * INC;
    for (int it = gw; it < I7; it += NGW) {
        if (it < I0) { const int r = it; tr_item(win, INC, 0, MIXC, WSP(bf16, WS_WIN), DM, 0, scr, r / 152, r % 152, F.lane); }
        else if (it < I1) { }
        else if (it < I2) { const int r = it - I1; const int k = r / 512, rr = r % 512; tr_item(INP(36) + ((size_t)l * 4 + k) * 512 * DM, DM, 0, DM, WSP(bf16, WS_WPK), 512, k * DM, scr, rr / 64, rr % 64, F.lane, 1.0f / 255.0f); }
        else if (it < I3) { const int r = it - I2; tr_item(INP(37) + (size_t)l * DM * DM, DM, 0, DM, WSP(bf16, WS_WOUT), DM, 0, scr, r / 64, r % 64, F.lane); }
        else if (it < I4) { const int r = it - I3; tr_item(INP(39) + (size_t)l * DM * FF, FF, 0, FF, WSP(bf16, WS_WFG), DM, 0, scr, r / 192, r % 192, F.lane); }
        else if (it < I5) { const int r = it - I4; tr_item(INP(40) + (size_t)l * DM * FF, FF, 0, FF, WSP(bf16, WS_WFU), DM, 0, scr, r / 192, r % 192, F.lane); }
        else if (it < I6) { const int r = it - I5; tr_item(INP(43) + (size_t)l * FF * DM, DM, 0, DM, WSP(bf16, WS_WFD), FF, 0, scr, r / 64, r % 64, F.lane); }
        else { const int r = it - I6; tr_item(INP(11) + (size_t)l * 512 * 512, 512, 0, 512, WSP(bf16, WS_WGLU), 512, 0, scr, r / 16, r % 16, F.lane); }
    }
}
__device__ __forceinline__ void rmsnorm_rows(Frame& F, const float* x, const bf16* xb, const float* g, bf16* obf, float* of32, unsigned* a8 = nullptr, float* sa = nullptr) {
    const int gw = F.blk * NWAVES + F.wave, NGW = F.G * NWAVES;
    f32x4 gv[8];
#pragma unroll
    for (int j = 0; j < 8; ++j) gv[j] = ((const f32x4*)g)[64 * j + F.lane];
    for (int m = gw; m < MTOK; m += NGW) {
        f32x4 v[8]; float s = 0.f;
        if (x) { const f32x4* xr = (const f32x4*)(x + (size_t)m * DM) + F.lane;
#pragma unroll
            for (int j = 0; j < 8; ++j) v[j] = xr[64 * j]; }
        else { const u32x2* xr = (const u32x2*)(xb + (size_t)m * DM) + F.lane; u32x2 w[8];
#pragma unroll
            for (int j = 0; j < 8; ++j) w[j] = xr[64 * j];
#pragma unroll
            for (int j = 0; j < 8; ++j) v[j] = (f32x4){lo16(w[j].x), hi16(w[j].x), lo16(w[j].y), hi16(w[j].y)}; }
#pragma unroll
        for (int j = 0; j < 8; ++j) s += (v[j].x * v[j].x + v[j].y * v[j].y) + (v[j].z * v[j].z + v[j].w * v[j].w);
        const float rs = 1.0f / sqrtf(wave_sum(s) * (1.f / DM) + 1e-6f);
#pragma unroll
        for (int j = 0; j < 8; ++j) v[j] = v[j] * rs * gv[j];
        if (obf) { u32x2* o = (u32x2*)(obf + (size_t)m * DM) + F.lane;
#pragma unroll
            for (int j = 0; j < 8; ++j) { u32x2 w; w.x = pk2(v[j].x, v[j].y); w.y = pk2(v[j].z, v[j].w); o[64 * j] = w; } }
        if (of32) { f32x4* o = (f32x4*)(of32 + (size_t)m * DM) + F.lane;
#pragma unroll
            for (int j = 0; j < 8; ++j) o[64 * j] = v[j]; }
        if (a8) {
            float am = 0.f;
#pragma unroll
            for (int j = 0; j < 8; ++j) am = fmaxf(fmaxf(am, fmaxf(fabsf(v[j].x), fabsf(v[j].y))), fmaxf(fabsf(v[j].z), fabsf(v[j].w)));
            am = fmaxf(wave_max(am), 1e-20f); const float inv = 127.0f / am;
            unsigned* o = a8 + (size_t)m * (DM / 4) + F.lane;
#pragma unroll
            for (int j = 0; j < 8; ++j) o[64 * j] = q8x4(v[j].x, v[j].y, v[j].z, v[j].w, inv);
            if (F.lane == 0) sa[m] = am * (1.0f / 127.0f); }
    }
}
__device__ __forceinline__ void convert_cols_i8(Frame& F, const float* W, int ld, int col0, int nb, signed char* W8, float* sb, int row_off) {
    LAS float* red = (LAS float*)(F.lds + 8 * 16384 - 4096);
    LAS float* scl = red + 512;
    const int tid = F.tid, n = tid & 31, kg = tid >> 5; const float* wp = W + col0 + 32 * nb + n;
    float am = 0.f;
#pragma unroll 1
    for (int i0 = 0; i0 < 128; i0 += 32) { float t[32];
#pragma unroll
        for (int i = 0; i < 32; ++i) t[i] = wp[(size_t)(kg + 16 * (i0 + i)) * ld];
#pragma unroll
        for (int i = 0; i < 32; ++i) am = fmaxf(am, fabsf(t[i])); }
    red[kg * 32 + n] = am;
    __syncthreads();
    if (tid < 32) { float a = 0.f;
#pragma unroll
        for (int q = 0; q < 16; ++q) a = fmaxf(a, red[q * 32 + tid]);
        a = fmaxf(a, 1e-30f); scl[tid] = 127.0f / a; sb[row_off + 32 * nb + tid] = a * (1.0f / 127.0f); }
    __syncthreads();
    LAS float* scr = (LAS float*)(F.lds + F.wave * 16384);
    const int lane = F.lane, rn = lane >> 1, half = lane & 1; const float inv = scl[rn];
#pragma unroll 1
    for (int kb = F.wave; kb < 32; kb += NWAVES) {
        { float t[32];
#pragma unroll
          for (int i = 0; i < 32; ++i) t[i] = W[(size_t)(64 * kb + 2 * i + (lane >> 5)) * ld + col0 + 32 * nb + (lane & 31)];
#pragma unroll
          for (int i = 0; i < 32; ++i) scr[(2 * i + (lane >> 5)) * 33 + (lane & 31)] = t[i]; }
        asm volatile("s_waitcnt lgkmcnt(0)" ::: "memory");
        const LAS float* sp = scr + (32 * half) * 33 + rn;
        u32x4 w0, w1;
        w0.x = q8x4(sp[0 * 33], sp[1 * 33], sp[2 * 33], sp[3 * 33], inv); w0.y = q8x4(sp[4 * 33], sp[5 * 33], sp[6 * 33], sp[7 * 33], inv);
        w0.z = q8x4(sp[8 * 33], sp[9 * 33], sp[10 * 33], sp[11 * 33], inv); w0.w = q8x4(sp[12 * 33], sp[13 * 33], sp[14 * 33], sp[15 * 33], inv);
        w1.x = q8x4(sp[16 * 33], sp[17 * 33], sp[18 * 33], sp[19 * 33], inv); w1.y = q8x4(sp[20 * 33], sp[21 * 33], sp[22 * 33], sp[23 * 33], inv);
        w1.z = q8x4(sp[24 * 33], sp[25 * 33], sp[26 * 33], sp[27 * 33], inv); w1.w = q8x4(sp[28 * 33], sp[29 * 33], sp[30 * 33], sp[31 * 33], inv);
        u32x4* d = (u32x4*)(W8 + (size_t)(row_off + 32 * nb + rn) * DM + 64 * kb + 32 * half); d[0] = w0; d[1] = w1;
        asm volatile("s_waitcnt lgkmcnt(0)" ::: "memory");
    }
    __syncthreads();
}

constexpr int WAVE_LDS = 16384;
constexpr int LR_XLD = 72, LR_FLD = 66, LR_ALD = 132;
constexpr int LR_XF = 16 * LR_XLD * 2, LR_AB = LR_XF + 16 * LR_FLD * 4;
template <bool FINAL> __device__ __forceinline__ void lru_task(Frame& F, int l, int task) {
    const int lane = F.lane, fr = lane & 15, fq = lane >> 4; const int b = task >> 9, h = (task >> 6) & 7, c = task & 63; const int ch = 64 * h + lane;
    LAS unsigned char* wl = F.lds + F.wave * WAVE_LDS;
    LAS bf16* XC = (LAS bf16*)wl; LAS float* XF = (LAS float*)(wl + LR_XF); LAS float* AB = (LAS float*)(wl + LR_AB);
    const float* WA = INP(14) + ((size_t)l * 8 + h) * 4096; const float* WX = INP(16) + ((size_t)l * 8 + h) * 4096;
    bf16x8 Wa[4][2], Wx[4][2];
#pragma unroll
    for (int nt = 0; nt < 4; ++nt)
#pragma unroll
        for (int kk = 0; kk < 2; ++kk) { const float* pa = WA + (size_t)(32 * kk + 8 * fq) * 64 + 16 * nt + fr; const float* px_ = WX + (size_t)(32 * kk + 8 * fq) * 64 + 16 * nt + fr;
            u32x4 wa_, wx_; wa_.x = pk2(pa[0], pa[64]); wa_.y = pk2(pa[128], pa[192]); wa_.z = pk2(pa[256], pa[320]); wa_.w = pk2(pa[384], pa[448]);
            wx_.x = pk2(px_[0], px_[64]); wx_.y = pk2(px_[128], px_[192]); wx_.z = pk2(px_[256], px_[320]); wx_.w = pk2(px_[384], px_[448]);
            Wa[nt][kk] = __builtin_bit_cast(bf16x8, wa_); Wx[nt][kk] = __builtin_bit_cast(bf16x8, wx_); }
    float ba4[4], bx4[4], sp4[4], slp[4];
#pragma unroll
    for (int nt = 0; nt < 4; ++nt) { const int jj = l * 512 + 64 * h + 16 * nt + fr; ba4[nt] = INP(15)[jj]; bx4[nt] = INP(17)[jj]; sp4[nt] = softplusf_(-INP(18)[jj]); slp[nt] = 0.f; }
    const float* cwp = INP(12) + (size_t)l * 4 * 512 + ch;
    const float cw0 = cwp[0], cw1 = cwp[512], cw2 = cwp[1024], cw3 = cwp[1536];
    const float cb = INP(13)[l * 512 + ch];
    const size_t row0 = (size_t)b * SEQ + (size_t)c * 128;
    const bf16* px = WSP(const bf16, WS_PROJ) + row0 * MIXP + PC_LRX + ch;
    const bf16* pg = WSP(const bf16, WS_PROJ) + row0 * MIXP + PC_LRG + ch;
    float xm3 = 0.f, xm2 = 0.f, xm1 = 0.f;
    if (c > 0) { xm3 = bf2f(*(px - 3 * (ptrdiff_t)MIXP)); xm2 = bf2f(*(px - 2 * (ptrdiff_t)MIXP)); xm1 = bf2f(*(px - (ptrdiff_t)MIXP)); }
    float hs = 0.f;
    const size_t cidx = ((size_t)b * 64 + c) * 512 + ch;
    if (FINAL) hs = WSP(const float, WS_LRI)[cidx];
    bf16* yo = WSP(bf16, WS_YK) + (size_t)1 * MTOK * 512 + row0 * 512 + ch;
    bf16 xs[16], gs[16];
#pragma unroll
    for (int j = 0; j < 16; ++j) { xs[j] = px[(size_t)j * MIXP]; if (FINAL) gs[j] = pg[(size_t)j * MIXP]; }
#pragma unroll 1
    for (int sb = 0; sb < 8; ++sb) {
#pragma unroll
        for (int t = 0; t < 16; ++t) { const float xv = bf2f(xs[t]); const float xc = cb + cw0 * xm3 + cw1 * xm2 + cw2 * xm1 + cw3 * xv; xm3 = xm2; xm2 = xm1; xm1 = xv;
            XC[t * LR_XLD + lane] = (bf16)f2bf(xc); XF[t * LR_FLD + lane] = xc; }
        float gl[16];
        if (FINAL) {
#pragma unroll
            for (int t = 0; t < 16; ++t) gl[t] = bf2f(gs[t]); }
        if (sb < 7) {
#pragma unroll
            for (int j = 0; j < 16; ++j) { xs[j] = px[(size_t)((sb + 1) * 16 + j) * MIXP]; if (FINAL) gs[j] = pg[(size_t)((sb + 1) * 16 + j) * MIXP]; } }
        const bf16x8 af0 = *(const LAS bf16x8*)(XC + fr * LR_XLD + 8 * fq), af1 = *(const LAS bf16x8*)(XC + fr * LR_XLD + 32 + 8 * fq);
#pragma unroll
        for (int nt = 0; nt < 4; ++nt) {
            f32x4 aa = (f32x4){0.f, 0.f, 0.f, 0.f}, ax = (f32x4){0.f, 0.f, 0.f, 0.f};
            aa = __builtin_amdgcn_mfma_f32_16x16x32_bf16(af0, Wa[nt][0], aa, 0, 0, 0); aa = __builtin_amdgcn_mfma_f32_16x16x32_bf16(af1, Wa[nt][1], aa, 0, 0, 0);
            ax = __builtin_amdgcn_mfma_f32_16x16x32_bf16(af0, Wx[nt][0], ax, 0, 0, 0); ax = __builtin_amdgcn_mfma_f32_16x16x32_bf16(af1, Wx[nt][1], ax, 0, 0, 0);
#pragma unroll
            for (int e = 0; e < 4; ++e) { const int t = 4 * fq + e, jj = 16 * nt + fr; const float xc = XF[t * LR_FLD + jj];
                const float r = sigmoidf_(aa[e] + ba4[nt]), ig = sigmoidf_(ax[e] + bx4[nt]); const float la = -8.0f * r * sp4[nt]; const float av = __expf(la);
                const float mult = __builtin_amdgcn_sqrtf(fmaxf(1.0f - av * av, 0.f));
                AB[t * LR_ALD + jj] = av; AB[t * LR_ALD + 64 + jj] = xc * ig * mult; if (!FINAL) slp[nt] += la; }
        }
#pragma unroll
        for (int t = 0; t < 16; ++t) { const float av = AB[t * LR_ALD + lane], bv = AB[t * LR_ALD + 64 + lane]; hs = av * hs + bv;
            if (FINAL) yo[(size_t)(sb * 16 + t) * 512] = (bf16)f2bf(hs * geluf_(gl[t])); }
    }
    if (!FINAL) { WSP(float, WS_LRE)[cidx] = hs;
#pragma unroll
        for (int nt = 0; nt < 4; ++nt) { float v = slp[nt]; v += __shfl_xor(v, 16); v += __shfl_xor(v, 32); if (fq == 0) WSP(float, WS_LRA)[((size_t)b * 64 + c) * 512 + 64 * h + 16 * nt + fr] = v; } }
}
__device__ __forceinline__ void lru_carry(Frame& F, int task) {
    const int b = task >> 3, ch = (task & 7) * 64 + F.lane; float run = 0.f;
    const float* A = WSP(const float, WS_LRA) + (size_t)b * 64 * 512 + ch; const float* E = WSP(const float, WS_LRE) + (size_t)b * 64 * 512 + ch; float* I = WSP(float, WS_LRI) + (size_t)b * 64 * 512 + ch;
#pragma unroll 1
    for (int c0 = 0; c0 < 64; c0 += 32) { float av[32], ev[32];
#pragma unroll
        for (int j = 0; j < 32; ++j) { av[j] = A[(size_t)(c0 + j) * 512]; ev[j] = E[(size_t)(c0 + j) * 512]; }
#pragma unroll
        for (int j = 0; j < 32; ++j) { I[(size_t)(c0 + j) * 512] = run; run = __expf(av[j]) * run + ev[j]; } }
}

constexpr int S5_XLD = 132, S5_SLD = 136, S5_SB = 16 * S5_XLD * 4;
template <bool FINAL> __device__ __forceinline__ void s5_task(Frame& F, int l, int task) {
    const int lane = F.lane, fr = lane & 15, fq = lane >> 4; const int b = task >> 11, g = (task >> 6) & 31, c = task & 63; const int p = lane;
    LAS unsigned char* wl = F.lds + F.wave * WAVE_LDS;
    LAS float* X = (LAS float*)wl; LAS bf16* Sb = (LAS bf16*)(wl + S5_SB);
    const int lg = l * 32 + g;
    const float lr = INP(3)[lg * 64 + p], li = INP(4)[lg * 64 + p]; const float dt = expf(INP(10)[lg]);
    const float mag = expf(lr * dt); float sn, cs; sincosf(li * dt, &sn, &cs); const float abr = mag * cs, abi = mag * sn;
    const float den = lr * lr + li * li, nr = abr - 1.0f, ni = abi; const float fre = (nr * lr + ni * li) / den, fim = (ni * lr - nr * li) / den;
    bf16x8 Bf[8];
#pragma unroll
    for (int nq = 0; nq < 4; ++nq) { const int pp = 16 * nq + fr; const float fr_ = __shfl(fre, pp), fi_ = __shfl(fim, pp);
        u32x4 wr_ = (u32x4){0u, 0u, 0u, 0u}, wi_ = (u32x4){0u, 0u, 0u, 0u};
        if (fq < 2) { const f32x4* br = (const f32x4*)(INP(5) + ((size_t)lg * 64 + pp) * 16 + 8 * fq); const f32x4* bi = (const f32x4*)(INP(6) + ((size_t)lg * 64 + pp) * 16 + 8 * fq);
            const f32x4 r0 = br[0], r1 = br[1], i0 = bi[0], i1 = bi[1];
            wr_.x = pk2(fr_ * r0[0] - fi_ * i0[0], fr_ * r0[1] - fi_ * i0[1]); wr_.y = pk2(fr_ * r0[2] - fi_ * i0[2], fr_ * r0[3] - fi_ * i0[3]);
            wr_.z = pk2(fr_ * r1[0] - fi_ * i1[0], fr_ * r1[1] - fi_ * i1[1]); wr_.w = pk2(fr_ * r1[2] - fi_ * i1[2], fr_ * r1[3] - fi_ * i1[3]);
            wi_.x = pk2(fr_ * i0[0] + fi_ * r0[0], fr_ * i0[1] + fi_ * r0[1]); wi_.y = pk2(fr_ * i0[2] + fi_ * r0[2], fr_ * i0[3] + fi_ * r0[3]);
            wi_.z = pk2(fr_ * i1[0] + fi_ * r1[0], fr_ * i1[1] + fi_ * r1[1]); wi_.w = pk2(fr_ * i1[2] + fi_ * r1[2], fr_ * i1[3] + fi_ * r1[3]); }
        Bf[nq] = __builtin_bit_cast(bf16x8, wr_); Bf[nq + 4] = __builtin_bit_cast(bf16x8, wi_); }
    bf16x8 Cf[4], Df;
    if (FINAL) {
#pragma unroll
        for (int kk = 0; kk < 4; ++kk) { const float* src = (kk < 2 ? INP(7) : INP(8)) + ((size_t)lg * 16 + fr) * 64 + 32 * (kk & 1) + 8 * fq; const float sg = kk < 2 ? 1.0f : -1.0f;
            const f32x4 c0 = *(const f32x4*)src, c1 = *(const f32x4*)(src + 4);
            u32x4 w; w.x = pk2(sg * c0[0], sg * c0[1]); w.y = pk2(sg * c0[2], sg * c0[3]); w.z = pk2(sg * c1[0], sg * c1[1]); w.w = pk2(sg * c1[2], sg * c1[3]); Cf[kk] = __builtin_bit_cast(bf16x8, w); }
        const float dv = INP(9)[l * 512 + 16 * g + fr]; float dd[8];
#pragma unroll
        for (int j = 0; j < 8; ++j) dd[j] = (8 * fq + j == fr) ? dv : 0.f;
        u32x4 w; w.x = pk2(dd[0], dd[1]); w.y = pk2(dd[2], dd[3]); w.z = pk2(dd[4], dd[5]); w.w = pk2(dd[6], dd[7]); Df = __builtin_bit_cast(bf16x8, w);
    }
    float sre = 0.f, sim = 0.f;
    const size_t sidx = (((size_t)b * 32 + g) * 64 + c) * 128 + p;
    if (FINAL) { sre = WSP(const float, WS_S5I)[sidx]; sim = WSP(const float, WS_S5I)[sidx + 64]; }
    const size_t row0 = (size_t)b * SEQ + (size_t)c * 128;
    const bf16* up = WSP(const bf16, WS_PROJ) + (row0 + fr) * MIXP + PC_S5U + 16 * g + 8 * (fq & 1);
    u32x4 aun = *(const u32x4*)up;
#pragma unroll 1
    for (int sb = 0; sb < 8; ++sb) {
        u32x4 au_ = aun; if (fq >= 2) au_ = (u32x4){0u, 0u, 0u, 0u};
        const bf16x8 au = __builtin_bit_cast(bf16x8, au_);
        if (sb < 7) aun = *(const u32x4*)(up + (size_t)(sb + 1) * 16 * MIXP);
#pragma unroll
        for (int nt = 0; nt < 8; ++nt) { const f32x4 a = __builtin_amdgcn_mfma_f32_16x16x32_bf16(au, Bf[nt], (f32x4){0.f, 0.f, 0.f, 0.f}, 0, 0, 0);
#pragma unroll
            for (int e = 0; e < 4; ++e) X[(4 * fq + e) * S5_XLD + 16 * nt + fr] = a[e]; }
#pragma unroll
        for (int t = 0; t < 16; ++t) { const float xr = X[t * S5_XLD + p], xi = X[t * S5_XLD + 64 + p];
            const float nre = abr * sre - abi * sim + xr, nim = abr * sim + abi * sre + xi; sre = nre; sim = nim;
            if (FINAL) { Sb[t * S5_SLD + p] = (bf16)f2bf(sre); Sb[t * S5_SLD + 64 + p] = (bf16)f2bf(sim); } }
        if (FINAL) {
            f32x4 y = (f32x4){0.f, 0.f, 0.f, 0.f};
#pragma unroll
            for (int kk = 0; kk < 4; ++kk) y = __builtin_amdgcn_mfma_f32_16x16x32_bf16(*(const LAS bf16x8*)(Sb + fr * S5_SLD + 32 * kk + 8 * fq), Cf[kk], y, 0, 0, 0);
            y = __builtin_amdgcn_mfma_f32_16x16x32_bf16(au, Df, y, 0, 0, 0);
#pragma unroll
            for (int e = 0; e < 4; ++e) WSP(bf16, WS_S5Z)[(row0 + sb * 16 + 4 * fq + e) * 512 + 16 * g + fr] = (bf16)f2bf(geluf_(y[e]));
        }
    }
    if (!FINAL) { WSP(float, WS_S5E)[sidx] = sre; WSP(float, WS_S5E)[sidx + 64] = sim; }
}
__device__ __forceinline__ void s5_carry(Frame& F, int l, int task) {
    const int b = task >> 5, g = task & 31, p = F.lane;
    const float lr = INP(3)[(l * 32 + g) * 64 + p], li = INP(4)[(l * 32 + g) * 64 + p]; const float dt = expf(INP(10)[l * 32 + g]);
    const float mag = expf(lr * dt); float sn, cs; sincosf(li * dt, &sn, &cs); float ar = mag * cs, ai = mag * sn;
#pragma unroll
    for (int i = 0; i < 7; ++i) { const float nr = ar * ar - ai * ai, ni = (ar + ar) * ai; ar = nr; ai = ni; }
    float rr = 0.f, ri = 0.f;
    const float* E = WSP(const float, WS_S5E) + (((size_t)b * 32 + g) * 64) * 128 + p; float* I = WSP(float, WS_S5I) + (((size_t)b * 32 + g) * 64) * 128 + p;
#pragma unroll 1
    for (int c0 = 0; c0 < 64; c0 += 32) { float er[32], ei[32];
#pragma unroll
        for (int j = 0; j < 32; ++j) { er[j] = E[(size_t)(c0 + j) * 128]; ei[j] = E[(size_t)(c0 + j) * 128 + 64]; }
#pragma unroll
        for (int j = 0; j < 32; ++j) { I[(size_t)(c0 + j) * 128] = rr; I[(size_t)(c0 + j) * 128 + 64] = ri;
            const float nr = ar * rr - ai * ri + er[j], ni = ar * ri + ai * rr + ei[j]; rr = nr; ri = ni; } }
}

constexpr int M2_CS = 0, M2_BS = 17408, M2_BST = 34816, M2_XT = 53248, M2_GS = 90112, M2_CUM = 107520, M2_DTV = 108544, M2_END = 109568;
constexpr int LDP = 136, LDT = 72, LDG = 68;
__device__ __forceinline__ void m2_stage(Frame& F, int l, int b, int c, int gr) {
    LAS bf16* Cs = (LAS bf16*)(F.lds + M2_CS); LAS bf16* Bs = (LAS bf16*)(F.lds + M2_BS); LAS bf16* BsT = (LAS bf16*)(F.lds + M2_BST); LAS bf16* XT = (LAS bf16*)(F.lds + M2_XT);
    LAS float* cum = (LAS float*)(F.lds + M2_CUM); LAS float* dtv = (LAS float*)(F.lds + M2_DTV);
    const int tid = F.tid; const size_t row0 = (size_t)b * SEQ + (size_t)c * 64;
    {
        const int kind = tid < 256 ? 0 : (tid < 384 ? 1 : 2); const int idx = kind == 0 ? tid : (kind == 1 ? tid - 256 : tid - 384);
        const int col = kind == 0 ? 256 * gr + idx : (kind == 1 ? 512 + 128 * gr + idx : 768 + 128 * gr + idx);
        const float* cwp = INP(19) + (size_t)l * 4 * 1024 + col; const float cw0 = cwp[0], cw1 = cwp[1024], cw2 = cwp[2048], cw3 = cwp[3072]; const float cb = INP(20)[l * 1024 + col];
        const bf16* px = WSP(const bf16, WS_PROJ) + row0 * MIXP + PC_XBC + col;
        float xm3 = 0.f, xm2 = 0.f, xm1 = 0.f;
        if (c > 0) { xm3 = bf2f(*(px - 3 * (ptrdiff_t)MIXP)); xm2 = bf2f(*(px - 2 * (ptrdiff_t)MIXP)); xm1 = bf2f(*(px - (ptrdiff_t)MIXP)); }
        bf16 xall[64];
#pragma unroll
        for (int j = 0; j < 64; ++j) xall[j] = px[(size_t)j * MIXP];
#pragma unroll
        for (int tb = 0; tb < 8; ++tb) {
            float vv[8];
#pragma unroll
            for (int j = 0; j < 8; ++j) { const float xv = bf2f(xall[tb * 8 + j]);
                vv[j] = siluf_(cb + cw0 * xm3 + cw1 * xm2 + cw2 * xm1 + cw3 * xv); xm3 = xm2; xm2 = xm1; xm1 = xv; }
            u32x4 w; w.x = pk2(vv[0], vv[1]); w.y = pk2(vv[2], vv[3]); w.z = pk2(vv[4], vv[5]); w.w = pk2(vv[6], vv[7]);
            if (kind == 0) *(LAS u32x4*)(XT + idx * LDT + tb * 8) = w;
            else if (kind == 1) { *(LAS u32x4*)(BsT + idx * LDT + tb * 8) = w;
#pragma unroll
                for (int j = 0; j < 8; ++j) Bs[(tb * 8 + j) * LDP + idx] = (bf16)f2bf(vv[j]); }
            else {
#pragma unroll
                for (int j = 0; j < 8; ++j) Cs[(tb * 8 + j) * LDP + idx] = (bf16)f2bf(vv[j]); }
        }
    }
    if (tid < 256) { const int hh = tid >> 6, t = tid & 63, h = 4 * gr + hh;
        const float dtr = bf2f(WSP(const bf16, WS_PROJ)[(row0 + t) * MIXP + PC_DT + h]);
        const float dt = softplusf_(dtr + INP(21)[l * 8 + h]); const float a = -expf(INP(22)[l * 8 + h]);
        float s = dt * a;
#pragma unroll
        for (int o = 1; o < 64; o <<= 1) { const float n = __shfl_up(s, o); if (t >= o) s += n; }
        dtv[hh * 64 + t] = dt; cum[hh * 64 + t] = s; }
    __syncthreads();
}
__device__ __forceinline__ bf16x8 ldfrag(const LAS bf16* p) { return *(const LAS bf16x8*)p; }
__device__ __forceinline__ void m2_pass1(Frame& F, int l, int task) {
    const int b = task >> 8, c = (task >> 1) & 127, gr = task & 1;
    m2_stage(F, l, b, c, gr);
    LAS bf16* BsT = (LAS bf16*)(F.lds + M2_BST); LAS bf16* XT = (LAS bf16*)(F.lds + M2_XT); LAS float* cum = (LAS float*)(F.lds + M2_CUM); LAS float* dtv = (LAS float*)(F.lds + M2_DTV);
    const int lane = F.lane, hh = F.wave >> 1, half = F.wave & 1, h = 4 * gr + hh; const int fr = lane & 15, fq = lane >> 4;
    const float clast = cum[hh * 64 + 63];
    f32x4 acc[2][8];
#pragma unroll
    for (int i = 0; i < 2; ++i)
#pragma unroll
        for (int j = 0; j < 8; ++j) acc[i][j] = (f32x4){0.f, 0.f, 0.f, 0.f};
#pragma unroll
    for (int kk = 0; kk < 2; ++kk) {
        float fj[8];
#pragma unroll
        for (int e = 0; e < 8; ++e) { const int j = 32 * kk + 8 * fq + e; fj[e] = dtv[hh * 64 + j] * __expf(clast - cum[hh * 64 + j]); }
        bf16x8 af[2];
#pragma unroll
        for (int pi = 0; pi < 2; ++pi) { const int p = 16 * (2 * half + pi) + fr; const u32x4 raw = *(const LAS u32x4*)(XT + (64 * hh + p) * LDT + 32 * kk + 8 * fq);
            u32x4 w; w.x = pk2(lo16(raw.x) * fj[0], hi16(raw.x) * fj[1]); w.y = pk2(lo16(raw.y) * fj[2], hi16(raw.y) * fj[3]); w.z = pk2(lo16(raw.z) * fj[4], hi16(raw.z) * fj[5]); w.w = pk2(lo16(raw.w) * fj[6], hi16(raw.w) * fj[7]);
            af[pi] = __builtin_bit_cast(bf16x8, w); }
#pragma unroll
        for (int nt = 0; nt < 8; ++nt) { const bf16x8 bfr = ldfrag(BsT + (16 * nt + fr) * LDT + 32 * kk + 8 * fq);
#pragma unroll
            for (int pi = 0; pi < 2; ++pi) acc[pi][nt] = __builtin_amdgcn_mfma_f32_16x16x32_bf16(af[pi], bfr, acc[pi][nt], 0, 0, 0); }
    }
    bf16* S = WSP(bf16, WS_M2S) + ((((size_t)b * 128 + c) * 8 + h) * 64) * 128;
#pragma unroll
    for (int pi = 0; pi < 2; ++pi)
#pragma unroll
        for (int nt = 0; nt < 8; ++nt)
#pragma unroll
            for (int e = 0; e < 4; ++e) S[(size_t)(16 * (2 * half + pi) + 4 * fq + e) * 128 + 16 * nt + fr] = (bf16)f2bf(acc[pi][nt][e]);
    if (half == 0 && lane == 0) WSP(float, WS_M2D)[((size_t)b * 128 + c) * 8 + h] = __expf(clast);
    __syncthreads();
}
__device__ __forceinline__ void m2_carry(Frame& F) {
    const int gt = F.blk * NTHR + F.tid, stride = F.G * NTHR, NE = NB * 8 * 8192;
    int vz; asm volatile("v_mov_b32 %0, 0" : "=v"(vz));
    for (int e0 = gt; e0 < NE; e0 += 2 * stride) {
        const int e1 = (e0 + stride < NE) ? e0 + stride : e0; const bool two = e1 != e0;
        bf16* S0 = WSP(bf16, WS_M2S) + (((size_t)(e0 >> 16) * 128) * 8 + ((e0 >> 13) & 7)) * 8192 + (e0 & 8191); const float* D0 = WSP(const float, WS_M2D) + (size_t)(e0 >> 16) * 128 * 8 + ((e0 >> 13) & 7) + vz;
        bf16* S1 = WSP(bf16, WS_M2S) + (((size_t)(e1 >> 16) * 128) * 8 + ((e1 >> 13) & 7)) * 8192 + (e1 & 8191); const float* D1 = WSP(const float, WS_M2D) + (size_t)(e1 >> 16) * 128 * 8 + ((e1 >> 13) & 7) + vz;
        float run0 = 0.f, run1 = 0.f;
#pragma unroll 1
        for (int c0 = 0; c0 < 128; c0 += 16) {
            bf16 t0[16], t1[16]; float d0[16], d1[16];
#pragma unroll
            for (int j = 0; j < 16; ++j) { t0[j] = S0[(size_t)(c0 + j) * 8 * 8192]; d0[j] = D0[(c0 + j) * 8]; t1[j] = S1[(size_t)(c0 + j) * 8 * 8192]; d1[j] = D1[(c0 + j) * 8]; }
#pragma unroll
            for (int j = 0; j < 16; ++j) { S0[(size_t)(c0 + j) * 8 * 8192] = (bf16)f2bf(run0); run0 = d0[j] * run0 + bf2f(t0[j]);
                if (two) S1[(size_t)(c0 + j) * 8 * 8192] = (bf16)f2bf(run1); run1 = d1[j] * run1 + bf2f(t1[j]); }
        }
    }
}
__device__ __forceinline__ void m2_pass2(Frame& F, int l, int task) {
    const int b = task >> 8, c = (task >> 1) & 127, gr = task & 1;
    m2_stage(F, l, b, c, gr);
    LAS bf16* Cs = (LAS bf16*)(F.lds + M2_CS); LAS bf16* Bs = (LAS bf16*)(F.lds + M2_BS); LAS bf16* XT = (LAS bf16*)(F.lds + M2_XT);
    LAS float* Gs = (LAS float*)(F.lds + M2_GS); LAS float* cum = (LAS float*)(F.lds + M2_CUM); LAS float* dtv = (LAS float*)(F.lds + M2_DTV);
    const int lane = F.lane, w = F.wave, fr = lane & 15, fq = lane >> 4;
#pragma unroll
    for (int q = 0; q < 2; ++q) { const int tile = 2 * w + q, it = tile >> 2, jt = tile & 3; f32x4 a = (f32x4){0.f, 0.f, 0.f, 0.f};
#pragma unroll
        for (int kk = 0; kk < 4; ++kk) a = __builtin_amdgcn_mfma_f32_16x16x32_bf16(ldfrag(Cs + (16 * it + fr) * LDP + 32 * kk + 8 * fq), ldfrag(Bs + (16 * jt + fr) * LDP + 32 * kk + 8 * fq), a, 0, 0, 0);
#pragma unroll
        for (int e = 0; e < 4; ++e) Gs[(16 * it + 4 * fq + e) * LDG + 16 * jt + fr] = a[e]; }
    __syncthreads();
    const int hh = w >> 1, half = w & 1, h = 4 * gr + hh;
    f32x4 accd[2][4], acco[2][4];
#pragma unroll
    for (int i = 0; i < 2; ++i)
#pragma unroll
        for (int j = 0; j < 4; ++j) { accd[i][j] = (f32x4){0.f, 0.f, 0.f, 0.f}; acco[i][j] = (f32x4){0.f, 0.f, 0.f, 0.f}; }
#pragma unroll
    for (int ii = 0; ii < 2; ++ii) { const int it = 2 * half + ii; const int i = 16 * it + fr; const float ci = cum[hh * 64 + i];
#pragma unroll
        for (int kk = 0; kk < 2; ++kk) { if (32 * kk > 16 * it + 15) continue;
            float wv[8];
#pragma unroll
            for (int e = 0; e < 8; ++e) { const int j = 32 * kk + 8 * fq + e; const float gv = Gs[i * LDG + j]; wv[e] = (j <= i) ? gv * __expf(ci - cum[hh * 64 + j]) * dtv[hh * 64 + j] : 0.f; }
            u32x4 ww; ww.x = pk2(wv[0], wv[1]); ww.y = pk2(wv[2], wv[3]); ww.z = pk2(wv[4], wv[5]); ww.w = pk2(wv[6], wv[7]);
            const bf16x8 af = __builtin_bit_cast(bf16x8, ww);
#pragma unroll
            for (int pt = 0; pt < 4; ++pt) accd[ii][pt] = __builtin_amdgcn_mfma_f32_16x16x32_bf16(af, ldfrag(XT + (64 * hh + 16 * pt + fr) * LDT + 32 * kk + 8 * fq), accd[ii][pt], 0, 0, 0); } }
    const bf16* S = WSP(const bf16, WS_M2S) + ((((size_t)b * 128 + c) * 8 + h) * 64) * 128;
#pragma unroll
    for (int kk = 0; kk < 4; ++kk) {
        bf16x8 bfr[4];
#pragma unroll
        for (int pt = 0; pt < 4; ++pt) bfr[pt] = *(const bf16x8*)(S + (size_t)(16 * pt + fr) * 128 + 32 * kk + 8 * fq);
#pragma unroll
        for (int ii = 0; ii < 2; ++ii) { const bf16x8 af = ldfrag(Cs + (16 * (2 * half + ii) + fr) * LDP + 32 * kk + 8 * fq);
#pragma unroll
            for (int pt = 0; pt < 4; ++pt) acco[ii][pt] = __builtin_amdgcn_mfma_f32_16x16x32_bf16(af, bfr[pt], acco[ii][pt], 0, 0, 0); }
    }
    const float dpar = INP(23)[l * 8 + h]; const size_t row0 = (size_t)b * SEQ + (size_t)c * 64;
#pragma unroll
    for (int ii = 0; ii < 2; ++ii)
#pragma unroll
        for (int e = 0; e < 4; ++e) { const int i = 16 * (2 * half + ii) + 4 * fq + e; const float ec = __expf(cum[hh * 64 + i]);
#pragma unroll
            for (int pt = 0; pt < 4; ++pt) { const int p = 16 * pt + fr;
                float y = accd[ii][pt][e] + ec * acco[ii][pt][e] + dpar * bf2f(XT[(64 * hh + p) * LDT + i]);
                const float z = bf2f(WSP(const bf16, WS_PROJ)[(row0 + i) * MIXP + PC_M2Z + 64 * h + p]);
                WSP(float, WS_M2Y)[(row0 + i) * 512 + 64 * h + p] = y * siluf_(z); } }
    __syncthreads();
}
__device__ __forceinline__ void m2_norm(Frame& F, int l, int gw, int ngw) {
    f32x4 g0 = *(const f32x4*)(INP(24) + l * 512 + 8 * F.lane), g1 = *(const f32x4*)(INP(24) + l * 512 + 8 * F.lane + 4);
    for (int m = gw; m < MTOK; m += ngw) { const f32x4* yp = (const f32x4*)(WSP(const float, WS_M2Y) + (size_t)m * 512 + 8 * F.lane); const f32x4 a = yp[0], b = yp[1];
        const float ss = wave_sum((a.x * a.x + a.y * a.y) + (a.z * a.z + a.w * a.w) + (b.x * b.x + b.y * b.y) + (b.z * b.z + b.w * b.w));
        const float rs = 1.0f / sqrtf(ss * (1.f / 512.f) + 1e-6f);
        u32x4 w; w.x = pk2(a.x * rs * g0.x, a.y * rs * g0.y); w.y = pk2(a.z * rs * g0.z, a.w * rs * g0.w); w.z = pk2(b.x * rs * g1.x, b.y * rs * g1.y); w.w = pk2(b.z * rs * g1.z, b.w * rs * g1.w);
        *(u32x4*)(WSP(bf16, WS_YK) + (size_t)2 * MTOK * 512 + (size_t)m * 512 + 8 * F.lane) = w; }
}

constexpr int RP_LDA = 72, RP_LDB = 104;
#define RWP_WFRAG(dst, base, ldrow) do { const float* p_ = (base); u32x4 w_; w_.x = pk2(p_[0], p_[512]); w_.y = pk2(p_[1024], p_[1536]); w_.z = pk2(p_[2048], p_[2560]); w_.w = pk2(p_[3072], p_[3584]); dst = __builtin_bit_cast(bf16x8, w_); } while (0)
__device__ __forceinline__ void rw_pre(Frame& F, int l, int task) {
    LAS bf16* SM0 = (LAS bf16*)F.lds;
    const int tid = F.tid, lane = F.lane, hh = F.wave, fr = lane & 15, fq = lane >> 4;
    const float* mu = INP(25) + (size_t)l * RWC;
    const size_t rowb = (size_t)task * 128;
    const bf16* P = WSP(const bf16, WS_PROJ);
    const bool nofirst = (rowb & (SEQ - 1)) != 0;
    const int c4 = 64 * hh + 4 * fr;
    {
        bf16x8 Bw[4], Ba[4];
#pragma unroll
        for (int ct = 0; ct < 4; ++ct) { RWP_WFRAG(Bw[ct], INP(27) + ((size_t)l * 32 + 8 * fq) * 512 + c4 + ct, 512); RWP_WFRAG(Ba[ct], INP(29) + ((size_t)l * 32 + 8 * fq) * 512 + c4 + ct, 512); }
        const float* pw0 = INP(26) + l * 512 + c4; const float* pa0 = INP(28) + l * 512 + c4; const float* pkk = INP(31) + l * 512 + c4; const float* pka = INP(32) + l * 512 + c4; const float* prk = INP(33) + l * 512 + c4;
        const int sj = tid & 63, st0 = tid >> 6, st1 = 8 + (tid >> 6); const float smu = mu[1536 + sj];
        const bf16* sq = P + rowb * MIXP + PC_RW + 1536 + sj;
        bf16 sc0, sp0, sc1, sp1;
        u32x2 rkv[4][3], rkvp[3];
        const bf16* rq = P + (rowb + 4 * fq) * MIXP + PC_RW + c4;
#define RWP_STAGE_LOAD(sb) do { const size_t o_ = (size_t)((sb) * 16) * MIXP; sc0 = sq[o_ + (size_t)st0 * MIXP]; sc1 = sq[o_ + (size_t)st1 * MIXP]; sp1 = sq[o_ + (size_t)(st1 - 1) * MIXP]; \
            sp0 = (nofirst || (sb) > 0 || st0 > 0) ? sq[o_ + (size_t)st0 * MIXP - MIXP] : (bf16)0; } while (0)
#define RWP_STAGE_WRITE(buf) do { { const float pt_ = bf2f(sc0), pp_ = bf2f(sp0); const float pm_ = pt_ + (pp_ - pt_) * smu; SM0[(buf) * 1664 + st0 * RP_LDA + sj] = (bf16)f2bf(sj < 32 ? (1.0f - 2.0f * rcpf_(__expf(2.0f * pm_) + 1.0f)) : pm_); } \
            { const float pt_ = bf2f(sc1), pp_ = bf2f(sp1); const float pm_ = pt_ + (pp_ - pt_) * smu; SM0[(buf) * 1664 + st1 * RP_LDA + sj] = (bf16)f2bf(sj < 32 ? (1.0f - 2.0f * rcpf_(__expf(2.0f * pm_) + 1.0f)) : pm_); } } while (0)
#define RWP_RKV_LOAD(sb, cur, prev) do { const bf16* q_ = rq + (size_t)((sb) * 16) * MIXP; \
            _Pragma("unroll") for (int e_ = 0; e_ < 4; ++e_) _Pragma("unroll") for (int a_ = 0; a_ < 3; ++a_) cur[e_][a_] = *(const u32x2*)(q_ + (size_t)e_ * MIXP + 512 * a_); \
            const bool hp_ = nofirst || (sb) > 0 || fq > 0; \
            _Pragma("unroll") for (int a_ = 0; a_ < 3; ++a_) prev[a_] = hp_ ? *(const u32x2*)(q_ - (ptrdiff_t)MIXP + 512 * a_) : (u32x2){0u, 0u}; } while (0)
        RWP_STAGE_LOAD(0); RWP_RKV_LOAD(0, rkv, rkvp); RWP_STAGE_WRITE(0);
        __syncthreads();
#pragma unroll 1
        for (int sb = 0; sb < 8; ++sb) {
            if (sb < 7) { RWP_STAGE_LOAD(sb + 1); }
            const LAS bf16* SM = SM0 + (sb & 1) * 1664;
            const bf16x8 Aw = ldfrag(SM + fr * RP_LDA + 8 * fq), Aa = ldfrag(SM + fr * RP_LDA + 32 + 8 * fq);
            f32x4 aw[4], aa[4];
#pragma unroll
            for (int ct = 0; ct < 4; ++ct) { const f32x4 z = (f32x4){0.f, 0.f, 0.f, 0.f};
                aw[ct] = __builtin_amdgcn_mfma_f32_16x16x32_bf16(Aw, Bw[ct], z, 0, 0, 0); aa[ct] = __builtin_amdgcn_mfma_f32_16x16x32_bf16(Aa, Ba[ct], z, 0, 0, 0); }
            const size_t r0 = rowb + sb * 16 + 4 * fq;
            asm volatile("" ::: "memory");
            const f32x4 mu_r = *(const f32x4*)(mu + c4), mu_k = *(const f32x4*)(mu + 512 + c4), mu_v = *(const f32x4*)(mu + 1024 + c4);
            const f32x4 w0c = *(const f32x4*)pw0, a0c = *(const f32x4*)pa0, kkc = *(const f32x4*)pkk, kac = *(const f32x4*)pka, rkc = *(const f32x4*)prk;
#pragma unroll
            for (int e = 0; e < 4; ++e) { const size_t row = r0 + e; const size_t o = row * 512 + c4;
                const u32x2 pr_ = e == 0 ? rkvp[0] : rkv[e > 0 ? e - 1 : 0][0], pk_ = e == 0 ? rkvp[1] : rkv[e > 0 ? e - 1 : 0][1], pv_ = e == 0 ? rkvp[2] : rkv[e > 0 ? e - 1 : 0][2];
                const float rc[4] = {lo16(rkv[e][0].x), hi16(rkv[e][0].x), lo16(rkv[e][0].y), hi16(rkv[e][0].y)}, rp[4] = {lo16(pr_.x), hi16(pr_.x), lo16(pr_.y), hi16(pr_.y)};
                const float kc[4] = {lo16(rkv[e][1].x), hi16(rkv[e][1].x), lo16(rkv[e][1].y), hi16(rkv[e][1].y)}, kp[4] = {lo16(pk_.x), hi16(pk_.x), lo16(pk_.y), hi16(pk_.y)};
                const float vc[4] = {lo16(rkv[e][2].x), hi16(rkv[e][2].x), lo16(rkv[e][2].y), hi16(rkv[e][2].y)}, vp[4] = {lo16(pv_.x), hi16(pv_.x), lo16(pv_.y), hi16(pv_.y)};
                float rr[4], kpr[4], vv[4], kk[4], av[4], dec[4]; float ssp = 0.f, bonp = 0.f;
#pragma unroll
                for (int ct = 0; ct < 4; ++ct) {
                    rr[ct] = rc[ct] + (rp[ct] - rc[ct]) * mu_r[ct]; const float k = kc[ct] + (kp[ct] - kc[ct]) * mu_k[ct]; vv[ct] = vc[ct] + (vp[ct] - vc[ct]) * mu_v[ct];
                    const float wlog = -softplusf_(-(aw[ct][e] + w0c[ct])) - 0.5f; dec[ct] = __expf(-__expf(wlog)); av[ct] = sigmoidf_(aa[ct][e] + a0c[ct]);
                    kk[ct] = k * kkc[ct]; ssp += kk[ct] * kk[ct]; kpr[ct] = k * (1.0f + (av[ct] - 1.0f) * kac[ct]); bonp += rr[ct] * kpr[ct] * rkc[ct]; }
                const float ss = row16_sum(ssp), bon = row16_sum(bonp); const float rn = __builtin_amdgcn_rsqf(fmaxf(ss, 1e-24f));
                u32x2 w;
                w.x = pk2(rr[0], rr[1]); w.y = pk2(rr[2], rr[3]); *(u32x2*)(WSP(bf16, WS_RW_R) + o) = w;
                w.x = pk2(kpr[0], kpr[1]); w.y = pk2(kpr[2], kpr[3]); *(u32x2*)(WSP(bf16, WS_RW_K) + o) = w;
                w.x = pk2(vv[0], vv[1]); w.y = pk2(vv[2], vv[3]); *(u32x2*)(WSP(bf16, WS_RW_V) + o) = w;
                w.x = pk2(-kk[0] * rn, -kk[1] * rn); w.y = pk2(-kk[2] * rn, -kk[3] * rn); *(u32x2*)(WSP(bf16, WS_RW_A) + o) = w;
                w.x = pk2(kk[0] * rn * av[0], kk[1] * rn * av[1]); w.y = pk2(kk[2] * rn * av[2], kk[3] * rn * av[3]); *(u32x2*)(WSP(bf16, WS_RW_B) + o) = w;
                *(f32x4*)(WSP(float, WS_RW_DEC) + o) = (f32x4){dec[0], dec[1], dec[2], dec[3]};
                if (fr == 0) WSP(float, WS_RW_BON)[row * 8 + hh] = bon; }
            if (sb < 7) { RWP_RKV_LOAD(sb + 1, rkv, rkvp); RWP_STAGE_WRITE((sb + 1) & 1); }
            __syncthreads();
        }
#undef RWP_STAGE_LOAD
#undef RWP_STAGE_WRITE
#undef RWP_RKV_LOAD
    }
    {
        int tidb = F.tid; asm volatile("" : "+v"(tidb));
        const int tid = tidb, lane = tid & 63, fr = lane & 15, fq = lane >> 4; const int c4 = 64 * hh + 4 * fr;
        bf16x8 Bg[4][3];
#pragma unroll
        for (int ct = 0; ct < 4; ++ct)
#pragma unroll
            for (int kk = 0; kk < 3; ++kk) RWP_WFRAG(Bg[ct][kk], INP(30) + ((size_t)l * 96 + 32 * kk + 8 * fq) * 512 + c4 + ct, 512);
        int stk[3], sjj[3]; float smv[3]; bf16 sc[3], sp[3];
#pragma unroll
        for (int i = 0; i < 3; ++i) { const int idx = tid + 512 * i; stk[i] = idx / 96; sjj[i] = idx % 96; smv[i] = mu[1600 + sjj[i]]; }
        const bf16* sq = P + rowb * MIXP + PC_RW + 1600;
#define RWP_STAGE_LOAD(sb) do { _Pragma("unroll") for (int i_ = 0; i_ < 3; ++i_) { const bf16* q_ = sq + (size_t)((sb) * 16 + stk[i_]) * MIXP + sjj[i_]; sc[i_] = q_[0]; \
            sp[i_] = (nofirst || (sb) > 0 || stk[i_] > 0) ? *(q_ - (ptrdiff_t)MIXP) : (bf16)0; } } while (0)
#define RWP_STAGE_WRITE(buf) do { _Pragma("unroll") for (int i_ = 0; i_ < 3; ++i_) { const float pt_ = bf2f(sc[i_]), pp_ = bf2f(sp[i_]); \
            SM0[(buf) * 1664 + stk[i_] * RP_LDB + sjj[i_]] = (bf16)f2bf(sigmoidf_(pt_ + (pp_ - pt_) * smv[i_])); } } while (0)
        RWP_STAGE_LOAD(0); RWP_STAGE_WRITE(0);
        __syncthreads();
#pragma unroll 1
        for (int sb = 0; sb < 8; ++sb) {
            if (sb < 7) RWP_STAGE_LOAD(sb + 1);
            const LAS bf16* SM = SM0 + (sb & 1) * 1664;
            const bf16x8 Ag0 = ldfrag(SM + fr * RP_LDB + 8 * fq), Ag1 = ldfrag(SM + fr * RP_LDB + 32 + 8 * fq), Ag2 = ldfrag(SM + fr * RP_LDB + 64 + 8 * fq);
            f32x4 ag[4];
#pragma unroll
            for (int ct = 0; ct < 4; ++ct) { f32x4 g = __builtin_amdgcn_mfma_f32_16x16x32_bf16(Ag0, Bg[ct][0], (f32x4){0.f, 0.f, 0.f, 0.f}, 0, 0, 0);
                g = __builtin_amdgcn_mfma_f32_16x16x32_bf16(Ag1, Bg[ct][1], g, 0, 0, 0); ag[ct] = __builtin_amdgcn_mfma_f32_16x16x32_bf16(Ag2, Bg[ct][2], g, 0, 0, 0); }
            const size_t r0 = rowb + sb * 16 + 4 * fq;
#pragma unroll
            for (int e = 0; e < 4; ++e) { u32x2 w; w.x = pk2(ag[0][e], ag[1][e]); w.y = pk2(ag[2][e], ag[3][e]); *(u32x2*)(WSP(bf16, WS_RW_G) + (r0 + e) * 512 + c4) = w; }
            if (sb < 7) RWP_STAGE_WRITE((sb + 1) & 1);
            __syncthreads();
        }
#undef RWP_STAGE_LOAD
#undef RWP_STAGE_WRITE
    }
}
constexpr int RC_G1 = 0, RC_G2 = 8192, RC_Q1 = 10240, RC_Q2 = 12288, RC_GAM = 13312, RC_VT = 13568, RC_BYTES = 16384;
constexpr size_t WS_RWC = WS_PROJ;
constexpr int CP_IMG = 0, CP_MAT = 9216, CP_P2 = 13568, CP_Q2 = 14656;
constexpr int CP_P1I = 0, CP_BGI = 3072, CP_Q1I = 6144;
__device__ __forceinline__ void rw_chunk_prep(Frame& F, int task) {
    int lane = F.lane; asm volatile("" : "+v"(lane)); const int fr = lane & 15, fq = lane >> 4; const int b = task >> 12, h = (task >> 9) & 7, c = task & 511;
    LAS unsigned char* wl = F.lds + F.wave * WAVE_LDS;
    LAS bf16* IMG = (LAS bf16*)(wl + CP_IMG); LAS float* MAT = (LAS float*)(wl + CP_MAT); LAS float* P2m = (LAS float*)(wl + CP_P2); LAS float* Q2m = (LAS float*)(wl + CP_Q2);
    unsigned char* rec = F.ws + WS_RWC + (size_t)task * RC_BYTES;
    const size_t e0 = ((size_t)b * SEQ + (size_t)c * 16) * 512 + 64 * h + lane;
    float At[16], Bt[16], Kt[16], Rt[16]; float gT;
    { float wv[16]; bf16 av[16], bv[16], kv[16], rv[16];
#pragma unroll
      for (int t = 0; t < 16; ++t) { const size_t o = e0 + (size_t)t * 512; wv[t] = WSP(const float, WS_RW_DEC)[o]; av[t] = WSP(const bf16, WS_RW_A)[o]; bv[t] = WSP(const bf16, WS_RW_B)[o]; kv[t] = WSP(const bf16, WS_RW_K)[o]; rv[t] = WSP(const bf16, WS_RW_R)[o]; }
      float g = 1.0f;
#pragma unroll
      for (int t = 0; t < 16; ++t) { const float gp = g; g *= wv[t]; const float inv = rcpf_(g);
          At[t] = bf2f(av[t]) * gp; Bt[t] = bf2f(bv[t]) * inv; Kt[t] = bf2f(kv[t]) * inv; Rt[t] = bf2f(rv[t]) * g;
          IMG[0 * 1152 + t * 72 + lane] = (bf16)f2bf(At[t]); IMG[1 * 1152 + t * 72 + lane] = (bf16)f2bf(Bt[t]); IMG[2 * 1152 + t * 72 + lane] = (bf16)f2bf(Kt[t]); IMG[3 * 1152 + t * 72 + lane] = (bf16)f2bf(Rt[t]); }
      gT = g; }
    { unsigned vp[8];
#pragma unroll
      for (int t = 0; t < 16; t += 2) vp[t >> 1] = (unsigned)WSP(const bf16, WS_RW_V)[e0 + (size_t)t * 512] | ((unsigned)WSP(const bf16, WS_RW_V)[e0 + (size_t)(t + 1) * 512] << 16);
      u32x4* d = (u32x4*)(rec + RC_VT + lane * 32); d[0] = (u32x4){vp[0], vp[1], vp[2], vp[3]}; d[1] = (u32x4){vp[4], vp[5], vp[6], vp[7]};
      ((float*)(rec + RC_GAM))[lane] = gT; }
    { f32x4 nab = (f32x4){0.f, 0.f, 0.f, 0.f}, nak = nab, mbr = nab, mkr = nab;
#pragma unroll
      for (int kk = 0; kk < 2; ++kk) { const int o = fr * 72 + 32 * kk + 8 * fq;
          const bf16x8 fa = ldfrag(IMG + 0 * 1152 + o), fb = ldfrag(IMG + 1 * 1152 + o), fk = ldfrag(IMG + 2 * 1152 + o), frr = ldfrag(IMG + 3 * 1152 + o);
          nab = __builtin_amdgcn_mfma_f32_16x16x32_bf16(fb, fa, nab, 0, 0, 0); nak = __builtin_amdgcn_mfma_f32_16x16x32_bf16(fk, fa, nak, 0, 0, 0);
          mbr = __builtin_amdgcn_mfma_f32_16x16x32_bf16(fb, frr, mbr, 0, 0, 0); mkr = __builtin_amdgcn_mfma_f32_16x16x32_bf16(fk, frr, mkr, 0, 0, 0); }
#pragma unroll
      for (int e = 0; e < 4; ++e) { const int s_ = 4 * fq + e, t_ = fr; const int o = s_ * 17 + t_;
          MAT[0 * 272 + o] = s_ < t_ ? nab[e] : 0.f; MAT[1 * 272 + o] = s_ < t_ ? nak[e] : 0.f; MAT[2 * 272 + o] = s_ <= t_ ? mbr[e] : 0.f; MAT[3 * 272 + o] = s_ <= t_ ? mkr[e] : 0.f; } }
    float P1[16], P2[16];
#pragma unroll
    for (int t = 0; t < 16; ++t) { float p1 = At[t], p2 = MAT[1 * 272 + fr * 17 + t];
#pragma unroll
        for (int s_ = 0; s_ < t; ++s_) { const float n = MAT[0 * 272 + s_ * 17 + t]; p1 += P1[s_] * n; p2 += P2[s_] * n; }
        P1[t] = p1; P2[t] = p2; asm volatile("" ::: "memory"); }
    LAS bf16* Q1I = (LAS bf16*)(wl + CP_Q1I);
#pragma unroll
    for (int t = 0; t < 16; ++t) { float q1 = Rt[t], q2 = MAT[3 * 272 + fr * 17 + t];
#pragma unroll
        for (int s_ = 0; s_ <= t; ++s_) { const float m = MAT[2 * 272 + s_ * 17 + t]; q1 += P1[s_] * m; q2 += P2[s_] * m; }
        Q1I[t * 72 + lane] = (bf16)f2bf(q1); if (lane < 16) { Q2m[lane * 17 + t] = q2; P2m[lane * 17 + t] = P2[t]; }
        asm volatile("" ::: "memory"); }
    { LAS bf16* P1I = (LAS bf16*)(wl + CP_P1I); LAS bf16* BGI = (LAS bf16*)(wl + CP_BGI);
      u32x4 w0, w1;
      w0.x = pk2(P1[0], P1[1]); w0.y = pk2(P1[2], P1[3]); w0.z = pk2(P1[4], P1[5]); w0.w = pk2(P1[6], P1[7]); w1.x = pk2(P1[8], P1[9]); w1.y = pk2(P1[10], P1[11]); w1.z = pk2(P1[12], P1[13]); w1.w = pk2(P1[14], P1[15]);
      *(LAS u32x4*)(P1I + lane * 24) = w0; *(LAS u32x4*)(P1I + lane * 24 + 8) = w1;
      w0.x = pk2(Bt[0] * gT, Bt[1] * gT); w0.y = pk2(Bt[2] * gT, Bt[3] * gT); w0.z = pk2(Bt[4] * gT, Bt[5] * gT); w0.w = pk2(Bt[6] * gT, Bt[7] * gT);
      w1.x = pk2(Bt[8] * gT, Bt[9] * gT); w1.y = pk2(Bt[10] * gT, Bt[11] * gT); w1.z = pk2(Bt[12] * gT, Bt[13] * gT); w1.w = pk2(Bt[14] * gT, Bt[15] * gT);
      *(LAS u32x4*)(BGI + lane * 24) = w0; *(LAS u32x4*)(BGI + lane * 24 + 8) = w1;
      const u32x4 z4 = (u32x4){0u, 0u, 0u, 0u};
      bf16x8 Af[4], Bf[4];
#pragma unroll
      for (int i = 0; i < 4; ++i) { u32x4 ta = z4, tb = z4; if (fq < 2) { ta = *(const LAS u32x4*)(P1I + (16 * i + fr) * 24 + 8 * fq); tb = *(const LAS u32x4*)(BGI + (16 * i + fr) * 24 + 8 * fq); }
          Af[i] = __builtin_bit_cast(bf16x8, ta); Bf[i] = __builtin_bit_cast(bf16x8, tb); }
#pragma unroll
      for (int j = 0; j < 4; ++j)
#pragma unroll
          for (int s_ = 0; s_ < 2; ++s_) { const f32x4 lo = __builtin_amdgcn_mfma_f32_16x16x32_bf16(Af[2 * s_], Bf[j], (f32x4){0.f, 0.f, 0.f, 0.f}, 0, 0, 0);
              const f32x4 hi = __builtin_amdgcn_mfma_f32_16x16x32_bf16(Af[2 * s_ + 1], Bf[j], (f32x4){0.f, 0.f, 0.f, 0.f}, 0, 0, 0);
              u32x4 w; w.x = pk2(lo[0], lo[1]); w.y = pk2(lo[2], lo[3]); w.z = pk2(hi[0], hi[1]); w.w = pk2(hi[2], hi[3]);
              *(u32x4*)(rec + RC_G1 + ((j * 2 + s_) * 64 + lane) * 16) = w; } }
    { float g2v[16];
#pragma unroll
      for (int t = 0; t < 16; ++t) { float acc = Kt[t];
#pragma unroll
          for (int s_ = 0; s_ < 16; ++s_) acc += P2m[t * 17 + s_] * Bt[s_];
          g2v[t] = acc * gT; asm volatile("" ::: "memory"); }
      u32x4 w0, w1; w0.x = pk2(g2v[0], g2v[1]); w0.y = pk2(g2v[2], g2v[3]); w0.z = pk2(g2v[4], g2v[5]); w0.w = pk2(g2v[6], g2v[7]); w1.x = pk2(g2v[8], g2v[9]); w1.y = pk2(g2v[10], g2v[11]); w1.z = pk2(g2v[12], g2v[13]); w1.w = pk2(g2v[14], g2v[15]);
      u32x4* d = (u32x4*)(rec + RC_G2 + lane * 32); d[0] = w0; d[1] = w1; }
    {
#pragma unroll
      for (int s_ = 0; s_ < 2; ++s_) { const u32x2 lo = *(const LAS u32x2*)(Q1I + fr * 72 + 32 * s_ + 4 * fq), hi = *(const LAS u32x2*)(Q1I + fr * 72 + 32 * s_ + 16 + 4 * fq);
          *(u32x4*)(rec + RC_Q1 + (s_ * 64 + lane) * 16) = (u32x4){lo.x, lo.y, hi.x, hi.y}; } }
    { u32x4 w = (u32x4){0u, 0u, 0u, 0u};
      if (fq < 2) { float q[8];
#pragma unroll
          for (int j = 0; j < 8; ++j) q[j] = Q2m[(8 * fq + j) * 17 + fr];
          w.x = pk2(q[0], q[1]); w.y = pk2(q[2], q[3]); w.z = pk2(q[4], q[5]); w.w = pk2(q[6], q[7]); }
      *(u32x4*)(rec + RC_Q2 + lane * 16) = w; }
}
__device__ __forceinline__ void rw_chunk_step(const LAS unsigned char* rc, f32x4 (&X)[4], float* yo, int w, int lane, int fr, int fq) {
    const u32x4 z4 = (u32x4){0u, 0u, 0u, 0u};
    u32x4 b0, b1; b0.x = pk2(X[0][0], X[0][1]); b0.y = pk2(X[0][2], X[0][3]); b0.z = pk2(X[1][0], X[1][1]); b0.w = pk2(X[1][2], X[1][3]);
    b1.x = pk2(X[2][0], X[2][1]); b1.y = pk2(X[2][2], X[2][3]); b1.z = pk2(X[3][0], X[3][1]); b1.w = pk2(X[3][2], X[3][3]);
    const bf16x8 Bx0 = __builtin_bit_cast(bf16x8, b0), Bx1 = __builtin_bit_cast(bf16x8, b1);
    u32x4 vt = z4; if (fq < 2) vt = *(const LAS u32x4*)(rc + RC_VT + (16 * w + fr) * 32 + 16 * fq);
    const bf16x8 Vf = __builtin_bit_cast(bf16x8, vt);
    f32x4 Y = (f32x4){0.f, 0.f, 0.f, 0.f};
    Y = __builtin_amdgcn_mfma_f32_16x16x32_bf16(*(const LAS bf16x8*)(rc + RC_Q1 + (0 * 64 + lane) * 16), Bx0, Y, 0, 0, 0);
    Y = __builtin_amdgcn_mfma_f32_16x16x32_bf16(*(const LAS bf16x8*)(rc + RC_Q1 + (1 * 64 + lane) * 16), Bx1, Y, 0, 0, 0);
    Y = __builtin_amdgcn_mfma_f32_16x16x32_bf16(*(const LAS bf16x8*)(rc + RC_Q2 + lane * 16), Vf, Y, 0, 0, 0);
#pragma unroll
    for (int j = 0; j < 4; ++j) { const f32x4 gm = *(const LAS f32x4*)(rc + RC_GAM + (16 * j + 4 * fq) * 4);
        f32x4 C = X[j] * gm;
        C = __builtin_amdgcn_mfma_f32_16x16x32_bf16(*(const LAS bf16x8*)(rc + RC_G1 + ((j * 2 + 0) * 64 + lane) * 16), Bx0, C, 0, 0, 0);
        C = __builtin_amdgcn_mfma_f32_16x16x32_bf16(*(const LAS bf16x8*)(rc + RC_G1 + ((j * 2 + 1) * 64 + lane) * 16), Bx1, C, 0, 0, 0);
        u32x4 g2 = z4; if (fq < 2) g2 = *(const LAS u32x4*)(rc + RC_G2 + (16 * j + fr) * 32 + 16 * fq);
        C = __builtin_amdgcn_mfma_f32_16x16x32_bf16(__builtin_bit_cast(bf16x8, g2), Vf, C, 0, 0, 0);
        X[j] = C; }
#pragma unroll
    for (int e = 0; e < 4; ++e) yo[(size_t)(4 * fq + e) * 512] = Y[e];
}
__device__ __forceinline__ void rw_scan2(Frame& F, int task) {
    const int tid = F.tid, lane = F.lane, w = F.wave, fr = lane & 15, fq = lane >> 4;
    const unsigned char* recs = F.ws + WS_RWC + (size_t)task * 512 * RC_BYTES;
    constexpr int NP = SEQ / 32;
    if (w >= 4) {
        const int lt = tid - 256;
        const u32x4* src = (const u32x4*)recs + lt;
        u32x4 rg[4][8];
#pragma unroll
        for (int u = 0; u < 4; ++u)
#pragma unroll
            for (int i = 0; i < 8; ++i) rg[u][i] = src[(size_t)u * 2048 + i * 256];
#pragma unroll 1
        for (int g4 = 0; g4 < NP / 4; ++g4) {
#pragma unroll
            for (int u = 0; u < 4; ++u) { const int g = 4 * g4 + u;
                LAS u32x4* dst = (LAS u32x4*)(F.lds + ((2 * g) & 7) * RC_BYTES) + lt;
#pragma unroll
                for (int i = 0; i < 8; ++i) dst[i * 256] = rg[u][i];
                if (g + 4 < NP) {
#pragma unroll
                    for (int i = 0; i < 8; ++i) rg[u][i] = src[(size_t)(g + 4) * 2048 + i * 256]; }
                __syncthreads(); }
        }
        __syncthreads();
    } else {
        const int b = task >> 3, h = task & 7;
        f32x4 X[4];
#pragma unroll
        for (int j = 0; j < 4; ++j) X[j] = (f32x4){0.f, 0.f, 0.f, 0.f};
        float* yo = WSP(float, WS_RW_Y) + ((size_t)b * SEQ) * 512 + 64 * h + 16 * w + fr;
        __syncthreads();
#pragma unroll 1
        for (int g = 0; g < NP; ++g) {
            rw_chunk_step(F.lds + ((2 * g) & 7) * RC_BYTES, X, yo + (size_t)(2 * g) * 16 * 512, w, lane, fr, fq);
            rw_chunk_step(F.lds + ((2 * g + 1) & 7) * RC_BYTES, X, yo + (size_t)(2 * g + 1) * 16 * 512, w, lane, fr, fq);
            __syncthreads();
        }
    }
}
__device__ __forceinline__ void rw_post(Frame& F, int l, int gw, int ngw) {
    const int lane = F.lane;
    const f32x4 g0 = *(const f32x4*)(INP(34) + l * 512 + 8 * lane), g1 = *(const f32x4*)(INP(34) + l * 512 + 8 * lane + 4);
    const f32x4 b0 = *(const f32x4*)(INP(35) + l * 512 + 8 * lane), b1 = *(const f32x4*)(INP(35) + l * 512 + 8 * lane + 4);
    for (int m = gw; m < MTOK; m += ngw) { const size_t o = (size_t)m * 512 + 8 * lane;
        const f32x4 ya = *(const f32x4*)(WSP(const float, WS_RW_Y) + o), yb = *(const f32x4*)(WSP(const float, WS_RW_Y) + o + 4);
        float y[8] = {ya.x, ya.y, ya.z, ya.w, yb.x, yb.y, yb.z, yb.w};
        float s = 0.f;
#pragma unroll
        for (int j = 0; j < 8; ++j) s += y[j];
        s += __shfl_xor(s, 1); s += __shfl_xor(s, 2); s += __shfl_xor(s, 4); const float mean = s * (1.f / 64.f);
        float qv = 0.f;
#pragma unroll
        for (int j = 0; j < 8; ++j) { y[j] -= mean; qv += y[j] * y[j]; }
        qv += __shfl_xor(qv, 1); qv += __shfl_xor(qv, 2); qv += __shfl_xor(qv, 4); const float rs = 1.0f / sqrtf(qv * (1.f / 64.f) + 64e-5f);
        const u32x4 vr = *(const u32x4*)(WSP(const bf16, WS_RW_V) + o), gr_ = *(const u32x4*)(WSP(const bf16, WS_RW_G) + o);
        const float bon = WSP(const float, WS_RW_BON)[(size_t)m * 8 + (lane >> 3)];
        const float vv[8] = {lo16(vr.x), hi16(vr.x), lo16(vr.y), hi16(vr.y), lo16(vr.z), hi16(vr.z), lo16(vr.w), hi16(vr.w)};
        const float gg[8] = {lo16(gr_.x), hi16(gr_.x), lo16(gr_.y), hi16(gr_.y), lo16(gr_.z), hi16(gr_.z), lo16(gr_.w), hi16(gr_.w)};
        const float lg[8] = {g0.x, g0.y, g0.z, g0.w, g1.x, g1.y, g1.z, g1.w}, lb[8] = {b0.x, b0.y, b0.z, b0.w, b1.x, b1.y, b1.z, b1.w};
        float ov[8];
#pragma unroll
        for (int j = 0; j < 8; ++j) ov[j] = (y[j] * rs * lg[j] + lb[j] + bon * vv[j]) * gg[j];
        u32x4 w; w.x = pk2(ov[0], ov[1]); w.y = pk2(ov[2], ov[3]); w.z = pk2(ov[4], ov[5]); w.w = pk2(ov[6], ov[7]);
        *(u32x4*)(WSP(bf16, WS_YK) + (size_t)3 * MTOK * 512 + o) = w; }
}

#ifndef GATE_NA
#define GATE_NA 17
#endif
#ifndef PHMASK
#define PHMASK 0xFFFFFFFFu
#endif
#define PH(n) (((PHMASK) >> (n)) & 1u)
#ifndef REPMASK
#define REPMASK 0u
#endif
#define NREP(n) ((((REPMASK) >> (n)) & 1u) ? 2 : 1)
#ifndef TPSMASK
#define TPSMASK 0u
#endif
#define TPS_B(n) unsigned long long tps_##n = 0ull; if (((TPSMASK) >> (n)) & 1u) tps_##n = __builtin_amdgcn_s_memrealtime()
#define TPS_E(n) do { if (((TPSMASK) >> (n)) & 1u) { const unsigned long long t1_ = __builtin_amdgcn_s_memrealtime(); const unsigned long long d_ = t1_ - tps_##n; while (__builtin_amdgcn_s_memrealtime() - t1_ < d_) __builtin_amdgcn_s_sleep(8); } } while (0)
#ifndef TPMASK
#define TPMASK 0u
#endif
#define TP(n) do { if (((TPMASK) >> (n)) & 1u) { const unsigned long long t1_ = __builtin_amdgcn_s_memrealtime(); const unsigned long long d_ = t1_ - tp0; while (__builtin_amdgcn_s_memrealtime() - t1_ < d_) __builtin_amdgcn_s_sleep(8); tp0 = __builtin_amdgcn_s_memrealtime(); } else if (TPMASK) tp0 = __builtin_amdgcn_s_memrealtime(); } while (0)
template <class T> __device__ __forceinline__ T* launder_ptr(T* p) { const unsigned long long w = (unsigned long long)p; unsigned lo = __builtin_amdgcn_readfirstlane((unsigned)w), hi = __builtin_amdgcn_readfirstlane((unsigned)(w >> 32));
    asm volatile("" : "+s"(lo), "+s"(hi)); return (T*)(GAS T*)(((unsigned long long)hi << 32) | lo); }
#define PHASE_BEGIN() do { F.ws = launder_ptr(F.ws); F.out = launder_ptr(F.out); { unsigned la_ = __builtin_amdgcn_readfirstlane((unsigned)(size_t)F.lds); int bk_ = __builtin_amdgcn_readfirstlane(F.blk); asm volatile("" : "+s"(la_), "+s"(bk_)); F.lds = (LAS unsigned char*)(size_t)la_; F.blk = bk_; } { int wv_ = __builtin_amdgcn_readfirstlane(F.wave); asm volatile("" : "+s"(wv_)); F.wave = wv_; } F.tid = F.wave * 64 + (int)__builtin_amdgcn_mbcnt_hi(~0u, __builtin_amdgcn_mbcnt_lo(~0u, 0u)); asm volatile("" : "+v"(F.tid)); F.lane = F.tid & 63; } while (0)
__global__ void __launch_bounds__(NTHR, 2) hybrid_fwd(Args args) {
    extern __shared__ __attribute__((aligned(16))) unsigned char lds_raw[];
    Frame F;
    F.lds = (LAS unsigned char*)lds_raw; F.out = args.out; F.ws = args.ws;
    F.tid = threadIdx.x; F.lane = F.tid & 63; F.wave = __builtin_amdgcn_readfirstlane(F.tid >> 6); F.blk = blockIdx.x; F.G = gridDim.x;
    volatile LAS unsigned* MISC = (volatile LAS unsigned*)(F.lds + LDS_MISC);
    if (F.tid < 64) MISC[F.tid] = 0u;
    if (F.tid < 45) { const unsigned long long p = ((const __attribute__((address_space(4))) unsigned long long*)__builtin_amdgcn_kernarg_segment_ptr())[F.tid]; MISC[64 + 2 * F.tid] = (unsigned)p; MISC[64 + 2 * F.tid + 1] = (unsigned)(p >> 32); }
    __syncthreads();
    XcdBarrier bar = xcd_barrier_post((unsigned*)(F.ws + WS_CTL) + CW_BAR, MISC + 8);
#define gw (F.blk * NWAVES + F.wave)
#define NGW (F.G * NWAVES)
#define glds (F.lds)

    unsigned long long tp0 = TPMASK ? __builtin_amdgcn_s_memrealtime() : 0ull;
#pragma unroll 1
    for (int l = 0; l < DEPTH; ++l) {
        const float* xin = (l == 0) ? INP(0) : F.out;
        PHASE_BEGIN();
        for (int rep_ = 0; rep_ < NREP(0); ++rep_) if (PH(0)) { convert_weights(F, l);
            for (int nb = F.blk; nb < NGATE / 32 + 2 * (FF / 32); nb += F.G) {
                const int seg = nb < NGATE / 32 ? 0 : (nb < NGATE / 32 + FF / 32 ? 1 : 2);
                const float* Wp = seg == 0 ? INP(2) + (size_t)l * DM * INC : (seg == 1 ? INP(39) : INP(40)) + (size_t)l * DM * FF;
                signed char* W8p = seg == 0 ? WSP(signed char, WS_WIN) + (size_t)MIXP * DM * 2 : (seg == 1 ? WSP(signed char, WS_WFG) : WSP(signed char, WS_WFU));
                convert_cols_i8(F, Wp, seg == 0 ? INC : FF, seg == 0 ? MIXC : 0, nb - (seg == 0 ? 0 : (seg == 1 ? NGATE / 32 : NGATE / 32 + FF / 32)), W8p, WSP(float, WS_SB) + 16384 * seg, 0); }
            { const float* cw = INP(41) + (size_t)l * 3 * FF; const float* cb = INP(42) + (size_t)l * FF;
              for (int c = F.blk * 512 + F.tid; c < FF; c += F.G * 512) { WSP(unsigned, WS_SB)[65536 + c] = pk2(cw[c], cw[FF + c]); WSP(unsigned, WS_SB)[65536 + 8192 + c] = pk2(cw[2 * FF + c], cb[c]); } } }
        PHASE_BEGIN();
        for (int rep_ = 0; rep_ < NREP(1); ++rep_) if (PH(1)) rmsnorm_rows(F, l == 0 ? INP(0) : nullptr, (const bf16*)F.out, INP(1) + (size_t)l * DM, WSP(bf16, WS_H), nullptr, WSP(unsigned, WS_A8), WSP(float, WS_SA));
        xcd_barrier(bar); TP(0);
        PHASE_BEGIN();
        for (int rep_ = 0; rep_ < NREP(2); ++rep_) if (PH(2)) { pg8::Gemm g{WSP(const bf16, WS_H), WSP(const bf16, WS_WIN), MTOK, MIXP, DM}; pg8::StaticOrder S; S.init(MTOK, MIXP, F.G, F.blk);
          pg8::EpiStore<0> E{WSP(bf16, WS_PROJ), MIXP}; pg8::gemm_phase(glds, g, S, E, F.tid); }
        PHASE_BEGIN();
        if (PH(2) && F.blk >= 128) {
          pg8::Gemm g{WSP(const bf16, WS_A8), (const bf16*)(WSP(const signed char, WS_WIN) + (size_t)MIXP * DM * 2), MTOK, NGATE, DM / 2};
          pg8::SplitOrder S; S.init(MTOK, NGATE, 128, F.blk - 128, 4096 - 256, 2);
          pg8::EpiGateU8 E{WSP(unsigned char, WS_GATES), WSP(const float, WS_SA), WSP(const float, WS_SB)}; pg8::gemm_phase(glds, g, S, E, F.tid); }
        xcd_barrier(bar); TP(1);
        PHASE_BEGIN();
        TPS_B(3); for (int rep_ = 0; rep_ < NREP(3); ++rep_) if (PH(3)) for (int t = F.blk; t < MTOK / 128; t += F.G) rw_pre(F, l, t); TPS_E(3);
        PHASE_BEGIN();
        TPS_B(4); for (int rep_ = 0; rep_ < NREP(4); ++rep_) if (PH(4)) for (int t = F.blk; t < 1024; t += F.G) m2_pass1(F, l, t); TPS_E(4);
        PHASE_BEGIN();
        TPS_B(5); for (int rep_ = 0; rep_ < NREP(5); ++rep_) if (PH(5)) for (int t = gw; t < 8192; t += NGW) s5_task<false>(F, l, t); TPS_E(5);
        PHASE_BEGIN();
        TPS_B(6); for (int rep_ = 0; rep_ < NREP(6); ++rep_) if (PH(6)) for (int t = gw; t < 2048; t += NGW) lru_task<false>(F, l, t); TPS_E(6);
        xcd_barrier(bar); TP(2);
        PHASE_BEGIN();
        for (int rep_ = 0; rep_ < NREP(7); ++rep_) if (PH(7)) m2_carry(F);
        PHASE_BEGIN();
        for (int rep_ = 0; rep_ < NREP(8); ++rep_) if (PH(8)) for (int t = gw; t < 128; t += NGW) s5_carry(F, l, t);
        PHASE_BEGIN();
        for (int rep_ = 0; rep_ < NREP(9); ++rep_) if (PH(9)) for (int t = NGW - 1 - gw; t < 32; t += NGW) lru_carry(F, t);
        xcd_barrier(bar); TP(3);
        PHASE_BEGIN();
        TPS_B(10); for (int rep_ = 0; rep_ < NREP(10); ++rep_) if (PH(10)) for (int t = F.blk; t < 1024; t += F.G) m2_pass2(F, l, t); TPS_E(10);
        PHASE_BEGIN();
        TPS_B(11); for (int rep_ = 0; rep_ < NREP(11); ++rep_) if (PH(11)) for (int t = gw; t < 8192; t += NGW) s5_task<true>(F, l, t); TPS_E(11);
        PHASE_BEGIN();
        TPS_B(12); for (int rep_ = 0; rep_ < NREP(12); ++rep_) if (PH(12)) for (int t = gw; t < 2048; t += NGW) lru_task<true>(F, l, t); TPS_E(12);
        xcd_barrier(bar); TP(4);
        PHASE_BEGIN();
        for (int rep_ = 0; rep_ < NREP(14); ++rep_) if (PH(14)) {
            { pg8::Gemm g{WSP(const bf16, WS_S5Z), WSP(const bf16, WS_WGLU), MTOK, 512, 512}; pg8::StaticOrder S; S.init(MTOK, 512, F.G, F.blk);
              pg8::EpiGlu E{WSP(const bf16, WS_S5Z), WSP(bf16, WS_YK)}; pg8::gemm_phase(glds, g, S, E, F.tid); }
            m2_norm(F, l, gw, NGW);
        }
        PHASE_BEGIN();
        TPS_B(24); for (int rep_ = 0; rep_ < NREP(24); ++rep_) if (PH(24)) for (int t = gw; t < NB * 8 * 512; t += NGW) rw_chunk_prep(F, t); TPS_E(24);
        xcd_barrier(bar); TP(5);
        PHASE_BEGIN();
        if (F.blk < 32) { if (PH(13)) rw_scan2(F, F.blk); }
        PHASE_BEGIN();
        if (PH(16)) { pg8::Gemm g{WSP(const bf16, WS_A8), (const bf16*)(WSP(const signed char, WS_WIN) + (size_t)MIXP * DM * 2), MTOK, NGATE, DM / 2};
          pg8::SplitOrder S; if (F.blk >= 32) S.init(MTOK, NGATE, 224, F.blk - 32, 0, GATE_NA); else S.init(MTOK, NGATE, 32, F.blk, 224 * GATE_NA, (4096 - 256 - 224 * GATE_NA) / 32);
          pg8::EpiGateU8 E{WSP(unsigned char, WS_GATES), WSP(const float, WS_SA), WSP(const float, WS_SB)}; pg8::gemm_phase(glds, g, S, E, F.tid); }
        xcd_barrier(bar); TP(6);
        PHASE_BEGIN();
        for (int rep_ = 0; rep_ < NREP(15); ++rep_) if (PH(15)) rw_post(F, l, gw, NGW);
        xcd_barrier(bar); TP(7);
        PHASE_BEGIN();
        for (int rep_ = 0; rep_ < NREP(17); ++rep_) if (PH(17)) { pg8::Gemm g{WSP(const bf16, WS_YK), WSP(const bf16, WS_WPK), 4 * MTOK, 4 * DM, 512}; pg8::OrderYK S{F.G, F.blk};
          pg8::EpiGateAcc E{WSP(const unsigned char, WS_GATES), WSP(bf16, WS_MERGED)}; pg8::gemm_phase(glds, g, S, E, F.tid); }
        xcd_barrier(bar); TP(8);
        PHASE_BEGIN();
        for (int rep_ = 0; rep_ < NREP(18); ++rep_) if (PH(18)) { pg8::Gemm g{WSP(const bf16, WS_MERGED), WSP(const bf16, WS_WOUT), MTOK, DM, DM}; pg8::StaticOrder S; S.init(MTOK, DM, F.G, F.blk);
          pg8::EpiAddX E{l == 0 ? INP(0) : nullptr, (const bf16*)F.out, (bf16*)F.out, DM}; pg8::gemm_phase(glds, g, S, E, F.tid); }
        xcd_barrier(bar); TP(9);
        PHASE_BEGIN();
        for (int rep_ = 0; rep_ < NREP(19); ++rep_) if (PH(19)) rmsnorm_rows(F, nullptr, (const bf16*)F.out, INP(38) + (size_t)l * DM, nullptr, nullptr, WSP(unsigned, WS_A8), WSP(float, WS_SA));
        xcd_barrier(bar); TP(10);
        PHASE_BEGIN();
        for (int rep_ = 0; rep_ < NREP(20); ++rep_) if (PH(20)) { pg8::Gemm g{WSP(const bf16, WS_A8), WSP(const bf16, WS_WFG), MTOK, FF, DM / 2}; pg8::StaticOrder S; S.init(MTOK, FF, F.G, F.blk);
          pg8::EpiStoreI8<0> E{WSP(bf16, WS_FG), FF, WSP(const float, WS_SA), WSP(const float, WS_SB) + 16384}; pg8::gemm_phase(glds, g, S, E, F.tid); }
        xcd_barrier(bar); TP(11);
        PHASE_BEGIN();
        for (int rep_ = 0; rep_ < NREP(21); ++rep_) if (PH(21)) { pg8::Gemm g{WSP(const bf16, WS_A8), WSP(const bf16, WS_WFU), MTOK, FF, DM / 2}; pg8::StaticOrder S; S.init(MTOK, FF, F.G, F.blk);
          pg8::EpiFfnUp<true> E{WSP(const bf16, WS_FG), WSP(bf16, WS_HID), WSP(const unsigned, WS_SB) + 65536, WSP(const unsigned, WS_SB) + 65536 + 8192, WSP(const float, WS_SA), WSP(const float, WS_SB) + 32768}; pg8::gemm_phase(glds, g, S, E, F.tid); }
        xcd_barrier(bar); TP(12);
        PHASE_BEGIN();
        for (int rep_ = 0; rep_ < NREP(22); ++rep_) if (PH(22)) { pg8::Gemm g{WSP(const bf16, WS_HID), WSP(const bf16, WS_WFD), MTOK, DM, FF}; pg8::StaticOrder S; S.init(MTOK, DM, F.G, F.blk);
          pg8::EpiAddX E{nullptr, (const bf16*)F.out, l == DEPTH - 1 ? WSP(bf16, WS_H) : (bf16*)F.out, DM}; pg8::gemm_phase(glds, g, S, E, F.tid); }
        xcd_barrier(bar); TP(13);
    }
    PHASE_BEGIN();
    for (int rep_ = 0; rep_ < NREP(23); ++rep_) if (PH(23)) rmsnorm_rows(F, nullptr, WSP(const bf16, WS_H), INP(44), nullptr, F.out);
}

extern "C" void kernel_launch(void* const* d_in, const int* in_sizes, int n_in, void* d_out, int out_size, void* d_ws, size_t ws_size, hipStream_t stream) {
    static int grid = 0;
    if (grid == 0) {
        if (n_in != 45 || in_sizes[0] != MTOK * DM || out_size != MTOK * DM || ws_size < WS_END) {
            fprintf(stderr, "kernel_launch: unexpected shapes/workspace (n_in %d, in0 %d, out %d, ws %zu, need %zu); nothing launched\n", n_in, n_in > 0 ? in_sizes[0] : -1, out_size, ws_size, (size_t)WS_END); grid = -1; return; }
        int dev = 0, cus = 0, per_cu = 0;
        if (hipGetDevice(&dev) != hipSuccess || hipDeviceGetAttribute(&cus, hipDeviceAttributeMultiprocessorCount, dev) != hipSuccess) { grid = -1; return; }
        if (hipFuncSetAttribute((const void*)hybrid_fwd, hipFuncAttributeMaxDynamicSharedMemorySize, LDS_BYTES) != hipSuccess) { fprintf(stderr, "kernel_launch: hipFuncSetAttribute failed\n"); grid = -1; return; }
        if (hipOccupancyMaxActiveBlocksPerMultiprocessor(&per_cu, (const void*)hybrid_fwd, NTHR, LDS_BYTES) != hipSuccess || per_cu < 1) { fprintf(stderr, "kernel_launch: occupancy query says %d\n", per_cu); }
        (void)hipGetLastError();
        grid = cus;
        if (grid != 256) fprintf(stderr, "kernel_launch: note: %d CUs\n", grid);
    }
    if (grid < 0) return;
    if (hipMemsetAsync((char*)d_ws + WS_CTL, 0, CTL_BYTES, stream) != hipSuccess) return;
    Args a{};
    for (int i = 0; i < 45; ++i) a.in[i] = (const float*)d_in[i];
    a.out = (float*)d_out; a.ws = (unsigned char*)d_ws;
    hipLaunchKernelGGL(hybrid_fwd, dim3(grid), dim3(NTHR), LDS_BYTES, stream, a);
}
```

```cpp
#include <hip/hip_runtime.h>
#include <cstdio>
#include <cstdint>

#define LAS __attribute__((address_space(3)))
typedef unsigned short bf16;
typedef short bf16x8 __attribute__((ext_vector_type(8)));
typedef float f32x4 __attribute__((ext_vector_type(4)));
typedef float f32x2 __attribute__((ext_vector_type(2)));
typedef unsigned u32x4 __attribute__((ext_vector_type(4)));
typedef unsigned u32x2 __attribute__((ext_vector_type(2)));
typedef __bf16 bf16v2 __attribute__((ext_vector_type(2)));
typedef int i32x4 __attribute__((ext_vector_type(4)));

constexpr int NB = 4, SEQ = 8192, DM = 2048, MTOK = NB * SEQ, DEPTH = 4;
constexpr int MIXC = 4776, MIXP = 4864, INC = 12968, FF = 6144, NGATE = 8192;
constexpr int RWC = 1696;
constexpr int PC_S5U = 0, PC_LRX = 512, PC_LRG = 1024, PC_M2Z = 1536, PC_XBC = 2048, PC_DT = 3072, PC_RW = 3080;

constexpr size_t MiB = 1u << 20;
constexpr size_t WS_CTL = 0, CTL_BYTES = 1 * MiB;
constexpr size_t WS_WIN = 1 * MiB, WS_WPK = 52 * MiB, WS_WOUT = 60 * MiB, WS_WFG = 68 * MiB, WS_WFU = 92 * MiB, WS_WFD = 116 * MiB, WS_WGLU = 140 * MiB;
constexpr size_t WS_SA = 141 * MiB, WS_SB = 142 * MiB;
constexpr size_t WS_A8 = 1538 * MiB;
constexpr size_t WS_H = 144 * MiB, WS_YK = 272 * MiB, WS_PROJ = 400 * MiB, WS_MERGED = 400 * MiB, WS_GATES = 900 * MiB;
constexpr size_t WS_RW_R = 1216 * MiB, WS_RW_K = 1248 * MiB, WS_RW_V = 1280 * MiB, WS_RW_A = 1312 * MiB, WS_RW_B = 1344 * MiB, WS_RW_G = 1376 * MiB,
                 WS_RW_DEC = 1408 * MiB, WS_RW_Y = 1472 * MiB, WS_RW_BON = 1536 * MiB, WS_END = 1602 * MiB;
constexpr size_t WS_S5Z = 704 * MiB, WS_S5E = 736 * MiB, WS_S5I = 740 * MiB, WS_LRE = 744 * MiB, WS_LRA = 745 * MiB, WS_LRI = 746 * MiB;
constexpr size_t WS_M2S = 752 * MiB, WS_M2D = 816 * MiB, WS_M2Y = 820 * MiB;
constexpr size_t WS_FG = 400 * MiB, WS_HID = 784 * MiB;
constexpr int CW_BAR = 4096;

__device__ __forceinline__ float bf2f(bf16 b) { return __uint_as_float(((unsigned)b) << 16); }
__device__ __forceinline__ unsigned f2bf(float f) { const __bf16 b = (__bf16)f; return (unsigned)__builtin_bit_cast(unsigned short, b); }
__device__ __forceinline__ unsigned pk2(float lo, float hi) { const f32x2 v = {lo, hi}; const bf16v2 b = __builtin_convertvector(v, bf16v2); return __builtin_bit_cast(unsigned, b); }
__device__ __forceinline__ float lo16(unsigned w) { return __uint_as_float(w << 16); }
__device__ __forceinline__ float hi16(unsigned w) { return __uint_as_float(w & 0xffff0000u); }
__device__ __forceinline__ float rcpf_(float x) { return __builtin_amdgcn_rcpf(x); }
__device__ __forceinline__ float sigmoidf_(float x) { return rcpf_(1.0f + __expf(-x)); }
__device__ __forceinline__ float siluf_(float x) { return x * rcpf_(1.0f + __expf(-x)); }
__device__ __forceinline__ float geluf_(float x) { const float u = 0.7978845608028654f * (x + 0.044715f * x * x * x); return x * rcpf_(1.0f + __expf(-2.0f * u)); }
__device__ __forceinline__ float softplusf_(float x) { return fmaxf(x, 0.f) + __logf(1.0f + __expf(-fabsf(x))); }
__device__ __forceinline__ float row16_sum(float v) {
    v += __int_as_float(__builtin_amdgcn_update_dpp(0, __float_as_int(v), 0x128, 0xf, 0xf, true));
    v += __int_as_float(__builtin_amdgcn_update_dpp(0, __float_as_int(v), 0x124, 0xf, 0xf, true));
    v += __int_as_float(__builtin_amdgcn_update_dpp(0, __float_as_int(v), 0x122, 0xf, 0xf, true));
    v += __int_as_float(__builtin_amdgcn_update_dpp(0, __float_as_int(v), 0x121, 0xf, 0xf, true));
    return v;
}
__device__ __forceinline__ float wave_sum(float v) {
    v = row16_sum(v);
    const float a = __int_as_float(__builtin_amdgcn_readlane(__float_as_int(v), 0)), b = __int_as_float(__builtin_amdgcn_readlane(__float_as_int(v), 16));
    const float c = __int_as_float(__builtin_amdgcn_readlane(__float_as_int(v), 32)), d = __int_as_float(__builtin_amdgcn_readlane(__float_as_int(v), 48));
    return (a + b) + (c + d);
}
__device__ __forceinline__ float wave_max(float v) {
    v = fmaxf(v, __int_as_float(__builtin_amdgcn_update_dpp(0, __float_as_int(v), 0x128, 0xf, 0xf, true)));
    v = fmaxf(v, __int_as_float(__builtin_amdgcn_update_dpp(0, __float_as_int(v), 0x124, 0xf, 0xf, true)));
    v = fmaxf(v, __int_as_float(__builtin_amdgcn_update_dpp(0, __float_as_int(v), 0x122, 0xf, 0xf, true)));
    v = fmaxf(v, __int_as_float(__builtin_amdgcn_update_dpp(0, __float_as_int(v), 0x121, 0xf, 0xf, true)));
    const float a = __int_as_float(__builtin_amdgcn_readlane(__float_as_int(v), 0)), b = __int_as_float(__builtin_amdgcn_readlane(__float_as_int(v), 16));
    const float c = __int_as_float(__builtin_amdgcn_readlane(__float_as_int(v), 32)), d = __int_as_float(__builtin_amdgcn_readlane(__float_as_int(v), 48));
    return fmaxf(fmaxf(a, b), fmaxf(c, d));
}
__device__ __forceinline__ unsigned q8x4(float a, float b, float c, float d, float inv) {
    const int q0 = (int)rintf(a * inv), q1 = (int)rintf(b * inv), q2 = (int)rintf(c * inv), q3 = (int)rintf(d * inv);
    return (unsigned)(q0 & 0xff) | ((unsigned)(q1 & 0xff) << 8) | ((unsigned)(q2 & 0xff) << 16) | ((unsigned)q3 << 24);
}
__device__ __forceinline__ float rdlane(float v, int l) { return __int_as_float(__builtin_amdgcn_readlane(__float_as_int(v), l)); }

namespace pg8 {
constexpr int BM = 256, BK = 64, HALF = 128, HTB = HALF * BK * 2, STAGE_BYTES = 8 * HTB, NXCD = 8, WGM = 4;
__host__ __device__ __forceinline__ int lds_byte(int r, int c) { const int st = (r >> 4) * 2 + (c >> 5), rr = r & 15, cc = c & 31, ob = rr * 64 + cc * 2; return st * 1024 + (ob ^ (((ob >> 9) & 1) << 5)); }
__host__ __device__ __forceinline__ void stage_rc(int b, int& R, int& C) { const int st = b / 1024, sb = b % 1024, swz = sb ^ (((sb >> 9) & 1) << 5); R = (st >> 1) * 16 + swz / 64; C = (st & 1) * 32 + (swz % 64) / 2; }
__host__ __device__ __forceinline__ int perm32(int rho) { const int n = rho >> 4, i = rho & 15; return 8 * (i >> 2) + 4 * n + (i & 3); }
struct Unit { int pm, pn; };
struct Gemm { const bf16* A; const bf16* Bt; int M, N, K; };
struct StaticOrder {
    int nM, nN, nwg, G, c;
    __device__ void init(int M, int N, int G_, int c_) { nM = M / BM; nN = N / BM; nwg = nM * nN; G = G_; c = c_; }
    __device__ bool next(int i, Unit& u) const {
        const long L = (long)i * G + c; if (L >= nwg || c < 0) return false;
        int wgid = (int)L; { const int q = nwg / NXCD, r = nwg % NXCD, xcd = wgid % NXCD, off = wgid / NXCD; wgid = (xcd < r ? xcd * (q + 1) : r * (q + 1) + (xcd - r) * q) + off; }
        const int nig = WGM * nN, gid = wgid / nig, fm = gid * WGM, gsz = (nM - fm) < WGM ? (nM - fm) : WGM;
        u.pm = fm + ((wgid % nig) % gsz); u.pn = (wgid % nig) / gsz; return true;
    }
    __device__ __forceinline__ void a_ready(const Unit&) const {}
    __device__ __forceinline__ void done(const Unit&) const {}
};
struct SplitOrder {
    int nM, nN, nwg, G, c, base, n;
    __device__ void init(int M, int N, int G_, int c_, int base_, int n_) { nM = M / BM; nN = N / BM; nwg = nM * nN; G = G_; c = c_; base = base_; n = n_; }
    __device__ bool next(int i, Unit& u) const {
        if (i >= n) return false; const long L = (long)base + (long)i * G + c; if (L >= nwg) return false;
        int wgid = (int)L; { const int q = nwg / NXCD, r = nwg % NXCD, xcd = wgid % NXCD, off = wgid / NXCD; wgid = (xcd < r ? xcd * (q + 1) : r * (q + 1) + (xcd - r) * q) + off; }
        const int nig = WGM * nN, gid = wgid / nig, fm = gid * WGM, gsz = (nM - fm) < WGM ? (nM - fm) : WGM;
        u.pm = fm + ((wgid % nig) % gsz); u.pn = (wgid % nig) / gsz; return true;
    }
    __device__ __forceinline__ void a_ready(const Unit&) const {}
    __device__ __forceinline__ void done(const Unit&) const {}
};
struct OrderYK {
    int G, c;
    __device__ bool next(int i, Unit& u) const {
        const int k = i & 3; const long T = (long)(i >> 2) * G + c; if (T >= 1024) return false;
        int wgid = (int)T; { const int xcd = wgid % 8, off = wgid / 8; wgid = xcd * 128 + off; }
        const int gid = wgid / 32, fm = gid * 4; const int pm = fm + ((wgid % 32) % 4), pn = (wgid % 32) / 4;
        u.pm = k * 128 + pm; u.pn = k * 8 + pn; return true;
    }
    __device__ __forceinline__ void a_ready(const Unit&) const {}
    __device__ __forceinline__ void done(const Unit&) const {}
};
__device__ __forceinline__ unsigned cvt_pk_bf16(float lo, float hi) { return pk2(lo, hi); }

template <bool I8> struct AccOf { typedef f32x4 T; }; template <> struct AccOf<true> { typedef i32x4 T; };
template <int ACT> struct EpiStore {
    static constexpr bool I8 = false; static constexpr bool PERM = true;
    struct Pre {}; __device__ __forceinline__ void prefetch(Pre&, const Unit&, int, int, int, int) const {}
    bf16* O; int ldc;
    __device__ __forceinline__ void operator()(const f32x4 (&acc)[2][2][4][2], const Unit& u, int wr, int wc, int fr, int fq, const Pre&) const {
        const int row0 = u.pm * BM + wr * 64 + fr, col0 = u.pn * BM + wc * 32 + 8 * fq;
#pragma unroll
        for (int ai = 0; ai < 2; ++ai)
#pragma unroll
            for (int m = 0; m < 4; ++m) { bf16* rowp = O + (size_t)(row0 + ai * HALF + m * 16) * ldc + col0;
#pragma unroll
                for (int bj = 0; bj < 2; ++bj) { f32x4 v0 = acc[ai][bj][m][0], v1 = acc[ai][bj][m][1];
                    if (ACT == 1) {
#pragma unroll
                        for (int j = 0; j < 4; ++j) { v0[j] = sigmoidf_(v0[j]); v1[j] = sigmoidf_(v1[j]); } }
                    u32x4 w; w.x = cvt_pk_bf16(v0[0], v0[1]); w.y = cvt_pk_bf16(v0[2], v0[3]); w.z = cvt_pk_bf16(v1[0], v1[1]); w.w = cvt_pk_bf16(v1[2], v1[3]);
                    *(u32x4*)(rowp + bj * HALF) = w; } }
    }
};
template <int ACT> struct EpiStoreI8 {
    static constexpr bool I8 = true; static constexpr bool PERM = true;
    bf16* O; int ldc; const float* sa; const float* sb;
    struct Pre { float sav[4]; f32x4 s[2]; };
    __device__ __forceinline__ void prefetch(Pre& P, const Unit& u, int wr, int wc, int fr, int fq) const {
        const int row0 = u.pm * BM + wr * 64 + fr, col0 = u.pn * BM + wc * 32 + 8 * fq;
#pragma unroll
        for (int i = 0; i < 4; ++i) P.sav[i] = sa[row0 + i * 16];
        P.s[0] = *(const f32x4*)(sb + col0); P.s[1] = *(const f32x4*)(sb + col0 + 4);
    }
    __device__ __forceinline__ void operator()(const i32x4 (&acc)[2][2][4][2], const Unit& u, int wr, int wc, int fr, int fq, const Pre& P) const {
        const int row0 = u.pm * BM + wr * 64 + fr, col0 = u.pn * BM + wc * 32 + 8 * fq;
        float sav[8];
#pragma unroll
        for (int i = 0; i < 8; ++i) { sav[i] = i < 4 ? P.sav[i] : sa[row0 + HALF + (i & 3) * 16]; if (ACT == 1) sav[i] *= -1.4426950408889634f; }
        const f32x4 t0 = *(const f32x4*)(sb + col0 + HALF), t1 = *(const f32x4*)(sb + col0 + HALF + 4);
#pragma unroll
        for (int bj = 0; bj < 2; ++bj) { f32x4 s0 = P.s[0], s1 = P.s[1]; if (bj) { s0 = t0; s1 = t1; }
            const f32x2 sp[4] = {{s0[0], s0[1]}, {s0[2], s0[3]}, {s1[0], s1[1]}, {s1[2], s1[3]}};
#pragma unroll
            for (int ai = 0; ai < 2; ++ai)
#pragma unroll
                for (int m = 0; m < 4; ++m) { const float ra = sav[ai * 4 + m]; const f32x2 rav = {ra, ra}; const i32x4 a0 = acc[ai][bj][m][0], a1 = acc[ai][bj][m][1];
                    f32x2 x[4] = {{(float)a0[0], (float)a0[1]}, {(float)a0[2], (float)a0[3]}, {(float)a1[0], (float)a1[1]}, {(float)a1[2], (float)a1[3]}};
#pragma unroll
                    for (int p = 0; p < 4; ++p) { x[p] = x[p] * (sp[p] * rav);
                        if (ACT == 1) { f32x2 e = {__builtin_amdgcn_exp2f(x[p][0]), __builtin_amdgcn_exp2f(x[p][1])}; e = e + (f32x2){1.0f, 1.0f}; x[p][0] = rcpf_(e[0]); x[p][1] = rcpf_(e[1]); } }
                    u32x4 w; w.x = cvt_pk_bf16(x[0][0], x[0][1]); w.y = cvt_pk_bf16(x[1][0], x[1][1]); w.z = cvt_pk_bf16(x[2][0], x[2][1]); w.w = cvt_pk_bf16(x[3][0], x[3][1]);
                    *(u32x4*)(O + (size_t)(row0 + ai * HALF + m * 16) * ldc + col0 + bj * HALF) = w; } }
    }
};
struct EpiGateU8 {
    static constexpr bool I8 = true; static constexpr bool PERM = true;
    unsigned char* O; const float* sa; const float* sb;
    struct Pre { float sav[2]; f32x4 s[2]; };
    __device__ __forceinline__ void prefetch(Pre& P, const Unit& u, int wr, int wc, int fr, int fq) const {
        const int row0 = u.pm * BM + wr * 64 + fr, col0 = u.pn * BM + wc * 64 + 16 * fq;
#pragma unroll
        for (int i = 0; i < 2; ++i) P.sav[i] = sa[row0 + i * 16];
        P.s[0] = *(const f32x4*)(sb + col0); P.s[1] = *(const f32x4*)(sb + col0 + 4);
    }
    __device__ __forceinline__ void operator()(const i32x4 (&acc)[2][2][4][2], const Unit& u, int wr, int wc, int fr, int fq, const Pre& P) const {
        const int row0 = u.pm * BM + wr * 64 + fr, col0 = u.pn * BM + wc * 64 + 16 * fq;
        float sav[8];
#pragma unroll
        for (int i = 0; i < 8; ++i) sav[i] = (i < 2 ? P.sav[i] : sa[row0 + (i >> 2) * HALF + (i & 3) * 16]) * -1.4426950408889634f;
        const f32x4 t0 = *(const f32x4*)(sb + col0 + 8), t1 = *(const f32x4*)(sb + col0 + 12);
#pragma unroll
        for (int ai = 0; ai < 2; ++ai) { unsigned d[4][4];
#pragma unroll
            for (int bj = 0; bj < 2; ++bj) { f32x4 s0 = P.s[0], s1 = P.s[1]; if (bj) { s0 = t0; s1 = t1; }
                const f32x2 sp[4] = {{s0[0], s0[1]}, {s0[2], s0[3]}, {s1[0], s1[1]}, {s1[2], s1[3]}};
#pragma unroll
                for (int m = 0; m < 4; ++m) { const float ra = sav[ai * 4 + m]; const f32x2 rav = {ra, ra}; const i32x4 a0 = acc[ai][bj][m][0], a1 = acc[ai][bj][m][1];
                    f32x2 x[4] = {{(float)a0[0], (float)a0[1]}, {(float)a0[2], (float)a0[3]}, {(float)a1[0], (float)a1[1]}, {(float)a1[2], (float)a1[3]}};
                    unsigned tb[8];
#pragma unroll
                    for (int p = 0; p < 4; ++p) { x[p] = x[p] * (sp[p] * rav);
#pragma unroll
                        for (int h = 0; h < 2; ++h) { const float e = __builtin_amdgcn_exp2f(x[p][h]); const float r = rcpf_(e * (1.0f / 255.0f) + (1.0f / 255.0f));
                            tb[2 * p + h] = __float_as_uint(fmaxf(r, 1.0f) + 8388608.0f); } }
#pragma unroll
                    for (int n = 0; n < 2; ++n) { const unsigned w01 = __builtin_amdgcn_perm(tb[4 * n + 1], tb[4 * n], 0x0c0c0400u), w23 = __builtin_amdgcn_perm(tb[4 * n + 3], tb[4 * n + 2], 0x0c0c0400u);
                        d[m][2 * bj + n] = __builtin_amdgcn_perm(w23, w01, 0x05040100u); } }
                __builtin_amdgcn_sched_barrier(0); }
#pragma unroll
            for (int m = 0; m < 4; ++m) { u32x4 w; w.x = d[m][0]; w.y = d[m][1]; w.z = d[m][2]; w.w = d[m][3];
                *(u32x4*)(O + (size_t)(row0 + ai * HALF + m * 16) * NGATE + col0) = w; } }
    }
};
struct EpiAddX {
    static constexpr bool I8 = false; static constexpr bool PERM = true;
    struct Pre {}; __device__ __forceinline__ void prefetch(Pre&, const Unit&, int, int, int, int) const {}
    const float* basef; const bf16* baseb; bf16* out; int ldc;
    __device__ __forceinline__ void operator()(const f32x4 (&acc)[2][2][4][2], const Unit& u, int wr, int wc, int fr, int fq, const Pre&) const {
        const int row0 = u.pm * BM + wr * 64 + fr, col0 = u.pn * BM + wc * 32 + 8 * fq;
#pragma unroll
        for (int ai = 0; ai < 2; ++ai) { u32x4 w[4][2];
            if (!basef) {
#pragma unroll
                for (int m = 0; m < 4; ++m)
#pragma unroll
                    for (int bj = 0; bj < 2; ++bj) w[m][bj] = *(const u32x4*)(baseb + (size_t)(row0 + ai * HALF + m * 16) * ldc + col0 + bj * HALF); }
            asm volatile("" ::: "memory");
#pragma unroll
            for (int m = 0; m < 4; ++m)
#pragma unroll
                for (int bj = 0; bj < 2; ++bj) { const size_t p = (size_t)(row0 + ai * HALF + m * 16) * ldc + col0 + bj * HALF; f32x4 b0, b1;
                    if (basef) { b0 = *(const f32x4*)(basef + p); b1 = *(const f32x4*)(basef + p + 4); }
                    else { const u32x4 ww = w[m][bj]; b0 = (f32x4){lo16(ww.x), hi16(ww.x), lo16(ww.y), hi16(ww.y)}; b1 = (f32x4){lo16(ww.z), hi16(ww.z), lo16(ww.w), hi16(ww.w)}; }
                    b0 = b0 + acc[ai][bj][m][0]; b1 = b1 + acc[ai][bj][m][1];
                    u32x4 o; o.x = cvt_pk_bf16(b0[0], b0[1]); o.y = cvt_pk_bf16(b0[2], b0[3]); o.z = cvt_pk_bf16(b1[0], b1[1]); o.w = cvt_pk_bf16(b1[2], b1[3]);
                    *(u32x4*)(out + p) = o; }
            asm volatile("" ::: "memory"); }
    }
};
struct EpiGateAcc {
    static constexpr bool I8 = false; static constexpr bool PERM = true; static constexpr bool CHAIN = true;
    struct Pre {}; __device__ __forceinline__ void prefetch(Pre&, const Unit&, int, int, int, int) const {}
    const unsigned char* gates; bf16* merged;
    __device__ __forceinline__ bool is_last(const Unit& u) const { return (u.pn >> 3) == 3; }
    __device__ __forceinline__ void rescale(f32x4 (&acc)[2][2][4][2], const Unit& u, bool carry, int wr, int wc, int fr, int fq) const {
        const int k = u.pn >> 3, pn = u.pn & 7, pm = u.pm & 127;
        const int row0 = pm * BM + wr * 64 + fr, col0 = pn * BM + wc * 32 + 8 * fq;
#pragma unroll
        for (int ai = 0; ai < 2; ++ai) { u32x2 ga[4][2], gb[4][2];
#pragma unroll
            for (int m = 0; m < 4; ++m)
#pragma unroll
                for (int bj = 0; bj < 2; ++bj) { ga[m][bj] = (u32x2){0u, 0u}; gb[m][bj] = (u32x2){0x01010101u, 0x01010101u}; }
            if (carry) {
#pragma unroll
                for (int m = 0; m < 4; ++m)
#pragma unroll
                    for (int bj = 0; bj < 2; ++bj) { const unsigned char* gp = gates + (size_t)(row0 + ai * HALF + m * 16) * NGATE + k * DM + col0 + bj * HALF; ga[m][bj] = *(const u32x2*)gp; gb[m][bj] = *(const u32x2*)(gp + DM); } }
            asm volatile("" ::: "memory");
#pragma unroll
            for (int m = 0; m < 4; ++m)
#pragma unroll
                for (int bj = 0; bj < 2; ++bj) { const u32x2 a = ga[m][bj], b = gb[m][bj];
#pragma unroll
                    for (int n = 0; n < 2; ++n) { const unsigned aw = n ? a.y : a.x, bw = n ? b.y : b.x;
                        const f32x4 f = {(float)(aw & 0xffu) * rcpf_((float)(bw & 0xffu)), (float)((aw >> 8) & 0xffu) * rcpf_((float)((bw >> 8) & 0xffu)),
                                         (float)((aw >> 16) & 0xffu) * rcpf_((float)((bw >> 16) & 0xffu)), (float)(aw >> 24) * rcpf_((float)(bw >> 24))};
                        acc[ai][bj][m][n] = acc[ai][bj][m][n] * f; }
                    __builtin_amdgcn_sched_barrier(0); } }
    }
    __device__ __forceinline__ void operator()(const f32x4 (&acc)[2][2][4][2], const Unit& u, int wr, int wc, int fr, int fq, const Pre&) const {
        const int k = u.pn >> 3, pn = u.pn & 7, pm = u.pm & 127;
        const int row0 = pm * BM + wr * 64 + fr, col0 = pn * BM + wc * 32 + 8 * fq;
#pragma unroll
        for (int ai = 0; ai < 2; ++ai) { u32x2 g[4][2];
#pragma unroll
            for (int m = 0; m < 4; ++m)
#pragma unroll
                for (int bj = 0; bj < 2; ++bj) g[m][bj] = *(const u32x2*)(gates + (size_t)(row0 + ai * HALF + m * 16) * NGATE + k * DM + col0 + bj * HALF);
            asm volatile("" ::: "memory");
#pragma unroll
            for (int m = 0; m < 4; ++m)
#pragma unroll
                for (int bj = 0; bj < 2; ++bj) { const size_t r = (size_t)(row0 + ai * HALF + m * 16); const int c = col0 + bj * HALF;
                    const f32x4 v0 = acc[ai][bj][m][0], v1 = acc[ai][bj][m][1]; const u32x2 gg = g[m][bj];
                    float o[8];
                    o[0] = (float)(gg.x & 0xffu) * v0[0]; o[1] = (float)((gg.x >> 8) & 0xffu) * v0[1]; o[2] = (float)((gg.x >> 16) & 0xffu) * v0[2]; o[3] = (float)(gg.x >> 24) * v0[3];
                    o[4] = (float)(gg.y & 0xffu) * v1[0]; o[5] = (float)((gg.y >> 8) & 0xffu) * v1[1]; o[6] = (float)((gg.y >> 16) & 0xffu) * v1[2]; o[7] = (float)(gg.y >> 24) * v1[3];
                    u32x4 w; w.x = cvt_pk_bf16(o[0], o[1]); w.y = cvt_pk_bf16(o[2], o[3]); w.z = cvt_pk_bf16(o[4], o[5]); w.w = cvt_pk_bf16(o[6], o[7]);
                    *(u32x4*)(merged + r * DM + c) = w; } }
    }
};
struct EpiGlu {
    static constexpr bool I8 = false; static constexpr bool PERM = true;
    struct Pre {}; __device__ __forceinline__ void prefetch(Pre&, const Unit&, int, int, int, int) const {}
    const bf16* Z; bf16* O;
    __device__ __forceinline__ void operator()(const f32x4 (&acc)[2][2][4][2], const Unit& u, int wr, int wc, int fr, int fq, const Pre&) const {
        const int row0 = u.pm * BM + wr * 64 + fr, col0 = u.pn * BM + wc * 32 + 8 * fq;
#pragma unroll
        for (int ai = 0; ai < 2; ++ai)
#pragma unroll
            for (int m = 0; m < 4; ++m) { const size_t r = (size_t)(row0 + ai * HALF + m * 16);
#pragma unroll
                for (int bj = 0; bj < 2; ++bj) { const int c = col0 + bj * HALF;
                    const u32x4 z = *(const u32x4*)(Z + r * 512 + c);
                    const f32x4 v0 = acc[ai][bj][m][0], v1 = acc[ai][bj][m][1];
                    float o[8];
                    o[0] = lo16(z.x) * sigmoidf_(v0[0]); o[1] = hi16(z.x) * sigmoidf_(v0[1]); o[2] = lo16(z.y) * sigmoidf_(v0[2]); o[3] = hi16(z.y) * sigmoidf_(v0[3]);
                    o[4] = lo16(z.z) * sigmoidf_(v1[0]); o[5] = hi16(z.z) * sigmoidf_(v1[1]); o[6] = lo16(z.w) * sigmoidf_(v1[2]); o[7] = hi16(z.w) * sigmoidf_(v1[3]);
                    u32x4 w; w.x = cvt_pk_bf16(o[0], o[1]); w.y = cvt_pk_bf16(o[2], o[3]); w.z = cvt_pk_bf16(o[4], o[5]); w.w = cvt_pk_bf16(o[6], o[7]);
                    *(u32x4*)(O + r * 512 + c) = w; }
                asm volatile("" ::: "memory"); }
    }
};
template <bool I8_> struct EpiFfnUp {
    static constexpr bool I8 = I8_; static constexpr bool PERM = true;
    const bf16* G; bf16* O; const unsigned* w01; const unsigned* w2b; const float* sa; const float* sb;
    struct Pre {}; __device__ __forceinline__ void prefetch(Pre&, const Unit&, int, int, int, int) const {}
    __device__ __forceinline__ void operator()(const typename AccOf<I8_>::T (&acc)[2][2][4][2], const Unit& u, int wr, int wc, int fr, int fq, const Pre& P) const {
        const int rowb = u.pm * BM + wr * 64, col0 = u.pn * BM + wc * 32 + 8 * fq; const bool l15 = fr == 15, l14 = fr >= 14;
        u32x4 gb[2][3], wa[2], wb[2]; f32x4 sbv[2]; float sav[8];
#define FU_GLOAD(buf, k_) do { const int base_ = rowb + (((k_) >> 1) & 1) * HALF + 32 * ((k_) & 1), cc_ = col0 + ((k_) >> 2) * HALF; gb[buf][0] = (u32x4){0u, 0u, 0u, 0u}; \
            if (base_ & (SEQ - 1)) gb[buf][0] = *(const u32x4*)(G + (size_t)(base_ - 16 + fr) * FF + cc_); \
            gb[buf][1] = *(const u32x4*)(G + (size_t)(base_ + fr) * FF + cc_); gb[buf][2] = *(const u32x4*)(G + (size_t)(base_ + 16 + fr) * FF + cc_); } while (0)
#define FU_WLOAD(bj_) do { const int cc_ = col0 + (bj_) * HALF; wa[0] = *(const u32x4*)(w01 + cc_); wa[1] = *(const u32x4*)(w01 + cc_ + 4); wb[0] = *(const u32x4*)(w2b + cc_); wb[1] = *(const u32x4*)(w2b + cc_ + 4); \
            if constexpr (I8_) { sbv[0] = *(const f32x4*)(sb + cc_); sbv[1] = *(const f32x4*)(sb + cc_ + 4); } } while (0)
        FU_GLOAD(0, 0); FU_WLOAD(0);
        if constexpr (I8_) {
#pragma unroll
            for (int i = 0; i < 8; ++i) sav[i] = sa[rowb + fr + (i >> 2) * HALF + (i & 3) * 16]; }
#pragma unroll
        for (int k = 0; k < 8; ++k) { const int bj = k >> 2, ai = (k >> 1) & 1, mh = k & 1, cur = k & 1; const int c = col0 + bj * HALF;
            if (k < 7) FU_GLOAD(cur ^ 1, k + 1);
            asm volatile("" ::: "memory");
#pragma unroll
            for (int mm = 0; mm < 2; ++mm) { const int m = 2 * mh + mm; const size_t r = (size_t)(rowb + ai * HALF + m * 16 + fr); const u32x4 gp = gb[cur][mm], gc = gb[cur][mm + 1];
                f32x2 v[4];
#pragma unroll
                for (int p = 0; p < 4; ++p) v[p] = (f32x2){(float)acc[ai][bj][m][p >> 1][2 * (p & 1)], (float)acc[ai][bj][m][p >> 1][2 * (p & 1) + 1]};
                if constexpr (I8_) { const float ra = sav[ai * 4 + m]; const f32x2 rav = {ra, ra}; const f32x4 s0 = sbv[0], s1 = sbv[1];
                    v[0] = v[0] * ((f32x2){s0[0], s0[1]} * rav); v[1] = v[1] * ((f32x2){s0[2], s0[3]} * rav); v[2] = v[2] * ((f32x2){s1[0], s1[1]} * rav); v[3] = v[3] * ((f32x2){s1[2], s1[3]} * rav); }
                float o[8];
#pragma unroll
                for (int w = 0; w < 4; ++w) {
                    const unsigned x1w = (unsigned)__builtin_amdgcn_update_dpp(0, (int)(l15 ? gp[w] : gc[w]), 0x121, 0xf, 0xf, true);
                    const unsigned x0w = (unsigned)__builtin_amdgcn_update_dpp(0, (int)(l14 ? gp[w] : gc[w]), 0x122, 0xf, 0xf, true);
                    const unsigned wa_ = wa[w >> 1][2 * (w & 1)], wa1_ = wa[w >> 1][2 * (w & 1) + 1], wb_ = wb[w >> 1][2 * (w & 1)], wb1_ = wb[w >> 1][2 * (w & 1) + 1];
#pragma unroll
                    for (int h = 0; h < 2; ++h) { const int jj = 2 * w + h; const unsigned sel = h ? 0x07060302u : 0x05040100u;
                        const unsigned p01 = __builtin_amdgcn_perm(x1w, x0w, sel), p2 = __builtin_amdgcn_perm(0x3F803F80u, gc[w], sel);
                        float uu = __builtin_amdgcn_fdot2_f32_bf16(__builtin_bit_cast(bf16v2, p2), __builtin_bit_cast(bf16v2, h ? wb1_ : wb_), 0.0f, false);
                        uu = __builtin_amdgcn_fdot2_f32_bf16(__builtin_bit_cast(bf16v2, p01), __builtin_bit_cast(bf16v2, h ? wa1_ : wa_), uu, false);
                        const float z = uu * (uu * uu * -0.10294324f + -2.3022082f); const float e = __builtin_amdgcn_exp2f(z);
                        o[jj] = (uu * v[jj >> 1][jj & 1]) * rcpf_(1.0f + e); } }
                u32x4 wv; wv.x = cvt_pk_bf16(o[0], o[1]); wv.y = cvt_pk_bf16(o[2], o[3]); wv.z = cvt_pk_bf16(o[4], o[5]); wv.w = cvt_pk_bf16(o[6], o[7]);
                *(u32x4*)(O + r * FF + c) = wv; }
            asm volatile("" ::: "memory");
            if (k == 3) FU_WLOAD(1); }
#undef FU_GLOAD
#undef FU_WLOAD
    }
};

__device__ __forceinline__ f32x4 mma16(bf16x8 b, bf16x8 a, f32x4 c) { return __builtin_amdgcn_mfma_f32_16x16x32_bf16(b, a, c, 0, 0, 0); }
__device__ __forceinline__ i32x4 mma16(bf16x8 b, bf16x8 a, i32x4 c) { return __builtin_amdgcn_mfma_i32_16x16x64_i8(__builtin_bit_cast(i32x4, b), __builtin_bit_cast(i32x4, a), c, 0, 0, 0); }
#ifndef PG8_SP2
#define PG8_SP2 true
#endif
#ifndef PG8_ALIGN
#define PG8_ALIGN true
#endif
template <class E, class = void> struct IsChain { static constexpr bool v = false; }; template <> struct IsChain<EpiGateAcc> { static constexpr bool v = true; };
template <class E> struct BMode { static constexpr int v = E::PERM ? 1 : 0; }; template <> struct BMode<EpiGateU8> { static constexpr int v = 2; };
template <class Epi, class Sched, bool ALIGN_EPI = PG8_ALIGN, bool SP2 = PG8_SP2>
__device__ __forceinline__ void gemm_phase(LAS unsigned char* lds, const Gemm g, const Sched& S, const Epi& E, int tid_) {
    const int tid = tid_, wid = __builtin_amdgcn_readfirstlane(tid >> 6), lane = tid & 63, wr = wid >> 2, wc = wid & 3, fr = lane & 15, fq = lane >> 4;
    const int K = g.K, nt = K / BK;
    unsigned voffA[2], voffB[2];
#pragma unroll
    for (int i = 0; i < 2; ++i) { int R, C; stage_rc(tid * 16 + i * 8192, R, C); const int Rb = BMode<Epi>::v == 2 ? (64 * (R >> 5) + 16 * ((R >> 2) & 3) + 4 * ((R >> 4) & 1) + (R & 3)) : (BMode<Epi>::v == 1 ? ((R & ~31) + perm32(R & 31)) : R);
        voffA[i] = (unsigned)(R * K + C) * 2u; voffB[i] = (unsigned)(Rb * K + C) * 2u; }
    const size_t kstep = (size_t)(BK * 2);
    const size_t hstep = (size_t)HALF * K * 2;
    const size_t tstep = 2 * hstep;
    const size_t hstepB = BMode<Epi>::v == 2 ? (size_t)8 * K * 2 : hstep;
    const unsigned ldsw = (unsigned)wid * 1024u;
    const int aoff = lds_byte(wr * 64 + fr, fq * 8), boff = lds_byte(wc * 32 + fr, fq * 8);
#define PG8_SA(b, h) (((b) * 2 + (h)) * HTB)
#define PG8_SB(b, h) ((4 + (b) * 2 + (h)) * HTB)
#define PG8_STAGE(bufoff, gbase, voff) do { _Pragma("unroll") for (int _i = 0; _i < 2; ++_i) \
        __builtin_amdgcn_global_load_lds((const unsigned*)((const char*)(gbase) + (voff)[_i]), (LAS unsigned*)(lds + (bufoff) + ldsw + _i * 8192), 16, 0, 0); } while (0)
#define PG8_LDA(dst, b, h) do { _Pragma("unroll") for (int m = 0; m < 4; ++m) _Pragma("unroll") for (int k = 0; k < 2; ++k) dst[m][k] = *(const LAS bf16x8*)(lds + PG8_SA(b, h) + aoff + m * 2048 + k * 1024); } while (0)
#define PG8_LDB(dst, b, h) do { _Pragma("unroll") for (int n = 0; n < 2; ++n) _Pragma("unroll") for (int k = 0; k < 2; ++k) dst[n][k] = *(const LAS bf16x8*)(lds + PG8_SB(b, h) + boff + n * 2048 + k * 1024); } while (0)
#define PG8_MMA(ai, bj, At, Bt) do { __builtin_amdgcn_s_setprio(1); _Pragma("unroll") for (int m = 0; m < 4; ++m) _Pragma("unroll") for (int n = 0; n < 2; ++n) _Pragma("unroll") for (int k = 0; k < 2; ++k) \
        acc[ai][bj][m][n] = mma16(Bt[n][k], At[m][k], acc[ai][bj][m][n]); __builtin_amdgcn_s_setprio(0); } while (0)
#define PG8_WAIT_V(n) asm volatile("s_waitcnt vmcnt(" #n ")" ::: "memory")
#define PG8_WAIT_L(n) asm volatile("s_waitcnt lgkmcnt(" #n ")" ::: "memory")
#define PG8_BAR __builtin_amdgcn_s_barrier()
#define PG8_SCHED __builtin_amdgcn_sched_barrier(0)
    Unit cur, nxt; int ui = 0;
    if (!S.next(0, cur)) return;
    typedef typename AccOf<Epi::I8>::T acc_t;
    acc_t acc[2][2][4][2];
#pragma unroll
    for (int a = 0; a < 2; ++a)
#pragma unroll
        for (int b = 0; b < 2; ++b)
#pragma unroll
            for (int m = 0; m < 4; ++m)
#pragma unroll
                for (int n = 0; n < 2; ++n) acc[a][b][m][n] = (acc_t){0, 0, 0, 0};
    bf16x8 At[4][2], B0[2][2], B1[2][2];
    typename Epi::Pre pre;
    const char* cA = (const char*)g.A + (size_t)cur.pm * tstep; const char* cB = (const char*)g.Bt + (size_t)cur.pn * tstep;
    S.a_ready(cur);
    if constexpr (SP2) {
        PG8_STAGE(PG8_SB(0, 0), cB, voffB); PG8_STAGE(PG8_SB(0, 1), cB + hstepB, voffB); PG8_STAGE(PG8_SA(0, 0), cA, voffA); PG8_STAGE(PG8_SA(0, 1), cA + hstep, voffA);
        if (wr == 1) PG8_BAR;
        PG8_WAIT_V(2); PG8_BAR;
        PG8_STAGE(PG8_SB(1, 0), cB + kstep, voffB); PG8_STAGE(PG8_SA(1, 0), cA + kstep, voffA); PG8_STAGE(PG8_SB(1, 1), cB + hstepB + kstep, voffB);
        PG8_WAIT_V(6); PG8_BAR;
    } else {
    PG8_STAGE(PG8_SB(0, 0), cB, voffB); PG8_STAGE(PG8_SA(0, 0), cA, voffA); PG8_STAGE(PG8_SB(0, 1), cB + hstepB, voffB); PG8_STAGE(PG8_SA(0, 1), cA + hstep, voffA);
    if (wr == 1) PG8_BAR;
    PG8_WAIT_V(4); PG8_BAR;
    PG8_STAGE(PG8_SB(1, 0), cB + kstep, voffB); PG8_STAGE(PG8_SA(1, 0), cA + kstep, voffA); PG8_STAGE(PG8_SB(1, 1), cB + hstepB + kstep, voffB);
    PG8_WAIT_V(6); PG8_BAR;
    }
    for (;;) {
        const bool has_next = S.next(ui + 1, nxt);
        const char* nA = has_next ? (const char*)g.A + (size_t)nxt.pm * tstep : cA; const char* nB = has_next ? (const char*)g.Bt + (size_t)nxt.pn * tstep : cB;
        for (int t = 0; t < nt; t += 2) {
            const bool last = (t == nt - 2);
            const char* a1 = cA + (size_t)(t + 1) * kstep;
            const char* a2 = last ? nA : cA + (size_t)(t + 2) * kstep; const char* b2 = last ? nB : cB + (size_t)(t + 2) * kstep;
            const char* a3 = a2 + kstep; const char* b3 = b2 + kstep;
            if (last && has_next) S.a_ready(nxt);
            if (last) E.prefetch(pre, cur, wr, wc, fr, fq);
            if constexpr (SP2) {
            PG8_LDB(B0, 0, 0); PG8_LDB(B1, 0, 1); PG8_SCHED; PG8_LDA(At, 0, 0); PG8_STAGE(PG8_SA(1, 1), a1 + hstep, voffA);
            PG8_WAIT_V(8); PG8_WAIT_L(0); PG8_BAR; PG8_MMA(0, 0, At, B0); PG8_MMA(0, 1, At, B1); PG8_BAR; PG8_SCHED;
            PG8_LDA(At, 0, 1); PG8_STAGE(PG8_SB(0, 0), b2, voffB); PG8_STAGE(PG8_SB(0, 1), b2 + hstepB, voffB); PG8_STAGE(PG8_SA(0, 0), a2, voffA);
            PG8_WAIT_V(8); PG8_WAIT_L(0); PG8_BAR; PG8_MMA(1, 0, At, B0); PG8_MMA(1, 1, At, B1); PG8_BAR; PG8_SCHED;
            PG8_LDB(B0, 1, 0); PG8_LDB(B1, 1, 1); PG8_SCHED; PG8_LDA(At, 1, 0); PG8_STAGE(PG8_SA(0, 1), a2 + hstep, voffA);
            PG8_WAIT_V(8); PG8_WAIT_L(0); PG8_BAR; PG8_MMA(0, 0, At, B0); PG8_MMA(0, 1, At, B1); PG8_BAR; PG8_SCHED;
            PG8_LDA(At, 1, 1); PG8_STAGE(PG8_SB(1, 0), b3, voffB); PG8_STAGE(PG8_SB(1, 1), b3 + hstepB, voffB); PG8_STAGE(PG8_SA(1, 0), a3, voffA);
            PG8_WAIT_V(8); PG8_WAIT_L(0); PG8_BAR; PG8_MMA(1, 0, At, B0); PG8_MMA(1, 1, At, B1); PG8_BAR; PG8_SCHED;
            } else {
            PG8_LDB(B0, 0, 0); PG8_SCHED; PG8_LDA(At, 0, 0); PG8_STAGE(PG8_SA(1, 1), a1 + hstep, voffA);
            PG8_WAIT_L(8); PG8_BAR; PG8_WAIT_L(0); PG8_MMA(0, 0, At, B0); PG8_BAR; PG8_SCHED;
            PG8_LDB(B1, 0, 1); PG8_STAGE(PG8_SB(0, 0), b2, voffB);
            PG8_BAR; PG8_WAIT_L(0); PG8_MMA(0, 1, At, B1); PG8_BAR;
            PG8_LDA(At, 0, 1); PG8_STAGE(PG8_SA(0, 0), a2, voffA);
            PG8_BAR; PG8_WAIT_L(0); PG8_MMA(1, 0, At, B0); PG8_BAR; PG8_SCHED;
            PG8_STAGE(PG8_SB(0, 1), b2 + hstepB, voffB);
            PG8_WAIT_V(6); PG8_BAR; PG8_MMA(1, 1, At, B1); PG8_BAR;
            PG8_LDB(B0, 1, 0); PG8_SCHED; PG8_LDA(At, 1, 0); PG8_STAGE(PG8_SA(0, 1), a2 + hstep, voffA);
            PG8_WAIT_L(8); PG8_BAR; PG8_WAIT_L(0); PG8_MMA(0, 0, At, B0); PG8_BAR; PG8_SCHED;
            PG8_LDB(B1, 1, 1); PG8_STAGE(PG8_SB(1, 0), b3, voffB);
            PG8_BAR; PG8_WAIT_L(0); PG8_MMA(0, 1, At, B1); PG8_BAR;
            PG8_LDA(At, 1, 1); PG8_STAGE(PG8_SA(1, 0), a3, voffA);
            PG8_BAR; PG8_WAIT_L(0); PG8_MMA(1, 0, At, B0); PG8_BAR; PG8_SCHED;
            PG8_STAGE(PG8_SB(1, 1), b3 + hstepB, voffB);
            PG8_WAIT_V(6); PG8_BAR; PG8_MMA(1, 1, At, B1); PG8_BAR;
            }
        }
        if constexpr (ALIGN_EPI) { if (wr == 0) PG8_BAR; }
        if constexpr (IsChain<Epi>::v) { const bool carry = !E.is_last(cur); if (!carry) E(acc, cur, wr, wc, fr, fq, pre); E.rescale(acc, cur, carry, wr, wc, fr, fq); }
        else E(acc, cur, wr, wc, fr, fq, pre);
        S.done(cur);
        if (!has_next) break;
        if constexpr (!IsChain<Epi>::v) {
#pragma unroll
        for (int a = 0; a < 2; ++a)
#pragma unroll
            for (int b = 0; b < 2; ++b)
#pragma unroll
                for (int m = 0; m < 4; ++m)
#pragma unroll
                    for (int n = 0; n < 2; ++n) acc[a][b][m][n] = (acc_t){0, 0, 0, 0};
        }
        cur = nxt; cA = nA; cB = nB; ++ui;
        if constexpr (ALIGN_EPI) { if (wr == 1) PG8_BAR; }
    }
    PG8_WAIT_V(0);
    if constexpr (!ALIGN_EPI) { if (wr == 0) PG8_BAR; }
    PG8_BAR;
#undef PG8_SA
#undef PG8_SB
#undef PG8_STAGE
#undef PG8_LDA
#undef PG8_LDB
#undef PG8_MMA
#undef PG8_WAIT_V
#undef PG8_WAIT_L
#undef PG8_BAR
#undef PG8_SCHED
}
}

#define XB_TMO      128
#define XB_XCNT(j)  (256  + 64 * (j))
#define XB_XSUB(j)  (1280 + 64 * (j))
#define XB_XGEN(j)  (2304 + 64 * (j))
#define XB_TOP      3328
#define XB_TOPGEN   3392
#define XCD_BAR_WORDS 3456
#define XB_SPIN_CAP (1u << 22)
__device__ __forceinline__ unsigned xb_ld(unsigned* p)              { return __hip_atomic_load(p, __ATOMIC_RELAXED, __HIP_MEMORY_SCOPE_AGENT); }
__device__ __forceinline__ unsigned xb_add(unsigned* p, unsigned v) { return __hip_atomic_fetch_add(p, v, __ATOMIC_RELAXED, __HIP_MEMORY_SCOPE_AGENT); }
__device__ __forceinline__ unsigned xb_xcc_id() { return (unsigned)__builtin_amdgcn_s_getreg((3 << 11) | 20) & 0xFu; }
#define XB_SPIN(cond, bar) do { unsigned _sp = 0; while (cond) { __builtin_amdgcn_s_sleep(1); \
    if ((++_sp & 255u) == 0u) { if (xb_ld(&(bar)[XB_TMO])) break; if (_sp > XB_SPIN_CAP) { atomicAdd(&(bar)[XB_TMO], 1u); break; } } } } while (0)
struct XcdBarrier { unsigned* bar; unsigned x; volatile LAS unsigned* st; };
__device__ __forceinline__ XcdBarrier xcd_barrier_post(unsigned* bar, volatile LAS unsigned* st) {
    XcdBarrier b; b.bar = bar; b.x = xb_xcc_id(); b.st = st;
    if (threadIdx.x == 0) (void)xb_add(&bar[XB_XCNT(b.x)], 1u);
    return b;
}
__device__ __forceinline__ void xcd_barrier_complete(unsigned* bar, unsigned x, unsigned& nloc, unsigned& nx) {
    const unsigned G = gridDim.x * gridDim.y * gridDim.z;
    unsigned sum, cnt, mine, sp = 0u;
    for (;;) {
        sum = 0u; cnt = 0u; mine = 0u;
#pragma unroll
        for (unsigned j = 0; j < 16; ++j) { const unsigned c = xb_ld(&bar[XB_XCNT(j)]); sum += c; cnt += (c > 0u) ? 1u : 0u; mine = (j == x) ? c : mine; }
        if (sum == G) break;
        __builtin_amdgcn_s_sleep(1);
        if ((++sp & 255u) == 0u) { if (xb_ld(&bar[XB_TMO])) break; if (sp > XB_SPIN_CAP) { atomicAdd(&bar[XB_TMO], 1u); break; } }
    }
    nloc = mine > 0u ? mine : 1u; nx = cnt > 0u ? cnt : 1u;
}
__device__ __forceinline__ void xcd_barrier(const XcdBarrier& b) {
    asm volatile("s_waitcnt vmcnt(0)" ::: "memory");
    __syncthreads();
    if (threadIdx.x == 0) {
        unsigned* bar = b.bar;
        { unsigned long long w_ = (unsigned long long)bar; unsigned lo_ = __builtin_amdgcn_readfirstlane((unsigned)w_), hi_ = __builtin_amdgcn_readfirstlane((unsigned)(w_ >> 32)); asm volatile("" : "+s"(lo_), "+s"(hi_)); bar = (unsigned*)(((unsigned long long)hi_ << 32) | lo_); }
        __builtin_amdgcn_s_waitcnt(0);
        unsigned nloc = b.st[0], nx = b.st[1];
        if (nloc == 0u) { xcd_barrier_complete(bar, b.x, nloc, nx); b.st[0] = nloc; b.st[1] = nx; }
        const unsigned old = xb_add(&bar[XB_XSUB(b.x)], 1u);
        const unsigned gen = old / nloc;
        if (old + 1u == (gen + 1u) * nloc) {
            __builtin_amdgcn_fence(__ATOMIC_RELEASE, "agent");
            asm volatile("s_waitcnt vmcnt(0)" ::: "memory");
            const unsigned og = xb_add(&bar[XB_TOP], 1u);
            const unsigned tg = og / nx;
            if (og + 1u == (tg + 1u) * nx) xb_add(&bar[XB_TOPGEN], 1u);
            else XB_SPIN(xb_ld(&bar[XB_TOPGEN]) == tg, bar);
            __builtin_amdgcn_fence(__ATOMIC_ACQUIRE, "agent");
            xb_add(&bar[XB_XGEN(b.x)], 1u);
            asm volatile("s_waitcnt vmcnt(0)" ::: "memory");
        } else {
            XB_SPIN(xb_ld(&bar[XB_XGEN(b.x)]) == gen, bar);
            __builtin_amdgcn_fence(__ATOMIC_ACQUIRE, "agent");
            asm volatile("s_waitcnt vmcnt(0)" ::: "memory");
        }
    }
    __syncthreads();
}

constexpr int NWAVES = 8, NTHR = 512;
constexpr int LDS_MISC = 131072, LDS_BYTES = 131072 + 1024;
struct Args { const float* in[45]; float* out; unsigned char* ws; };
#define GAS __attribute__((address_space(1)))
struct Frame {
    LAS unsigned char* lds; float* out; unsigned char* ws;
    int tid, lane, wave, blk, G;
};
#define WSP(T, off) ((T*)(F.ws + (off)))
__device__ __forceinline__ const float* inp_(LAS unsigned char* lds, int k) {
    const LAS unsigned* t = (const LAS unsigned*)(lds + 131072 + 256) + 2 * k;
    const unsigned lo = __builtin_amdgcn_readfirstlane(t[0]), hi = __builtin_amdgcn_readfirstlane(t[1]);
    return (const float*)(const GAS float*)(((unsigned long long)hi << 32) | lo);
}
#define INP(k) inp_(F.lds, (k))

__device__ __forceinline__ void tr_item(const float* W, int ld, int col0, int ncv, bf16* WT, int K, int row_off, LAS float* scr, int kb, int nb, int lane, float scale = 1.0f) {
    const int k0 = 64 * kb, n0 = 32 * nb; const int nn = n0 + (lane & 31); const bool ok = nn < ncv;
    { float t[32]; const float* wp = W + (size_t)(k0 + (lane >> 5)) * ld + col0 + (ok ? nn : 0);
#pragma unroll
      for (int i = 0; i < 32; ++i) t[i] = wp[(size_t)(2 * i) * ld];
#pragma unroll
      for (int i = 0; i < 32; ++i) scr[(2 * i + (lane >> 5)) * 33 + (lane & 31)] = ok ? t[i] * scale : 0.f; }
    asm volatile("s_waitcnt lgkmcnt(0)" ::: "memory");
    const int c = lane & 7;
#pragma unroll
    for (int j = 0; j < 4; ++j) { const int n = (lane >> 3) + 8 * j; const LAS float* s = scr + (8 * c) * 33 + n;
        u32x4 o; o.x = pk2(s[0 * 33], s[1 * 33]); o.y = pk2(s[2 * 33], s[3 * 33]); o.z = pk2(s[4 * 33], s[5 * 33]); o.w = pk2(s[6 * 33], s[7 * 33]);
        *(u32x4*)(WT + (size_t)(row_off + n0 + n) * K + k0 + 8 * c) = o; }
    asm volatile("s_waitcnt lgkmcnt(0)" ::: "memory");
}
__device__ __forceinline__ void convert_weights(Frame& F, int l) {
    LAS float* scr = (LAS float*)(F.lds + F.wave * 16384);
    const int gw = F.blk * NWAVES + F.wave, NGW = F.G * NWAVES;
    constexpr int I0 = 32 * 152, I1 = I0, I2 = I1 + 4 * 8 * 64, I3 = I2 + 32 * 64, I4 = I3, I5 = I4, I6 = I5 + 96 * 64, I7 = I6 + 8 * 16;
    const float* win = INP(2) + (size_t)l * DM * INC;
    for (int it = gw; it < I7; it += NGW) {
        if (it < I0) { const int r = it; tr_item(win, INC, 0, MIXC, WSP(bf16, WS_WIN), DM, 0, scr, r / 152, r % 152, F.lane); }
        else if (it < I1) { }
        else if (it < I2) { const int r = it - I1; const int k = r / 512, rr = r % 512; tr_item(INP(36) + ((size_t)l * 4 + k) * 512 * DM, DM, 0, DM, WSP(bf16, WS_WPK), 512, k * DM, scr, rr / 64, rr % 64, F.lane, 1.0f / 255.0f); }
        else if (it < I3) { const int r = it - I2; tr_item(INP(37) + (size_t)l * DM * DM, DM, 0, DM, WSP(bf16, WS_WOUT), DM, 0, scr, r / 64, r % 64, F.lane); }
        else if (it < I4) { const int r = it - I3; tr_item(INP(39) + (size_t)l * DM * FF, FF, 0, FF, WSP(bf16, WS_WFG), DM, 0, scr, r / 192, r % 192, F.lane); }
        else if (it < I5) { const int r = it - I4; tr_item(INP(40) + (size_t)l * DM * FF, FF, 0, FF, WSP(bf16, WS_WFU), DM, 0, scr, r / 192, r % 192, F.lane); }
        else if (it < I6) { const int r = it - I5; tr_item(INP(43) + (size_t)l * FF * DM, DM, 0, DM, WSP(bf16, WS_WFD), FF, 0, scr, r / 64, r % 64, F.lane); }
        else { const int r = it - I6; tr_item(INP(11) + (size_t)l * 512 * 512, 512, 0, 512, WSP(bf16, WS_WGLU), 512, 0, scr, r / 16, r % 16, F.lane); }
    }
}
__device__ __forceinline__ void rmsnorm_rows(Frame& F, const float* x, const bf16* xb, const float* g, bf16* obf, float* of32, unsigned* a8 = nullptr, float* sa = nullptr) {
    const int gw = F.blk * NWAVES + F.wave, NGW = F.G * NWAVES;
    f32x4 gv[8];
#pragma unroll
    for (int j = 0; j < 8; ++j) gv[j] = ((const f32x4*)g)[64 * j + F.lane];
    for (int m = gw; m < MTOK; m += NGW) {
        f32x4 v[8]; float s = 0.f;
        if (x) { const f32x4* xr = (const f32x4*)(x + (size_t)m * DM) + F.lane;
#pragma unroll
            for (int j = 0; j < 8; ++j) v[j] = xr[64 * j]; }
        else { const u32x2* xr = (const u32x2*)(xb + (size_t)m * DM) + F.lane; u32x2 w[8];
#pragma unroll
            for (int j = 0; j < 8; ++j) w[j] = xr[64 * j];
#pragma unroll
            for (int j = 0; j < 8; ++j) v[j] = (f32x4){lo16(w[j].x), hi16(w[j].x), lo16(w[j].y), hi16(w[j].y)}; }
#pragma unroll
        for (int j = 0; j < 8; ++j) s += (v[j].x * v[j].x + v[j].y * v[j].y) + (v[j].z * v[j].z + v[j].w * v[j].w);
        const float rs = 1.0f / sqrtf(wave_sum(s) * (1.f / DM) + 1e-6f);
#pragma unroll
        for (int j = 0; j < 8; ++j) v[j] = v[j] * rs * gv[j];
        if (obf) { u32x2* o = (u32x2*)(obf + (size_t)m * DM) + F.lane;
#pragma unroll
            for (int j = 0; j < 8; ++j) { u32x2 w; w.x = pk2(v[j].x, v[j].y); w.y = pk2(v[j].z, v[j].w); o[64 * j] = w; } }
        if (of32) { f32x4* o = (f32x4*)(of32 + (size_t)m * DM) + F.lane;
#pragma unroll
            for (int j = 0; j < 8; ++j) o[64 * j] = v[j]; }
        if (a8) {
            float am = 0.f;
#pragma unroll
            for (int j = 0; j < 8; ++j) am = fmaxf(fmaxf(am, fmaxf(fabsf(v[j].x), fabsf(v[j].y))), fmaxf(fabsf(v[j].z), fabsf(v[j].w)));
            am = fmaxf(wave_max(am), 1e-20f); const float inv = 127.0f / am;
            unsigned* o = a8 + (size_t)m * (DM / 4) + F.lane;
#pragma unroll
            for (int j = 0; j < 8; ++j) o[64 * j] = q8x4(v[j].x, v[j].y, v[j].z, v[j].w, inv);
            if (F.lane == 0) sa[m] = am * (1.0f / 127.0f); }
    }
}
__device__ __forceinline__ void convert_cols_i8(Frame& F, const float* W, int ld, int col0, int nb, signed char* W8, float* sb, int row_off) {
    constexpr int PITCH = 2064;
    LAS float* red = (LAS float*)(F.lds + 8 * 16384 - 4096);
    LAS float* scl = red + 512;
    const int tid = F.tid, n = tid & 31, kg = tid >> 5; const float* wp = W + col0 + 32 * nb + n + (size_t)(4 * kg) * ld;
    float v[128]; float am = 0.f;
#pragma unroll
    for (int j = 0; j < 32; ++j)
#pragma unroll
        for (int e = 0; e < 4; ++e) v[4 * j + e] = wp[(size_t)(64 * j + e) * ld];
#pragma unroll
    for (int i = 0; i < 128; ++i) am = fmaxf(am, fabsf(v[i]));
    red[kg * 32 + n] = am;
    __syncthreads();
    if (tid < 32) { float a = 0.f;
#pragma unroll
        for (int q = 0; q < 16; ++q) a = fmaxf(a, red[q * 32 + tid]);
        a = fmaxf(a, 1e-30f); scl[tid] = 127.0f / a; sb[row_off + 32 * nb + tid] = a * (1.0f / 127.0f); }
    __syncthreads();
    const float inv = scl[n];
    LAS unsigned char* img = F.lds + n * PITCH + 4 * kg;
#pragma unroll
    for (int j = 0; j < 32; ++j) *(LAS unsigned*)(img + 64 * j) = q8x4(v[4 * j], v[4 * j + 1], v[4 * j + 2], v[4 * j + 3], inv);
    __syncthreads();
#pragma unroll
    for (int q = 0; q < 8; ++q) { const int c = tid + 512 * q, rn = c >> 7, ko = (c & 127) * 16;
        *(u32x4*)(W8 + (size_t)(row_off + 32 * nb + rn) * DM + ko) = *(const LAS u32x4*)(F.lds + rn * PITCH + ko); }
    __syncthreads();
}

constexpr int WAVE_LDS = 16384;
constexpr int LR_XLD = 72, LR_FLD = 66, LR_ALD = 132;
constexpr int LR_XF = 16 * LR_XLD * 2, LR_AB = LR_XF + 16 * LR_FLD * 4;
template <bool FINAL> __device__ __forceinline__ void lru_task(Frame& F, int l, int task) {
    const int lane = F.lane, fr = lane & 15, fq = lane >> 4; const int b = task >> 9, h = (task >> 6) & 7, c = task & 63; const int ch = 64 * h + lane;
    LAS unsigned char* wl = F.lds + F.wave * WAVE_LDS;
    LAS bf16* XC = (LAS bf16*)wl; LAS float* XF = (LAS float*)(wl + LR_XF); LAS float* AB = (LAS float*)(wl + LR_AB);
    const float* WA = INP(14) + ((size_t)l * 8 + h) * 4096; const float* WX = INP(16) + ((size_t)l * 8 + h) * 4096;
    bf16x8 Wa[4][2], Wx[4][2];
#pragma unroll
    for (int nt = 0; nt < 4; ++nt)
#pragma unroll
        for (int kk = 0; kk < 2; ++kk) { const float* pa = WA + (size_t)(32 * kk + 8 * fq) * 64 + 16 * nt + fr; const float* px_ = WX + (size_t)(32 * kk + 8 * fq) * 64 + 16 * nt + fr;
            u32x4 wa_, wx_; wa_.x = pk2(pa[0], pa[64]); wa_.y = pk2(pa[128], pa[192]); wa_.z = pk2(pa[256], pa[320]); wa_.w = pk2(pa[384], pa[448]);
            wx_.x = pk2(px_[0], px_[64]); wx_.y = pk2(px_[128], px_[192]); wx_.z = pk2(px_[256], px_[320]); wx_.w = pk2(px_[384], px_[448]);
            Wa[nt][kk] = __builtin_bit_cast(bf16x8, wa_); Wx[nt][kk] = __builtin_bit_cast(bf16x8, wx_); }
    float ba4[4], bx4[4], sp4[4], slp[4];
#pragma unroll
    for (int nt = 0; nt < 4; ++nt) { const int jj = l * 512 + 64 * h + 16 * nt + fr; ba4[nt] = INP(15)[jj]; bx4[nt] = INP(17)[jj]; sp4[nt] = softplusf_(-INP(18)[jj]); slp[nt] = 0.f; }
    const float* cwp = INP(12) + (size_t)l * 4 * 512 + ch;
    const float cw0 = cwp[0], cw1 = cwp[512], cw2 = cwp[1024], cw3 = cwp[1536];
    const float cb = INP(13)[l * 512 + ch];
    const size_t row0 = (size_t)b * SEQ + (size_t)c * 128;
    const bf16* px = WSP(const bf16, WS_PROJ) + row0 * MIXP + PC_LRX + ch;
    const bf16* pg = WSP(const bf16, WS_PROJ) + row0 * MIXP + PC_LRG + ch;
    float xm3 = 0.f, xm2 = 0.f, xm1 = 0.f;
    if (c > 0) { xm3 = bf2f(*(px - 3 * (ptrdiff_t)MIXP)); xm2 = bf2f(*(px - 2 * (ptrdiff_t)MIXP)); xm1 = bf2f(*(px - (ptrdiff_t)MIXP)); }
    float hs = 0.f;
    const size_t cidx = ((size_t)b * 64 + c) * 512 + ch;
    if (FINAL) hs = WSP(const float, WS_LRI)[cidx];
    bf16* yo = WSP(bf16, WS_YK) + (size_t)1 * MTOK * 512 + row0 * 512 + ch;
    bf16 xs[16], gs[16];
#pragma unroll
    for (int j = 0; j < 16; ++j) { xs[j] = px[(size_t)j * MIXP]; if (FINAL) gs[j] = pg[(size_t)j * MIXP]; }
#pragma unroll 1
    for (int sb = 0; sb < 8; ++sb) {
#pragma unroll
        for (int t = 0; t < 16; ++t) { const float xv = bf2f(xs[t]); const float xc = cb + cw0 * xm3 + cw1 * xm2 + cw2 * xm1 + cw3 * xv; xm3 = xm2; xm2 = xm1; xm1 = xv;
            XC[t * LR_XLD + lane] = (bf16)f2bf(xc); XF[t * LR_FLD + lane] = xc; }
        float gl[16];
        if (FINAL) {
#pragma unroll
            for (int t = 0; t < 16; ++t) gl[t] = bf2f(gs[t]); }
        if (sb < 7) {
#pragma unroll
            for (int j = 0; j < 16; ++j) { xs[j] = px[(size_t)((sb + 1) * 16 + j) * MIXP]; if (FINAL) gs[j] = pg[(size_t)((sb + 1) * 16 + j) * MIXP]; } }
        const bf16x8 af0 = *(const LAS bf16x8*)(XC + fr * LR_XLD + 8 * fq), af1 = *(const LAS bf16x8*)(XC + fr * LR_XLD + 32 + 8 * fq);
#pragma unroll
        for (int nt = 0; nt < 4; ++nt) {
            f32x4 aa = (f32x4){0.f, 0.f, 0.f, 0.f}, ax = (f32x4){0.f, 0.f, 0.f, 0.f};
            aa = __builtin_amdgcn_mfma_f32_16x16x32_bf16(af0, Wa[nt][0], aa, 0, 0, 0); aa = __builtin_amdgcn_mfma_f32_16x16x32_bf16(af1, Wa[nt][1], aa, 0, 0, 0);
            ax = __builtin_amdgcn_mfma_f32_16x16x32_bf16(af0, Wx[nt][0], ax, 0, 0, 0); ax = __builtin_amdgcn_mfma_f32_16x16x32_bf16(af1, Wx[nt][1], ax, 0, 0, 0);
#pragma unroll
            for (int e = 0; e < 4; ++e) { const int t = 4 * fq + e, jj = 16 * nt + fr; const float xc = XF[t * LR_FLD + jj];
                const float r = sigmoidf_(aa[e] + ba4[nt]), ig = sigmoidf_(ax[e] + bx4[nt]); const float la = -8.0f * r * sp4[nt]; const float av = __expf(la);
                const float mult = __builtin_amdgcn_sqrtf(fmaxf(1.0f - av * av, 0.f));
                AB[t * LR_ALD + jj] = av; AB[t * LR_ALD + 64 + jj] = xc * ig * mult; if (!FINAL) slp[nt] += la; }
        }
#pragma unroll
        for (int t = 0; t < 16; ++t) { const float av = AB[t * LR_ALD + lane], bv = AB[t * LR_ALD + 64 + lane]; hs = av * hs + bv;
            if (FINAL) yo[(size_t)(sb * 16 + t) * 512] = (bf16)f2bf(hs * geluf_(gl[t])); }
    }
    if (!FINAL) { WSP(float, WS_LRE)[cidx] = hs;
#pragma unroll
        for (int nt = 0; nt < 4; ++nt) { float v = slp[nt]; v += __shfl_xor(v, 16); v += __shfl_xor(v, 32); if (fq == 0) WSP(float, WS_LRA)[((size_t)b * 64 + c) * 512 + 64 * h + 16 * nt + fr] = v; } }
}
__device__ __forceinline__ void lru_carry(Frame& F, int task) {
    const int b = task >> 3, ch = (task & 7) * 64 + F.lane; float run = 0.f;
    const float* A = WSP(const float, WS_LRA) + (size_t)b * 64 * 512 + ch; const float* E = WSP(const float, WS_LRE) + (size_t)b * 64 * 512 + ch; float* I = WSP(float, WS_LRI) + (size_t)b * 64 * 512 + ch;
#pragma unroll 1
    for (int c0 = 0; c0 < 64; c0 += 32) { float av[32], ev[32];
#pragma unroll
        for (int j = 0; j < 32; ++j) { av[j] = A[(size_t)(c0 + j) * 512]; ev[j] = E[(size_t)(c0 + j) * 512]; }
#pragma unroll
        for (int j = 0; j < 32; ++j) { I[(size_t)(c0 + j) * 512] = run; run = __expf(av[j]) * run + ev[j]; } }
}

constexpr int S5_XLD = 132, S5_SLD = 136, S5_SB = 16 * S5_XLD * 4;
template <bool FINAL> __device__ __forceinline__ void s5_task(Frame& F, int l, int task) {
    const int lane = F.lane, fr = lane & 15, fq = lane >> 4; const int b = task >> 11, g = (task >> 6) & 31, c = task & 63; const int p = lane;
    LAS unsigned char* wl = F.lds + F.wave * WAVE_LDS;
    LAS float* X = (LAS float*)wl; LAS bf16* Sb = (LAS bf16*)(wl + S5_SB);
    const int lg = l * 32 + g;
    const float lr = INP(3)[lg * 64 + p], li = INP(4)[lg * 64 + p]; const float dt = expf(INP(10)[lg]);
    const float mag = expf(lr * dt); float sn, cs; sincosf(li * dt, &sn, &cs); const float abr = mag * cs, abi = mag * sn;
    const float den = lr * lr + li * li, nr = abr - 1.0f, ni = abi; const float fre = (nr * lr + ni * li) / den, fim = (ni * lr - nr * li) / den;
    bf16x8 Bf[8];
#pragma unroll
    for (int nq = 0; nq < 4; ++nq) { const int pp = 16 * nq + fr; const float fr_ = __shfl(fre, pp), fi_ = __shfl(fim, pp);
        u32x4 wr_ = (u32x4){0u, 0u, 0u, 0u}, wi_ = (u32x4){0u, 0u, 0u, 0u};
        if (fq < 2) { const f32x4* br = (const f32x4*)(INP(5) + ((size_t)lg * 64 + pp) * 16 + 8 * fq); const f32x4* bi = (const f32x4*)(INP(6) + ((size_t)lg * 64 + pp) * 16 + 8 * fq);
            const f32x4 r0 = br[0], r1 = br[1], i0 = bi[0], i1 = bi[1];
            wr_.x = pk2(fr_ * r0[0] - fi_ * i0[0], fr_ * r0[1] - fi_ * i0[1]); wr_.y = pk2(fr_ * r0[2] - fi_ * i0[2], fr_ * r0[3] - fi_ * i0[3]);
            wr_.z = pk2(fr_ * r1[0] - fi_ * i1[0], fr_ * r1[1] - fi_ * i1[1]); wr_.w = pk2(fr_ * r1[2] - fi_ * i1[2], fr_ * r1[3] - fi_ * i1[3]);
            wi_.x = pk2(fr_ * i0[0] + fi_ * r0[0], fr_ * i0[1] + fi_ * r0[1]); wi_.y = pk2(fr_ * i0[2] + fi_ * r0[2], fr_ * i0[3] + fi_ * r0[3]);
            wi_.z = pk2(fr_ * i1[0] + fi_ * r1[0], fr_ * i1[1] + fi_ * r1[1]); wi_.w = pk2(fr_ * i1[2] + fi_ * r1[2], fr_ * i1[3] + fi_ * r1[3]); }
        Bf[nq] = __builtin_bit_cast(bf16x8, wr_); Bf[nq + 4] = __builtin_bit_cast(bf16x8, wi_); }
    bf16x8 Cf[4], Df;
    if (FINAL) {
#pragma unroll
        for (int kk = 0; kk < 4; ++kk) { const float* src = (kk < 2 ? INP(7) : INP(8)) + ((size_t)lg * 16 + fr) * 64 + 32 * (kk & 1) + 8 * fq; const float sg = kk < 2 ? 1.0f : -1.0f;
            const f32x4 c0 = *(const f32x4*)src, c1 = *(const f32x4*)(src + 4);
            u32x4 w; w.x = pk2(sg * c0[0], sg * c0[1]); w.y = pk2(sg * c0[2], sg * c0[3]); w.z = pk2(sg * c1[0], sg * c1[1]); w.w = pk2(sg * c1[2], sg * c1[3]); Cf[kk] = __builtin_bit_cast(bf16x8, w); }
        const float dv = INP(9)[l * 512 + 16 * g + fr]; float dd[8];
#pragma unroll
        for (int j = 0; j < 8; ++j) dd[j] = (8 * fq + j == fr) ? dv : 0.f;
        u32x4 w; w.x = pk2(dd[0], dd[1]); w.y = pk2(dd[2], dd[3]); w.z = pk2(dd[4], dd[5]); w.w = pk2(dd[6], dd[7]); Df = __builtin_bit_cast(bf16x8, w);
    }
    float sre = 0.f, sim = 0.f;
    const size_t sidx = (((size_t)b * 32 + g) * 64 + c) * 128 + p;
    if (FINAL) { sre = WSP(const float, WS_S5I)[sidx]; sim = WSP(const float, WS_S5I)[sidx + 64]; }
    const size_t row0 = (size_t)b * SEQ + (size_t)c * 128;
    const bf16* up = WSP(const bf16, WS_PROJ) + (row0 + fr) * MIXP + PC_S5U + 16 * g + 8 * (fq & 1);
    u32x4 aun = *(const u32x4*)up;
#pragma unroll 1
    for (int sb = 0; sb < 8; ++sb) {
        u32x4 au_ = aun; if (fq >= 2) au_ = (u32x4){0u, 0u, 0u, 0u};
        const bf16x8 au = __builtin_bit_cast(bf16x8, au_);
        if (sb < 7) aun = *(const u32x4*)(up + (size_t)(sb + 1) * 16 * MIXP);
#pragma unroll
        for (int nt = 0; nt < 8; ++nt) { const f32x4 a = __builtin_amdgcn_mfma_f32_16x16x32_bf16(au, Bf[nt], (f32x4){0.f, 0.f, 0.f, 0.f}, 0, 0, 0);
#pragma unroll
            for (int e = 0; e < 4; ++e) X[(4 * fq + e) * S5_XLD + 16 * nt + fr] = a[e]; }
#pragma unroll
        for (int t = 0; t < 16; ++t) { const float xr = X[t * S5_XLD + p], xi = X[t * S5_XLD + 64 + p];
            const float nre = abr * sre - abi * sim + xr, nim = abr * sim + abi * sre + xi; sre = nre; sim = nim;
            if (FINAL) { Sb[t * S5_SLD + p] = (bf16)f2bf(sre); Sb[t * S5_SLD + 64 + p] = (bf16)f2bf(sim); } }
        if (FINAL) {
            f32x4 y = (f32x4){0.f, 0.f, 0.f, 0.f};
#pragma unroll
            for (int kk = 0; kk < 4; ++kk) y = __builtin_amdgcn_mfma_f32_16x16x32_bf16(*(const LAS bf16x8*)(Sb + fr * S5_SLD + 32 * kk + 8 * fq), Cf[kk], y, 0, 0, 0);
            y = __builtin_amdgcn_mfma_f32_16x16x32_bf16(au, Df, y, 0, 0, 0);
#pragma unroll
            for (int e = 0; e < 4; ++e) WSP(bf16, WS_S5Z)[(row0 + sb * 16 + 4 * fq + e) * 512 + 16 * g + fr] = (bf16)f2bf(geluf_(y[e]));
        }
    }
    if (!FINAL) { WSP(float, WS_S5E)[sidx] = sre; WSP(float, WS_S5E)[sidx + 64] = sim; }
}
__device__ __forceinline__ void s5_carry(Frame& F, int l, int task) {
    const int b = task >> 5, g = task & 31, p = F.lane;
    const float lr = INP(3)[(l * 32 + g) * 64 + p], li = INP(4)[(l * 32 + g) * 64 + p]; const float dt = expf(INP(10)[l * 32 + g]);
    const float mag = expf(lr * dt); float sn, cs; sincosf(li * dt, &sn, &cs); float ar = mag * cs, ai = mag * sn;
#pragma unroll
    for (int i = 0; i < 7; ++i) { const float nr = ar * ar - ai * ai, ni = (ar + ar) * ai; ar = nr; ai = ni; }
    float rr = 0.f, ri = 0.f;
    const float* E = WSP(const float, WS_S5E) + (((size_t)b * 32 + g) * 64) * 128 + p; float* I = WSP(float, WS_S5I) + (((size_t)b * 32 + g) * 64) * 128 + p;
#pragma unroll 1
    for (int c0 = 0; c0 < 64; c0 += 32) { float er[32], ei[32];
#pragma unroll
        for (int j = 0; j < 32; ++j) { er[j] = E[(size_t)(c0 + j) * 128]; ei[j] = E[(size_t)(c0 + j) * 128 + 64]; }
#pragma unroll
        for (int j = 0; j < 32; ++j) { I[(size_t)(c0 + j) * 128] = rr; I[(size_t)(c0 + j) * 128 + 64] = ri;
            const float nr = ar * rr - ai * ri + er[j], ni = ar * ri + ai * rr + ei[j]; rr = nr; ri = ni; } }
}

constexpr int M2_CS = 0, M2_BS = 17408, M2_BST = 34816, M2_XT = 53248, M2_GS = 90112, M2_CUM = 107520, M2_DTV = 108544, M2_END = 109568;
constexpr int LDP = 136, LDT = 72, LDG = 68;
__device__ __forceinline__ void m2_stage(Frame& F, int l, int b, int c, int gr) {
    LAS bf16* Cs = (LAS bf16*)(F.lds + M2_CS); LAS bf16* Bs = (LAS bf16*)(F.lds + M2_BS); LAS bf16* BsT = (LAS bf16*)(F.lds + M2_BST); LAS bf16* XT = (LAS bf16*)(F.lds + M2_XT);
    LAS float* cum = (LAS float*)(F.lds + M2_CUM); LAS float* dtv = (LAS float*)(F.lds + M2_DTV);
    const int tid = F.tid; const size_t row0 = (size_t)b * SEQ + (size_t)c * 64;
    {
        const int kind = tid < 256 ? 0 : (tid < 384 ? 1 : 2); const int idx = kind == 0 ? tid : (kind == 1 ? tid - 256 : tid - 384);
        const int col = kind == 0 ? 256 * gr + idx : (kind == 1 ? 512 + 128 * gr + idx : 768 + 128 * gr + idx);
        const float* cwp = INP(19) + (size_t)l * 4 * 1024 + col; const float cw0 = cwp[0], cw1 = cwp[1024], cw2 = cwp[2048], cw3 = cwp[3072]; const float cb = INP(20)[l * 1024 + col];
        const bf16* px = WSP(const bf16, WS_PROJ) + row0 * MIXP + PC_XBC + col;
        float xm3 = 0.f, xm2 = 0.f, xm1 = 0.f;
        if (c > 0) { xm3 = bf2f(*(px - 3 * (ptrdiff_t)MIXP)); xm2 = bf2f(*(px - 2 * (ptrdiff_t)MIXP)); xm1 = bf2f(*(px - (ptrdiff_t)MIXP)); }
        bf16 xall[64];
#pragma unroll
        for (int j = 0; j < 64; ++j) xall[j] = px[(size_t)j * MIXP];
#pragma unroll
        for (int tb = 0; tb < 8; ++tb) {
            float vv[8];
#pragma unroll
            for (int j = 0; j < 8; ++j) { const float xv = bf2f(xall[tb * 8 + j]);
                vv[j] = siluf_(cb + cw0 * xm3 + cw1 * xm2 + cw2 * xm1 + cw3 * xv); xm3 = xm2; xm2 = xm1; xm1 = xv; }
            u32x4 w; w.x = pk2(vv[0], vv[1]); w.y = pk2(vv[2], vv[3]); w.z = pk2(vv[4], vv[5]); w.w = pk2(vv[6], vv[7]);
            if (kind == 0) *(LAS u32x4*)(XT + idx * LDT + tb * 8) = w;
            else if (kind == 1) { *(LAS u32x4*)(BsT + idx * LDT + tb * 8) = w;
#pragma unroll
                for (int j = 0; j < 8; ++j) Bs[(tb * 8 + j) * LDP + idx] = (bf16)f2bf(vv[j]); }
            else {
#pragma unroll
                for (int j = 0; j < 8; ++j) Cs[(tb * 8 + j) * LDP + idx] = (bf16)f2bf(vv[j]); }
        }
    }
    if (tid < 256) { const int hh = tid >> 6, t = tid & 63, h = 4 * gr + hh;
        const float dtr = bf2f(WSP(const bf16, WS_PROJ)[(row0 + t) * MIXP + PC_DT + h]);
        const float dt = softplusf_(dtr + INP(21)[l * 8 + h]); const float a = -expf(INP(22)[l * 8 + h]);
        float s = dt * a;
#pragma unroll
        for (int o = 1; o < 64; o <<= 1) { const float n = __shfl_up(s, o); if (t >= o) s += n; }
        dtv[hh * 64 + t] = dt; cum[hh * 64 + t] = s; }
    __syncthreads();
}
__device__ __forceinline__ bf16x8 ldfrag(const LAS bf16* p) { return *(const LAS bf16x8*)p; }
__device__ __forceinline__ void m2_pass1(Frame& F, int l, int task) {
    const int b = task >> 8, c = (task >> 1) & 127, gr = task & 1;
    m2_stage(F, l, b, c, gr);
    LAS bf16* BsT = (LAS bf16*)(F.lds + M2_BST); LAS bf16* XT = (LAS bf16*)(F.lds + M2_XT); LAS float* cum = (LAS float*)(F.lds + M2_CUM); LAS float* dtv = (LAS float*)(F.lds + M2_DTV);
    const int lane = F.lane, hh = F.wave >> 1, half = F.wave & 1, h = 4 * gr + hh; const int fr = lane & 15, fq = lane >> 4;
    const float clast = cum[hh * 64 + 63];
    f32x4 acc[2][8];
#pragma unroll
    for (int i = 0; i < 2; ++i)
#pragma unroll
        for (int j = 0; j < 8; ++j) acc[i][j] = (f32x4){0.f, 0.f, 0.f, 0.f};
#pragma unroll
    for (int kk = 0; kk < 2; ++kk) {
        float fj[8];
#pragma unroll
        for (int e = 0; e < 8; ++e) { const int j = 32 * kk + 8 * fq + e; fj[e] = dtv[hh * 64 + j] * __expf(clast - cum[hh * 64 + j]); }
        bf16x8 af[2];
#pragma unroll
        for (int pi = 0; pi < 2; ++pi) { const int p = 16 * (2 * half + pi) + fr; const u32x4 raw = *(const LAS u32x4*)(XT + (64 * hh + p) * LDT + 32 * kk + 8 * fq);
            u32x4 w; w.x = pk2(lo16(raw.x) * fj[0], hi16(raw.x) * fj[1]); w.y = pk2(lo16(raw.y) * fj[2], hi16(raw.y) * fj[3]); w.z = pk2(lo16(raw.z) * fj[4], hi16(raw.z) * fj[5]); w.w = pk2(lo16(raw.w) * fj[6], hi16(raw.w) * fj[7]);
            af[pi] = __builtin_bit_cast(bf16x8, w); }
#pragma unroll
        for (int nt = 0; nt < 8; ++nt) { const bf16x8 bfr = ldfrag(BsT + (16 * nt + fr) * LDT + 32 * kk + 8 * fq);
#pragma unroll
            for (int pi = 0; pi < 2; ++pi) acc[pi][nt] = __builtin_amdgcn_mfma_f32_16x16x32_bf16(af[pi], bfr, acc[pi][nt], 0, 0, 0); }
    }
    bf16* S = WSP(bf16, WS_M2S) + ((((size_t)b * 128 + c) * 8 + h) * 64) * 128;
#pragma unroll
    for (int pi = 0; pi < 2; ++pi)
#pragma unroll
        for (int nt = 0; nt < 8; ++nt)
#pragma unroll
            for (int e = 0; e < 4; ++e) S[(size_t)(16 * (2 * half + pi) + 4 * fq + e) * 128 + 16 * nt + fr] = (bf16)f2bf(acc[pi][nt][e]);
    if (half == 0 && lane == 0) WSP(float, WS_M2D)[((size_t)b * 128 + c) * 8 + h] = __expf(clast);
    __syncthreads();
}
__device__ __forceinline__ void m2_carry(Frame& F) {
    const int gt = F.blk * NTHR + F.tid, stride = F.G * NTHR, NE = NB * 8 * 8192;
    int vz; asm volatile("v_mov_b32 %0, 0" : "=v"(vz));
    for (int e0 = gt; e0 < NE; e0 += 2 * stride) {
        const int e1 = (e0 + stride < NE) ? e0 + stride : e0; const bool two = e1 != e0;
        bf16* S0 = WSP(bf16, WS_M2S) + (((size_t)(e0 >> 16) * 128) * 8 + ((e0 >> 13) & 7)) * 8192 + (e0 & 8191); const float* D0 = WSP(const float, WS_M2D) + (size_t)(e0 >> 16) * 128 * 8 + ((e0 >> 13) & 7) + vz;
        bf16* S1 = WSP(bf16, WS_M2S) + (((size_t)(e1 >> 16) * 128) * 8 + ((e1 >> 13) & 7)) * 8192 + (e1 & 8191); const float* D1 = WSP(const float, WS_M2D) + (size_t)(e1 >> 16) * 128 * 8 + ((e1 >> 13) & 7) + vz;
        float run0 = 0.f, run1 = 0.f;
#pragma unroll 1
        for (int c0 = 0; c0 < 128; c0 += 16) {
            bf16 t0[16], t1[16]; float d0[16], d1[16];
#pragma unroll
            for (int j = 0; j < 16; ++j) { t0[j] = S0[(size_t)(c0 + j) * 8 * 8192]; d0[j] = D0[(c0 + j) * 8]; t1[j] = S1[(size_t)(c0 + j) * 8 * 8192]; d1[j] = D1[(c0 + j) * 8]; }
#pragma unroll
            for (int j = 0; j < 16; ++j) { S0[(size_t)(c0 + j) * 8 * 8192] = (bf16)f2bf(run0); run0 = d0[j] * run0 + bf2f(t0[j]);
                if (two) S1[(size_t)(c0 + j) * 8 * 8192] = (bf16)f2bf(run1); run1 = d1[j] * run1 + bf2f(t1[j]); }
        }
    }
}
__device__ __forceinline__ void m2_pass2(Frame& F, int l, int task) {
    const int b = task >> 8, c = (task >> 1) & 127, gr = task & 1;
    m2_stage(F, l, b, c, gr);
    LAS bf16* Cs = (LAS bf16*)(F.lds + M2_CS); LAS bf16* Bs = (LAS bf16*)(F.lds + M2_BS); LAS bf16* XT = (LAS bf16*)(F.lds + M2_XT);
    LAS float* Gs = (LAS float*)(F.lds + M2_GS); LAS float* cum = (LAS float*)(F.lds + M2_CUM); LAS float* dtv = (LAS float*)(F.lds + M2_DTV);
    const int lane = F.lane, w = F.wave, fr = lane & 15, fq = lane >> 4;
#pragma unroll
    for (int q = 0; q < 2; ++q) { const int tile = 2 * w + q, it = tile >> 2, jt = tile & 3; f32x4 a = (f32x4){0.f, 0.f, 0.f, 0.f};
#pragma unroll
        for (int kk = 0; kk < 4; ++kk) a = __builtin_amdgcn_mfma_f32_16x16x32_bf16(ldfrag(Cs + (16 * it + fr) * LDP + 32 * kk + 8 * fq), ldfrag(Bs + (16 * jt + fr) * LDP + 32 * kk + 8 * fq), a, 0, 0, 0);
#pragma unroll
        for (int e = 0; e < 4; ++e) Gs[(16 * it + 4 * fq + e) * LDG + 16 * jt + fr] = a[e]; }
    __syncthreads();
    const int hh = w >> 1, half = w & 1, h = 4 * gr + hh;
    f32x4 accd[2][4], acco[2][4];
#pragma unroll
    for (int i = 0; i < 2; ++i)
#pragma unroll
        for (int j = 0; j < 4; ++j) { accd[i][j] = (f32x4){0.f, 0.f, 0.f, 0.f}; acco[i][j] = (f32x4){0.f, 0.f, 0.f, 0.f}; }
#pragma unroll
    for (int ii = 0; ii < 2; ++ii) { const int it = 2 * half + ii; const int i = 16 * it + fr; const float ci = cum[hh * 64 + i];
#pragma unroll
        for (int kk = 0; kk < 2; ++kk) { if (32 * kk > 16 * it + 15) continue;
            float wv[8];
#pragma unroll
            for (int e = 0; e < 8; ++e) { const int j = 32 * kk + 8 * fq + e; const float gv = Gs[i * LDG + j]; wv[e] = (j <= i) ? gv * __expf(ci - cum[hh * 64 + j]) * dtv[hh * 64 + j] : 0.f; }
            u32x4 ww; ww.x = pk2(wv[0], wv[1]); ww.y = pk2(wv[2], wv[3]); ww.z = pk2(wv[4], wv[5]); ww.w = pk2(wv[6], wv[7]);
            const bf16x8 af = __builtin_bit_cast(bf16x8, ww);
#pragma unroll
            for (int pt = 0; pt < 4; ++pt) accd[ii][pt] = __builtin_amdgcn_mfma_f32_16x16x32_bf16(af, ldfrag(XT + (64 * hh + 16 * pt + fr) * LDT + 32 * kk + 8 * fq), accd[ii][pt], 0, 0, 0); } }
    const bf16* S = WSP(const bf16, WS_M2S) + ((((size_t)b * 128 + c) * 8 + h) * 64) * 128;
#pragma unroll
    for (int kk = 0; kk < 4; ++kk) {
        bf16x8 bfr[4];
#pragma unroll
        for (int pt = 0; pt < 4; ++pt) bfr[pt] = *(const bf16x8*)(S + (size_t)(16 * pt + fr) * 128 + 32 * kk + 8 * fq);
#pragma unroll
        for (int ii = 0; ii < 2; ++ii) { const bf16x8 af = ldfrag(Cs + (16 * (2 * half + ii) + fr) * LDP + 32 * kk + 8 * fq);
#pragma unroll
            for (int pt = 0; pt < 4; ++pt) acco[ii][pt] = __builtin_amdgcn_mfma_f32_16x16x32_bf16(af, bfr[pt], acco[ii][pt], 0, 0, 0); }
    }
    const float dpar = INP(23)[l * 8 + h]; const size_t row0 = (size_t)b * SEQ + (size_t)c * 64;
#pragma unroll
    for (int ii = 0; ii < 2; ++ii)
#pragma unroll
        for (int e = 0; e < 4; ++e) { const int i = 16 * (2 * half + ii) + 4 * fq + e; const float ec = __expf(cum[hh * 64 + i]);
#pragma unroll
            for (int pt = 0; pt < 4; ++pt) { const int p = 16 * pt + fr;
                float y = accd[ii][pt][e] + ec * acco[ii][pt][e] + dpar * bf2f(XT[(64 * hh + p) * LDT + i]);
                const float z = bf2f(WSP(const bf16, WS_PROJ)[(row0 + i) * MIXP + PC_M2Z + 64 * h + p]);
                WSP(float, WS_M2Y)[(row0 + i) * 512 + 64 * h + p] = y * siluf_(z); } }
    __syncthreads();
}
__device__ __forceinline__ void m2_norm(Frame& F, int l, int gw, int ngw) {
    f32x4 g0 = *(const f32x4*)(INP(24) + l * 512 + 8 * F.lane), g1 = *(const f32x4*)(INP(24) + l * 512 + 8 * F.lane + 4);
    for (int m = gw; m < MTOK; m += ngw) { const f32x4* yp = (const f32x4*)(WSP(const float, WS_M2Y) + (size_t)m * 512 + 8 * F.lane); const f32x4 a = yp[0], b = yp[1];
        const float ss = wave_sum((a.x * a.x + a.y * a.y) + (a.z * a.z + a.w * a.w) + (b.x * b.x + b.y * b.y) + (b.z * b.z + b.w * b.w));
        const float rs = 1.0f / sqrtf(ss * (1.f / 512.f) + 1e-6f);
        u32x4 w; w.x = pk2(a.x * rs * g0.x, a.y * rs * g0.y); w.y = pk2(a.z * rs * g0.z, a.w * rs * g0.w); w.z = pk2(b.x * rs * g1.x, b.y * rs * g1.y); w.w = pk2(b.z * rs * g1.z, b.w * rs * g1.w);
        *(u32x4*)(WSP(bf16, WS_YK) + (size_t)2 * MTOK * 512 + (size_t)m * 512 + 8 * F.lane) = w; }
}

constexpr int RP_LDA = 72, RP_LDB = 104;
#define RWP_WFRAG(dst, base, ldrow) do { const float* p_ = (base); u32x4 w_; w_.x = pk2(p_[0], p_[512]); w_.y = pk2(p_[1024], p_[1536]); w_.z = pk2(p_[2048], p_[2560]); w_.w = pk2(p_[3072], p_[3584]); dst = __builtin_bit_cast(bf16x8, w_); } while (0)
__device__ __forceinline__ void rw_pre(Frame& F, int l, int task) {
    LAS bf16* SM0 = (LAS bf16*)F.lds;
    const int tid = F.tid, lane = F.lane, hh = F.wave, fr = lane & 15, fq = lane >> 4;
    const float* mu = INP(25) + (size_t)l * RWC;
    const size_t rowb = (size_t)task * 128;
    const bf16* P = WSP(const bf16, WS_PROJ);
    const bool nofirst = (rowb & (SEQ - 1)) != 0;
    const int c4 = 64 * hh + 4 * fr;
    {
        bf16x8 Bw[4], Ba[4];
#pragma unroll
        for (int ct = 0; ct < 4; ++ct) { RWP_WFRAG(Bw[ct], INP(27) + ((size_t)l * 32 + 8 * fq) * 512 + c4 + ct, 512); RWP_WFRAG(Ba[ct], INP(29) + ((size_t)l * 32 + 8 * fq) * 512 + c4 + ct, 512); }
        const float* pw0 = INP(26) + l * 512 + c4; const float* pa0 = INP(28) + l * 512 + c4; const float* pkk = INP(31) + l * 512 + c4; const float* pka = INP(32) + l * 512 + c4; const float* prk = INP(33) + l * 512 + c4;
        const int sj = tid & 63, st0 = tid >> 6, st1 = 8 + (tid >> 6); const float smu = mu[1536 + sj];
        const bf16* sq = P + rowb * MIXP + PC_RW + 1536 + sj;
        bf16 sc0, sp0, sc1, sp1;
        u32x2 rkv[4][3], rkvp[3];
        const bf16* rq = P + (rowb + 4 * fq) * MIXP + PC_RW + c4;
#define RWP_STAGE_LOAD(sb) do { const size_t o_ = (size_t)((sb) * 16) * MIXP; sc0 = sq[o_ + (size_t)st0 * MIXP]; sc1 = sq[o_ + (size_t)st1 * MIXP]; sp1 = sq[o_ + (size_t)(st1 - 1) * MIXP]; \
            sp0 = (nofirst || (sb) > 0 || st0 > 0) ? sq[o_ + (size_t)st0 * MIXP - MIXP] : (bf16)0; } while (0)
#define RWP_STAGE_WRITE(buf) do { { const float pt_ = bf2f(sc0), pp_ = bf2f(sp0); const float pm_ = pt_ + (pp_ - pt_) * smu; SM0[(buf) * 1664 + st0 * RP_LDA + sj] = (bf16)f2bf(sj < 32 ? (1.0f - 2.0f * rcpf_(__expf(2.0f * pm_) + 1.0f)) : pm_); } \
            { const float pt_ = bf2f(sc1), pp_ = bf2f(sp1); const float pm_ = pt_ + (pp_ - pt_) * smu; SM0[(buf) * 1664 + st1 * RP_LDA + sj] = (bf16)f2bf(sj < 32 ? (1.0f - 2.0f * rcpf_(__expf(2.0f * pm_) + 1.0f)) : pm_); } } while (0)
#define RWP_RKV_LOAD(sb, cur, prev) do { const bf16* q_ = rq + (size_t)((sb) * 16) * MIXP; \
            _Pragma("unroll") for (int e_ = 0; e_ < 4; ++e_) _Pragma("unroll") for (int a_ = 0; a_ < 3; ++a_) cur[e_][a_] = *(const u32x2*)(q_ + (size_t)e_ * MIXP + 512 * a_); \
            const bool hp_ = nofirst || (sb) > 0 || fq > 0; \
            _Pragma("unroll") for (int a_ = 0; a_ < 3; ++a_) prev[a_] = hp_ ? *(const u32x2*)(q_ - (ptrdiff_t)MIXP + 512 * a_) : (u32x2){0u, 0u}; } while (0)
        RWP_STAGE_LOAD(0); RWP_RKV_LOAD(0, rkv, rkvp); RWP_STAGE_WRITE(0);
        __syncthreads();
#pragma unroll 1
        for (int sb = 0; sb < 8; ++sb) {
            if (sb < 7) { RWP_STAGE_LOAD(sb + 1); }
            const LAS bf16* SM = SM0 + (sb & 1) * 1664;
            const bf16x8 Aw = ldfrag(SM + fr * RP_LDA + 8 * fq), Aa = ldfrag(SM + fr * RP_LDA + 32 + 8 * fq);
            f32x4 aw[4], aa[4];
#pragma unroll
            for (int ct = 0; ct < 4; ++ct) { const f32x4 z = (f32x4){0.f, 0.f, 0.f, 0.f};
                aw[ct] = __builtin_amdgcn_mfma_f32_16x16x32_bf16(Aw, Bw[ct], z, 0, 0, 0); aa[ct] = __builtin_amdgcn_mfma_f32_16x16x32_bf16(Aa, Ba[ct], z, 0, 0, 0); }
            const size_t r0 = rowb + sb * 16 + 4 * fq;
            asm volatile("" ::: "memory");
            const f32x4 mu_r = *(const f32x4*)(mu + c4), mu_k = *(const f32x4*)(mu + 512 + c4), mu_v = *(const f32x4*)(mu + 1024 + c4);
            const f32x4 w0c = *(const f32x4*)pw0, a0c = *(const f32x4*)pa0, kkc = *(const f32x4*)pkk, kac = *(const f32x4*)pka, rkc = *(const f32x4*)prk;
#pragma unroll
            for (int e = 0; e < 4; ++e) { const size_t row = r0 + e; const size_t o = row * 512 + c4;
                const u32x2 pr_ = e == 0 ? rkvp[0] : rkv[e > 0 ? e - 1 : 0][0], pk_ = e == 0 ? rkvp[1] : rkv[e > 0 ? e - 1 : 0][1], pv_ = e == 0 ? rkvp[2] : rkv[e > 0 ? e - 1 : 0][2];
                const float rc[4] = {lo16(rkv[e][0].x), hi16(rkv[e][0].x), lo16(rkv[e][0].y), hi16(rkv[e][0].y)}, rp[4] = {lo16(pr_.x), hi16(pr_.x), lo16(pr_.y), hi16(pr_.y)};
                const float kc[4] = {lo16(rkv[e][1].x), hi16(rkv[e][1].x), lo16(rkv[e][1].y), hi16(rkv[e][1].y)}, kp[4] = {lo16(pk_.x), hi16(pk_.x), lo16(pk_.y), hi16(pk_.y)};
                const float vc[4] = {lo16(rkv[e][2].x), hi16(rkv[e][2].x), lo16(rkv[e][2].y), hi16(rkv[e][2].y)}, vp[4] = {lo16(pv_.x), hi16(pv_.x), lo16(pv_.y), hi16(pv_.y)};
                float rr[4], kpr[4], vv[4], kk[4], av[4], dec[4]; float ssp = 0.f, bonp = 0.f;
#pragma unroll
                for (int ct = 0; ct < 4; ++ct) {
                    rr[ct] = rc[ct] + (rp[ct] - rc[ct]) * mu_r[ct]; const float k = kc[ct] + (kp[ct] - kc[ct]) * mu_k[ct]; vv[ct] = vc[ct] + (vp[ct] - vc[ct]) * mu_v[ct];
                    const float wlog = -softplusf_(-(aw[ct][e] + w0c[ct])) - 0.5f; dec[ct] = __expf(-__expf(wlog)); av[ct] = sigmoidf_(aa[ct][e] + a0c[ct]);
                    kk[ct] = k * kkc[ct]; ssp += kk[ct] * kk[ct]; kpr[ct] = k * (1.0f + (av[ct] - 1.0f) * kac[ct]); bonp += rr[ct] * kpr[ct] * rkc[ct]; }
                const float ss = row16_sum(ssp), bon = row16_sum(bonp); const float rn = __builtin_amdgcn_rsqf(fmaxf(ss, 1e-24f));
                u32x2 w;
                w.x = pk2(rr[0], rr[1]); w.y = pk2(rr[2], rr[3]); *(u32x2*)(WSP(bf16, WS_RW_R) + o) = w;
                w.x = pk2(kpr[0], kpr[1]); w.y = pk2(kpr[2], kpr[3]); *(u32x2*)(WSP(bf16, WS_RW_K) + o) = w;
                w.x = pk2(vv[0], vv[1]); w.y = pk2(vv[2], vv[3]); *(u32x2*)(WSP(bf16, WS_RW_V) + o) = w;
                w.x = pk2(-kk[0] * rn, -kk[1] * rn); w.y = pk2(-kk[2] * rn, -kk[3] * rn); *(u32x2*)(WSP(bf16, WS_RW_A) + o) = w;
                w.x = pk2(kk[0] * rn * av[0], kk[1] * rn * av[1]); w.y = pk2(kk[2] * rn * av[2], kk[3] * rn * av[3]); *(u32x2*)(WSP(bf16, WS_RW_B) + o) = w;
                *(f32x4*)(WSP(float, WS_RW_DEC) + o) = (f32x4){dec[0], dec[1], dec[2], dec[3]};
                if (fr == 0) WSP(float, WS_RW_BON)[row * 8 + hh] = bon; }
            if (sb < 7) { RWP_RKV_LOAD(sb + 1, rkv, rkvp); RWP_STAGE_WRITE((sb + 1) & 1); }
            __syncthreads();
        }
#undef RWP_STAGE_LOAD
#undef RWP_STAGE_WRITE
#undef RWP_RKV_LOAD
    }
    {
        int tidb = F.tid; asm volatile("" : "+v"(tidb));
        const int tid = tidb, lane = tid & 63, fr = lane & 15, fq = lane >> 4; const int c4 = 64 * hh + 4 * fr;
        bf16x8 Bg[4][3];
#pragma unroll
        for (int ct = 0; ct < 4; ++ct)
#pragma unroll
            for (int kk = 0; kk < 3; ++kk) RWP_WFRAG(Bg[ct][kk], INP(30) + ((size_t)l * 96 + 32 * kk + 8 * fq) * 512 + c4 + ct, 512);
        int stk[3], sjj[3]; float smv[3]; bf16 sc[3], sp[3];
#pragma unroll
        for (int i = 0; i < 3; ++i) { const int idx = tid + 512 * i; stk[i] = idx / 96; sjj[i] = idx % 96; smv[i] = mu[1600 + sjj[i]]; }
        const bf16* sq = P + rowb * MIXP + PC_RW + 1600;
#define RWP_STAGE_LOAD(sb) do { _Pragma("unroll") for (int i_ = 0; i_ < 3; ++i_) { const bf16* q_ = sq + (size_t)((sb) * 16 + stk[i_]) * MIXP + sjj[i_]; sc[i_] = q_[0]; \
            sp[i_] = (nofirst || (sb) > 0 || stk[i_] > 0) ? *(q_ - (ptrdiff_t)MIXP) : (bf16)0; } } while (0)
#define RWP_STAGE_WRITE(buf) do { _Pragma("unroll") for (int i_ = 0; i_ < 3; ++i_) { const float pt_ = bf2f(sc[i_]), pp_ = bf2f(sp[i_]); \
            SM0[(buf) * 1664 + stk[i_] * RP_LDB + sjj[i_]] = (bf16)f2bf(sigmoidf_(pt_ + (pp_ - pt_) * smv[i_])); } } while (0)
        RWP_STAGE_LOAD(0); RWP_STAGE_WRITE(0);
        __syncthreads();
#pragma unroll 1
        for (int sb = 0; sb < 8; ++sb) {
            if (sb < 7) RWP_STAGE_LOAD(sb + 1);
            const LAS bf16* SM = SM0 + (sb & 1) * 1664;
            const bf16x8 Ag0 = ldfrag(SM + fr * RP_LDB + 8 * fq), Ag1 = ldfrag(SM + fr * RP_LDB + 32 + 8 * fq), Ag2 = ldfrag(SM + fr * RP_LDB + 64 + 8 * fq);
            f32x4 ag[4];
#pragma unroll
            for (int ct = 0; ct < 4; ++ct) { f32x4 g = __builtin_amdgcn_mfma_f32_16x16x32_bf16(Ag0, Bg[ct][0], (f32x4){0.f, 0.f, 0.f, 0.f}, 0, 0, 0);
                g = __builtin_amdgcn_mfma_f32_16x16x32_bf16(Ag1, Bg[ct][1], g, 0, 0, 0); ag[ct] = __builtin_amdgcn_mfma_f32_16x16x32_bf16(Ag2, Bg[ct][2], g, 0, 0, 0); }
            const size_t r0 = rowb + sb * 16 + 4 * fq;
#pragma unroll
            for (int e = 0; e < 4; ++e) { u32x2 w; w.x = pk2(ag[0][e], ag[1][e]); w.y = pk2(ag[2][e], ag[3][e]); *(u32x2*)(WSP(bf16, WS_RW_G) + (r0 + e) * 512 + c4) = w; }
            if (sb < 7) RWP_STAGE_WRITE((sb + 1) & 1);
            __syncthreads();
        }
#undef RWP_STAGE_LOAD
#undef RWP_STAGE_WRITE
    }
}
constexpr int RC_G1 = 0, RC_G2 = 8192, RC_Q1 = 10240, RC_Q2 = 12288, RC_GAM = 13312, RC_VT = 13568, RC_BYTES = 16384;
constexpr size_t WS_RWC = WS_PROJ;
constexpr int CP_IMG = 0, CP_MAT = 9216, CP_P2 = 13568, CP_Q2 = 14656;
constexpr int CP_P1I = 0, CP_BGI = 3072, CP_Q1I = 6144;
__device__ __forceinline__ void rw_chunk_prep(Frame& F, int task) {
    int lane = F.lane; asm volatile("" : "+v"(lane)); const int fr = lane & 15, fq = lane >> 4; const int b = task >> 12, h = (task >> 9) & 7, c = task & 511;
    LAS unsigned char* wl = F.lds + F.wave * WAVE_LDS;
    LAS bf16* IMG = (LAS bf16*)(wl + CP_IMG); LAS float* MAT = (LAS float*)(wl + CP_MAT); LAS float* P2m = (LAS float*)(wl + CP_P2); LAS float* Q2m = (LAS float*)(wl + CP_Q2);
    unsigned char* rec = F.ws + WS_RWC + (size_t)task * RC_BYTES;
    const size_t e0 = ((size_t)b * SEQ + (size_t)c * 16) * 512 + 64 * h + lane;
    float At[16], Bt[16], Kt[16], Rt[16]; float gT;
    { float wv[16]; bf16 av[16], bv[16], kv[16], rv[16];
#pragma unroll
      for (int t = 0; t < 16; ++t) { const size_t o = e0 + (size_t)t * 512; wv[t] = WSP(const float, WS_RW_DEC)[o]; av[t] = WSP(const bf16, WS_RW_A)[o]; bv[t] = WSP(const bf16, WS_RW_B)[o]; kv[t] = WSP(const bf16, WS_RW_K)[o]; rv[t] = WSP(const bf16, WS_RW_R)[o]; }
      float g = 1.0f;
#pragma unroll
      for (int t = 0; t < 16; ++t) { const float gp = g; g *= wv[t]; const float inv = rcpf_(g);
          At[t] = bf2f(av[t]) * gp; Bt[t] = bf2f(bv[t]) * inv; Kt[t] = bf2f(kv[t]) * inv; Rt[t] = bf2f(rv[t]) * g;
          IMG[0 * 1152 + t * 72 + lane] = (bf16)f2bf(At[t]); IMG[1 * 1152 + t * 72 + lane] = (bf16)f2bf(Bt[t]); IMG[2 * 1152 + t * 72 + lane] = (bf16)f2bf(Kt[t]); IMG[3 * 1152 + t * 72 + lane] = (bf16)f2bf(Rt[t]); }
      gT = g; }
    { unsigned vp[8];
#pragma unroll
      for (int t = 0; t < 16; t += 2) vp[t >> 1] = (unsigned)WSP(const bf16, WS_RW_V)[e0 + (size_t)t * 512] | ((unsigned)WSP(const bf16, WS_RW_V)[e0 + (size_t)(t + 1) * 512] << 16);
      u32x4* d = (u32x4*)(rec + RC_VT + lane * 32); d[0] = (u32x4){vp[0], vp[1], vp[2], vp[3]}; d[1] = (u32x4){vp[4], vp[5], vp[6], vp[7]};
      ((float*)(rec + RC_GAM))[lane] = gT; }
    { f32x4 nab = (f32x4){0.f, 0.f, 0.f, 0.f}, nak = nab, mbr = nab, mkr = nab;
#pragma unroll
      for (int kk = 0; kk < 2; ++kk) { const int o = fr * 72 + 32 * kk + 8 * fq;
          const bf16x8 fa = ldfrag(IMG + 0 * 1152 + o), fb = ldfrag(IMG + 1 * 1152 + o), fk = ldfrag(IMG + 2 * 1152 + o), frr = ldfrag(IMG + 3 * 1152 + o);
          nab = __builtin_amdgcn_mfma_f32_16x16x32_bf16(fb, fa, nab, 0, 0, 0); nak = __builtin_amdgcn_mfma_f32_16x16x32_bf16(fk, fa, nak, 0, 0, 0);
          mbr = __builtin_amdgcn_mfma_f32_16x16x32_bf16(fb, frr, mbr, 0, 0, 0); mkr = __builtin_amdgcn_mfma_f32_16x16x32_bf16(fk, frr, mkr, 0, 0, 0); }
#pragma unroll
      for (int e = 0; e < 4; ++e) { const int s_ = 4 * fq + e, t_ = fr; const int o = s_ * 17 + t_;
          MAT[0 * 272 + o] = s_ < t_ ? nab[e] : 0.f; MAT[1 * 272 + o] = s_ < t_ ? nak[e] : 0.f; MAT[2 * 272 + o] = s_ <= t_ ? mbr[e] : 0.f; MAT[3 * 272 + o] = s_ <= t_ ? mkr[e] : 0.f; } }
    float P1[16], P2[16];
#pragma unroll
    for (int t = 0; t < 16; ++t) { float p1 = At[t], p2 = MAT[1 * 272 + fr * 17 + t];
#pragma unroll
        for (int s_ = 0; s_ < t; ++s_) { const float n = MAT[0 * 272 + s_ * 17 + t]; p1 += P1[s_] * n; p2 += P2[s_] * n; }
        P1[t] = p1; P2[t] = p2; asm volatile("" ::: "memory"); }
    LAS bf16* Q1I = (LAS bf16*)(wl + CP_Q1I);
#pragma unroll
    for (int t = 0; t < 16; ++t) { float q1 = Rt[t], q2 = MAT[3 * 272 + fr * 17 + t];
#pragma unroll
        for (int s_ = 0; s_ <= t; ++s_) { const float m = MAT[2 * 272 + s_ * 17 + t]; q1 += P1[s_] * m; q2 += P2[s_] * m; }
        Q1I[t * 72 + lane] = (bf16)f2bf(q1); if (lane < 16) { Q2m[lane * 17 + t] = q2; P2m[lane * 17 + t] = P2[t]; }
        asm volatile("" ::: "memory"); }
    { LAS bf16* P1I = (LAS bf16*)(wl + CP_P1I); LAS bf16* BGI = (LAS bf16*)(wl + CP_BGI);
      u32x4 w0, w1;
      w0.x = pk2(P1[0], P1[1]); w0.y = pk2(P1[2], P1[3]); w0.z = pk2(P1[4], P1[5]); w0.w = pk2(P1[6], P1[7]); w1.x = pk2(P1[8], P1[9]); w1.y = pk2(P1[10], P1[11]); w1.z = pk2(P1[12], P1[13]); w1.w = pk2(P1[14], P1[15]);
      *(LAS u32x4*)(P1I + lane * 24) = w0; *(LAS u32x4*)(P1I + lane * 24 + 8) = w1;
      w0.x = pk2(Bt[0] * gT, Bt[1] * gT); w0.y = pk2(Bt[2] * gT, Bt[3] * gT); w0.z = pk2(Bt[4] * gT, Bt[5] * gT); w0.w = pk2(Bt[6] * gT, Bt[7] * gT);
      w1.x = pk2(Bt[8] * gT, Bt[9] * gT); w1.y = pk2(Bt[10] * gT, Bt[11] * gT); w1.z = pk2(Bt[12] * gT, Bt[13] * gT); w1.w = pk2(Bt[14] * gT, Bt[15] * gT);
      *(LAS u32x4*)(BGI + lane * 24) = w0; *(LAS u32x4*)(BGI + lane * 24 + 8) = w1;
      const u32x4 z4 = (u32x4){0u, 0u, 0u, 0u};
      bf16x8 Af[4], Bf[4];
#pragma unroll
      for (int i = 0; i < 4; ++i) { u32x4 ta = z4, tb = z4; if (fq < 2) { ta = *(const LAS u32x4*)(P1I + (16 * i + fr) * 24 + 8 * fq); tb = *(const LAS u32x4*)(BGI + (16 * i + fr) * 24 + 8 * fq); }
          Af[i] = __builtin_bit_cast(bf16x8, ta); Bf[i] = __builtin_bit_cast(bf16x8, tb); }
#pragma unroll
      for (int j = 0; j < 4; ++j)
#pragma unroll
          for (int s_ = 0; s_ < 2; ++s_) { const f32x4 lo = __builtin_amdgcn_mfma_f32_16x16x32_bf16(Af[2 * s_], Bf[j], (f32x4){0.f, 0.f, 0.f, 0.f}, 0, 0, 0);
              const f32x4 hi = __builtin_amdgcn_mfma_f32_16x16x32_bf16(Af[2 * s_ + 1], Bf[j], (f32x4){0.f, 0.f, 0.f, 0.f}, 0, 0, 0);
              u32x4 w; w.x = pk2(lo[0], lo[1]); w.y = pk2(lo[2], lo[3]); w.z = pk2(hi[0], hi[1]); w.w = pk2(hi[2], hi[3]);
              *(u32x4*)(rec + RC_G1 + ((j * 2 + s_) * 64 + lane) * 16) = w; } }
    { float g2v[16];
#pragma unroll
      for (int t = 0; t < 16; ++t) { float acc = Kt[t];
#pragma unroll
          for (int s_ = 0; s_ < 16; ++s_) acc += P2m[t * 17 + s_] * Bt[s_];
          g2v[t] = acc * gT; asm volatile("" ::: "memory"); }
      u32x4 w0, w1; w0.x = pk2(g2v[0], g2v[1]); w0.y = pk2(g2v[2], g2v[3]); w0.z = pk2(g2v[4], g2v[5]); w0.w = pk2(g2v[6], g2v[7]); w1.x = pk2(g2v[8], g2v[9]); w1.y = pk2(g2v[10], g2v[11]); w1.z = pk2(g2v[12], g2v[13]); w1.w = pk2(g2v[14], g2v[15]);
      u32x4* d = (u32x4*)(rec + RC_G2 + lane * 32); d[0] = w0; d[1] = w1; }
    {
#pragma unroll
      for (int s_ = 0; s_ < 2; ++s_) { const u32x2 lo = *(const LAS u32x2*)(Q1I + fr * 72 + 32 * s_ + 4 * fq), hi = *(const LAS u32x2*)(Q1I + fr * 72 + 32 * s_ + 16 + 4 * fq);
          *(u32x4*)(rec + RC_Q1 + (s_ * 64 + lane) * 16) = (u32x4){lo.x, lo.y, hi.x, hi.y}; } }
    { u32x4 w = (u32x4){0u, 0u, 0u, 0u};
      if (fq < 2) { float q[8];
#pragma unroll
          for (int j = 0; j < 8; ++j) q[j] = Q2m[(8 * fq + j) * 17 + fr];
          w.x = pk2(q[0], q[1]); w.y = pk2(q[2], q[3]); w.z = pk2(q[4], q[5]); w.w = pk2(q[6], q[7]); }
      *(u32x4*)(rec + RC_Q2 + lane * 16) = w; }
}
__device__ __forceinline__ void rw_chunk_step(const LAS unsigned char* rc, f32x4 (&X)[4], float* yo, int w, int lane, int fr, int fq) {
    const u32x4 z4 = (u32x4){0u, 0u, 0u, 0u};
    u32x4 b0, b1; b0.x = pk2(X[0][0], X[0][1]); b0.y = pk2(X[0][2], X[0][3]); b0.z = pk2(X[1][0], X[1][1]); b0.w = pk2(X[1][2], X[1][3]);
    b1.x = pk2(X[2][0], X[2][1]); b1.y = pk2(X[2][2], X[2][3]); b1.z = pk2(X[3][0], X[3][1]); b1.w = pk2(X[3][2], X[3][3]);
    const bf16x8 Bx0 = __builtin_bit_cast(bf16x8, b0), Bx1 = __builtin_bit_cast(bf16x8, b1);
    u32x4 vt = z4; if (fq < 2) vt = *(const LAS u32x4*)(rc + RC_VT + (16 * w + fr) * 32 + 16 * fq);
    const bf16x8 Vf = __builtin_bit_cast(bf16x8, vt);
    f32x4 Y = (f32x4){0.f, 0.f, 0.f, 0.f};
    Y = __builtin_amdgcn_mfma_f32_16x16x32_bf16(*(const LAS bf16x8*)(rc + RC_Q1 + (0 * 64 + lane) * 16), Bx0, Y, 0, 0, 0);
    Y = __builtin_amdgcn_mfma_f32_16x16x32_bf16(*(const LAS bf16x8*)(rc + RC_Q1 + (1 * 64 + lane) * 16), Bx1, Y, 0, 0, 0);
    Y = __builtin_amdgcn_mfma_f32_16x16x32_bf16(*(const LAS bf16x8*)(rc + RC_Q2 + lane * 16), Vf, Y, 0, 0, 0);
#pragma unroll
    for (int j = 0; j < 4; ++j) { const f32x4 gm = *(const LAS f32x4*)(rc + RC_GAM + (16 * j + 4 * fq) * 4);
        f32x4 C = X[j] * gm;
        C = __builtin_amdgcn_mfma_f32_16x16x32_bf16(*(const LAS bf16x8*)(rc + RC_G1 + ((j * 2 + 0) * 64 + lane) * 16), Bx0, C, 0, 0, 0);
        C = __builtin_amdgcn_mfma_f32_16x16x32_bf16(*(const LAS bf16x8*)(rc + RC_G1 + ((j * 2 + 1) * 64 + lane) * 16), Bx1, C, 0, 0, 0);
        u32x4 g2 = z4; if (fq < 2) g2 = *(const LAS u32x4*)(rc + RC_G2 + (16 * j + fr) * 32 + 16 * fq);
        C = __builtin_amdgcn_mfma_f32_16x16x32_bf16(__builtin_bit_cast(bf16x8, g2), Vf, C, 0, 0, 0);
        X[j] = C; }
#pragma unroll
    for (int e = 0; e < 4; ++e) yo[(size_t)(4 * fq + e) * 512] = Y[e];
}
__device__ __forceinline__ void rw_scan2(Frame& F, int task) {
    const int tid = F.tid, lane = F.lane, w = F.wave, fr = lane & 15, fq = lane >> 4;
    const unsigned char* recs = F.ws + WS_RWC + (size_t)task * 512 * RC_BYTES;
    constexpr int NP = SEQ / 32;
    if (w >= 4) {
        const int lt = tid - 256;
        const u32x4* src = (const u32x4*)recs + lt;
        u32x4 rg[4][8];
#pragma unroll
        for (int u = 0; u < 4; ++u)
#pragma unroll
            for (int i = 0; i < 8; ++i) rg[u][i] = src[(size_t)u * 2048 + i * 256];
#pragma unroll 1
        for (int g4 = 0; g4 < NP / 4; ++g4) {
#pragma unroll
            for (int u = 0; u < 4; ++u) { const int g = 4 * g4 + u;
                LAS u32x4* dst = (LAS u32x4*)(F.lds + ((2 * g) & 7) * RC_BYTES) + lt;
#pragma unroll
                for (int i = 0; i < 8; ++i) dst[i * 256] = rg[u][i];
                if (g + 4 < NP) {
#pragma unroll
                    for (int i = 0; i < 8; ++i) rg[u][i] = src[(size_t)(g + 4) * 2048 + i * 256]; }
                __syncthreads(); }
        }
        __syncthreads();
    } else {
        const int b = task >> 3, h = task & 7;
        f32x4 X[4];
#pragma unroll
        for (int j = 0; j < 4; ++j) X[j] = (f32x4){0.f, 0.f, 0.f, 0.f};
        float* yo = WSP(float, WS_RW_Y) + ((size_t)b * SEQ) * 512 + 64 * h + 16 * w + fr;
        __syncthreads();
#pragma unroll 1
        for (int g = 0; g < NP; ++g) {
            rw_chunk_step(F.lds + ((2 * g) & 7) * RC_BYTES, X, yo + (size_t)(2 * g) * 16 * 512, w, lane, fr, fq);
            rw_chunk_step(F.lds + ((2 * g + 1) & 7) * RC_BYTES, X, yo + (size_t)(2 * g + 1) * 16 * 512, w, lane, fr, fq);
            __syncthreads();
        }
    }
}
__device__ __forceinline__ void rw_post(Frame& F, int l, int gw, int ngw) {
    const int lane = F.lane;
    const f32x4 g0 = *(const f32x4*)(INP(34) + l * 512 + 8 * lane), g1 = *(const f32x4*)(INP(34) + l * 512 + 8 * lane + 4);
    const f32x4 b0 = *(const f32x4*)(INP(35) + l * 512 + 8 * lane), b1 = *(const f32x4*)(INP(35) + l * 512 + 8 * lane + 4);
    for (int m = gw; m < MTOK; m += ngw) { const size_t o = (size_t)m * 512 + 8 * lane;
        const f32x4 ya = *(const f32x4*)(WSP(const float, WS_RW_Y) + o), yb = *(const f32x4*)(WSP(const float, WS_RW_Y) + o + 4);
        float y[8] = {ya.x, ya.y, ya.z, ya.w, yb.x, yb.y, yb.z, yb.w};
        float s = 0.f;
#pragma unroll
        for (int j = 0; j < 8; ++j) s += y[j];
        s += __shfl_xor(s, 1); s += __shfl_xor(s, 2); s += __shfl_xor(s, 4); const float mean = s * (1.f / 64.f);
        float qv = 0.f;
#pragma unroll
        for (int j = 0; j < 8; ++j) { y[j] -= mean; qv += y[j] * y[j]; }
        qv += __shfl_xor(qv, 1); qv += __shfl_xor(qv, 2); qv += __shfl_xor(qv, 4); const float rs = 1.0f / sqrtf(qv * (1.f / 64.f) + 64e-5f);
        const u32x4 vr = *(const u32x4*)(WSP(const bf16, WS_RW_V) + o), gr_ = *(const u32x4*)(WSP(const bf16, WS_RW_G) + o);
        const float bon = WSP(const float, WS_RW_BON)[(size_t)m * 8 + (lane >> 3)];
        const float vv[8] = {lo16(vr.x), hi16(vr.x), lo16(vr.y), hi16(vr.y), lo16(vr.z), hi16(vr.z), lo16(vr.w), hi16(vr.w)};
        const float gg[8] = {lo16(gr_.x), hi16(gr_.x), lo16(gr_.y), hi16(gr_.y), lo16(gr_.z), hi16(gr_.z), lo16(gr_.w), hi16(gr_.w)};
        const float lg[8] = {g0.x, g0.y, g0.z, g0.w, g1.x, g1.y, g1.z, g1.w}, lb[8] = {b0.x, b0.y, b0.z, b0.w, b1.x, b1.y, b1.z, b1.w};
        float ov[8];
#pragma unroll
        for (int j = 0; j < 8; ++j) ov[j] = (y[j] * rs * lg[j] + lb[j] + bon * vv[j]) * gg[j];
        u32x4 w; w.x = pk2(ov[0], ov[1]); w.y = pk2(ov[2], ov[3]); w.z = pk2(ov[4], ov[5]); w.w = pk2(ov[6], ov[7]);
        *(u32x4*)(WSP(bf16, WS_YK) + (size_t)3 * MTOK * 512 + o) = w; }
}

#ifndef GATE_NA
#define GATE_NA 17
#endif
#ifndef PHMASK
#define PHMASK 0xFFFFFFFFu
#endif
#define PH(n) (((PHMASK) >> (n)) & 1u)
#ifndef REPMASK
#define REPMASK 0u
#endif
#define NREP(n) ((((REPMASK) >> (n)) & 1u) ? 2 : 1)
#ifndef TPSMASK
#define TPSMASK 0u
#endif
#define TPS_B(n) unsigned long long tps_##n = 0ull; if (((TPSMASK) >> (n)) & 1u) tps_##n = __builtin_amdgcn_s_memrealtime()
#define TPS_E(n) do { if (((TPSMASK) >> (n)) & 1u) { const unsigned long long t1_ = __builtin_amdgcn_s_memrealtime(); const unsigned long long d_ = t1_ - tps_##n; while (__builtin_amdgcn_s_memrealtime() - t1_ < d_) __builtin_amdgcn_s_sleep(8); } } while (0)
#ifndef TPMASK
#define TPMASK 0u
#endif
#define TP(n) do { if (((TPMASK) >> (n)) & 1u) { const unsigned long long t1_ = __builtin_amdgcn_s_memrealtime(); const unsigned long long d_ = t1_ - tp0; while (__builtin_amdgcn_s_memrealtime() - t1_ < d_) __builtin_amdgcn_s_sleep(8); tp0 = __builtin_amdgcn_s_memrealtime(); } else if (TPMASK) tp0 = __builtin_amdgcn_s_memrealtime(); } while (0)
template <class T> __device__ __forceinline__ T* launder_ptr(T* p) { const unsigned long long w = (unsigned long long)p; unsigned lo = __builtin_amdgcn_readfirstlane((unsigned)w), hi = __builtin_amdgcn_readfirstlane((unsigned)(w >> 32));
    asm volatile("" : "+s"(lo), "+s"(hi)); return (T*)(GAS T*)(((unsigned long long)hi << 32) | lo); }
#define PHASE_BEGIN() do { F.ws = launder_ptr(F.ws); F.out = launder_ptr(F.out); { unsigned la_ = __builtin_amdgcn_readfirstlane((unsigned)(size_t)F.lds); int bk_ = __builtin_amdgcn_readfirstlane(F.blk); asm volatile("" : "+s"(la_), "+s"(bk_)); F.lds = (LAS unsigned char*)(size_t)la_; F.blk = bk_; } { int wv_ = __builtin_amdgcn_readfirstlane(F.wave); asm volatile("" : "+s"(wv_)); F.wave = wv_; } F.tid = F.wave * 64 + (int)__builtin_amdgcn_mbcnt_hi(~0u, __builtin_amdgcn_mbcnt_lo(~0u, 0u)); asm volatile("" : "+v"(F.tid)); F.lane = F.tid & 63; } while (0)
__global__ void __launch_bounds__(NTHR, 2) hybrid_fwd(Args args) {
    extern __shared__ __attribute__((aligned(16))) unsigned char lds_raw[];
    Frame F;
    F.lds = (LAS unsigned char*)lds_raw; F.out = args.out; F.ws = args.ws;
    F.tid = threadIdx.x; F.lane = F.tid & 63; F.wave = __builtin_amdgcn_readfirstlane(F.tid >> 6); F.blk = blockIdx.x; F.G = gridDim.x;
    volatile LAS unsigned* MISC = (volatile LAS unsigned*)(F.lds + LDS_MISC);
    if (F.tid < 64) MISC[F.tid] = 0u;
    if (F.tid < 45) { const unsigned long long p = ((const __attribute__((address_space(4))) unsigned long long*)__builtin_amdgcn_kernarg_segment_ptr())[F.tid]; MISC[64 + 2 * F.tid] = (unsigned)p; MISC[64 + 2 * F.tid + 1] = (unsigned)(p >> 32); }
    __syncthreads();
    XcdBarrier bar = xcd_barrier_post((unsigned*)(F.ws + WS_CTL) + CW_BAR, MISC + 8);
#define gw (F.blk * NWAVES + F.wave)
#define NGW (F.G * NWAVES)
#define glds (F.lds)

    unsigned long long tp0 = TPMASK ? __builtin_amdgcn_s_memrealtime() : 0ull;
#pragma unroll 1
    for (int l = 0; l < DEPTH; ++l) {
        const float* xin = (l == 0) ? INP(0) : F.out;
        PHASE_BEGIN();
        for (int rep_ = 0; rep_ < NREP(0); ++rep_) if (PH(0)) { convert_weights(F, l);
            for (int nb = F.blk; nb < NGATE / 32 + 2 * (FF / 32); nb += F.G) {
                const int seg = nb < NGATE / 32 ? 0 : (nb < NGATE / 32 + FF / 32 ? 1 : 2);
                const float* Wp = seg == 0 ? INP(2) + (size_t)l * DM * INC : (seg == 1 ? INP(39) : INP(40)) + (size_t)l * DM * FF;
                signed char* W8p = seg == 0 ? WSP(signed char, WS_WIN) + (size_t)MIXP * DM * 2 : (seg == 1 ? WSP(signed char, WS_WFG) : WSP(signed char, WS_WFU));
                convert_cols_i8(F, Wp, seg == 0 ? INC : FF, seg == 0 ? MIXC : 0, nb - (seg == 0 ? 0 : (seg == 1 ? NGATE / 32 : NGATE / 32 + FF / 32)), W8p, WSP(float, WS_SB) + 16384 * seg, 0); }
            { const float* cw = INP(41) + (size_t)l * 3 * FF; const float* cb = INP(42) + (size_t)l * FF;
              for (int c = F.blk * 512 + F.tid; c < FF; c += F.G * 512) { WSP(unsigned, WS_SB)[65536 + c] = pk2(cw[c], cw[FF + c]); WSP(unsigned, WS_SB)[65536 + 8192 + c] = pk2(cw[2 * FF + c], cb[c]); } } }
        PHASE_BEGIN();
        for (int rep_ = 0; rep_ < NREP(1); ++rep_) if (PH(1)) rmsnorm_rows(F, l == 0 ? INP(0) : nullptr, (const bf16*)F.out, INP(1) + (size_t)l * DM, WSP(bf16, WS_H), nullptr, WSP(unsigned, WS_A8), WSP(float, WS_SA));
        xcd_barrier(bar); TP(0);
        PHASE_BEGIN();
        for (int rep_ = 0; rep_ < NREP(2); ++rep_) if (PH(2)) { pg8::Gemm g{WSP(const bf16, WS_H), WSP(const bf16, WS_WIN), MTOK, MIXP, DM}; pg8::StaticOrder S; S.init(MTOK, MIXP, F.G, F.blk);
          pg8::EpiStore<0> E{WSP(bf16, WS_PROJ), MIXP}; pg8::gemm_phase(glds, g, S, E, F.tid); }
        PHASE_BEGIN();
        if (PH(2) && F.blk >= 128) {
          pg8::Gemm g{WSP(const bf16, WS_A8), (const bf16*)(WSP(const signed char, WS_WIN) + (size_t)MIXP * DM * 2), MTOK, NGATE, DM / 2};
          pg8::SplitOrder S; S.init(MTOK, NGATE, 128, F.blk - 128, 4096 - 256, 2);
          pg8::EpiGateU8 E{WSP(unsigned char, WS_GATES), WSP(const float, WS_SA), WSP(const float, WS_SB)}; pg8::gemm_phase(glds, g, S, E, F.tid); }
        xcd_barrier(bar); TP(1);
        PHASE_BEGIN();
        TPS_B(3); for (int rep_ = 0; rep_ < NREP(3); ++rep_) if (PH(3)) for (int t = F.blk; t < MTOK / 128; t += F.G) rw_pre(F, l, t); TPS_E(3);
        PHASE_BEGIN();
        TPS_B(4); for (int rep_ = 0; rep_ < NREP(4); ++rep_) if (PH(4)) for (int t = F.blk; t < 1024; t += F.G) m2_pass1(F, l, t); TPS_E(4);
        PHASE_BEGIN();
        TPS_B(5); for (int rep_ = 0; rep_ < NREP(5); ++rep_) if (PH(5)) for (int t = gw; t < 8192; t += NGW) s5_task<false>(F, l, t); TPS_E(5);
        PHASE_BEGIN();
        TPS_B(6); for (int rep_ = 0; rep_ < NREP(6); ++rep_) if (PH(6)) for (int t = gw; t < 2048; t += NGW) lru_task<false>(F, l, t); TPS_E(6);
        xcd_barrier(bar); TP(2);
        PHASE_BEGIN();
        for (int rep_ = 0; rep_ < NREP(7); ++rep_) if (PH(7)) m2_carry(F);
        PHASE_BEGIN();
        for (int rep_ = 0; rep_ < NREP(8); ++rep_) if (PH(8)) for (int t = gw; t < 128; t += NGW) s5_carry(F, l, t);
        PHASE_BEGIN();
        for (int rep_ = 0; rep_ < NREP(9); ++rep_) if (PH(9)) for (int t = NGW - 1 - gw; t < 32; t += NGW) lru_carry(F, t);
        xcd_barrier(bar); TP(3);
        PHASE_BEGIN();
        TPS_B(10); for (int rep_ = 0; rep_ < NREP(10); ++rep_) if (PH(10)) for (int t = F.blk; t < 1024; t += F.G) m2_pass2(F, l, t); TPS_E(10);
        PHASE_BEGIN();
        TPS_B(11); for (int rep_ = 0; rep_ < NREP(11); ++rep_) if (PH(11)) for (int t = gw; t < 8192; t += NGW) s5_task<true>(F, l, t); TPS_E(11);
        PHASE_BEGIN();
        TPS_B(12); for (int rep_ = 0; rep_ < NREP(12); ++rep_) if (PH(12)) for (int t = gw; t < 2048; t += NGW) lru_task<true>(F, l, t); TPS_E(12);
        xcd_barrier(bar); TP(4);
        PHASE_BEGIN();
        for (int rep_ = 0; rep_ < NREP(14); ++rep_) if (PH(14)) {
            { pg8::Gemm g{WSP(const bf16, WS_S5Z), WSP(const bf16, WS_WGLU), MTOK, 512, 512}; pg8::StaticOrder S; S.init(MTOK, 512, F.G, F.blk);
              pg8::EpiGlu E{WSP(const bf16, WS_S5Z), WSP(bf16, WS_YK)}; pg8::gemm_phase(glds, g, S, E, F.tid); }
            m2_norm(F, l, gw, NGW);
        }
        PHASE_BEGIN();
        TPS_B(24); for (int rep_ = 0; rep_ < NREP(24); ++rep_) if (PH(24)) for (int t = gw; t < NB * 8 * 512; t += NGW) rw_chunk_prep(F, t); TPS_E(24);
        xcd_barrier(bar); TP(5);
        PHASE_BEGIN();
        if (F.blk < 32) { if (PH(13)) rw_scan2(F, F.blk); }
        PHASE_BEGIN();
        if (PH(16)) { pg8::Gemm g{WSP(const bf16, WS_A8), (const bf16*)(WSP(const signed char, WS_WIN) + (size_t)MIXP * DM * 2), MTOK, NGATE, DM / 2};
          pg8::SplitOrder S; if (F.blk >= 32) S.init(MTOK, NGATE, 224, F.blk - 32, 0, GATE_NA); else S.init(MTOK, NGATE, 32, F.blk, 224 * GATE_NA, (4096 - 256 - 224 * GATE_NA) / 32);
          pg8::EpiGateU8 E{WSP(unsigned char, WS_GATES), WSP(const float, WS_SA), WSP(const float, WS_SB)}; pg8::gemm_phase(glds, g, S, E, F.tid); }
        xcd_barrier(bar); TP(6);
        PHASE_BEGIN();
        for (int rep_ = 0; rep_ < NREP(15); ++rep_) if (PH(15)) rw_post(F, l, gw, NGW);
        xcd_barrier(bar); TP(7);
        PHASE_BEGIN();
        for (int rep_ = 0; rep_ < NREP(17); ++rep_) if (PH(17)) { pg8::Gemm g{WSP(const bf16, WS_YK), WSP(const bf16, WS_WPK), 4 * MTOK, 4 * DM, 512}; pg8::OrderYK S{F.G, F.blk};
          pg8::EpiGateAcc E{WSP(const unsigned char, WS_GATES), WSP(bf16, WS_MERGED)}; pg8::gemm_phase(glds, g, S, E, F.tid); }
        xcd_barrier(bar); TP(8);
        PHASE_BEGIN();
        for (int rep_ = 0; rep_ < NREP(18); ++rep_) if (PH(18)) { pg8::Gemm g{WSP(const bf16, WS_MERGED), WSP(const bf16, WS_WOUT), MTOK, DM, DM}; pg8::StaticOrder S; S.init(MTOK, DM, F.G, F.blk);
          pg8::EpiAddX E{l == 0 ? INP(0) : nullptr, (const bf16*)F.out, (bf16*)F.out, DM}; pg8::gemm_phase(glds, g, S, E, F.tid); }
        xcd_barrier(bar); TP(9);
        PHASE_BEGIN();
        for (int rep_ = 0; rep_ < NREP(19); ++rep_) if (PH(19)) rmsnorm_rows(F, nullptr, (const bf16*)F.out, INP(38) + (size_t)l * DM, nullptr, nullptr, WSP(unsigned, WS_A8), WSP(float, WS_SA));
        xcd_barrier(bar); TP(10);
        PHASE_BEGIN();
        for (int rep_ = 0; rep_ < NREP(20); ++rep_) if (PH(20)) { pg8::Gemm g{WSP(const bf16, WS_A8), WSP(const bf16, WS_WFG), MTOK, FF, DM / 2}; pg8::StaticOrder S; S.init(MTOK, FF, F.G, F.blk);
          pg8::EpiStoreI8<0> E{WSP(bf16, WS_FG), FF, WSP(const float, WS_SA), WSP(const float, WS_SB) + 16384}; pg8::gemm_phase(glds, g, S, E, F.tid); }
        xcd_barrier(bar); TP(11);
        PHASE_BEGIN();
        for (int rep_ = 0; rep_ < NREP(21); ++rep_) if (PH(21)) { pg8::Gemm g{WSP(const bf16, WS_A8), WSP(const bf16, WS_WFU), MTOK, FF, DM / 2}; pg8::StaticOrder S; S.init(MTOK, FF, F.G, F.blk);
          pg8::EpiFfnUp<true> E{WSP(const bf16, WS_FG), WSP(bf16, WS_HID), WSP(const unsigned, WS_SB) + 65536, WSP(const unsigned, WS_SB) + 65536 + 8192, WSP(const float, WS_SA), WSP(const float, WS_SB) + 32768}; pg8::gemm_phase(glds, g, S, E, F.tid); }
        xcd_barrier(bar); TP(12);
        PHASE_BEGIN();
        for (int rep_ = 0; rep_ < NREP(22); ++rep_) if (PH(22)) { pg8::Gemm g{WSP(const bf16, WS_HID), WSP(const bf16, WS_WFD), MTOK, DM, FF}; pg8::StaticOrder S; S.init(MTOK, DM, F.G, F.blk);
          pg8::EpiAddX E{nullptr, (const bf16*)F.out, l == DEPTH - 1 ? WSP(bf16, WS_H) : (bf16*)F.out, DM}; pg8::gemm_phase(glds, g, S, E, F.tid); }
        xcd_barrier(bar); TP(13);
    }
    PHASE_BEGIN();
    for (int rep_ = 0; rep_ < NREP(23); ++rep_) if (PH(23)) rmsnorm_rows(F, nullptr, WSP(const bf16, WS_H), INP(44), nullptr, F.out);
}

extern "C" void kernel_launch(void* const* d_in, const int* in_sizes, int n_in, void* d_out, int out_size, void* d_ws, size_t ws_size, hipStream_t stream) {
    static int grid = 0;
    if (grid == 0) {
        if (n_in != 45 || in_sizes[0] != MTOK * DM || out_size != MTOK * DM || ws_size < WS_END) {
            fprintf(stderr, "kernel_launch: unexpected shapes/workspace (n_in %d, in0 %d, out %d, ws %zu, need %zu); nothing launched\n", n_in, n_in > 0 ? in_sizes[0] : -1, out_size, ws_size, (size_t)WS_END); grid = -1; return; }
        int dev = 0, cus = 0, per_cu = 0;
        if (hipGetDevice(&dev) != hipSuccess || hipDeviceGetAttribute(&cus, hipDeviceAttributeMultiprocessorCount, dev) != hipSuccess) { grid = -1; return; }
        if (hipFuncSetAttribute((const void*)hybrid_fwd, hipFuncAttributeMaxDynamicSharedMemorySize, LDS_BYTES) != hipSuccess) { fprintf(stderr, "kernel_launch: hipFuncSetAttribute failed\n"); grid = -1; return; }
        if (hipOccupancyMaxActiveBlocksPerMultiprocessor(&per_cu, (const void*)hybrid_fwd, NTHR, LDS_BYTES) != hipSuccess || per_cu < 1) { fprintf(stderr, "kernel_launch: occupancy query says %d\n", per_cu); }
        (void)hipGetLastError();
        grid = cus;
        if (grid != 256) fprintf(stderr, "kernel_launch: note: %d CUs\n", grid);
    }
    if (grid < 0) return;
    if (hipMemsetAsync((char*)d_ws + WS_CTL, 0, CTL_BYTES, stream) != hipSuccess) return;
    Args a{};
    for (int i = 0; i < 45; ++i) a.in[i] = (const float*)d_in[i];
    a.out = (float*)d_out; a.ws = (unsigned char*)d_ws;
    hipLaunchKernelGGL(hybrid_fwd, dim3(grid), dim3(NTHR), LDS_BYTES, stream, a);
}
```

```cpp
#include <hip/hip_runtime.h>
#include <cstdio>
#include <cstdint>

#define LAS __attribute__((address_space(3)))
typedef unsigned short bf16;
typedef short bf16x8 __attribute__((ext_vector_type(8)));
typedef float f32x4 __attribute__((ext_vector_type(4)));
typedef float f32x2 __attribute__((ext_vector_type(2)));
typedef unsigned u32x4 __attribute__((ext_vector_type(4)));
typedef unsigned u32x2 __attribute__((ext_vector_type(2)));
typedef __bf16 bf16v2 __attribute__((ext_vector_type(2)));
typedef int i32x4 __attribute__((ext_vector_type(4)));

constexpr int NB = 4, SEQ = 8192, DM = 2048, MTOK = NB * SEQ, DEPTH = 4;
constexpr int MIXC = 4776, MIXP = 4864, INC = 12968, FF = 6144, NGATE = 8192;
constexpr int RWC = 1696;
constexpr int PC_S5U = 0, PC_LRX = 512, PC_LRG = 1024, PC_M2Z = 1536, PC_XBC = 2048, PC_DT = 3072, PC_RW = 3080;

constexpr size_t MiB = 1u << 20;
constexpr size_t WS_CTL = 0, CTL_BYTES = 1 * MiB;
constexpr size_t WS_WIN = 1 * MiB, WS_WPK = 52 * MiB, WS_WOUT = 60 * MiB, WS_WFG = 68 * MiB, WS_WFU = 92 * MiB, WS_WFD = 116 * MiB, WS_WGLU = 140 * MiB;
constexpr size_t WS_SA = 141 * MiB, WS_SB = 142 * MiB;
constexpr size_t WS_A8 = 1538 * MiB;
constexpr size_t WS_H = 144 * MiB, WS_YK = 272 * MiB, WS_PROJ = 400 * MiB, WS_MERGED = 400 * MiB, WS_GATES = 900 * MiB;
constexpr size_t WS_RW_R = 1216 * MiB, WS_RW_K = 1248 * MiB, WS_RW_V = 1280 * MiB, WS_RW_A = 1312 * MiB, WS_RW_B = 1344 * MiB, WS_RW_G = 1376 * MiB,
                 WS_RW_DEC = 1408 * MiB, WS_RW_Y = 1472 * MiB, WS_RW_BON = 1536 * MiB, WS_END = 1602 * MiB;
constexpr size_t WS_S5Z = 704 * MiB, WS_S5E = 736 * MiB, WS_S5I = 740 * MiB, WS_LRE = 744 * MiB, WS_LRA = 745 * MiB, WS_LRI = 746 * MiB;
constexpr size_t WS_M2S = 752 * MiB, WS_M2D = 816 * MiB, WS_M2Y = 820 * MiB;
constexpr size_t WS_FG = 400 * MiB, WS_HID = 784 * MiB;
constexpr int CW_BAR = 4096;

__device__ __forceinline__ float bf2f(bf16 b) { return __uint_as_float(((unsigned)b) << 16); }
__device__ __forceinline__ unsigned f2bf(float f) { const __bf16 b = (__bf16)f; return (unsigned)__builtin_bit_cast(unsigned short, b); }
__device__ __forceinline__ unsigned pk2(float lo, float hi) { const f32x2 v = {lo, hi}; const bf16v2 b = __builtin_convertvector(v, bf16v2); return __builtin_bit_cast(unsigned, b); }
__device__ __forceinline__ float lo16(unsigned w) { return __uint_as_float(w << 16); }
__device__ __forceinline__ float hi16(unsigned w) { return __uint_as_float(w & 0xffff0000u); }
__device__ __forceinline__ float rcpf_(float x) { return __builtin_amdgcn_rcpf(x); }
__device__ __forceinline__ float sigmoidf_(float x) { return rcpf_(1.0f + __expf(-x)); }
__device__ __forceinline__ float siluf_(float x) { return x * rcpf_(1.0f + __expf(-x)); }
__device__ __forceinline__ float geluf_(float x) { const float u = 0.7978845608028654f * (x + 0.044715f * x * x * x); return x * rcpf_(1.0f + __expf(-2.0f * u)); }
__device__ __forceinline__ float softplusf_(float x) { return fmaxf(x, 0.f) + __logf(1.0f + __expf(-fabsf(x))); }
__device__ __forceinline__ float row16_sum(float v) {
    v += __int_as_float(__builtin_amdgcn_update_dpp(0, __float_as_int(v), 0x128, 0xf, 0xf, true));
    v += __int_as_float(__builtin_amdgcn_update_dpp(0, __float_as_int(v), 0x124, 0xf, 0xf, true));
    v += __int_as_float(__builtin_amdgcn_update_dpp(0, __float_as_int(v), 0x122, 0xf, 0xf, true));
    v += __int_as_float(__builtin_amdgcn_update_dpp(0, __float_as_int(v), 0x121, 0xf, 0xf, true));
    return v;
}
__device__ __forceinline__ float wave_sum(float v) {
    v = row16_sum(v);
    const float a = __int_as_float(__builtin_amdgcn_readlane(__float_as_int(v), 0)), b = __int_as_float(__builtin_amdgcn_readlane(__float_as_int(v), 16));
    const float c = __int_as_float(__builtin_amdgcn_readlane(__float_as_int(v), 32)), d = __int_as_float(__builtin_amdgcn_readlane(__float_as_int(v), 48));
    return (a + b) + (c + d);
}
__device__ __forceinline__ float wave_max(float v) {
    v = fmaxf(v, __int_as_float(__builtin_amdgcn_update_dpp(0, __float_as_int(v), 0x128, 0xf, 0xf, true)));
    v = fmaxf(v, __int_as_float(__builtin_amdgcn_update_dpp(0, __float_as_int(v), 0x124, 0xf, 0xf, true)));
    v = fmaxf(v, __int_as_float(__builtin_amdgcn_update_dpp(0, __float_as_int(v), 0x122, 0xf, 0xf, true)));
    v = fmaxf(v, __int_as_float(__builtin_amdgcn_update_dpp(0, __float_as_int(v), 0x121, 0xf, 0xf, true)));
    const float a = __int_as_float(__builtin_amdgcn_readlane(__float_as_int(v), 0)), b = __int_as_float(__builtin_amdgcn_readlane(__float_as_int(v), 16));
    const float c = __int_as_float(__builtin_amdgcn_readlane(__float_as_int(v), 32)), d = __int_as_float(__builtin_amdgcn_readlane(__float_as_int(v), 48));
    return fmaxf(fmaxf(a, b), fmaxf(c, d));
}
__device__ __forceinline__ unsigned q8x4(float a, float b, float c, float d, float inv) {
    const int q0 = (int)rintf(a * inv), q1 = (int)rintf(b * inv), q2 = (int)rintf(c * inv), q3 = (int)rintf(d * inv);
    return (unsigned)(q0 & 0xff) | ((unsigned)(q1 & 0xff) << 8) | ((unsigned)(q2 & 0xff) << 16) | ((unsigned)q3 << 24);
}
__device__ __forceinline__ float rdlane(float v, int l) { return __int_as_float(__builtin_amdgcn_readlane(__float_as_int(v), l)); }

namespace pg8 {
constexpr int BM = 256, BK = 64, HALF = 128, HTB = HALF * BK * 2, STAGE_BYTES = 8 * HTB, NXCD = 8, WGM = 4;
__host__ __device__ __forceinline__ int lds_byte(int r, int c) { const int st = (r >> 4) * 2 + (c >> 5), rr = r & 15, cc = c & 31, ob = rr * 64 + cc * 2; return st * 1024 + (ob ^ (((ob >> 9) & 1) << 5)); }
__host__ __device__ __forceinline__ void stage_rc(int b, int& R, int& C) { const int st = b / 1024, sb = b % 1024, swz = sb ^ (((sb >> 9) & 1) << 5); R = (st >> 1) * 16 + swz / 64; C = (st & 1) * 32 + (swz % 64) / 2; }
__host__ __device__ __forceinline__ int perm32(int rho) { const int n = rho >> 4, i = rho & 15; return 8 * (i >> 2) + 4 * n + (i & 3); }
struct Unit { int pm, pn; };
struct Gemm { const bf16* A; const bf16* Bt; int M, N, K; };
struct StaticOrder {
    int nM, nN, nwg, G, c;
    __device__ void init(int M, int N, int G_, int c_) { nM = M / BM; nN = N / BM; nwg = nM * nN; G = G_; c = c_; }
    __device__ bool next(int i, Unit& u) const {
        const long L = (long)i * G + c; if (L >= nwg || c < 0) return false;
        int wgid = (int)L; { const int q = nwg / NXCD, r = nwg % NXCD, xcd = wgid % NXCD, off = wgid / NXCD; wgid = (xcd < r ? xcd * (q + 1) : r * (q + 1) + (xcd - r) * q) + off; }
        const int nig = WGM * nN, gid = wgid / nig, fm = gid * WGM, gsz = (nM - fm) < WGM ? (nM - fm) : WGM;
        u.pm = fm + ((wgid % nig) % gsz); u.pn = (wgid % nig) / gsz; return true;
    }
    __device__ __forceinline__ void a_ready(const Unit&) const {}
    __device__ __forceinline__ void done(const Unit&) const {}
};
struct SplitOrder {
    int nM, nN, nwg, G, c, base, n;
    __device__ void init(int M, int N, int G_, int c_, int base_, int n_) { nM = M / BM; nN = N / BM; nwg = nM * nN; G = G_; c = c_; base = base_; n = n_; }
    __device__ bool next(int i, Unit& u) const {
        if (i >= n) return false; const long L = (long)base + (long)i * G + c; if (L >= nwg) return false;
        int wgid = (int)L; { const int q = nwg / NXCD, r = nwg % NXCD, xcd = wgid % NXCD, off = wgid / NXCD; wgid = (xcd < r ? xcd * (q + 1) : r * (q + 1) + (xcd - r) * q) + off; }
        const int nig = WGM * nN, gid = wgid / nig, fm = gid * WGM, gsz = (nM - fm) < WGM ? (nM - fm) : WGM;
        u.pm = fm + ((wgid % nig) % gsz); u.pn = (wgid % nig) / gsz; return true;
    }
    __device__ __forceinline__ void a_ready(const Unit&) const {}
    __device__ __forceinline__ void done(const Unit&) const {}
};
struct OrderYK {
    int G, c;
    __device__ bool next(int i, Unit& u) const {
        const int k = i & 3; const long T = (long)(i >> 2) * G + c; if (T >= 1024) return false;
        int wgid = (int)T; { const int xcd = wgid % 8, off = wgid / 8; wgid = xcd * 128 + off; }
        const int gid = wgid / 32, fm = gid * 4; const int pm = fm + ((wgid % 32) % 4), pn = (wgid % 32) / 4;
        u.pm = k * 128 + pm; u.pn = k * 8 + pn; return true;
    }
    __device__ __forceinline__ void a_ready(const Unit&) const {}
    __device__ __forceinline__ void done(const Unit&) const {}
};
__device__ __forceinline__ unsigned cvt_pk_bf16(float lo, float hi) { return pk2(lo, hi); }

template <bool I8> struct AccOf { typedef f32x4 T; }; template <> struct AccOf<true> { typedef i32x4 T; };
template <int ACT> struct EpiStore {
    static constexpr bool I8 = false; static constexpr bool PERM = true;
    struct Pre {}; __device__ __forceinline__ void prefetch(Pre&, const Unit&, int, int, int, int) const {}
    bf16* O; int ldc;
    __device__ __forceinline__ void operator()(const f32x4 (&acc)[2][2][4][2], const Unit& u, int wr, int wc, int fr, int fq, const Pre&) const {
        const int row0 = u.pm * BM + wr * 64 + fr, col0 = u.pn * BM + wc * 32 + 8 * fq;
#pragma unroll
        for (int ai = 0; ai < 2; ++ai)
#pragma unroll
            for (int m = 0; m < 4; ++m) { bf16* rowp = O + (size_t)(row0 + ai * HALF + m * 16) * ldc + col0;
#pragma unroll
                for (int bj = 0; bj < 2; ++bj) { f32x4 v0 = acc[ai][bj][m][0], v1 = acc[ai][bj][m][1];
                    if (ACT == 1) {
#pragma unroll
                        for (int j = 0; j < 4; ++j) { v0[j] = sigmoidf_(v0[j]); v1[j] = sigmoidf_(v1[j]); } }
                    u32x4 w; w.x = cvt_pk_bf16(v0[0], v0[1]); w.y = cvt_pk_bf16(v0[2], v0[3]); w.z = cvt_pk_bf16(v1[0], v1[1]); w.w = cvt_pk_bf16(v1[2], v1[3]);
                    *(u32x4*)(rowp + bj * HALF) = w; } }
    }
};
template <int ACT> struct EpiStoreI8 {
    static constexpr bool I8 = true; static constexpr bool PERM = true;
    bf16* O; int ldc; const float* sa; const float* sb;
    struct Pre { float sav[4]; f32x4 s[2]; };
    __device__ __forceinline__ void prefetch(Pre& P, const Unit& u, int wr, int wc, int fr, int fq) const {
        const int row0 = u.pm * BM + wr * 64 + fr, col0 = u.pn * BM + wc * 32 + 8 * fq;
#pragma unroll
        for (int i = 0; i < 4; ++i) P.sav[i] = sa[row0 + i * 16];
        P.s[0] = *(const f32x4*)(sb + col0); P.s[1] = *(const f32x4*)(sb + col0 + 4);
    }
    __device__ __forceinline__ void operator()(const i32x4 (&acc)[2][2][4][2], const Unit& u, int wr, int wc, int fr, int fq, const Pre& P) const {
        const int row0 = u.pm * BM + wr * 64 + fr, col0 = u.pn * BM + wc * 32 + 8 * fq;
        float sav[8];
#pragma unroll
        for (int i = 0; i < 8; ++i) { sav[i] = i < 4 ? P.sav[i] : sa[row0 + HALF + (i & 3) * 16]; if (ACT == 1) sav[i] *= -1.4426950408889634f; }
        const f32x4 t0 = *(const f32x4*)(sb + col0 + HALF), t1 = *(const f32x4*)(sb + col0 + HALF + 4);
#pragma unroll
        for (int bj = 0; bj < 2; ++bj) { f32x4 s0 = P.s[0], s1 = P.s[1]; if (bj) { s0 = t0; s1 = t1; }
            const f32x2 sp[4] = {{s0[0], s0[1]}, {s0[2], s0[3]}, {s1[0], s1[1]}, {s1[2], s1[3]}};
#pragma unroll
            for (int ai = 0; ai < 2; ++ai)
#pragma unroll
                for (int m = 0; m < 4; ++m) { const float ra = sav[ai * 4 + m]; const f32x2 rav = {ra, ra}; const i32x4 a0 = acc[ai][bj][m][0], a1 = acc[ai][bj][m][1];
                    f32x2 x[4] = {{(float)a0[0], (float)a0[1]}, {(float)a0[2], (float)a0[3]}, {(float)a1[0], (float)a1[1]}, {(float)a1[2], (float)a1[3]}};
#pragma unroll
                    for (int p = 0; p < 4; ++p) { x[p] = x[p] * (sp[p] * rav);
                        if (ACT == 1) { f32x2 e = {__builtin_amdgcn_exp2f(x[p][0]), __builtin_amdgcn_exp2f(x[p][1])}; e = e + (f32x2){1.0f, 1.0f}; x[p][0] = rcpf_(e[0]); x[p][1] = rcpf_(e[1]); } }
                    u32x4 w; w.x = cvt_pk_bf16(x[0][0], x[0][1]); w.y = cvt_pk_bf16(x[1][0], x[1][1]); w.z = cvt_pk_bf16(x[2][0], x[2][1]); w.w = cvt_pk_bf16(x[3][0], x[3][1]);
                    *(u32x4*)(O + (size_t)(row0 + ai * HALF + m * 16) * ldc + col0 + bj * HALF) = w; } }
    }
};
struct EpiGateU8 {
    static constexpr bool I8 = true; static constexpr bool PERM = true;
    unsigned char* O; const float* sa; const float* sb;
    struct Pre { float sav[2]; f32x4 s[2]; };
    __device__ __forceinline__ void prefetch(Pre& P, const Unit& u, int wr, int wc, int fr, int fq) const {
        const int row0 = u.pm * BM + wr * 64 + fr, col0 = u.pn * BM + wc * 64 + 16 * fq;
#pragma unroll
        for (int i = 0; i < 2; ++i) P.sav[i] = sa[row0 + i * 16];
        P.s[0] = *(const f32x4*)(sb + col0); P.s[1] = *(const f32x4*)(sb + col0 + 4);
    }
    __device__ __forceinline__ void operator()(const i32x4 (&acc)[2][2][4][2], const Unit& u, int wr, int wc, int fr, int fq, const Pre& P) const {
        const int row0 = u.pm * BM + wr * 64 + fr, col0 = u.pn * BM + wc * 64 + 16 * fq;
        float sav[8];
#pragma unroll
        for (int i = 0; i < 8; ++i) sav[i] = (i < 2 ? P.sav[i] : sa[row0 + (i >> 2) * HALF + (i & 3) * 16]) * -1.4426950408889634f;
        const f32x4 t0 = *(const f32x4*)(sb + col0 + 8), t1 = *(const f32x4*)(sb + col0 + 12);
#pragma unroll
        for (int ai = 0; ai < 2; ++ai) { unsigned d[4][4];
#pragma unroll
            for (int bj = 0; bj < 2; ++bj) { f32x4 s0 = P.s[0], s1 = P.s[1]; if (bj) { s0 = t0; s1 = t1; }
                const f32x2 sp[4] = {{s0[0], s0[1]}, {s0[2], s0[3]}, {s1[0], s1[1]}, {s1[2], s1[3]}};
#pragma unroll
                for (int m = 0; m < 4; ++m) { const float ra = sav[ai * 4 + m]; const f32x2 rav = {ra, ra}; const i32x4 a0 = acc[ai][bj][m][0], a1 = acc[ai][bj][m][1];
                    f32x2 x[4] = {{(float)a0[0], (float)a0[1]}, {(float)a0[2], (float)a0[3]}, {(float)a1[0], (float)a1[1]}, {(float)a1[2], (float)a1[3]}};
                    unsigned tb[8];
#pragma unroll
                    for (int p = 0; p < 4; ++p) { x[p] = x[p] * (sp[p] * rav);
#pragma unroll
                        for (int h = 0; h < 2; ++h) { const float e = __builtin_amdgcn_exp2f(x[p][h]); const float r = rcpf_(e * (1.0f / 255.0f) + (1.0f / 255.0f));
                            tb[2 * p + h] = __float_as_uint(fmaxf(r, 1.0f) + 8388608.0f); } }
#pragma unroll
                    for (int n = 0; n < 2; ++n) { const unsigned w01 = __builtin_amdgcn_perm(tb[4 * n + 1], tb[4 * n], 0x0c0c0400u), w23 = __builtin_amdgcn_perm(tb[4 * n + 3], tb[4 * n + 2], 0x0c0c0400u);
                        d[m][2 * bj + n] = __builtin_amdgcn_perm(w23, w01, 0x05040100u); } }
                __builtin_amdgcn_sched_barrier(0); }
#pragma unroll
            for (int m = 0; m < 4; ++m) { u32x4 w; w.x = d[m][0]; w.y = d[m][1]; w.z = d[m][2]; w.w = d[m][3];
                *(u32x4*)(O + (size_t)(row0 + ai * HALF + m * 16) * NGATE + col0) = w; } }
    }
};
struct EpiAddX {
    static constexpr bool I8 = false; static constexpr bool PERM = true;
    struct Pre {}; __device__ __forceinline__ void prefetch(Pre&, const Unit&, int, int, int, int) const {}
    const float* basef; const bf16* baseb; bf16* out; int ldc;
    __device__ __forceinline__ void operator()(const f32x4 (&acc)[2][2][4][2], const Unit& u, int wr, int wc, int fr, int fq, const Pre&) const {
        const int row0 = u.pm * BM + wr * 64 + fr, col0 = u.pn * BM + wc * 32 + 8 * fq;
#pragma unroll
        for (int ai = 0; ai < 2; ++ai) { u32x4 w[4][2];
            if (!basef) {
#pragma unroll
                for (int m = 0; m < 4; ++m)
#pragma unroll
                    for (int bj = 0; bj < 2; ++bj) w[m][bj] = *(const u32x4*)(baseb + (size_t)(row0 + ai * HALF + m * 16) * ldc + col0 + bj * HALF); }
            asm volatile("" ::: "memory");
#pragma unroll
            for (int m = 0; m < 4; ++m)
#pragma unroll
                for (int bj = 0; bj < 2; ++bj) { const size_t p = (size_t)(row0 + ai * HALF + m * 16) * ldc + col0 + bj * HALF; f32x4 b0, b1;
                    if (basef) { b0 = *(const f32x4*)(basef + p); b1 = *(const f32x4*)(basef + p + 4); }
                    else { const u32x4 ww = w[m][bj]; b0 = (f32x4){lo16(ww.x), hi16(ww.x), lo16(ww.y), hi16(ww.y)}; b1 = (f32x4){lo16(ww.z), hi16(ww.z), lo16(ww.w), hi16(ww.w)}; }
                    b0 = b0 + acc[ai][bj][m][0]; b1 = b1 + acc[ai][bj][m][1];
                    u32x4 o; o.x = cvt_pk_bf16(b0[0], b0[1]); o.y = cvt_pk_bf16(b0[2], b0[3]); o.z = cvt_pk_bf16(b1[0], b1[1]); o.w = cvt_pk_bf16(b1[2], b1[3]);
                    *(u32x4*)(out + p) = o; }
            asm volatile("" ::: "memory"); }
    }
};
struct EpiGateAcc {
    static constexpr bool I8 = false; static constexpr bool PERM = true; static constexpr bool CHAIN = true;
    struct Pre {}; __device__ __forceinline__ void prefetch(Pre&, const Unit&, int, int, int, int) const {}
    const unsigned char* gates; bf16* merged;
    __device__ __forceinline__ bool is_last(const Unit& u) const { return (u.pn >> 3) == 3; }
    __device__ __forceinline__ void rescale(f32x4 (&acc)[2][2][4][2], const Unit& u, bool carry, int wr, int wc, int fr, int fq) const {
        const int k = u.pn >> 3, pn = u.pn & 7, pm = u.pm & 127;
        const int row0 = pm * BM + wr * 64 + fr, col0 = pn * BM + wc * 32 + 8 * fq;
#pragma unroll
        for (int ai = 0; ai < 2; ++ai) { u32x2 ga[4][2], gb[4][2];
#pragma unroll
            for (int m = 0; m < 4; ++m)
#pragma unroll
                for (int bj = 0; bj < 2; ++bj) { ga[m][bj] = (u32x2){0u, 0u}; gb[m][bj] = (u32x2){0x01010101u, 0x01010101u}; }
            if (carry) {
#pragma unroll
                for (int m = 0; m < 4; ++m)
#pragma unroll
                    for (int bj = 0; bj < 2; ++bj) { const unsigned char* gp = gates + (size_t)(row0 + ai * HALF + m * 16) * NGATE + k * DM + col0 + bj * HALF; ga[m][bj] = *(const u32x2*)gp; gb[m][bj] = *(const u32x2*)(gp + DM); } }
            asm volatile("" ::: "memory");
#pragma unroll
            for (int m = 0; m < 4; ++m)
#pragma unroll
                for (int bj = 0; bj < 2; ++bj) { const u32x2 a = ga[m][bj], b = gb[m][bj];
#pragma unroll
                    for (int n = 0; n < 2; ++n) { const unsigned aw = n ? a.y : a.x, bw = n ? b.y : b.x;
                        const f32x4 f = {(float)(aw & 0xffu) * rcpf_((float)(bw & 0xffu)), (float)((aw >> 8) & 0xffu) * rcpf_((float)((bw >> 8) & 0xffu)),
                                         (float)((aw >> 16) & 0xffu) * rcpf_((float)((bw >> 16) & 0xffu)), (float)(aw >> 24) * rcpf_((float)(bw >> 24))};
                        acc[ai][bj][m][n] = acc[ai][bj][m][n] * f; }
                    __builtin_amdgcn_sched_barrier(0); } }
    }
    __device__ __forceinline__ void operator()(const f32x4 (&acc)[2][2][4][2], const Unit& u, int wr, int wc, int fr, int fq, const Pre&) const {
        const int k = u.pn >> 3, pn = u.pn & 7, pm = u.pm & 127;
        const int row0 = pm * BM + wr * 64 + fr, col0 = pn * BM + wc * 32 + 8 * fq;
#pragma unroll
        for (int ai = 0; ai < 2; ++ai) { u32x2 g[4][2];
#pragma unroll
            for (int m = 0; m < 4; ++m)
#pragma unroll
                for (int bj = 0; bj < 2; ++bj) g[m][bj] = *(const u32x2*)(gates + (size_t)(row0 + ai * HALF + m * 16) * NGATE + k * DM + col0 + bj * HALF);
            asm volatile("" ::: "memory");
#pragma unroll
            for (int m = 0; m < 4; ++m)
#pragma unroll
                for (int bj = 0; bj < 2; ++bj) { const size_t r = (size_t)(row0 + ai * HALF + m * 16); const int c = col0 + bj * HALF;
                    const f32x4 v0 = acc[ai][bj][m][0], v1 = acc[ai][bj][m][1]; const u32x2 gg = g[m][bj];
                    float o[8];
                    o[0] = (float)(gg.x & 0xffu) * v0[0]; o[1] = (float)((gg.x >> 8) & 0xffu) * v0[1]; o[2] = (float)((gg.x >> 16) & 0xffu) * v0[2]; o[3] = (float)(gg.x >> 24) * v0[3];
                    o[4] = (float)(gg.y & 0xffu) * v1[0]; o[5] = (float)((gg.y >> 8) & 0xffu) * v1[1]; o[6] = (float)((gg.y >> 16) & 0xffu) * v1[2]; o[7] = (float)(gg.y >> 24) * v1[3];
                    u32x4 w; w.x = cvt_pk_bf16(o[0], o[1]); w.y = cvt_pk_bf16(o[2], o[3]); w.z = cvt_pk_bf16(o[4], o[5]); w.w = cvt_pk_bf16(o[6], o[7]);
                    *(u32x4*)(merged + r * DM + c) = w; } }
    }
};
struct EpiGlu {
    static constexpr bool I8 = false; static constexpr bool PERM = true;
    struct Pre {}; __device__ __forceinline__ void prefetch(Pre&, const Unit&, int, int, int, int) const {}
    const bf16* Z; bf16* O;
    __device__ __forceinline__ void operator()(const f32x4 (&acc)[2][2][4][2], const Unit& u, int wr, int wc, int fr, int fq, const Pre&) const {
        const int row0 = u.pm * BM + wr * 64 + fr, col0 = u.pn * BM + wc * 32 + 8 * fq;
#pragma unroll
        for (int ai = 0; ai < 2; ++ai)
#pragma unroll
            for (int m = 0; m < 4; ++m) { const size_t r = (size_t)(row0 + ai * HALF + m * 16);
#pragma unroll
                for (int bj = 0; bj < 2; ++bj) { const int c = col0 + bj * HALF;
                    const u32x4 z = *(const u32x4*)(Z + r * 512 + c);
                    const f32x4 v0 = acc[ai][bj][m][0], v1 = acc[ai][bj][m][1];
                    float o[8];
                    o[0] = lo16(z.x) * sigmoidf_(v0[0]); o[1] = hi16(z.x) * sigmoidf_(v0[1]); o[2] = lo16(z.y) * sigmoidf_(v0[2]); o[3] = hi16(z.y) * sigmoidf_(v0[3]);
                    o[4] = lo16(z.z) * sigmoidf_(v1[0]); o[5] = hi16(z.z) * sigmoidf_(v1[1]); o[6] = lo16(z.w) * sigmoidf_(v1[2]); o[7] = hi16(z.w) * sigmoidf_(v1[3]);
                    u32x4 w; w.x = cvt_pk_bf16(o[0], o[1]); w.y = cvt_pk_bf16(o[2], o[3]); w.z = cvt_pk_bf16(o[4], o[5]); w.w = cvt_pk_bf16(o[6], o[7]);
                    *(u32x4*)(O + r * 512 + c) = w; }
                asm volatile("" ::: "memory"); }
    }
};
template <bool I8_> struct EpiFfnUp {
    static constexpr bool I8 = I8_; static constexpr bool PERM = true;
    const bf16* G; bf16* O; const unsigned* w01; const unsigned* w2b; const float* sa; const float* sb;
    struct Pre {}; __device__ __forceinline__ void prefetch(Pre&, const Unit&, int, int, int, int) const {}
    __device__ __forceinline__ void operator()(const typename AccOf<I8_>::T (&acc)[2][2][4][2], const Unit& u, int wr, int wc, int fr, int fq, const Pre& P) const {
        const int rowb = u.pm * BM + wr * 64, col0 = u.pn * BM + wc * 32 + 8 * fq; const bool l15 = fr == 15, l14 = fr >= 14;
        u32x4 gb[2][3], wa[2], wb[2]; f32x4 sbv[2]; float sav[8];
#define FU_GLOAD(buf, k_) do { const int base_ = rowb + (((k_) >> 1) & 1) * HALF + 32 * ((k_) & 1), cc_ = col0 + ((k_) >> 2) * HALF; gb[buf][0] = (u32x4){0u, 0u, 0u, 0u}; \
            if (base_ & (SEQ - 1)) gb[buf][0] = *(const u32x4*)(G + (size_t)(base_ - 16 + fr) * FF + cc_); \
            gb[buf][1] = *(const u32x4*)(G + (size_t)(base_ + fr) * FF + cc_); gb[buf][2] = *(const u32x4*)(G + (size_t)(base_ + 16 + fr) * FF + cc_); } while (0)
#define FU_WLOAD(bj_) do { const int cc_ = col0 + (bj_) * HALF; wa[0] = *(const u32x4*)(w01 + cc_); wa[1] = *(const u32x4*)(w01 + cc_ + 4); wb[0] = *(const u32x4*)(w2b + cc_); wb[1] = *(const u32x4*)(w2b + cc_ + 4); \
            if constexpr (I8_) { sbv[0] = *(const f32x4*)(sb + cc_); sbv[1] = *(const f32x4*)(sb + cc_ + 4); } } while (0)
        FU_GLOAD(0, 0); FU_WLOAD(0);
        if constexpr (I8_) {
#pragma unroll
            for (int i = 0; i < 8; ++i) sav[i] = sa[rowb + fr + (i >> 2) * HALF + (i & 3) * 16]; }
#pragma unroll
        for (int k = 0; k < 8; ++k) { const int bj = k >> 2, ai = (k >> 1) & 1, mh = k & 1, cur = k & 1; const int c = col0 + bj * HALF;
            if (k < 7) FU_GLOAD(cur ^ 1, k + 1);
            asm volatile("" ::: "memory");
#pragma unroll
            for (int mm = 0; mm < 2; ++mm) { const int m = 2 * mh + mm; const size_t r = (size_t)(rowb + ai * HALF + m * 16 + fr); const u32x4 gp = gb[cur][mm], gc = gb[cur][mm + 1];
                f32x2 v[4];
#pragma unroll
                for (int p = 0; p < 4; ++p) v[p] = (f32x2){(float)acc[ai][bj][m][p >> 1][2 * (p & 1)], (float)acc[ai][bj][m][p >> 1][2 * (p & 1) + 1]};
                if constexpr (I8_) { const float ra = sav[ai * 4 + m]; const f32x2 rav = {ra, ra}; const f32x4 s0 = sbv[0], s1 = sbv[1];
                    v[0] = v[0] * ((f32x2){s0[0], s0[1]} * rav); v[1] = v[1] * ((f32x2){s0[2], s0[3]} * rav); v[2] = v[2] * ((f32x2){s1[0], s1[1]} * rav); v[3] = v[3] * ((f32x2){s1[2], s1[3]} * rav); }
                float o[8];
#pragma unroll
                for (int w = 0; w < 4; ++w) {
                    const unsigned x1w = (unsigned)__builtin_amdgcn_update_dpp(0, (int)(l15 ? gp[w] : gc[w]), 0x121, 0xf, 0xf, true);
                    const unsigned x0w = (unsigned)__builtin_amdgcn_update_dpp(0, (int)(l14 ? gp[w] : gc[w]), 0x122, 0xf, 0xf, true);
                    const unsigned wa_ = wa[w >> 1][2 * (w & 1)], wa1_ = wa[w >> 1][2 * (w & 1) + 1], wb_ = wb[w >> 1][2 * (w & 1)], wb1_ = wb[w >> 1][2 * (w & 1) + 1];
#pragma unroll
                    for (int h = 0; h < 2; ++h) { const int jj = 2 * w + h; const unsigned sel = h ? 0x07060302u : 0x05040100u;
                        const unsigned p01 = __builtin_amdgcn_perm(x1w, x0w, sel), p2 = __builtin_amdgcn_perm(0x3F803F80u, gc[w], sel);
                        float uu = __builtin_amdgcn_fdot2_f32_bf16(__builtin_bit_cast(bf16v2, p2), __builtin_bit_cast(bf16v2, h ? wb1_ : wb_), 0.0f, false);
                        uu = __builtin_amdgcn_fdot2_f32_bf16(__builtin_bit_cast(bf16v2, p01), __builtin_bit_cast(bf16v2, h ? wa1_ : wa_), uu, false);
                        const float z = uu * (uu * uu * -0.10294324f + -2.3022082f); const float e = __builtin_amdgcn_exp2f(z);
                        o[jj] = (uu * v[jj >> 1][jj & 1]) * rcpf_(1.0f + e); } }
                u32x4 wv; wv.x = cvt_pk_bf16(o[0], o[1]); wv.y = cvt_pk_bf16(o[2], o[3]); wv.z = cvt_pk_bf16(o[4], o[5]); wv.w = cvt_pk_bf16(o[6], o[7]);
                *(u32x4*)(O + r * FF + c) = wv; }
            asm volatile("" ::: "memory");
            if (k == 3) FU_WLOAD(1); }
#undef FU_GLOAD
#undef FU_WLOAD
    }
};

__device__ __forceinline__ f32x4 mma16(bf16x8 b, bf16x8 a, f32x4 c) { return __builtin_amdgcn_mfma_f32_16x16x32_bf16(b, a, c, 0, 0, 0); }
__device__ __forceinline__ i32x4 mma16(bf16x8 b, bf16x8 a, i32x4 c) { return __builtin_amdgcn_mfma_i32_16x16x64_i8(__builtin_bit_cast(i32x4, b), __builtin_bit_cast(i32x4, a), c, 0, 0, 0); }
#ifndef PG8_SP2
#define PG8_SP2 true
#endif
#ifndef PG8_ALIGN
#define PG8_ALIGN true
#endif
template <class E, class = void> struct IsChain { static constexpr bool v = false; }; template <> struct IsChain<EpiGateAcc> { static constexpr bool v = true; };
template <class E> struct BMode { static constexpr int v = E::PERM ? 1 : 0; }; template <> struct BMode<EpiGateU8> { static constexpr int v = 2; };
template <class Epi, class Sched, bool ALIGN_EPI = PG8_ALIGN, bool SP2 = PG8_SP2>
__device__ __forceinline__ void gemm_phase(LAS unsigned char* lds, const Gemm g, const Sched& S, const Epi& E, int tid_) {
    const int tid = tid_, wid = __builtin_amdgcn_readfirstlane(tid >> 6), lane = tid & 63, wr = wid >> 2, wc = wid & 3, fr = lane & 15, fq = lane >> 4;
    const int K = g.K, nt = K / BK;
    unsigned voffA[2], voffB[2];
#pragma unroll
    for (int i = 0; i < 2; ++i) { int R, C; stage_rc(tid * 16 + i * 8192, R, C); const int Rb = BMode<Epi>::v == 2 ? (64 * (R >> 5) + 16 * ((R >> 2) & 3) + 4 * ((R >> 4) & 1) + (R & 3)) : (BMode<Epi>::v == 1 ? ((R & ~31) + perm32(R & 31)) : R);
        voffA[i] = (unsigned)(R * K + C) * 2u; voffB[i] = (unsigned)(Rb * K + C) * 2u; }
    const size_t kstep = (size_t)(BK * 2);
    const size_t hstep = (size_t)HALF * K * 2;
    const size_t tstep = 2 * hstep;
    const size_t hstepB = BMode<Epi>::v == 2 ? (size_t)8 * K * 2 : hstep;
    const unsigned ldsw = (unsigned)wid * 1024u;
    const int aoff = lds_byte(wr * 64 + fr, fq * 8), boff = lds_byte(wc * 32 + fr, fq * 8);
#define PG8_SA(b, h) (((b) * 2 + (h)) * HTB)
#define PG8_SB(b, h) ((4 + (b) * 2 + (h)) * HTB)
#define PG8_STAGE(bufoff, gbase, voff) do { _Pragma("unroll") for (int _i = 0; _i < 2; ++_i) \
        __builtin_amdgcn_global_load_lds((const unsigned*)((const char*)(gbase) + (voff)[_i]), (LAS unsigned*)(lds + (bufoff) + ldsw + _i * 8192), 16, 0, 0); } while (0)
#define PG8_LDA(dst, b, h) do { _Pragma("unroll") for (int m = 0; m < 4; ++m) _Pragma("unroll") for (int k = 0; k < 2; ++k) dst[m][k] = *(const LAS bf16x8*)(lds + PG8_SA(b, h) + aoff + m * 2048 + k * 1024); } while (0)
#define PG8_LDB(dst, b, h) do { _Pragma("unroll") for (int n = 0; n < 2; ++n) _Pragma("unroll") for (int k = 0; k < 2; ++k) dst[n][k] = *(const LAS bf16x8*)(lds + PG8_SB(b, h) + boff + n * 2048 + k * 1024); } while (0)
#define PG8_MMA(ai, bj, At, Bt) do { __builtin_amdgcn_s_setprio(1); _Pragma("unroll") for (int m = 0; m < 4; ++m) _Pragma("unroll") for (int n = 0; n < 2; ++n) _Pragma("unroll") for (int k = 0; k < 2; ++k) \
        acc[ai][bj][m][n] = mma16(Bt[n][k], At[m][k], acc[ai][bj][m][n]); __builtin_amdgcn_s_setprio(0); } while (0)
#define PG8_WAIT_V(n) asm volatile("s_waitcnt vmcnt(" #n ")" ::: "memory")
#define PG8_WAIT_L(n) asm volatile("s_waitcnt lgkmcnt(" #n ")" ::: "memory")
#define PG8_BAR __builtin_amdgcn_s_barrier()
#define PG8_SCHED __builtin_amdgcn_sched_barrier(0)
    Unit cur, nxt; int ui = 0;
    if (!S.next(0, cur)) return;
    typedef typename AccOf<Epi::I8>::T acc_t;
    acc_t acc[2][2][4][2];
#pragma unroll
    for (int a = 0; a < 2; ++a)
#pragma unroll
        for (int b = 0; b < 2; ++b)
#pragma unroll
            for (int m = 0; m < 4; ++m)
#pragma unroll
                for (int n = 0; n < 2; ++n) acc[a][b][m][n] = (acc_t){0, 0, 0, 0};
    bf16x8 At[4][2], B0[2][2], B1[2][2];
    typename Epi::Pre pre;
    const char* cA = (const char*)g.A + (size_t)cur.pm * tstep; const char* cB = (const char*)g.Bt + (size_t)cur.pn * tstep;
    S.a_ready(cur);
    if constexpr (SP2) {
        PG8_STAGE(PG8_SB(0, 0), cB, voffB); PG8_STAGE(PG8_SB(0, 1), cB + hstepB, voffB); PG8_STAGE(PG8_SA(0, 0), cA, voffA); PG8_STAGE(PG8_SA(0, 1), cA + hstep, voffA);
        if (wr == 1) PG8_BAR;
        PG8_WAIT_V(2); PG8_BAR;
        PG8_STAGE(PG8_SB(1, 0), cB + kstep, voffB); PG8_STAGE(PG8_SA(1, 0), cA + kstep, voffA); PG8_STAGE(PG8_SB(1, 1), cB + hstepB + kstep, voffB);
        PG8_WAIT_V(6); PG8_BAR;
    } else {
    PG8_STAGE(PG8_SB(0, 0), cB, voffB); PG8_STAGE(PG8_SA(0, 0), cA, voffA); PG8_STAGE(PG8_SB(0, 1), cB + hstepB, voffB); PG8_STAGE(PG8_SA(0, 1), cA + hstep, voffA);
    if (wr == 1) PG8_BAR;
    PG8_WAIT_V(4); PG8_BAR;
    PG8_STAGE(PG8_SB(1, 0), cB + kstep, voffB); PG8_STAGE(PG8_SA(1, 0), cA + kstep, voffA); PG8_STAGE(PG8_SB(1, 1), cB + hstepB + kstep, voffB);
    PG8_WAIT_V(6); PG8_BAR;
    }
    for (;;) {
        const bool has_next = S.next(ui + 1, nxt);
        const char* nA = has_next ? (const char*)g.A + (size_t)nxt.pm * tstep : cA; const char* nB = has_next ? (const char*)g.Bt + (size_t)nxt.pn * tstep : cB;
        for (int t = 0; t < nt; t += 2) {
            const bool last = (t == nt - 2);
            const char* a1 = cA + (size_t)(t + 1) * kstep;
            const char* a2 = last ? nA : cA + (size_t)(t + 2) * kstep; const char* b2 = last ? nB : cB + (size_t)(t + 2) * kstep;
            const char* a3 = a2 + kstep; const char* b3 = b2 + kstep;
            if (last && has_next) S.a_ready(nxt);
            if (last) E.prefetch(pre, cur, wr, wc, fr, fq);
            if constexpr (SP2) {
            PG8_LDB(B0, 0, 0); PG8_LDB(B1, 0, 1); PG8_SCHED; PG8_LDA(At, 0, 0); PG8_STAGE(PG8_SA(1, 1), a1 + hstep, voffA);
            PG8_WAIT_V(8); PG8_WAIT_L(0); PG8_BAR; PG8_MMA(0, 0, At, B0); PG8_MMA(0, 1, At, B1); PG8_BAR; PG8_SCHED;
            PG8_LDA(At, 0, 1); PG8_STAGE(PG8_SB(0, 0), b2, voffB); PG8_STAGE(PG8_SB(0, 1), b2 + hstepB, voffB); PG8_STAGE(PG8_SA(0, 0), a2, voffA);
            PG8_WAIT_V(8); PG8_WAIT_L(0); PG8_BAR; PG8_MMA(1, 0, At, B0); PG8_MMA(1, 1, At, B1); PG8_BAR; PG8_SCHED;
            PG8_LDB(B0, 1, 0); PG8_LDB(B1, 1, 1); PG8_SCHED; PG8_LDA(At, 1, 0); PG8_STAGE(PG8_SA(0, 1), a2 + hstep, voffA);
            PG8_WAIT_V(8); PG8_WAIT_L(0); PG8_BAR; PG8_MMA(0, 0, At, B0); PG8_MMA(0, 1, At, B1); PG8_BAR; PG8_SCHED;
            PG8_LDA(At, 1, 1); PG8_STAGE(PG8_SB(1, 0), b3, voffB); PG8_STAGE(PG8_SB(1, 1), b3 + hstepB, voffB); PG8_STAGE(PG8_SA(1, 0), a3, voffA);
            PG8_WAIT_V(8); PG8_WAIT_L(0); PG8_BAR; PG8_MMA(1, 0, At, B0); PG8_MMA(1, 1, At, B1); PG8_BAR; PG8_SCHED;
            } else {
            PG8_LDB(B0, 0, 0); PG8_SCHED; PG8_LDA(At, 0, 0); PG8_STAGE(PG8_SA(1, 1), a1 + hstep, voffA);
            PG8_WAIT_L(8); PG8_BAR; PG8_WAIT_L(0); PG8_MMA(0, 0, At, B0); PG8_BAR; PG8_SCHED;
            PG8_LDB(B1, 0, 1); PG8_STAGE(PG8_SB(0, 0), b2, voffB);
            PG8_BAR; PG8_WAIT_L(0); PG8_MMA(0, 1, At, B1); PG8_BAR;
            PG8_LDA(At, 0, 1); PG8_STAGE(PG8_SA(0, 0), a2, voffA);
            PG8_BAR; PG8_WAIT_L(0); PG8_MMA(1, 0, At, B0); PG8_BAR; PG8_SCHED;
            PG8_STAGE(PG8_SB(0, 1), b2 + hstepB, voffB);
            PG8_WAIT_V(6); PG8_BAR; PG8_MMA(1, 1, At, B1); PG8_BAR;
            PG8_LDB(B0, 1, 0); PG8_SCHED; PG8_LDA(At, 1, 0); PG8_STAGE(PG8_SA(0, 1), a2 + hstep, voffA);
            PG8_WAIT_L(8); PG8_BAR; PG8_WAIT_L(0); PG8_MMA(0, 0, At, B0); PG8_BAR; PG8_SCHED;
            PG8_LDB(B1, 1, 1); PG8_STAGE(PG8_SB(1, 0), b3, voffB);
            PG8_BAR; PG8_WAIT_L(0); PG8_MMA(0, 1, At, B1); PG8_BAR;
            PG8_LDA(At, 1, 1); PG8_STAGE(PG8_SA(1, 0), a3, voffA);
            PG8_BAR; PG8_WAIT_L(0); PG8_MMA(1, 0, At, B0); PG8_BAR; PG8_SCHED;
            PG8_STAGE(PG8_SB(1, 1), b3 + hstepB, voffB);
            PG8_WAIT_V(6); PG8_BAR; PG8_MMA(1, 1, At, B1); PG8_BAR;
            }
        }
        if constexpr (ALIGN_EPI) { if (wr == 0) PG8_BAR; }
        if constexpr (IsChain<Epi>::v) { const bool carry = !E.is_last(cur); if (!carry) E(acc, cur, wr, wc, fr, fq, pre); E.rescale(acc, cur, carry, wr, wc, fr, fq); }
        else E(acc, cur, wr, wc, fr, fq, pre);
        S.done(cur);
        if (!has_next) break;
        if constexpr (!IsChain<Epi>::v) {
#pragma unroll
        for (int a = 0; a < 2; ++a)
#pragma unroll
            for (int b = 0; b < 2; ++b)
#pragma unroll
                for (int m = 0; m < 4; ++m)
#pragma unroll
                    for (int n = 0; n < 2; ++n) acc[a][b][m][n] = (acc_t){0, 0, 0, 0};
        }
        cur = nxt; cA = nA; cB = nB; ++ui;
        if constexpr (ALIGN_EPI) { if (wr == 1) PG8_BAR; }
    }
    PG8_WAIT_V(0);
    if constexpr (!ALIGN_EPI) { if (wr == 0) PG8_BAR; }
    PG8_BAR;
#undef PG8_SA
#undef PG8_SB
#undef PG8_STAGE
#undef PG8_LDA
#undef PG8_LDB
#undef PG8_MMA
#undef PG8_WAIT_V
#undef PG8_WAIT_L
#undef PG8_BAR
#undef PG8_SCHED
}
}

#define XB_TMO      128
#define XB_XCNT(j)  (256  + 64 * (j))
#define XB_XSUB(j)  (1280 + 64 * (j))
#define XB_XGEN(j)  (2304 + 64 * (j))
#define XB_TOP      3328
#define XB_TOPGEN   3392
#define XCD_BAR_WORDS 3456
#define XB_SPIN_CAP (1u << 22)
__device__ __forceinline__ unsigned xb_ld(unsigned* p)              { return __hip_atomic_load(p, __ATOMIC_RELAXED, __HIP_MEMORY_SCOPE_AGENT); }
__device__ __forceinline__ unsigned xb_add(unsigned* p, unsigned v) { return __hip_atomic_fetch_add(p, v, __ATOMIC_RELAXED, __HIP_MEMORY_SCOPE_AGENT); }
__device__ __forceinline__ unsigned xb_xcc_id() { return (unsigned)__builtin_amdgcn_s_getreg((3 << 11) | 20) & 0xFu; }
#define XB_SPIN(cond, bar) do { unsigned _sp = 0; while (cond) { __builtin_amdgcn_s_sleep(1); \
    if ((++_sp & 255u) == 0u) { if (xb_ld(&(bar)[XB_TMO])) break; if (_sp > XB_SPIN_CAP) { atomicAdd(&(bar)[XB_TMO], 1u); break; } } } } while (0)
struct XcdBarrier { unsigned* bar; unsigned x; volatile LAS unsigned* st; };
__device__ __forceinline__ XcdBarrier xcd_barrier_post(unsigned* bar, volatile LAS unsigned* st) {
    XcdBarrier b; b.bar = bar; b.x = xb_xcc_id(); b.st = st;
    if (threadIdx.x == 0) (void)xb_add(&bar[XB_XCNT(b.x)], 1u);
    return b;
}
__device__ __forceinline__ void xcd_barrier_complete(unsigned* bar, unsigned x, unsigned& nloc, unsigned& nx) {
    const unsigned G = gridDim.x * gridDim.y * gridDim.z;
    unsigned sum, cnt, mine, sp = 0u;
    for (;;) {
        sum = 0u; cnt = 0u; mine = 0u;
#pragma unroll
        for (unsigned j = 0; j < 16; ++j) { const unsigned c = xb_ld(&bar[XB_XCNT(j)]); sum += c; cnt += (c > 0u) ? 1u : 0u; mine = (j == x) ? c : mine; }
        if (sum == G) break;
        __builtin_amdgcn_s_sleep(1);
        if ((++sp & 255u) == 0u) { if (xb_ld(&bar[XB_TMO])) break; if (sp > XB_SPIN_CAP) { atomicAdd(&bar[XB_TMO], 1u); break; } }
    }
    nloc = mine > 0u ? mine : 1u; nx = cnt > 0u ? cnt : 1u;
}
__device__ __forceinline__ void xcd_barrier(const XcdBarrier& b) {
    asm volatile("s_waitcnt vmcnt(0)" ::: "memory");
    __syncthreads();
    if (threadIdx.x == 0) {
        unsigned* bar = b.bar;
        { unsigned long long w_ = (unsigned long long)bar; unsigned lo_ = __builtin_amdgcn_readfirstlane((unsigned)w_), hi_ = __builtin_amdgcn_readfirstlane((unsigned)(w_ >> 32)); asm volatile("" : "+s"(lo_), "+s"(hi_)); bar = (unsigned*)(((unsigned long long)hi_ << 32) | lo_); }
        __builtin_amdgcn_s_waitcnt(0);
        unsigned nloc = b.st[0], nx = b.st[1];
        if (nloc == 0u) { xcd_barrier_complete(bar, b.x, nloc, nx); b.st[0] = nloc; b.st[1] = nx; }
        const unsigned old = xb_add(&bar[XB_XSUB(b.x)], 1u);
        const unsigned gen = old / nloc;
        if (old + 1u == (gen + 1u) * nloc) {
            __builtin_amdgcn_fence(__ATOMIC_RELEASE, "agent");
            asm volatile("s_waitcnt vmcnt(0)" ::: "memory");
            const unsigned og = xb_add(&bar[XB_TOP], 1u);
            const unsigned tg = og / nx;
            if (og + 1u == (tg + 1u) * nx) xb_add(&bar[XB_TOPGEN], 1u);
            else XB_SPIN(xb_ld(&bar[XB_TOPGEN]) == tg, bar);
            __builtin_amdgcn_fence(__ATOMIC_ACQUIRE, "agent");
            xb_add(&bar[XB_XGEN(b.x)], 1u);
            asm volatile("s_waitcnt vmcnt(0)" ::: "memory");
        } else {
            XB_SPIN(xb_ld(&bar[XB_XGEN(b.x)]) == gen, bar);
            __builtin_amdgcn_fence(__ATOMIC_ACQUIRE, "agent");
            asm volatile("s_waitcnt vmcnt(0)" ::: "memory");
        }
    }
    __syncthreads();
}

constexpr int NWAVES = 8, NTHR = 512;
constexpr int LDS_MISC = 131072, LDS_BYTES = 131072 + 1024;
struct Args { const float* in[45]; float* out; unsigned char* ws; };
#define GAS __attribute__((address_space(1)))
struct Frame {
    LAS unsigned char* lds; float* out; unsigned char* ws;
    int tid, lane, wave, blk, G;
};
#define WSP(T, off) ((T*)(F.ws + (off)))
__device__ __forceinline__ const float* inp_(LAS unsigned char* lds, int k) {
    const LAS unsigned* t = (const LAS unsigned*)(lds + 131072 + 256) + 2 * k;
    const unsigned lo = __builtin_amdgcn_readfirstlane(t[0]), hi = __builtin_amdgcn_readfirstlane(t[1]);
    return (const float*)(const GAS float*)(((unsigned long long)hi << 32) | lo);
}
#define INP(k) inp_(F.lds, (k))

__device__ __forceinline__ void tr_item(const float* W, int ld, int col0, int ncv, bf16* WT, int K, int row_off, LAS float* scr, int kb, int nb, int lane, float scale = 1.0f) {
    const int k0 = 64 * kb, n0 = 32 * nb; const int nn = n0 + (lane & 31); const bool ok = nn < ncv;
    { float t[32]; const float* wp = W + (size_t)(k0 + (lane >> 5)) * ld + col0 + (ok ? nn : 0);
#pragma unroll
      for (int i = 0; i < 32; ++i) t[i] = wp[(size_t)(2 * i) * ld];
#pragma unroll
      for (int i = 0; i < 32; ++i) scr[(2 * i + (lane >> 5)) * 33 + (lane & 31)] = ok ? t[i] * scale : 0.f; }
    asm volatile("s_waitcnt lgkmcnt(0)" ::: "memory");
    const int c = lane & 7;
#pragma unroll
    for (int j = 0; j < 4; ++j) { const int n = (lane >> 3) + 8 * j; const LAS float* s = scr + (8 * c) * 33 + n;
        u32x4 o; o.x = pk2(s[0 * 33], s[1 * 33]); o.y = pk2(s[2 * 33], s[3 * 33]); o.z = pk2(s[4 * 33], s[5 * 33]); o.w = pk2(s[6 * 33], s[7 * 33]);
        *(u32x4*)(WT + (size_t)(row_off + n0 + n) * K + k0 + 8 * c) = o; }
    asm volatile("s_waitcnt lgkmcnt(0)" ::: "memory");
}
__device__ __forceinline__ void convert_weights(Frame& F, int l) {
    LAS float* scr = (LAS float*)(F.lds + F.wave * 16384);
    const int gw = F.blk * NWAVES + F.wave, NGW = F.G * NWAVES;
    constexpr int I0 = 32 * 152, I1 = I0, I2 = I1 + 4 * 8 * 64, I3 = I2 + 32 * 64, I4 = I3, I5 = I4, I6 = I5 + 96 * 64, I7 = I6 + 8 * 16;
    const float* win = INP(2) + (size_t)l * DM * INC;
    for (int it = gw; it < I7; it += NGW) {
        if (it < I0) { const int r = it; tr_item(win, INC, 0, MIXC, WSP(bf16, WS_WIN), DM, 0, scr, r / 152, r % 152, F.lane); }
        else if (it < I1) { }
        else if (it < I2) { const int r = it - I1; const int k = r / 512, rr = r % 512; tr_item(INP(36) + ((size_t)l * 4 + k) * 512 * DM, DM, 0, DM, WSP(bf16, WS_WPK), 512, k * DM, scr, rr / 64, rr % 64, F.lane, 1.0f / 255.0f); }
        else if (it < I3) { const int r = it - I2; tr_item(INP(37) + (size_t)l * DM * DM, DM, 0, DM, WSP(bf16, WS_WOUT), DM, 0, scr, r / 64, r % 64, F.lane); }
        else if (it < I4) { const int r = it - I3; tr_item(INP(39) + (size_t)l * DM * FF, FF, 0, FF, WSP(bf16, WS_WFG), DM, 0, scr, r / 192, r % 192, F.lane); }
        else if (it < I5) { const int r = it - I4; tr_item(INP(40) + (size_t)l * DM * FF, FF, 0, FF, WSP(bf16, WS_WFU), DM, 0, scr, r / 192, r % 192, F.lane); }
        else if (it < I6) { const int r = it - I5; tr_item(INP(43) + (size_t)l * FF * DM, DM, 0, DM, WSP(bf16, WS_WFD), FF, 0, scr, r / 64, r % 64, F.lane); }
        else { const int r = it - I6; tr_item(INP(11) + (size_t)l * 512 * 512, 512, 0, 512, WSP(bf16, WS_WGLU), 512, 0, scr, r / 16, r % 16, F.lane); }
    }
}
__device__ __forceinline__ void rmsnorm_rows(Frame& F, const float* x, const bf16* xb, const float* g, bf16* obf, float* of32, unsigned* a8 = nullptr, float* sa = nullptr) {
    const int gw = F.blk * NWAVES + F.wave, NGW = F.G * NWAVES;
    f32x4 gv[8];
#pragma unroll
    for (int j = 0; j < 8; ++j) gv[j] = ((const f32x4*)g)[64 * j + F.lane];
    for (int m = gw; m < MTOK; m += NGW) {
        f32x4 v[8]; float s = 0.f;
        if (x) { const f32x4* xr = (const f32x4*)(x + (size_t)m * DM) + F.lane;
#pragma unroll
            for (int j = 0; j < 8; ++j) v[j] = xr[64 * j]; }
        else { const u32x2* xr = (const u32x2*)(xb + (size_t)m * DM) + F.lane; u32x2 w[8];
#pragma unroll
            for (int j = 0; j < 8; ++j) w[j] = xr[64 * j];
#pragma unroll
            for (int j = 0; j < 8; ++j) v[j] = (f32x4){lo16(w[j].x), hi16(w[j].x), lo16(w[j].y), hi16(w[j].y)}; }
#pragma unroll
        for (int j = 0; j < 8; ++j) s += (v[j].x * v[j].x + v[j].y * v[j].y) + (v[j].z * v[j].z + v[j].w * v[j].w);
        const float rs = 1.0f / sqrtf(wave_sum(s) * (1.f / DM) + 1e-6f);
#pragma unroll
        for (int j = 0; j < 8; ++j) v[j] = v[j] * rs * gv[j];
        if (obf) { u32x2* o = (u32x2*)(obf + (size_t)m * DM) + F.lane;
#pragma unroll
            for (int j = 0; j < 8; ++j) { u32x2 w; w.x = pk2(v[j].x, v[j].y); w.y = pk2(v[j].z, v[j].w); o[64 * j] = w; } }
        if (of32) { f32x4* o = (f32x4*)(of32 + (size_t)m * DM) + F.lane;
#pragma unroll
            for (int j = 0; j < 8; ++j) o[64 * j] = v[j]; }
        if (a8) {
            float am = 0.f;
#pragma unroll
            for (int j = 0; j < 8; ++j) am = fmaxf(fmaxf(am, fmaxf(fabsf(v[j].x), fabsf(v[j].y))), fmaxf(fabsf(v[j].z), fabsf(v[j].w)));
            am = fmaxf(wave_max(am), 1e-20f); const float inv = 127.0f / am;
            unsigned* o = a8 + (size_t)m * (DM / 4) + F.lane;
#pragma unroll
            for (int j = 0; j < 8; ++j) o[64 * j] = q8x4(v[j].x, v[j].y, v[j].z, v[j].w, inv);
            if (F.lane == 0) sa[m] = am * (1.0f / 127.0f); }
    }
}
__device__ __forceinline__ void convert_cols_i8(Frame& F, const float* W, int ld, int col0, int nb, signed char* W8, float* sb, int row_off) {
    constexpr int PITCH = 2064;
    LAS float* red = (LAS float*)(F.lds + 8 * 16384 - 4096);
    LAS float* scl = red + 512;
    const int tid = F.tid, n = tid & 31, kg = tid >> 5; const float* wp = W + col0 + 32 * nb + n + (size_t)(4 * kg) * ld;
    float v[128]; float am = 0.f;
#pragma unroll
    for (int j = 0; j < 32; ++j)
#pragma unroll
        for (int e = 0; e < 4; ++e) v[4 * j + e] = wp[(size_t)(64 * j + e) * ld];
#pragma unroll
    for (int i = 0; i < 128; ++i) am = fmaxf(am, fabsf(v[i]));
    red[kg * 32 + n] = am;
    __syncthreads();
    if (tid < 32) { float a = 0.f;
#pragma unroll
        for (int q = 0; q < 16; ++q) a = fmaxf(a, red[q * 32 + tid]);
        a = fmaxf(a, 1e-30f); scl[tid] = 127.0f / a; sb[row_off + 32 * nb + tid] = a * (1.0f / 127.0f); }
    __syncthreads();
    const float inv = scl[n];
    LAS unsigned char* img = F.lds + n * PITCH + 4 * kg;
#pragma unroll
    for (int j = 0; j < 32; ++j) *(LAS unsigned*)(img + 64 * j) = q8x4(v[4 * j], v[4 * j + 1], v[4 * j + 2], v[4 * j + 3], inv);
    __syncthreads();
#pragma unroll
    for (int q = 0; q < 8; ++q) { const int c = tid + 512 * q, rn = c >> 7, ko = (c & 127) * 16;
        *(u32x4*)(W8 + (size_t)(row_off + 32 * nb + rn) * DM + ko) = *(const LAS u32x4*)(F.lds + rn * PITCH + ko); }
    __syncthreads();
}

constexpr int WAVE_LDS = 16384;
constexpr int LR_XLD = 72, LR_FLD = 66, LR_ALD = 132;
constexpr int LR_XF = 16 * LR_XLD * 2, LR_AB = LR_XF + 16 * LR_FLD * 4;
template <bool FINAL> __device__ __forceinline__ void lru_task(Frame& F, int l, int task) {
    const int lane = F.lane, fr = lane & 15, fq = lane >> 4; const int b = task >> 9, h = (task >> 6) & 7, c = task & 63; const int ch = 64 * h + lane;
    LAS unsigned char* wl = F.lds + F.wave * WAVE_LDS;
    LAS bf16* XC = (LAS bf16*)wl; LAS float* XF = (LAS float*)(wl + LR_XF); LAS float* AB = (LAS float*)(wl + LR_AB);
    const float* WA = INP(14) + ((size_t)l * 8 + h) * 4096; const float* WX = INP(16) + ((size_t)l * 8 + h) * 4096;
    bf16x8 Wa[4][2], Wx[4][2];
#pragma unroll
    for (int nt = 0; nt < 4; ++nt)
#pragma unroll
        for (int kk = 0; kk < 2; ++kk) { const float* pa = WA + (size_t)(32 * kk + 8 * fq) * 64 + 16 * nt + fr; const float* px_ = WX + (size_t)(32 * kk + 8 * fq) * 64 + 16 * nt + fr;
            u32x4 wa_, wx_; wa_.x = pk2(pa[0], pa[64]); wa_.y = pk2(pa[128], pa[192]); wa_.z = pk2(pa[256], pa[320]); wa_.w = pk2(pa[384], pa[448]);
            wx_.x = pk2(px_[0], px_[64]); wx_.y = pk2(px_[128], px_[192]); wx_.z = pk2(px_[256], px_[320]); wx_.w = pk2(px_[384], px_[448]);
            Wa[nt][kk] = __builtin_bit_cast(bf16x8, wa_); Wx[nt][kk] = __builtin_bit_cast(bf16x8, wx_); }
    float ba4[4], bx4[4], sp4[4], slp[4];
#pragma unroll
    for (int nt = 0; nt < 4; ++nt) { const int jj = l * 512 + 64 * h + 16 * nt + fr; ba4[nt] = INP(15)[jj]; bx4[nt] = INP(17)[jj]; sp4[nt] = softplusf_(-INP(18)[jj]); slp[nt] = 0.f; }
    const float* cwp = INP(12) + (size_t)l * 4 * 512 + ch;
    const float cw0 = cwp[0], cw1 = cwp[512], cw2 = cwp[1024], cw3 = cwp[1536];
    const float cb = INP(13)[l * 512 + ch];
    const size_t row0 = (size_t)b * SEQ + (size_t)c * 128;
    const bf16* px = WSP(const bf16, WS_PROJ) + row0 * MIXP + PC_LRX + ch;
    const bf16* pg = WSP(const bf16, WS_PROJ) + row0 * MIXP + PC_LRG + ch;
    float xm3 = 0.f, xm2 = 0.f, xm1 = 0.f;
    if (c > 0) { xm3 = bf2f(*(px - 3 * (ptrdiff_t)MIXP)); xm2 = bf2f(*(px - 2 * (ptrdiff_t)MIXP)); xm1 = bf2f(*(px - (ptrdiff_t)MIXP)); }
    float hs = 0.f;
    const size_t cidx = ((size_t)b * 64 + c) * 512 + ch;
    if (FINAL) hs = WSP(const float, WS_LRI)[cidx];
    bf16* yo = WSP(bf16, WS_YK) + (size_t)1 * MTOK * 512 + row0 * 512 + ch;
    bf16 xs[16], gs[16];
#pragma unroll
    for (int j = 0; j < 16; ++j) { xs[j] = px[(size_t)j * MIXP]; if (FINAL) gs[j] = pg[(size_t)j * MIXP]; }
#pragma unroll 1
    for (int sb = 0; sb < 8; ++sb) {
#pragma unroll
        for (int t = 0; t < 16; ++t) { const float xv = bf2f(xs[t]); const float xc = cb + cw0 * xm3 + cw1 * xm2 + cw2 * xm1 + cw3 * xv; xm3 = xm2; xm2 = xm1; xm1 = xv;
            XC[t * LR_XLD + lane] = (bf16)f2bf(xc); XF[t * LR_FLD + lane] = xc; }
        float gl[16];
        if (FINAL) {
#pragma unroll
            for (int t = 0; t < 16; ++t) gl[t] = bf2f(gs[t]); }
        if (sb < 7) {
#pragma unroll
            for (int j = 0; j < 16; ++j) { xs[j] = px[(size_t)((sb + 1) * 16 + j) * MIXP]; if (FINAL) gs[j] = pg[(size_t)((sb + 1) * 16 + j) * MIXP]; } }
        const bf16x8 af0 = *(const LAS bf16x8*)(XC + fr * LR_XLD + 8 * fq), af1 = *(const LAS bf16x8*)(XC + fr * LR_XLD + 32 + 8 * fq);
#pragma unroll
        for (int nt = 0; nt < 4; ++nt) {
            f32x4 aa = (f32x4){0.f, 0.f, 0.f, 0.f}, ax = (f32x4){0.f, 0.f, 0.f, 0.f};
            aa = __builtin_amdgcn_mfma_f32_16x16x32_bf16(af0, Wa[nt][0], aa, 0, 0, 0); aa = __builtin_amdgcn_mfma_f32_16x16x32_bf16(af1, Wa[nt][1], aa, 0, 0, 0);
            ax = __builtin_amdgcn_mfma_f32_16x16x32_bf16(af0, Wx[nt][0], ax, 0, 0, 0); ax = __builtin_amdgcn_mfma_f32_16x16x32_bf16(af1, Wx[nt][1], ax, 0, 0, 0);
#pragma unroll
            for (int e = 0; e < 4; ++e) { const int t = 4 * fq + e, jj = 16 * nt + fr; const float xc = XF[t * LR_FLD + jj];
                const float r = sigmoidf_(aa[e] + ba4[nt]), ig = sigmoidf_(ax[e] + bx4[nt]); const float la = -8.0f * r * sp4[nt]; const float av = __expf(la);
                const float mult = __builtin_amdgcn_sqrtf(fmaxf(1.0f - av * av, 0.f));
                AB[t * LR_ALD + jj] = av; AB[t * LR_ALD + 64 + jj] = xc * ig * mult; if (!FINAL) slp[nt] += la; }
        }
#pragma unroll
        for (int t = 0; t < 16; ++t) { const float av = AB[t * LR_ALD + lane], bv = AB[t * LR_ALD + 64 + lane]; hs = av * hs + bv;
            if (FINAL) yo[(size_t)(sb * 16 + t) * 512] = (bf16)f2bf(hs * geluf_(gl[t])); }
    }
    if (!FINAL) { WSP(float, WS_LRE)[cidx] = hs;
#pragma unroll
        for (int nt = 0; nt < 4; ++nt) { float v = slp[nt]; v += __shfl_xor(v, 16); v += __shfl_xor(v, 32); if (fq == 0) WSP(float, WS_LRA)[((size_t)b * 64 + c) * 512 + 64 * h + 16 * nt + fr] = v; } }
}
__device__ __forceinline__ void lru_carry(Frame& F, int task) {
    const int b = task >> 3, ch = (task & 7) * 64 + F.lane; float run = 0.f;
    const float* A = WSP(const float, WS_LRA) + (size_t)b * 64 * 512 + ch; const float* E = WSP(const float, WS_LRE) + (size_t)b * 64 * 512 + ch; float* I = WSP(float, WS_LRI) + (size_t)b * 64 * 512 + ch;
#pragma unroll 1
    for (int c0 = 0; c0 < 64; c0 += 32) { float av[32], ev[32];
#pragma unroll
        for (int j = 0; j < 32; ++j) { av[j] = A[(size_t)(c0 + j) * 512]; ev[j] = E[(size_t)(c0 + j) * 512]; }
#pragma unroll
        for (int j = 0; j < 32; ++j) { I[(size_t)(c0 + j) * 512] = run; run = __expf(av[j]) * run + ev[j]; } }
}

constexpr int S5_XLD = 132, S5_SLD = 136, S5_SB = 16 * S5_XLD * 4;
template <bool FINAL> __device__ __forceinline__ void s5_task(Frame& F, int l, int task) {
    const int lane = F.lane, fr = lane & 15, fq = lane >> 4; const int b = task >> 11, g = (task >> 6) & 31, c = task & 63; const int p = lane;
    LAS unsigned char* wl = F.lds + F.wave * WAVE_LDS;
    LAS float* X = (LAS float*)wl; LAS bf16* Sb = (LAS bf16*)(wl + S5_SB);
    const int lg = l * 32 + g;
    const float lr = INP(3)[lg * 64 + p], li = INP(4)[lg * 64 + p]; const float dt = expf(INP(10)[lg]);
    const float mag = expf(lr * dt); float sn, cs; sincosf(li * dt, &sn, &cs); const float abr = mag * cs, abi = mag * sn;
    const float den = lr * lr + li * li, nr = abr - 1.0f, ni = abi; const float fre = (nr * lr + ni * li) / den, fim = (ni * lr - nr * li) / den;
    bf16x8 Bf[8];
#pragma unroll
    for (int nq = 0; nq < 4; ++nq) { const int pp = 16 * nq + fr; const float fr_ = __shfl(fre, pp), fi_ = __shfl(fim, pp);
        u32x4 wr_ = (u32x4){0u, 0u, 0u, 0u}, wi_ = (u32x4){0u, 0u, 0u, 0u};
        if (fq < 2) { const f32x4* br = (const f32x4*)(INP(5) + ((size_t)lg * 64 + pp) * 16 + 8 * fq); const f32x4* bi = (const f32x4*)(INP(6) + ((size_t)lg * 64 + pp) * 16 + 8 * fq);
            const f32x4 r0 = br[0], r1 = br[1], i0 = bi[0], i1 = bi[1];
            wr_.x = pk2(fr_ * r0[0] - fi_ * i0[0], fr_ * r0[1] - fi_ * i0[1]); wr_.y = pk2(fr_ * r0[2] - fi_ * i0[2], fr_ * r0[3] - fi_ * i0[3]);
            wr_.z = pk2(fr_ * r1[0] - fi_ * i1[0], fr_ * r1[1] - fi_ * i1[1]); wr_.w = pk2(fr_ * r1[2] - fi_ * i1[2], fr_ * r1[3] - fi_ * i1[3]);
            wi_.x = pk2(fr_ * i0[0] + fi_ * r0[0], fr_ * i0[1] + fi_ * r0[1]); wi_.y = pk2(fr_ * i0[2] + fi_ * r0[2], fr_ * i0[3] + fi_ * r0[3]);
            wi_.z = pk2(fr_ * i1[0] + fi_ * r1[0], fr_ * i1[1] + fi_ * r1[1]); wi_.w = pk2(fr_ * i1[2] + fi_ * r1[2], fr_ * i1[3] + fi_ * r1[3]); }
        Bf[nq] = __builtin_bit_cast(bf16x8, wr_); Bf[nq + 4] = __builtin_bit_cast(bf16x8, wi_); }
    bf16x8 Cf[4], Df;
    if (FINAL) {
#pragma unroll
        for (int kk = 0; kk < 4; ++kk) { const float* src = (kk < 2 ? INP(7) : INP(8)) + ((size_t)lg * 16 + fr) * 64 + 32 * (kk & 1) + 8 * fq; const float sg = kk < 2 ? 1.0f : -1.0f;
            const f32x4 c0 = *(const f32x4*)src, c1 = *(const f32x4*)(src + 4);
            u32x4 w; w.x = pk2(sg * c0[0], sg * c0[1]); w.y = pk2(sg * c0[2], sg * c0[3]); w.z = pk2(sg * c1[0], sg * c1[1]); w.w = pk2(sg * c1[2], sg * c1[3]); Cf[kk] = __builtin_bit_cast(bf16x8, w); }
        const float dv = INP(9)[l * 512 + 16 * g + fr]; float dd[8];
#pragma unroll
        for (int j = 0; j < 8; ++j) dd[j] = (8 * fq + j == fr) ? dv : 0.f;
        u32x4 w; w.x = pk2(dd[0], dd[1]); w.y = pk2(dd[2], dd[3]); w.z = pk2(dd[4], dd[5]); w.w = pk2(dd[6], dd[7]); Df = __builtin_bit_cast(bf16x8, w);
    }
    float sre = 0.f, sim = 0.f;
    const size_t sidx = (((size_t)b * 32 + g) * 64 + c) * 128 + p;
    if (FINAL) { sre = WSP(const float, WS_S5I)[sidx]; sim = WSP(const float, WS_S5I)[sidx + 64]; }
    const size_t row0 = (size_t)b * SEQ + (size_t)c * 128;
    const bf16* up = WSP(const bf16, WS_PROJ) + (row0 + fr) * MIXP + PC_S5U + 16 * g + 8 * (fq & 1);
    u32x4 aun = *(const u32x4*)up;
#pragma unroll 1
    for (int sb = 0; sb < 8; ++sb) {
        u32x4 au_ = aun; if (fq >= 2) au_ = (u32x4){0u, 0u, 0u, 0u};
        const bf16x8 au = __builtin_bit_cast(bf16x8, au_);
        if (sb < 7) aun = *(const u32x4*)(up + (size_t)(sb + 1) * 16 * MIXP);
#pragma unroll
        for (int nt = 0; nt < 8; ++nt) { const f32x4 a = __builtin_amdgcn_mfma_f32_16x16x32_bf16(au, Bf[nt], (f32x4){0.f, 0.f, 0.f, 0.f}, 0, 0, 0);
#pragma unroll
            for (int e = 0; e < 4; ++e) X[(4 * fq + e) * S5_XLD + 16 * nt + fr] = a[e]; }
#pragma unroll
        for (int t = 0; t < 16; ++t) { const float xr = X[t * S5_XLD + p], xi = X[t * S5_XLD + 64 + p];
            const float nre = abr * sre - abi * sim + xr, nim = abr * sim + abi * sre + xi; sre = nre; sim = nim;
            if (FINAL) { Sb[t * S5_SLD + p] = (bf16)f2bf(sre); Sb[t * S5_SLD + 64 + p] = (bf16)f2bf(sim); } }
        if (FINAL) {
            f32x4 y = (f32x4){0.f, 0.f, 0.f, 0.f};
#pragma unroll
            for (int kk = 0; kk < 4; ++kk) y = __builtin_amdgcn_mfma_f32_16x16x32_bf16(*(const LAS bf16x8*)(Sb + fr * S5_SLD + 32 * kk + 8 * fq), Cf[kk], y, 0, 0, 0);
            y = __builtin_amdgcn_mfma_f32_16x16x32_bf16(au, Df, y, 0, 0, 0);
#pragma unroll
            for (int e = 0; e < 4; ++e) WSP(bf16, WS_S5Z)[(row0 + sb * 16 + 4 * fq + e) * 512 + 16 * g + fr] = (bf16)f2bf(geluf_(y[e]));
        }
    }
    if (!FINAL) { WSP(float, WS_S5E)[sidx] = sre; WSP(float, WS_S5E)[sidx + 64] = sim; }
}
__device__ __forceinline__ void s5_carry(Frame& F, int l, int task) {
    const int b = task >> 5, g = task & 31, p = F.lane;
    const float lr = INP(3)[(l * 32 + g) * 64 + p], li = INP(4)[(l * 32 + g) * 64 + p]; const float dt = expf(INP(10)[l * 32 + g]);
    const float mag = expf(lr * dt); float sn, cs; sincosf(li * dt, &sn, &cs); float ar = mag * cs, ai = mag * sn;
#pragma unroll
    for (int i = 0; i < 7; ++i) { const float nr = ar * ar - ai * ai, ni = (ar + ar) * ai; ar = nr; ai = ni; }
    float rr = 0.f, ri = 0.f;
    const float* E = WSP(const float, WS_S5E) + (((size_t)b * 32 + g) * 64) * 128 + p; float* I = WSP(float, WS_S5I) + (((size_t)b * 32 + g) * 64) * 128 + p;
#pragma unroll 1
    for (int c0 = 0; c0 < 64; c0 += 32) { float er[32], ei[32];
#pragma unroll
        for (int j = 0; j < 32; ++j) { er[j] = E[(size_t)(c0 + j) * 128]; ei[j] = E[(size_t)(c0 + j) * 128 + 64]; }
#pragma unroll
        for (int j = 0; j < 32; ++j) { I[(size_t)(c0 + j) * 128] = rr; I[(size_t)(c0 + j) * 128 + 64] = ri;
            const float nr = ar * rr - ai * ri + er[j], ni = ar * ri + ai * rr + ei[j]; rr = nr; ri = ni; } }
}

constexpr int M2_CS = 0, M2_BS = 17408, M2_BST = 34816, M2_XT = 53248, M2_GS = 90112, M2_CUM = 107520, M2_DTV = 108544, M2_END = 109568;
constexpr int LDP = 136, LDT = 72, LDG = 68;
__device__ __forceinline__ void m2_stage(Frame& F, int l, int b, int c, int gr) {
    LAS bf16* Cs = (LAS bf16*)(F.lds + M2_CS); LAS bf16* Bs = (LAS bf16*)(F.lds + M2_BS); LAS bf16* BsT = (LAS bf16*)(F.lds + M2_BST); LAS bf16* XT = (LAS bf16*)(F.lds + M2_XT);
    LAS float* cum = (LAS float*)(F.lds + M2_CUM); LAS float* dtv = (LAS float*)(F.lds + M2_DTV);
    const int tid = F.tid; const size_t row0 = (size_t)b * SEQ + (size_t)c * 64;
    {
        const int kind = tid < 256 ? 0 : (tid < 384 ? 1 : 2); const int idx = kind == 0 ? tid : (kind == 1 ? tid - 256 : tid - 384);
        const int col = kind == 0 ? 256 * gr + idx : (kind == 1 ? 512 + 128 * gr + idx : 768 + 128 * gr + idx);
        const float* cwp = INP(19) + (size_t)l * 4 * 1024 + col; const float cw0 = cwp[0], cw1 = cwp[1024], cw2 = cwp[2048], cw3 = cwp[3072]; const float cb = INP(20)[l * 1024 + col];
        const bf16* px = WSP(const bf16, WS_PROJ) + row0 * MIXP + PC_XBC + col;
        float xm3 = 0.f, xm2 = 0.f, xm1 = 0.f;
        if (c > 0) { xm3 = bf2f(*(px - 3 * (ptrdiff_t)MIXP)); xm2 = bf2f(*(px - 2 * (ptrdiff_t)MIXP)); xm1 = bf2f(*(px - (ptrdiff_t)MIXP)); }
        bf16 xall[64];
#pragma unroll
        for (int j = 0; j < 64; ++j) xall[j] = px[(size_t)j * MIXP];
#pragma unroll
        for (int tb = 0; tb < 8; ++tb) {
            float vv[8];
#pragma unroll
            for (int j = 0; j < 8; ++j) { const float xv = bf2f(xall[tb * 8 + j]);
                vv[j] = siluf_(cb + cw0 * xm3 + cw1 * xm2 + cw2 * xm1 + cw3 * xv); xm3 = xm2; xm2 = xm1; xm1 = xv; }
            u32x4 w; w.x = pk2(vv[0], vv[1]); w.y = pk2(vv[2], vv[3]); w.z = pk2(vv[4], vv[5]); w.w = pk2(vv[6], vv[7]);
            if (kind == 0) *(LAS u32x4*)(XT + idx * LDT + tb * 8) = w;
            else if (kind == 1) { *(LAS u32x4*)(BsT + idx * LDT + tb * 8) = w;
#pragma unroll
                for (int j = 0; j < 8; ++j) Bs[(tb * 8 + j) * LDP + idx] = (bf16)f2bf(vv[j]); }
            else {
#pragma unroll
                for (int j = 0; j < 8; ++j) Cs[(tb * 8 + j) * LDP + idx] = (bf16)f2bf(vv[j]); }
        }
    }
    if (tid < 256) { const int hh = tid >> 6, t = tid & 63, h = 4 * gr + hh;
        const float dtr = bf2f(WSP(const bf16, WS_PROJ)[(row0 + t) * MIXP + PC_DT + h]);
        const float dt = softplusf_(dtr + INP(21)[l * 8 + h]); const float a = -expf(INP(22)[l * 8 + h]);
        float s = dt * a;
#pragma unroll
        for (int o = 1; o < 64; o <<= 1) { const float n = __shfl_up(s, o); if (t >= o) s += n; }
        dtv[hh * 64 + t] = dt; cum[hh * 64 + t] = s; }
    __syncthreads();
}
__device__ __forceinline__ bf16x8 ldfrag(const LAS bf16* p) { return *(const LAS bf16x8*)p; }
__device__ __forceinline__ void m2_pass1(Frame& F, int l, int task) {
    const int b = task >> 8, c = (task >> 1) & 127, gr = task & 1;
    m2_stage(F, l, b, c, gr);
    LAS bf16* BsT = (LAS bf16*)(F.lds + M2_BST); LAS bf16* XT = (LAS bf16*)(F.lds + M2_XT); LAS float* cum = (LAS float*)(F.lds + M2_CUM); LAS float* dtv = (LAS float*)(F.lds + M2_DTV);
    const int lane = F.lane, hh = F.wave >> 1, half = F.wave & 1, h = 4 * gr + hh; const int fr = lane & 15, fq = lane >> 4;
    const float clast = cum[hh * 64 + 63];
    f32x4 acc[2][8];
#pragma unroll
    for (int i = 0; i < 2; ++i)
#pragma unroll
        for (int j = 0; j < 8; ++j) acc[i][j] = (f32x4){0.f, 0.f, 0.f, 0.f};
#pragma unroll
    for (int kk = 0; kk < 2; ++kk) {
        float fj[8];
#pragma unroll
        for (int e = 0; e < 8; ++e) { const int j = 32 * kk + 8 * fq + e; fj[e] = dtv[hh * 64 + j] * __expf(clast - cum[hh * 64 + j]); }
        bf16x8 af[2];
#pragma unroll
        for (int pi = 0; pi < 2; ++pi) { const int p = 16 * (2 * half + pi) + fr; const u32x4 raw = *(const LAS u32x4*)(XT + (64 * hh + p) * LDT + 32 * kk + 8 * fq);
            u32x4 w; w.x = pk2(lo16(raw.x) * fj[0], hi16(raw.x) * fj[1]); w.y = pk2(lo16(raw.y) * fj[2], hi16(raw.y) * fj[3]); w.z = pk2(lo16(raw.z) * fj[4], hi16(raw.z) * fj[5]); w.w = pk2(lo16(raw.w) * fj[6], hi16(raw.w) * fj[7]);
            af[pi] = __builtin_bit_cast(bf16x8, w); }
#pragma unroll
        for (int nt = 0; nt < 8; ++nt) { const bf16x8 bfr = ldfrag(BsT + (16 * nt + fr) * LDT + 32 * kk + 8 * fq);
#pragma unroll
            for (int pi = 0; pi < 2; ++pi) acc[pi][nt] = __builtin_amdgcn_mfma_f32_16x16x32_bf16(af[pi], bfr, acc[pi][nt], 0, 0, 0); }
    }
    bf16* S = WSP(bf16, WS_M2S) + ((((size_t)b * 128 + c) * 8 + h) * 64) * 128;
#pragma unroll
    for (int pi = 0; pi < 2; ++pi)
#pragma unroll
        for (int nt = 0; nt < 8; ++nt)
#pragma unroll
            for (int e = 0; e < 4; ++e) S[(size_t)(16 * (2 * half + pi) + 4 * fq + e) * 128 + 16 * nt + fr] = (bf16)f2bf(acc[pi][nt][e]);
    if (half == 0 && lane == 0) WSP(float, WS_M2D)[((size_t)b * 128 + c) * 8 + h] = __expf(clast);
    __syncthreads();
}
__device__ __forceinline__ void m2_carry(Frame& F) {
    const int gt = F.blk * NTHR + F.tid, stride = F.G * NTHR, NE = NB * 8 * 8192;
    int vz; asm volatile("v_mov_b32 %0, 0" : "=v"(vz));
    for (int e0 = gt; e0 < NE; e0 += 2 * stride) {
        const int e1 = (e0 + stride < NE) ? e0 + stride : e0; const bool two = e1 != e0;
        bf16* S0 = WSP(bf16, WS_M2S) + (((size_t)(e0 >> 16) * 128) * 8 + ((e0 >> 13) & 7)) * 8192 + (e0 & 8191); const float* D0 = WSP(const float, WS_M2D) + (size_t)(e0 >> 16) * 128 * 8 + ((e0 >> 13) & 7) + vz;
        bf16* S1 = WSP(bf16, WS_M2S) + (((size_t)(e1 >> 16) * 128) * 8 + ((e1 >> 13) & 7)) * 8192 + (e1 & 8191); const float* D1 = WSP(const float, WS_M2D) + (size_t)(e1 >> 16) * 128 * 8 + ((e1 >> 13) & 7) + vz;
        float run0 = 0.f, run1 = 0.f;
#pragma unroll 1
        for (int c0 = 0; c0 < 128; c0 += 16) {
            bf16 t0[16], t1[16]; float d0[16], d1[16];
#pragma unroll
            for (int j = 0; j < 16; ++j) { t0[j] = S0[(size_t)(c0 + j) * 8 * 8192]; d0[j] = D0[(c0 + j) * 8]; t1[j] = S1[(size_t)(c0 + j) * 8 * 8192]; d1[j] = D1[(c0 + j) * 8]; }
#pragma unroll
            for (int j = 0; j < 16; ++j) { S0[(size_t)(c0 + j) * 8 * 8192] = (bf16)f2bf(run0); run0 = d0[j] * run0 + bf2f(t0[j]);
                if (two) S1[(size_t)(c0 + j) * 8 * 8192] = (bf16)f2bf(run1); run1 = d1[j] * run1 + bf2f(t1[j]); }
        }
    }
}
__device__ __forceinline__ void m2_pass2(Frame& F, int l, int task) {
    const int b = task >> 8, c = (task >> 1) & 127, gr = task & 1;
    m2_stage(F, l, b, c, gr);
    LAS bf16* Cs = (LAS bf16*)(F.lds + M2_CS); LAS bf16* Bs = (LAS bf16*)(F.lds + M2_BS); LAS bf16* XT = (LAS bf16*)(F.lds + M2_XT);
    LAS float* Gs = (LAS float*)(F.lds + M2_GS); LAS float* cum = (LAS float*)(F.lds + M2_CUM); LAS float* dtv = (LAS float*)(F.lds + M2_DTV);
    const int lane = F.lane, w = F.wave, fr = lane & 15, fq = lane >> 4;
#pragma unroll
    for (int q = 0; q < 2; ++q) { const int tile = 2 * w + q, it = tile >> 2, jt = tile & 3; f32x4 a = (f32x4){0.f, 0.f, 0.f, 0.f};
#pragma unroll
        for (int kk = 0; kk < 4; ++kk) a = __builtin_amdgcn_mfma_f32_16x16x32_bf16(ldfrag(Cs + (16 * it + fr) * LDP + 32 * kk + 8 * fq), ldfrag(Bs + (16 * jt + fr) * LDP + 32 * kk + 8 * fq), a, 0, 0, 0);
#pragma unroll
        for (int e = 0; e < 4; ++e) Gs[(16 * it + 4 * fq + e) * LDG + 16 * jt + fr] = a[e]; }
    __syncthreads();
    const int hh = w >> 1, half = w & 1, h = 4 * gr + hh;
    f32x4 accd[2][4], acco[2][4];
#pragma unroll
    for (int i = 0; i < 2; ++i)
#pragma unroll
        for (int j = 0; j < 4; ++j) { accd[i][j] = (f32x4){0.f, 0.f, 0.f, 0.f}; acco[i][j] = (f32x4){0.f, 0.f, 0.f, 0.f}; }
#pragma unroll
    for (int ii = 0; ii < 2; ++ii) { const int it = 2 * half + ii; const int i = 16 * it + fr; const float ci = cum[hh * 64 + i];
#pragma unroll
        for (int kk = 0; kk < 2; ++kk) { if (32 * kk > 16 * it + 15) continue;
            float wv[8];
#pragma unroll
            for (int e = 0; e < 8; ++e) { const int j = 32 * kk + 8 * fq + e; const float gv = Gs[i * LDG + j]; wv[e] = (j <= i) ? gv * __expf(ci - cum[hh * 64 + j]) * dtv[hh * 64 + j] : 0.f; }
            u32x4 ww; ww.x = pk2(wv[0], wv[1]); ww.y = pk2(wv[2], wv[3]); ww.z = pk2(wv[4], wv[5]); ww.w = pk2(wv[6], wv[7]);
            const bf16x8 af = __builtin_bit_cast(bf16x8, ww);
#pragma unroll
            for (int pt = 0; pt < 4; ++pt) accd[ii][pt] = __builtin_amdgcn_mfma_f32_16x16x32_bf16(af, ldfrag(XT + (64 * hh + 16 * pt + fr) * LDT + 32 * kk + 8 * fq), accd[ii][pt], 0, 0, 0); } }
    const bf16* S = WSP(const bf16, WS_M2S) + ((((size_t)b * 128 + c) * 8 + h) * 64) * 128;
#pragma unroll
    for (int kk = 0; kk < 4; ++kk) {
        bf16x8 bfr[4];
#pragma unroll
        for (int pt = 0; pt < 4; ++pt) bfr[pt] = *(const bf16x8*)(S + (size_t)(16 * pt + fr) * 128 + 32 * kk + 8 * fq);
#pragma unroll
        for (int ii = 0; ii < 2; ++ii) { const bf16x8 af = ldfrag(Cs + (16 * (2 * half + ii) + fr) * LDP + 32 * kk + 8 * fq);
#pragma unroll
            for (int pt = 0; pt < 4; ++pt) acco[ii][pt] = __builtin_amdgcn_mfma_f32_16x16x32_bf16(af, bfr[pt], acco[ii][pt], 0, 0, 0); }
    }
    const float dpar = INP(23)[l * 8 + h]; const size_t row0 = (size_t)b * SEQ + (size_t)c * 64;
#pragma unroll
    for (int ii = 0; ii < 2; ++ii)
#pragma unroll
        for (int e = 0; e < 4; ++e) { const int i = 16 * (2 * half + ii) + 4 * fq + e; const float ec = __expf(cum[hh * 64 + i]);
#pragma unroll
            for (int pt = 0; pt < 4; ++pt) { const int p = 16 * pt + fr;
                float y = accd[ii][pt][e] + ec * acco[ii][pt][e] + dpar * bf2f(XT[(64 * hh + p) * LDT + i]);
                const float z = bf2f(WSP(const bf16, WS_PROJ)[(row0 + i) * MIXP + PC_M2Z + 64 * h + p]);
                WSP(float, WS_M2Y)[(row0 + i) * 512 + 64 * h + p] = y * siluf_(z); } }
    __syncthreads();
}
__device__ __forceinline__ void m2_norm(Frame& F, int l, int gw, int ngw) {
    f32x4 g0 = *(const f32x4*)(INP(24) + l * 512 + 8 * F.lane), g1 = *(const f32x4*)(INP(24) + l * 512 + 8 * F.lane + 4);
    for (int m = gw; m < MTOK; m += ngw) { const f32x4* yp = (const f32x4*)(WSP(const float, WS_M2Y) + (size_t)m * 512 + 8 * F.lane); const f32x4 a = yp[0], b = yp[1];
        const float ss = wave_sum((a.x * a.x + a.y * a.y) + (a.z * a.z + a.w * a.w) + (b.x * b.x + b.y * b.y) + (b.z * b.z + b.w * b.w));
        const float rs = 1.0f / sqrtf(ss * (1.f / 512.f) + 1e-6f);
        u32x4 w; w.x = pk2(a.x * rs * g0.x, a.y * rs * g0.y); w.y = pk2(a.z * rs * g0.z, a.w * rs * g0.w); w.z = pk2(b.x * rs * g1.x, b.y * rs * g1.y); w.w = pk2(b.z * rs * g1.z, b.w * rs * g1.w);
        *(u32x4*)(WSP(bf16, WS_YK) + (size_t)2 * MTOK * 512 + (size_t)m * 512 + 8 * F.lane) = w; }
}

constexpr int RP_LDA = 72, RP_LDB = 104;
#define RWP_WFRAG(dst, base, ldrow) do { const float* p_ = (base); u32x4 w_; w_.x = pk2(p_[0], p_[512]); w_.y = pk2(p_[1024], p_[1536]); w_.z = pk2(p_[2048], p_[2560]); w_.w = pk2(p_[3072], p_[3584]); dst = __builtin_bit_cast(bf16x8, w_); } while (0)
__device__ __forceinline__ void rw_pre(Frame& F, int l, int task) {
    LAS bf16* SM0 = (LAS bf16*)F.lds;
    const int tid = F.tid, lane = F.lane, hh = F.wave, fr = lane & 15, fq = lane >> 4;
    const float* mu = INP(25) + (size_t)l * RWC;
    const size_t rowb = (size_t)task * 128;
    const bf16* P = WSP(const bf16, WS_PROJ);
    const bool nofirst = (rowb & (SEQ - 1)) != 0;
    const int c4 = 64 * hh + 4 * fr;
    {
        bf16x8 Bw[4], Ba[4];
#pragma unroll
        for (int ct = 0; ct < 4; ++ct) { RWP_WFRAG(Bw[ct], INP(27) + ((size_t)l * 32 + 8 * fq) * 512 + c4 + ct, 512); RWP_WFRAG(Ba[ct], INP(29) + ((size_t)l * 32 + 8 * fq) * 512 + c4 + ct, 512); }
        const float* pw0 = INP(26) + l * 512 + c4; const float* pa0 = INP(28) + l * 512 + c4; const float* pkk = INP(31) + l * 512 + c4; const float* pka = INP(32) + l * 512 + c4; const float* prk = INP(33) + l * 512 + c4;
        const int sj = tid & 63, st0 = tid >> 6, st1 = 8 + (tid >> 6); const float smu = mu[1536 + sj];
        const bf16* sq = P + rowb * MIXP + PC_RW + 1536 + sj;
        bf16 sc0, sp0, sc1, sp1;
        u32x2 rkv[4][3], rkvp[3];
        const bf16* rq = P + (rowb + 4 * fq) * MIXP + PC_RW + c4;
#define RWP_STAGE_LOAD(sb) do { const size_t o_ = (size_t)((sb) * 16) * MIXP; sc0 = sq[o_ + (size_t)st0 * MIXP]; sc1 = sq[o_ + (size_t)st1 * MIXP]; sp1 = sq[o_ + (size_t)(st1 - 1) * MIXP]; \
            sp0 = (nofirst || (sb) > 0 || st0 > 0) ? sq[o_ + (size_t)st0 * MIXP - MIXP] : (bf16)0; } while (0)
#define RWP_STAGE_WRITE(buf) do { { const float pt_ = bf2f(sc0), pp_ = bf2f(sp0); const float pm_ = pt_ + (pp_ - pt_) * smu; SM0[(buf) * 1664 + st0 * RP_LDA + sj] = (bf16)f2bf(sj < 32 ? (1.0f - 2.0f * rcpf_(__expf(2.0f * pm_) + 1.0f)) : pm_); } \
            { const float pt_ = bf2f(sc1), pp_ = bf2f(sp1); const float pm_ = pt_ + (pp_ - pt_) * smu; SM0[(buf) * 1664 + st1 * RP_LDA + sj] = (bf16)f2bf(sj < 32 ? (1.0f - 2.0f * rcpf_(__expf(2.0f * pm_) + 1.0f)) : pm_); } } while (0)
#define RWP_RKV_LOAD(sb, cur, prev) do { const bf16* q_ = rq + (size_t)((sb) * 16) * MIXP; \
            _Pragma("unroll") for (int e_ = 0; e_ < 4; ++e_) _Pragma("unroll") for (int a_ = 0; a_ < 3; ++a_) cur[e_][a_] = *(const u32x2*)(q_ + (size_t)e_ * MIXP + 512 * a_); \
            const bool hp_ = nofirst || (sb) > 0 || fq > 0; \
            _Pragma("unroll") for (int a_ = 0; a_ < 3; ++a_) prev[a_] = hp_ ? *(const u32x2*)(q_ - (ptrdiff_t)MIXP + 512 * a_) : (u32x2){0u, 0u}; } while (0)
        RWP_STAGE_LOAD(0); RWP_RKV_LOAD(0, rkv, rkvp); RWP_STAGE_WRITE(0);
        __syncthreads();
#pragma unroll 1
        for (int sb = 0; sb < 8; ++sb) {
            if (sb < 7) { RWP_STAGE_LOAD(sb + 1); }
            const LAS bf16* SM = SM0 + (sb & 1) * 1664;
            const bf16x8 Aw = ldfrag(SM + fr * RP_LDA + 8 * fq), Aa = ldfrag(SM + fr * RP_LDA + 32 + 8 * fq);
            f32x4 aw[4], aa[4];
#pragma unroll
            for (int ct = 0; ct < 4; ++ct) { const f32x4 z = (f32x4){0.f, 0.f, 0.f, 0.f};
                aw[ct] = __builtin_amdgcn_mfma_f32_16x16x32_bf16(Aw, Bw[ct], z, 0, 0, 0); aa[ct] = __builtin_amdgcn_mfma_f32_16x16x32_bf16(Aa, Ba[ct], z, 0, 0, 0); }
            const size_t r0 = rowb + sb * 16 + 4 * fq;
            asm volatile("" ::: "memory");
            const f32x4 mu_r = *(const f32x4*)(mu + c4), mu_k = *(const f32x4*)(mu + 512 + c4), mu_v = *(const f32x4*)(mu + 1024 + c4);
            const f32x4 w0c = *(const f32x4*)pw0, a0c = *(const f32x4*)pa0, kkc = *(const f32x4*)pkk, kac = *(const f32x4*)pka, rkc = *(const f32x4*)prk;
#pragma unroll
            for (int e = 0; e < 4; ++e) { const size_t row = r0 + e; const size_t o = row * 512 + c4;
                const u32x2 pr_ = e == 0 ? rkvp[0] : rkv[e > 0 ? e - 1 : 0][0], pk_ = e == 0 ? rkvp[1] : rkv[e > 0 ? e - 1 : 0][1], pv_ = e == 0 ? rkvp[2] : rkv[e > 0 ? e - 1 : 0][2];
                const float rc[4] = {lo16(rkv[e][0].x), hi16(rkv[e][0].x), lo16(rkv[e][0].y), hi16(rkv[e][0].y)}, rp[4] = {lo16(pr_.x), hi16(pr_.x), lo16(pr_.y), hi16(pr_.y)};
                const float kc[4] = {lo16(rkv[e][1].x), hi16(rkv[e][1].x), lo16(rkv[e][1].y), hi16(rkv[e][1].y)}, kp[4] = {lo16(pk_.x), hi16(pk_.x), lo16(pk_.y), hi16(pk_.y)};
                const float vc[4] = {lo16(rkv[e][2].x), hi16(rkv[e][2].x), lo16(rkv[e][2].y), hi16(rkv[e][2].y)}, vp[4] = {lo16(pv_.x), hi16(pv_.x), lo16(pv_.y), hi16(pv_.y)};
                float rr[4], kpr[4], vv[4], kk[4], av[4], dec[4]; float ssp = 0.f, bonp = 0.f;
#pragma unroll
                for (int ct = 0; ct < 4; ++ct) {
                    rr[ct] = rc[ct] + (rp[ct] - rc[ct]) * mu_r[ct]; const float k = kc[ct] + (kp[ct] - kc[ct]) * mu_k[ct]; vv[ct] = vc[ct] + (vp[ct] - vc[ct]) * mu_v[ct];
                    const float wlog = -softplusf_(-(aw[ct][e] + w0c[ct])) - 0.5f; dec[ct] = __expf(-__expf(wlog)); av[ct] = sigmoidf_(aa[ct][e] + a0c[ct]);
                    kk[ct] = k * kkc[ct]; ssp += kk[ct] * kk[ct]; kpr[ct] = k * (1.0f + (av[ct] - 1.0f) * kac[ct]); bonp += rr[ct] * kpr[ct] * rkc[ct]; }
                const float ss = row16_sum(ssp), bon = row16_sum(bonp); const float rn = __builtin_amdgcn_rsqf(fmaxf(ss, 1e-24f));
                u32x2 w;
                w.x = pk2(rr[0], rr[1]); w.y = pk2(rr[2], rr[3]); *(u32x2*)(WSP(bf16, WS_RW_R) + o) = w;
                w.x = pk2(kpr[0], kpr[1]); w.y = pk2(kpr[2], kpr[3]); *(u32x2*)(WSP(bf16, WS_RW_K) + o) = w;
                w.x = pk2(vv[0], vv[1]); w.y = pk2(vv[2], vv[3]); *(u32x2*)(WSP(bf16, WS_RW_V) + o) = w;
                w.x = pk2(-kk[0] * rn, -kk[1] * rn); w.y = pk2(-kk[2] * rn, -kk[3] * rn); *(u32x2*)(WSP(bf16, WS_RW_A) + o) = w;
                w.x = pk2(kk[0] * rn * av[0], kk[1] * rn * av[1]); w.y = pk2(kk[2] * rn * av[2], kk[3] * rn * av[3]); *(u32x2*)(WSP(bf16, WS_RW_B) + o) = w;
                *(f32x4*)(WSP(float, WS_RW_DEC) + o) = (f32x4){dec[0], dec[1], dec[2], dec[3]};
                if (fr == 0) WSP(float, WS_RW_BON)[row * 8 + hh] = bon; }
            if (sb < 7) { RWP_RKV_LOAD(sb + 1, rkv, rkvp); RWP_STAGE_WRITE((sb + 1) & 1); }
            __syncthreads();
        }
#undef RWP_STAGE_LOAD
#undef RWP_STAGE_WRITE
#undef RWP_RKV_LOAD
    }
    {
        int tidb = F.tid; asm volatile("" : "+v"(tidb));
        const int tid = tidb, lane = tid & 63, fr = lane & 15, fq = lane >> 4; const int c4 = 64 * hh + 4 * fr;
        bf16x8 Bg[4][3];
#pragma unroll
        for (int ct = 0; ct < 4; ++ct)
#pragma unroll
            for (int kk = 0; kk < 3; ++kk) RWP_WFRAG(Bg[ct][kk], INP(30) + ((size_t)l * 96 + 32 * kk + 8 * fq) * 512 + c4 + ct, 512);
        int stk[3], sjj[3]; float smv[3]; bf16 sc[3], sp[3];
#pragma unroll
        for (int i = 0; i < 3; ++i) { const int idx = tid + 512 * i; stk[i] = idx / 96; sjj[i] = idx % 96; smv[i] = mu[1600 + sjj[i]]; }
        const bf16* sq = P + rowb * MIXP + PC_RW + 1600;
#define RWP_STAGE_LOAD(sb) do { _Pragma("unroll") for (int i_ = 0; i_ < 3; ++i_) { const bf16* q_ = sq + (size_t)((sb) * 16 + stk[i_]) * MIXP + sjj[i_]; sc[i_] = q_[0]; \
            sp[i_] = (nofirst || (sb) > 0 || stk[i_] > 0) ? *(q_ - (ptrdiff_t)MIXP) : (bf16)0; } } while (0)
#define RWP_STAGE_WRITE(buf) do { _Pragma("unroll") for (int i_ = 0; i_ < 3; ++i_) { const float pt_ = bf2f(sc[i_]), pp_ = bf2f(sp[i_]); \
            SM0[(buf) * 1664 + stk[i_] * RP_LDB + sjj[i_]] = (bf16)f2bf(sigmoidf_(pt_ + (pp_ - pt_) * smv[i_])); } } while (0)
        RWP_STAGE_LOAD(0); RWP_STAGE_WRITE(0);
        __syncthreads();
#pragma unroll 1
        for (int sb = 0; sb < 8; ++sb) {
            if (sb < 7) RWP_STAGE_LOAD(sb + 1);
            const LAS bf16* SM = SM0 + (sb & 1) * 1664;
            const bf16x8 Ag0 = ldfrag(SM + fr * RP_LDB + 8 * fq), Ag1 = ldfrag(SM + fr * RP_LDB + 32 + 8 * fq), Ag2 = ldfrag(SM + fr * RP_LDB + 64 + 8 * fq);
            f32x4 ag[4];
#pragma unroll
            for (int ct = 0; ct < 4; ++ct) { f32x4 g = __builtin_amdgcn_mfma_f32_16x16x32_bf16(Ag0, Bg[ct][0], (f32x4){0.f, 0.f, 0.f, 0.f}, 0, 0, 0);
                g = __builtin_amdgcn_mfma_f32_16x16x32_bf16(Ag1, Bg[ct][1], g, 0, 0, 0); ag[ct] = __builtin_amdgcn_mfma_f32_16x16x32_bf16(Ag2, Bg[ct][2], g, 0, 0, 0); }
            const size_t r0 = rowb + sb * 16 + 4 * fq;
#pragma unroll
            for (int e = 0; e < 4; ++e) { u32x2 w; w.x = pk2(ag[0][e], ag[1][e]); w.y = pk2(ag[2][e], ag[3][e]); *(u32x2*)(WSP(bf16, WS_RW_G) + (r0 + e) * 512 + c4) = w; }
            if (sb < 7) RWP_STAGE_WRITE((sb + 1) & 1);
            __syncthreads();
        }
#undef RWP_STAGE_LOAD
#undef RWP_STAGE_WRITE
    }
}
constexpr int RC_G1 = 0, RC_G2 = 8192, RC_Q1 = 10240, RC_Q2 = 12288, RC_GAM = 13312, RC_VT = 13568, RC_BYTES = 16384;
constexpr size_t WS_RWC = WS_PROJ;
constexpr int CP_IMG = 0, CP_MAT = 9216, CP_P2 = 13568, CP_Q2 = 14656;
constexpr int CP_P1I = 0, CP_BGI = 3072, CP_Q1I = 6144;
#define PREP_PK(r) ((r) < 6 ? (r) : (r) < 8 ? (r) + 3 : (r) < 10 ? (r) + 3 : (r) < 12 ? (r) - 4 : 8)
__device__ __forceinline__ void prep_flush(Frame& F, int task, int lane) {
    const LAS unsigned char* wl = F.lds + F.wave * WAVE_LDS; unsigned char* rec = F.ws + WS_PROJ + (size_t)task * 16384;
#pragma unroll
    for (int r = 0; r < 13; ++r) *(u32x4*)(rec + r * 1024 + lane * 16) = *(const LAS u32x4*)(wl + PREP_PK(r) * 1024 + lane * 16);
}
__device__ __forceinline__ void rw_chunk_prep(Frame& F, int task, int prev) {
    int lane = F.lane; asm volatile("" : "+v"(lane)); const int fr = lane & 15, fq = lane >> 4; const int b = task >> 12, h = (task >> 9) & 7, c = task & 511;
    LAS unsigned char* wl = F.lds + F.wave * WAVE_LDS;
    LAS bf16* IMG = (LAS bf16*)(wl + CP_IMG); LAS float* MAT = (LAS float*)(wl + CP_MAT); LAS float* P2m = (LAS float*)(wl + CP_P2); LAS float* Q2m = (LAS float*)(wl + CP_Q2);
    unsigned char* rec = F.ws + WS_RWC + (size_t)task * RC_BYTES;
    const size_t e0 = ((size_t)b * SEQ + (size_t)c * 16) * 512 + 64 * h + lane;
    float At[16], Bt[16], Kt[16], Rt[16]; float gT;
    { float wv[16]; bf16 av[16], bv[16], kv[16], rv[16];
#pragma unroll
      for (int t = 0; t < 16; ++t) { const size_t o = e0 + (size_t)t * 512; wv[t] = WSP(const float, WS_RW_DEC)[o]; av[t] = WSP(const bf16, WS_RW_A)[o]; bv[t] = WSP(const bf16, WS_RW_B)[o]; kv[t] = WSP(const bf16, WS_RW_K)[o]; rv[t] = WSP(const bf16, WS_RW_R)[o]; }
      asm volatile("" ::: "memory");
      if (prev >= 0) prep_flush(F, prev, lane);
      asm volatile("" ::: "memory");
      float g = 1.0f;
#pragma unroll
      for (int t = 0; t < 16; ++t) { const float gp = g; g *= wv[t]; const float inv = rcpf_(g);
          At[t] = bf2f(av[t]) * gp; Bt[t] = bf2f(bv[t]) * inv; Kt[t] = bf2f(kv[t]) * inv; Rt[t] = bf2f(rv[t]) * g;
          IMG[0 * 1152 + t * 72 + lane] = (bf16)f2bf(At[t]); IMG[1 * 1152 + t * 72 + lane] = (bf16)f2bf(Bt[t]); IMG[2 * 1152 + t * 72 + lane] = (bf16)f2bf(Kt[t]); IMG[3 * 1152 + t * 72 + lane] = (bf16)f2bf(Rt[t]); }
      gT = g; }
    { unsigned vp[8];
#pragma unroll
      for (int t = 0; t < 16; t += 2) vp[t >> 1] = (unsigned)WSP(const bf16, WS_RW_V)[e0 + (size_t)t * 512] | ((unsigned)WSP(const bf16, WS_RW_V)[e0 + (size_t)(t + 1) * 512] << 16);
      u32x4* d = (u32x4*)(rec + RC_VT + lane * 32); d[0] = (u32x4){vp[0], vp[1], vp[2], vp[3]}; d[1] = (u32x4){vp[4], vp[5], vp[6], vp[7]};
      ((float*)(rec + RC_GAM))[lane] = gT; }
    { f32x4 nab = (f32x4){0.f, 0.f, 0.f, 0.f}, nak = nab, mbr = nab, mkr = nab;
#pragma unroll
      for (int kk = 0; kk < 2; ++kk) { const int o = fr * 72 + 32 * kk + 8 * fq;
          const bf16x8 fa = ldfrag(IMG + 0 * 1152 + o), fb = ldfrag(IMG + 1 * 1152 + o), fk = ldfrag(IMG + 2 * 1152 + o), frr = ldfrag(IMG + 3 * 1152 + o);
          nab = __builtin_amdgcn_mfma_f32_16x16x32_bf16(fb, fa, nab, 0, 0, 0); nak = __builtin_amdgcn_mfma_f32_16x16x32_bf16(fk, fa, nak, 0, 0, 0);
          mbr = __builtin_amdgcn_mfma_f32_16x16x32_bf16(fb, frr, mbr, 0, 0, 0); mkr = __builtin_amdgcn_mfma_f32_16x16x32_bf16(fk, frr, mkr, 0, 0, 0); }
#pragma unroll
      for (int e = 0; e < 4; ++e) { const int s_ = 4 * fq + e, t_ = fr; const int o = s_ * 17 + t_;
          MAT[0 * 272 + o] = s_ < t_ ? nab[e] : 0.f; MAT[1 * 272 + o] = s_ < t_ ? nak[e] : 0.f; MAT[2 * 272 + o] = s_ <= t_ ? mbr[e] : 0.f; MAT[3 * 272 + o] = s_ <= t_ ? mkr[e] : 0.f; } }
    float P1[16], P2[16];
#pragma unroll
    for (int t = 0; t < 16; ++t) { float p1 = At[t], p2 = MAT[1 * 272 + fr * 17 + t];
#pragma unroll
        for (int s_ = 0; s_ < t; ++s_) { const float n = MAT[0 * 272 + s_ * 17 + t]; p1 += P1[s_] * n; p2 += P2[s_] * n; }
        P1[t] = p1; P2[t] = p2; asm volatile("" ::: "memory"); }
    LAS bf16* Q1I = (LAS bf16*)(wl + CP_Q1I);
#pragma unroll
    for (int t = 0; t < 16; ++t) { float q1 = Rt[t], q2 = MAT[3 * 272 + fr * 17 + t];
#pragma unroll
        for (int s_ = 0; s_ <= t; ++s_) { const float m = MAT[2 * 272 + s_ * 17 + t]; q1 += P1[s_] * m; q2 += P2[s_] * m; }
        Q1I[t * 72 + lane] = (bf16)f2bf(q1); if (lane < 16) { Q2m[lane * 17 + t] = q2; P2m[lane * 17 + t] = P2[t]; }
        asm volatile("" ::: "memory"); }
    { LAS bf16* P1I = (LAS bf16*)(wl + CP_P1I); LAS bf16* BGI = (LAS bf16*)(wl + CP_BGI);
      u32x4 w0, w1;
      w0.x = pk2(P1[0], P1[1]); w0.y = pk2(P1[2], P1[3]); w0.z = pk2(P1[4], P1[5]); w0.w = pk2(P1[6], P1[7]); w1.x = pk2(P1[8], P1[9]); w1.y = pk2(P1[10], P1[11]); w1.z = pk2(P1[12], P1[13]); w1.w = pk2(P1[14], P1[15]);
      *(LAS u32x4*)(P1I + lane * 24) = w0; *(LAS u32x4*)(P1I + lane * 24 + 8) = w1;
      w0.x = pk2(Bt[0] * gT, Bt[1] * gT); w0.y = pk2(Bt[2] * gT, Bt[3] * gT); w0.z = pk2(Bt[4] * gT, Bt[5] * gT); w0.w = pk2(Bt[6] * gT, Bt[7] * gT);
      w1.x = pk2(Bt[8] * gT, Bt[9] * gT); w1.y = pk2(Bt[10] * gT, Bt[11] * gT); w1.z = pk2(Bt[12] * gT, Bt[13] * gT); w1.w = pk2(Bt[14] * gT, Bt[15] * gT);
      *(LAS u32x4*)(BGI + lane * 24) = w0; *(LAS u32x4*)(BGI + lane * 24 + 8) = w1;
      const u32x4 z4 = (u32x4){0u, 0u, 0u, 0u};
      bf16x8 Af[4], Bf[4];
#pragma unroll
      for (int i = 0; i < 4; ++i) { u32x4 ta = z4, tb = z4; if (fq < 2) { ta = *(const LAS u32x4*)(P1I + (16 * i + fr) * 24 + 8 * fq); tb = *(const LAS u32x4*)(BGI + (16 * i + fr) * 24 + 8 * fq); }
          Af[i] = __builtin_bit_cast(bf16x8, ta); Bf[i] = __builtin_bit_cast(bf16x8, tb); }
#pragma unroll
      for (int j = 0; j < 4; ++j)
#pragma unroll
          for (int s_ = 0; s_ < 2; ++s_) { const f32x4 lo = __builtin_amdgcn_mfma_f32_16x16x32_bf16(Af[2 * s_], Bf[j], (f32x4){0.f, 0.f, 0.f, 0.f}, 0, 0, 0);
              const f32x4 hi = __builtin_amdgcn_mfma_f32_16x16x32_bf16(Af[2 * s_ + 1], Bf[j], (f32x4){0.f, 0.f, 0.f, 0.f}, 0, 0, 0);
              u32x4 w; w.x = pk2(lo[0], lo[1]); w.y = pk2(lo[2], lo[3]); w.z = pk2(hi[0], hi[1]); w.w = pk2(hi[2], hi[3]);
              *(LAS u32x4*)(wl + PREP_PK(j * 2 + s_) * 1024 + lane * 16) = w; } }
    { float g2v[16];
#pragma unroll
      for (int t = 0; t < 16; ++t) { float acc = Kt[t];
#pragma unroll
          for (int s_ = 0; s_ < 16; ++s_) acc += P2m[t * 17 + s_] * Bt[s_];
          g2v[t] = acc * gT; asm volatile("" ::: "memory"); }
      u32x4 w0, w1; w0.x = pk2(g2v[0], g2v[1]); w0.y = pk2(g2v[2], g2v[3]); w0.z = pk2(g2v[4], g2v[5]); w0.w = pk2(g2v[6], g2v[7]); w1.x = pk2(g2v[8], g2v[9]); w1.y = pk2(g2v[10], g2v[11]); w1.z = pk2(g2v[12], g2v[13]); w1.w = pk2(g2v[14], g2v[15]);
      LAS u32x4* d = (LAS u32x4*)(wl + PREP_PK(8) * 1024 + lane * 32); d[0] = w0; d[1] = w1; }
    { u32x4 q1s[2];
#pragma unroll
      for (int s_ = 0; s_ < 2; ++s_) { const u32x2 lo = *(const LAS u32x2*)(Q1I + fr * 72 + 32 * s_ + 4 * fq), hi = *(const LAS u32x2*)(Q1I + fr * 72 + 32 * s_ + 16 + 4 * fq);
          q1s[s_] = (u32x4){lo.x, lo.y, hi.x, hi.y}; }
      asm volatile("s_waitcnt lgkmcnt(0)" ::: "memory");
#pragma unroll
      for (int s_ = 0; s_ < 2; ++s_) *(LAS u32x4*)(wl + PREP_PK(10 + s_) * 1024 + lane * 16) = q1s[s_]; }
    { u32x4 w = (u32x4){0u, 0u, 0u, 0u};
      if (fq < 2) { float q[8];
#pragma unroll
          for (int j = 0; j < 8; ++j) q[j] = Q2m[(8 * fq + j) * 17 + fr];
          w.x = pk2(q[0], q[1]); w.y = pk2(q[2], q[3]); w.z = pk2(q[4], q[5]); w.w = pk2(q[6], q[7]); }
      *(LAS u32x4*)(wl + PREP_PK(12) * 1024 + lane * 16) = w; }
}
__device__ __forceinline__ void rw_chunk_step(const LAS unsigned char* rc, f32x4 (&X)[4], float* yo, int w, int lane, int fr, int fq) {
    const u32x4 z4 = (u32x4){0u, 0u, 0u, 0u};
    u32x4 b0, b1; b0.x = pk2(X[0][0], X[0][1]); b0.y = pk2(X[0][2], X[0][3]); b0.z = pk2(X[1][0], X[1][1]); b0.w = pk2(X[1][2], X[1][3]);
    b1.x = pk2(X[2][0], X[2][1]); b1.y = pk2(X[2][2], X[2][3]); b1.z = pk2(X[3][0], X[3][1]); b1.w = pk2(X[3][2], X[3][3]);
    const bf16x8 Bx0 = __builtin_bit_cast(bf16x8, b0), Bx1 = __builtin_bit_cast(bf16x8, b1);
    u32x4 vt = z4; if (fq < 2) vt = *(const LAS u32x4*)(rc + RC_VT + (16 * w + fr) * 32 + 16 * fq);
    const bf16x8 Vf = __builtin_bit_cast(bf16x8, vt);
    f32x4 Y = (f32x4){0.f, 0.f, 0.f, 0.f};
    Y = __builtin_amdgcn_mfma_f32_16x16x32_bf16(*(const LAS bf16x8*)(rc + RC_Q1 + (0 * 64 + lane) * 16), Bx0, Y, 0, 0, 0);
    Y = __builtin_amdgcn_mfma_f32_16x16x32_bf16(*(const LAS bf16x8*)(rc + RC_Q1 + (1 * 64 + lane) * 16), Bx1, Y, 0, 0, 0);
    Y = __builtin_amdgcn_mfma_f32_16x16x32_bf16(*(const LAS bf16x8*)(rc + RC_Q2 + lane * 16), Vf, Y, 0, 0, 0);
#pragma unroll
    for (int j = 0; j < 4; ++j) { const f32x4 gm = *(const LAS f32x4*)(rc + RC_GAM + (16 * j + 4 * fq) * 4);
        f32x4 C = X[j] * gm;
        C = __builtin_amdgcn_mfma_f32_16x16x32_bf16(*(const LAS bf16x8*)(rc + RC_G1 + ((j * 2 + 0) * 64 + lane) * 16), Bx0, C, 0, 0, 0);
        C = __builtin_amdgcn_mfma_f32_16x16x32_bf16(*(const LAS bf16x8*)(rc + RC_G1 + ((j * 2 + 1) * 64 + lane) * 16), Bx1, C, 0, 0, 0);
        u32x4 g2 = z4; if (fq < 2) g2 = *(const LAS u32x4*)(rc + RC_G2 + (16 * j + fr) * 32 + 16 * fq);
        C = __builtin_amdgcn_mfma_f32_16x16x32_bf16(__builtin_bit_cast(bf16x8, g2), Vf, C, 0, 0, 0);
        X[j] = C; }
#pragma unroll
    for (int e = 0; e < 4; ++e) yo[(size_t)(4 * fq + e) * 512] = Y[e];
}
__device__ __forceinline__ void rw_scan2(Frame& F, int task) {
    const int tid = F.tid, lane = F.lane, w = F.wave, fr = lane & 15, fq = lane >> 4;
    const unsigned char* recs = F.ws + WS_RWC + (size_t)task * 512 * RC_BYTES;
    constexpr int NP = SEQ / 32;
    if (w >= 4) {
        const int lt = tid - 256;
        const u32x4* src = (const u32x4*)recs + lt;
        u32x4 rg[4][8];
#pragma unroll
        for (int u = 0; u < 4; ++u)
#pragma unroll
            for (int i = 0; i < 8; ++i) rg[u][i] = src[(size_t)u * 2048 + i * 256];
#pragma unroll 1
        for (int g4 = 0; g4 < NP / 4; ++g4) {
#pragma unroll
            for (int u = 0; u < 4; ++u) { const int g = 4 * g4 + u;
                LAS u32x4* dst = (LAS u32x4*)(F.lds + ((2 * g) & 7) * RC_BYTES) + lt;
#pragma unroll
                for (int i = 0; i < 8; ++i) dst[i * 256] = rg[u][i];
                if (g + 4 < NP) {
#pragma unroll
                    for (int i = 0; i < 8; ++i) rg[u][i] = src[(size_t)(g + 4) * 2048 + i * 256]; }
                __syncthreads(); }
        }
        __syncthreads();
    } else {
        const int b = task >> 3, h = task & 7;
        f32x4 X[4];
#pragma unroll
        for (int j = 0; j < 4; ++j) X[j] = (f32x4){0.f, 0.f, 0.f, 0.f};
        float* yo = WSP(float, WS_RW_Y) + ((size_t)b * SEQ) * 512 + 64 * h + 16 * w + fr;
        __syncthreads();
#pragma unroll 1
        for (int g = 0; g < NP; ++g) {
            rw_chunk_step(F.lds + ((2 * g) & 7) * RC_BYTES, X, yo + (size_t)(2 * g) * 16 * 512, w, lane, fr, fq);
            rw_chunk_step(F.lds + ((2 * g + 1) & 7) * RC_BYTES, X, yo + (size_t)(2 * g + 1) * 16 * 512, w, lane, fr, fq);
            __syncthreads();
        }
    }
}
__device__ __forceinline__ void rw_post(Frame& F, int l, int gw, int ngw) {
    const int lane = F.lane;
    const f32x4 g0 = *(const f32x4*)(INP(34) + l * 512 + 8 * lane), g1 = *(const f32x4*)(INP(34) + l * 512 + 8 * lane + 4);
    const f32x4 b0 = *(const f32x4*)(INP(35) + l * 512 + 8 * lane), b1 = *(const f32x4*)(INP(35) + l * 512 + 8 * lane + 4);
    for (int m = gw; m < MTOK; m += ngw) { const size_t o = (size_t)m * 512 + 8 * lane;
        const f32x4 ya = *(const f32x4*)(WSP(const float, WS_RW_Y) + o), yb = *(const f32x4*)(WSP(const float, WS_RW_Y) + o + 4);
        float y[8] = {ya.x, ya.y, ya.z, ya.w, yb.x, yb.y, yb.z, yb.w};
        float s = 0.f;
#pragma unroll
        for (int j = 0; j < 8; ++j) s += y[j];
        s += __shfl_xor(s, 1); s += __shfl_xor(s, 2); s += __shfl_xor(s, 4); const float mean = s * (1.f / 64.f);
        float qv = 0.f;
#pragma unroll
        for (int j = 0; j < 8; ++j) { y[j] -= mean; qv += y[j] * y[j]; }
        qv += __shfl_xor(qv, 1); qv += __shfl_xor(qv, 2); qv += __shfl_xor(qv, 4); const float rs = 1.0f / sqrtf(qv * (1.f / 64.f) + 64e-5f);
        const u32x4 vr = *(const u32x4*)(WSP(const bf16, WS_RW_V) + o), gr_ = *(const u32x4*)(WSP(const bf16, WS_RW_G) + o);
        const float bon = WSP(const float, WS_RW_BON)[(size_t)m * 8 + (lane >> 3)];
        const float vv[8] = {lo16(vr.x), hi16(vr.x), lo16(vr.y), hi16(vr.y), lo16(vr.z), hi16(vr.z), lo16(vr.w), hi16(vr.w)};
        const float gg[8] = {lo16(gr_.x), hi16(gr_.x), lo16(gr_.y), hi16(gr_.y), lo16(gr_.z), hi16(gr_.z), lo16(gr_.w), hi16(gr_.w)};
        const float lg[8] = {g0.x, g0.y, g0.z, g0.w, g1.x, g1.y, g1.z, g1.w}, lb[8] = {b0.x, b0.y, b0.z, b0.w, b1.x, b1.y, b1.z, b1.w};
        float ov[8];
#pragma unroll
        for (int j = 0; j < 8; ++j) ov[j] = (y[j] * rs * lg[j] + lb[j] + bon * vv[j]) * gg[j];
        u32x4 w; w.x = pk2(ov[0], ov[1]); w.y = pk2(ov[2], ov[3]); w.z = pk2(ov[4], ov[5]); w.w = pk2(ov[6], ov[7]);
        *(u32x4*)(WSP(bf16, WS_YK) + (size_t)3 * MTOK * 512 + o) = w; }
}

#ifndef GATE_NA
#define GATE_NA 17
#endif
#ifndef PHMASK
#define PHMASK 0xFFFFFFFFu
#endif
#define PH(n) (((PHMASK) >> (n)) & 1u)
#ifndef REPMASK
#define REPMASK 0u
#endif
#define NREP(n) ((((REPMASK) >> (n)) & 1u) ? 2 : 1)
#ifndef TPSMASK
#define TPSMASK 0u
#endif
#define TPS_B(n) unsigned long long tps_##n = 0ull; if (((TPSMASK) >> (n)) & 1u) tps_##n = __builtin_amdgcn_s_memrealtime()
#define TPS_E(n) do { if (((TPSMASK) >> (n)) & 1u) { const unsigned long long t1_ = __builtin_amdgcn_s_memrealtime(); const unsigned long long d_ = t1_ - tps_##n; while (__builtin_amdgcn_s_memrealtime() - t1_ < d_) __builtin_amdgcn_s_sleep(8); } } while (0)
#ifndef TPMASK
#define TPMASK 0u
#endif
#define TP(n) do { if (((TPMASK) >> (n)) & 1u) { const unsigned long long t1_ = __builtin_amdgcn_s_memrealtime(); const unsigned long long d_ = t1_ - tp0; while (__builtin_amdgcn_s_memrealtime() - t1_ < d_) __builtin_amdgcn_s_sleep(8); tp0 = __builtin_amdgcn_s_memrealtime(); } else if (TPMASK) tp0 = __builtin_amdgcn_s_memrealtime(); } while (0)
template <class T> __device__ __forceinline__ T* launder_ptr(T* p) { const unsigned long long w = (unsigned long long)p; unsigned lo = __builtin_amdgcn_readfirstlane((unsigned)w), hi = __builtin_amdgcn_readfirstlane((unsigned)(w >> 32));
    asm volatile("" : "+s"(lo), "+s"(hi)); return (T*)(GAS T*)(((unsigned long long)hi << 32) | lo); }
#define PHASE_BEGIN() do { F.ws = launder_ptr(F.ws); F.out = launder_ptr(F.out); { unsigned la_ = __builtin_amdgcn_readfirstlane((unsigned)(size_t)F.lds); int bk_ = __builtin_amdgcn_readfirstlane(F.blk); asm volatile("" : "+s"(la_), "+s"(bk_)); F.lds = (LAS unsigned char*)(size_t)la_; F.blk = bk_; } { int wv_ = __builtin_amdgcn_readfirstlane(F.wave); asm volatile("" : "+s"(wv_)); F.wave = wv_; } F.tid = F.wave * 64 + (int)__builtin_amdgcn_mbcnt_hi(~0u, __builtin_amdgcn_mbcnt_lo(~0u, 0u)); asm volatile("" : "+v"(F.tid)); F.lane = F.tid & 63; } while (0)
__global__ void __launch_bounds__(NTHR, 2) hybrid_fwd(Args args) {
    extern __shared__ __attribute__((aligned(16))) unsigned char lds_raw[];
    Frame F;
    F.lds = (LAS unsigned char*)lds_raw; F.out = args.out; F.ws = args.ws;
    F.tid = threadIdx.x; F.lane = F.tid & 63; F.wave = __builtin_amdgcn_readfirstlane(F.tid >> 6); F.blk = blockIdx.x; F.G = gridDim.x;
    volatile LAS unsigned* MISC = (volatile LAS unsigned*)(F.lds + LDS_MISC);
    if (F.tid < 64) MISC[F.tid] = 0u;
    if (F.tid < 45) { const unsigned long long p = ((const __attribute__((address_space(4))) unsigned long long*)__builtin_amdgcn_kernarg_segment_ptr())[F.tid]; MISC[64 + 2 * F.tid] = (unsigned)p; MISC[64 + 2 * F.tid + 1] = (unsigned)(p >> 32); }
    __syncthreads();
    XcdBarrier bar = xcd_barrier_post((unsigned*)(F.ws + WS_CTL) + CW_BAR, MISC + 8);
#define gw (F.blk * NWAVES + F.wave)
#define NGW (F.G * NWAVES)
#define glds (F.lds)

    unsigned long long tp0 = TPMASK ? __builtin_amdgcn_s_memrealtime() : 0ull;
#pragma unroll 1
    for (int l = 0; l < DEPTH; ++l) {
        const float* xin = (l == 0) ? INP(0) : F.out;
        PHASE_BEGIN();
        for (int rep_ = 0; rep_ < NREP(0); ++rep_) if (PH(0)) { convert_weights(F, l);
            for (int nb = F.blk; nb < NGATE / 32 + 2 * (FF / 32); nb += F.G) {
                const int seg = nb < NGATE / 32 ? 0 : (nb < NGATE / 32 + FF / 32 ? 1 : 2);
                const float* Wp = seg == 0 ? INP(2) + (size_t)l * DM * INC : (seg == 1 ? INP(39) : INP(40)) + (size_t)l * DM * FF;
                signed char* W8p = seg == 0 ? WSP(signed char, WS_WIN) + (size_t)MIXP * DM * 2 : (seg == 1 ? WSP(signed char, WS_WFG) : WSP(signed char, WS_WFU));
                convert_cols_i8(F, Wp, seg == 0 ? INC : FF, seg == 0 ? MIXC : 0, nb - (seg == 0 ? 0 : (seg == 1 ? NGATE / 32 : NGATE / 32 + FF / 32)), W8p, WSP(float, WS_SB) + 16384 * seg, 0); }
            { const float* cw = INP(41) + (size_t)l * 3 * FF; const float* cb = INP(42) + (size_t)l * FF;
              for (int c = F.blk * 512 + F.tid; c < FF; c += F.G * 512) { WSP(unsigned, WS_SB)[65536 + c] = pk2(cw[c], cw[FF + c]); WSP(unsigned, WS_SB)[65536 + 8192 + c] = pk2(cw[2 * FF + c], cb[c]); } } }
        PHASE_BEGIN();
        for (int rep_ = 0; rep_ < NREP(1); ++rep_) if (PH(1)) rmsnorm_rows(F, l == 0 ? INP(0) : nullptr, (const bf16*)F.out, INP(1) + (size_t)l * DM, WSP(bf16, WS_H), nullptr, WSP(unsigned, WS_A8), WSP(float, WS_SA));
        xcd_barrier(bar); TP(0);
        PHASE_BEGIN();
        for (int rep_ = 0; rep_ < NREP(2); ++rep_) if (PH(2)) { pg8::Gemm g{WSP(const bf16, WS_H), WSP(const bf16, WS_WIN), MTOK, MIXP, DM}; pg8::StaticOrder S; S.init(MTOK, MIXP, F.G, F.blk);
          pg8::EpiStore<0> E{WSP(bf16, WS_PROJ), MIXP}; pg8::gemm_phase(glds, g, S, E, F.tid); }
        PHASE_BEGIN();
        if (PH(2) && F.blk >= 128) {
          pg8::Gemm g{WSP(const bf16, WS_A8), (const bf16*)(WSP(const signed char, WS_WIN) + (size_t)MIXP * DM * 2), MTOK, NGATE, DM / 2};
          pg8::SplitOrder S; S.init(MTOK, NGATE, 128, F.blk - 128, 4096 - 256, 2);
          pg8::EpiGateU8 E{WSP(unsigned char, WS_GATES), WSP(const float, WS_SA), WSP(const float, WS_SB)}; pg8::gemm_phase(glds, g, S, E, F.tid); }
        xcd_barrier(bar); TP(1);
        PHASE_BEGIN();
        TPS_B(3); for (int rep_ = 0; rep_ < NREP(3); ++rep_) if (PH(3)) for (int t = F.blk; t < MTOK / 128; t += F.G) rw_pre(F, l, t); TPS_E(3);
        PHASE_BEGIN();
        TPS_B(4); for (int rep_ = 0; rep_ < NREP(4); ++rep_) if (PH(4)) for (int t = F.blk; t < 1024; t += F.G) m2_pass1(F, l, t); TPS_E(4);
        PHASE_BEGIN();
        TPS_B(5); for (int rep_ = 0; rep_ < NREP(5); ++rep_) if (PH(5)) for (int t = gw; t < 8192; t += NGW) s5_task<false>(F, l, t); TPS_E(5);
        PHASE_BEGIN();
        TPS_B(6); for (int rep_ = 0; rep_ < NREP(6); ++rep_) if (PH(6)) for (int t = gw; t < 2048; t += NGW) lru_task<false>(F, l, t); TPS_E(6);
        xcd_barrier(bar); TP(2);
        PHASE_BEGIN();
        for (int rep_ = 0; rep_ < NREP(7); ++rep_) if (PH(7)) m2_carry(F);
        PHASE_BEGIN();
        for (int rep_ = 0; rep_ < NREP(8); ++rep_) if (PH(8)) for (int t = gw; t < 128; t += NGW) s5_carry(F, l, t);
        PHASE_BEGIN();
        for (int rep_ = 0; rep_ < NREP(9); ++rep_) if (PH(9)) for (int t = NGW - 1 - gw; t < 32; t += NGW) lru_carry(F, t);
        xcd_barrier(bar); TP(3);
        PHASE_BEGIN();
        TPS_B(10); for (int rep_ = 0; rep_ < NREP(10); ++rep_) if (PH(10)) for (int t = F.blk; t < 1024; t += F.G) m2_pass2(F, l, t); TPS_E(10);
        PHASE_BEGIN();
        TPS_B(11); for (int rep_ = 0; rep_ < NREP(11); ++rep_) if (PH(11)) for (int t = gw; t < 8192; t += NGW) s5_task<true>(F, l, t); TPS_E(11);
        PHASE_BEGIN();
        TPS_B(12); for (int rep_ = 0; rep_ < NREP(12); ++rep_) if (PH(12)) for (int t = gw; t < 2048; t += NGW) lru_task<true>(F, l, t); TPS_E(12);
        xcd_barrier(bar); TP(4);
        PHASE_BEGIN();
        for (int rep_ = 0; rep_ < NREP(14); ++rep_) if (PH(14)) {
            { pg8::Gemm g{WSP(const bf16, WS_S5Z), WSP(const bf16, WS_WGLU), MTOK, 512, 512}; pg8::StaticOrder S; S.init(MTOK, 512, F.G, F.blk);
              pg8::EpiGlu E{WSP(const bf16, WS_S5Z), WSP(bf16, WS_YK)}; pg8::gemm_phase(glds, g, S, E, F.tid); }
            m2_norm(F, l, gw, NGW);
        }
        PHASE_BEGIN();
        TPS_B(24); if (PH(24)) { int prev = -1;
#pragma unroll 1
            for (int t = gw; t < NB * 8 * 512; t += NGW) { rw_chunk_prep(F, t, prev); prev = t; }
            if (prev >= 0) prep_flush(F, prev, F.lane); } TPS_E(24);
        xcd_barrier(bar); TP(5);
        PHASE_BEGIN();
        if (F.blk < 32) { if (PH(13)) rw_scan2(F, F.blk); }
        PHASE_BEGIN();
        if (PH(16)) { pg8::Gemm g{WSP(const bf16, WS_A8), (const bf16*)(WSP(const signed char, WS_WIN) + (size_t)MIXP * DM * 2), MTOK, NGATE, DM / 2};
          pg8::SplitOrder S; if (F.blk >= 32) S.init(MTOK, NGATE, 224, F.blk - 32, 0, GATE_NA); else S.init(MTOK, NGATE, 32, F.blk, 224 * GATE_NA, (4096 - 256 - 224 * GATE_NA) / 32);
          pg8::EpiGateU8 E{WSP(unsigned char, WS_GATES), WSP(const float, WS_SA), WSP(const float, WS_SB)}; pg8::gemm_phase(glds, g, S, E, F.tid); }
        xcd_barrier(bar); TP(6);
        PHASE_BEGIN();
        for (int rep_ = 0; rep_ < NREP(15); ++rep_) if (PH(15)) rw_post(F, l, gw, NGW);
        xcd_barrier(bar); TP(7);
        PHASE_BEGIN();
        for (int rep_ = 0; rep_ < NREP(17); ++rep_) if (PH(17)) { pg8::Gemm g{WSP(const bf16, WS_YK), WSP(const bf16, WS_WPK), 4 * MTOK, 4 * DM, 512}; pg8::OrderYK S{F.G, F.blk};
          pg8::EpiGateAcc E{WSP(const unsigned char, WS_GATES), WSP(bf16, WS_MERGED)}; pg8::gemm_phase(glds, g, S, E, F.tid); }
        xcd_barrier(bar); TP(8);
        PHASE_BEGIN();
        for (int rep_ = 0; rep_ < NREP(18); ++rep_) if (PH(18)) { pg8::Gemm g{WSP(const bf16, WS_MERGED), WSP(const bf16, WS_WOUT), MTOK, DM, DM}; pg8::StaticOrder S; S.init(MTOK, DM, F.G, F.blk);
          pg8::EpiAddX E{l == 0 ? INP(0) : nullptr, (const bf16*)F.out, (bf16*)F.out, DM}; pg8::gemm_phase(glds, g, S, E, F.tid); }
        xcd_barrier(bar); TP(9);
        PHASE_BEGIN();
        for (int rep_ = 0; rep_ < NREP(19); ++rep_) if (PH(19)) rmsnorm_rows(F, nullptr, (const bf16*)F.out, INP(38) + (size_t)l * DM, nullptr, nullptr, WSP(unsigned, WS_A8), WSP(float, WS_SA));
        xcd_barrier(bar); TP(10);
        PHASE_BEGIN();
        for (int rep_ = 0; rep_ < NREP(20); ++rep_) if (PH(20)) { pg8::Gemm g{WSP(const bf16, WS_A8), WSP(const bf16, WS_WFG), MTOK, FF, DM / 2}; pg8::StaticOrder S; S.init(MTOK, FF, F.G, F.blk);
          pg8::EpiStoreI8<0> E{WSP(bf16, WS_FG), FF, WSP(const float, WS_SA), WSP(const float, WS_SB) + 16384}; pg8::gemm_phase(glds, g, S, E, F.tid); }
        xcd_barrier(bar); TP(11);
        PHASE_BEGIN();
        for (int rep_ = 0; rep_ < NREP(21); ++rep_) if (PH(21)) { pg8::Gemm g{WSP(const bf16, WS_A8), WSP(const bf16, WS_WFU), MTOK, FF, DM / 2}; pg8::StaticOrder S; S.init(MTOK, FF, F.G, F.blk);
          pg8::EpiFfnUp<true> E{WSP(const bf16, WS_FG), WSP(bf16, WS_HID), WSP(const unsigned, WS_SB) + 65536, WSP(const unsigned, WS_SB) + 65536 + 8192, WSP(const float, WS_SA), WSP(const float, WS_SB) + 32768}; pg8::gemm_phase(glds, g, S, E, F.tid); }
        xcd_barrier(bar); TP(12);
        PHASE_BEGIN();
        for (int rep_ = 0; rep_ < NREP(22); ++rep_) if (PH(22)) { pg8::Gemm g{WSP(const bf16, WS_HID), WSP(const bf16, WS_WFD), MTOK, DM, FF}; pg8::StaticOrder S; S.init(MTOK, DM, F.G, F.blk);
          pg8::EpiAddX E{nullptr, (const bf16*)F.out, l == DEPTH - 1 ? WSP(bf16, WS_H) : (bf16*)F.out, DM}; pg8::gemm_phase(glds, g, S, E, F.tid); }
        xcd_barrier(bar); TP(13);
    }
    PHASE_BEGIN();
    for (int rep_ = 0; rep_ < NREP(23); ++rep_) if (PH(23)) rmsnorm_rows(F, nullptr, WSP(const bf16, WS_H), INP(44), nullptr, F.out);
}

extern "C" void kernel_launch(void* const* d_in, const int* in_sizes, int n_in, void* d_out, int out_size, void* d_ws, size_t ws_size, hipStream_t stream) {
    static int grid = 0;
    if (grid == 0) {
        if (n_in != 45 || in_sizes[0] != MTOK * DM || out_size != MTOK * DM || ws_size < WS_END) {
            fprintf(stderr, "kernel_launch: unexpected shapes/workspace (n_in %d, in0 %d, out %d, ws %zu, need %zu); nothing launched\n", n_in, n_in > 0 ? in_sizes[0] : -1, out_size, ws_size, (size_t)WS_END); grid = -1; return; }
        int dev = 0, cus = 0, per_cu = 0;
        if (hipGetDevice(&dev) != hipSuccess || hipDeviceGetAttribute(&cus, hipDeviceAttributeMultiprocessorCount, dev) != hipSuccess) { grid = -1; return; }
        if (hipFuncSetAttribute((const void*)hybrid_fwd, hipFuncAttributeMaxDynamicSharedMemorySize, LDS_BYTES) != hipSuccess) { fprintf(stderr, "kernel_launch: hipFuncSetAttribute failed\n"); grid = -1; return; }
        if (hipOccupancyMaxActiveBlocksPerMultiprocessor(&per_cu, (const void*)hybrid_fwd, NTHR, LDS_BYTES) != hipSuccess || per_cu < 1) { fprintf(stderr, "kernel_launch: occupancy query says %d\n", per_cu); }
        (void)hipGetLastError();
        grid = cus;
        if (grid != 256) fprintf(stderr, "kernel_launch: note: %d CUs\n", grid);
    }
    if (grid < 0) return;
    if (hipMemsetAsync((char*)d_ws + WS_CTL, 0, CTL_BYTES, stream) != hipSuccess) return;
    Args a{};
    for (int i = 0; i < 45; ++i) a.in[i] = (const float*)d_in[i];
    a.out = (float*)d_out; a.ws = (unsigned char*)d_ws;
    hipLaunchKernelGGL(hybrid_fwd, dim3(grid), dim3(NTHR), LDS_BYTES, stream, a);
}
```
